# Optimizing an MI355X kernel written in HIP

```python
import numpy as np
import jax
import jax.numpy as jnp
from jax import lax

D_MODEL = 2048
BATCH = 4
SEQ = 2048
DEPTH = 2

H_A = 8
KV_A = 2
HPG_A = H_A // KV_A
HD_A = 128
L_CMP = 32
STRIDE_CMP = 16
L_SEL = 64
N_SEL = 8
WIN_A = 512
H_B = 8
KV_B = 2
HPG_B = H_B // KV_B
HD_B = 64
WIN_B = 128
H_C = 4
HD_C = 128
BLK_C = 256
TOPK_C = 3
Q_BLOCK = 128
GATHER_CHUNK = 64
N_GROUPS = 4
EXP_PER_GROUP = 8
N_EXPERTS = N_GROUPS * EXP_PER_GROUP
D_EXPERT = 256
TOPK_EXPERT = 2

LN_EPS = 1e-5
NEG_INF = -1e30

Q_A_W = H_A * HD_A
KV_A_W = 3 * 2 * KV_A * HD_A
GATE_A_W = 3 * H_A
Q_B_W = H_B * HD_B
KV_B_W = KV_B * HD_B
C_W = H_C * HD_C
MERGE_W = 3 * D_MODEL
IN_WIDTHS = (Q_A_W, KV_A_W, GATE_A_W, Q_B_W, KV_B_W, KV_B_W, C_W, C_W, C_W, MERGE_W)
D_IN = sum(IN_WIDTHS)

kernel_name = 'hybrid_nsa_swa_moba_hmoe'


def alibi_slopes(n):
    return jnp.asarray([2.0 ** (-8.0 * (i + 1) / n) for i in range(n)], jnp.float32)


def layer_norm(x, g, b):
    xf = x.astype(jnp.float32)
    mu = jnp.mean(xf, -1, keepdims=True)
    xc = xf - mu
    var = jnp.mean(xc * xc, -1, keepdims=True)
    return xc * lax.rsqrt(var + LN_EPS) * g.astype(jnp.float32) + b.astype(jnp.float32)


def banded_window_attention(q, k, v, slopes, window, sink=None):
    B, G, H, S, d = q.shape
    nqb = S // Q_BLOCK
    span = window + Q_BLOCK
    pad = ((0, 0), (0, 0), (window, 0), (0, 0))
    kidx = Q_BLOCK * np.arange(nqb)[:, None] + np.arange(span)[None, :]
    kw = jnp.pad(k, pad)[:, :, kidx]
    vw = jnp.pad(v, pad)[:, :, kidx]
    qb = q.reshape(B, G, H, nqb, Q_BLOCK, d)
    t_pos = Q_BLOCK * np.arange(nqb)[:, None] + np.arange(Q_BLOCK)[None, :]
    s_pos = kidx - window
    dist = t_pos[:, :, None] - s_pos[:, None, :]
    mask = jnp.asarray((dist >= 0) & (dist < window) & (s_pos[:, None, :] >= 0))
    s = jnp.einsum('bghcqd,bgckd->bghcqk', qb, kw, preferred_element_type=jnp.float32) * (d ** -0.5)
    s = s - slopes[:, :, None, None, None] * jnp.asarray(dist, jnp.float32)
    s = jnp.where(mask, s, NEG_INF)
    if sink is not None:
        sink_col = jnp.broadcast_to(sink.astype(jnp.float32)[:, :, None, None, None], s.shape[:-1] + (1,))
        p = jax.nn.softmax(jnp.concatenate([s, sink_col], -1), -1)[..., :-1]
    else:
        p = jax.nn.softmax(s, -1)
    o = jnp.einsum('bghcqk,bgckd->bghcqd', p, vw)
    return o.reshape(B, G, H, S, d)


def gathered_block_attention(q, k_blocks, v_blocks, blk_idx, blk_ok, slopes, with_own_block):
    B, G, H, S, d = q.shape
    L = k_blocks.shape[3]
    n = blk_idx.shape[-1]
    nch = S // GATHER_CHUNK
    scale = d ** -0.5
    offs = jnp.arange(L)
    sl = slopes.astype(jnp.float32)
    take = jax.vmap(jax.vmap(lambda blocks, idx: blocks[idx]))
    q_ch = jnp.moveaxis(q.reshape(B, G, H, nch, GATHER_CHUNK, d), 3, 0)
    i_ch = jnp.moveaxis(blk_idx.reshape(B, G, nch, GATHER_CHUNK, n), 2, 0)
    ok_ch = jnp.moveaxis(blk_ok.reshape(B, G, nch, GATHER_CHUNK, n), 2, 0)

    def chunk(args):
        q_c, idx_c, ok_c, c = args
        t = c * GATHER_CHUNK + jnp.arange(GATHER_CHUNK)
        kg = take(k_blocks, idx_c)
        vg = take(v_blocks, idx_c)
        dist = t[:, None, None] - (idx_c[..., None] * L + offs)
        mask = ok_c[..., None] & (dist >= 0)
        s = jnp.einsum('bghqd,bgqnld->bghqnl', q_c, kg, preferred_element_type=jnp.float32) * scale
        s = s - sl[:, :, None, None, None] * dist[:, :, None].astype(jnp.float32)
        s = jnp.where(mask[:, :, None], s, NEG_INF).reshape(B, G, H, GATHER_CHUNK, n * L)
        parts = [s]
        if with_own_block:
            own = (c * GATHER_CHUNK) // L
            k_own = lax.dynamic_index_in_dim(k_blocks, own, axis=2, keepdims=False)
            v_own = lax.dynamic_index_in_dim(v_blocks, own, axis=2, keepdims=False)
            dist_o = t[:, None] - (own * L + offs)[None, :]
            s_o = jnp.einsum('bghqd,bgld->bghql', q_c, k_own, preferred_element_type=jnp.float32) * scale
            s_o = jnp.where(dist_o >= 0, s_o - sl[:, :, None, None] * dist_o.astype(jnp.float32), NEG_INF)
            parts.append(s_o)
        p = jax.nn.softmax(jnp.concatenate(parts, -1), -1)
        o = jnp.einsum('bghqnl,bgqnld->bghqd', p[..., :n * L].reshape(B, G, H, GATHER_CHUNK, n, L), vg)
        if with_own_block:
            o = o + jnp.einsum('bghql,bgld->bghqd', p[..., n * L:], v_own)
        return o

    out = lax.map(chunk, (q_ch, i_ch, ok_ch, jnp.arange(nch)))
    return jnp.moveaxis(out, 0, 3).reshape(B, G, H, S, d)


def nsa_mixer(q, kv, gate_logits, cmp_pos, cmp_w):
    B, S, _ = q.shape
    f32 = jnp.float32
    q = q.reshape(B, S, KV_A, HPG_A, HD_A).transpose(0, 2, 3, 1, 4)
    kv = kv.reshape(B, S, 3, 2, KV_A, HD_A).transpose(2, 3, 0, 4, 1, 5)
    slopes = alibi_slopes(H_A).reshape(KV_A, HPG_A)
    pos = np.arange(S)

    n_cmp = (S - L_CMP) // STRIDE_CMP + 1
    c_start = STRIDE_CMP * np.arange(n_cmp)
    c_idx = c_start[:, None] + np.arange(L_CMP)[None, :]
    k_cmp = jnp.einsum('bgnld,lde->bgne', kv[0, 0][:, :, c_idx] + cmp_pos[0], cmp_w[0])
    v_cmp = jnp.einsum('bgnld,lde->bgne', kv[0, 1][:, :, c_idx] + cmp_pos[1], cmp_w[1])
    dist = pos[:, None] - (c_start + L_CMP - 1)[None, :]
    ok = jnp.asarray(dist >= 0)
    s = jnp.einsum('bghtd,bgnd->bghtn', q, k_cmp, preferred_element_type=f32) * (HD_A ** -0.5)
    s = s - slopes[:, :, None, None] * jnp.asarray(dist, f32)
    p_cmp = jax.nn.softmax(jnp.where(ok, s, NEG_INF), -1) * ok
    o_cmp = jnp.einsum('bghtn,bgnd->bghtd', p_cmp, v_cmp)

    n_sel = S // L_SEL
    s_start = L_SEL * np.arange(n_sel)
    inter = np.clip(np.minimum(c_start[:, None] + L_CMP, s_start[None, :] + L_SEL)
                    - np.maximum(c_start[:, None], s_start[None, :]), 0, None) / L_CMP
    imp = jnp.einsum('bghtn,nj->bgtj', p_cmp, jnp.asarray(inter, f32))
    blk_t = pos // L_SEL
    j = np.arange(n_sel)
    valid = j[None, :] <= blk_t[:, None]
    forced = (j[None, :] == 0) | (j[None, :] == blk_t[:, None]) | (j[None, :] == blk_t[:, None] - 1)
    imp = jnp.where(jnp.asarray(forced), jnp.inf, jnp.where(jnp.asarray(valid), imp, -jnp.inf))
    _, sel = lax.top_k(imp, min(N_SEL, n_sel))
    sel_ok = sel <= jnp.asarray(blk_t)[:, None]
    kb = kv[1, 0].reshape(B, KV_A, n_sel, L_SEL, HD_A)
    vb = kv[1, 1].reshape(B, KV_A, n_sel, L_SEL, HD_A)
    o_slc = gathered_block_attention(q, kb, vb, sel, sel_ok, slopes, False)

    o_win = banded_window_attention(q, kv[2, 0], kv[2, 1], slopes, WIN_A)

    g = jax.nn.sigmoid(gate_logits.astype(f32)).reshape(B, S, KV_A, HPG_A, 3).transpose(0, 2, 3, 1, 4)[..., None]
    o = g[..., 0, :] * o_cmp + g[..., 1, :] * o_slc + g[..., 2, :] * o_win
    return o.transpose(0, 3, 1, 2, 4).reshape(B, S, Q_A_W)


def swa_sink_mixer(q, k, v, sink):
    B, S, _ = q.shape
    q = q.reshape(B, S, KV_B, HPG_B, HD_B).transpose(0, 2, 3, 1, 4)
    k = k.reshape(B, S, KV_B, HD_B).transpose(0, 2, 1, 3)
    v = v.reshape(B, S, KV_B, HD_B).transpose(0, 2, 1, 3)
    slopes = alibi_slopes(H_B).reshape(KV_B, HPG_B)
    o = banded_window_attention(q, k, v, slopes, WIN_B, sink.reshape(KV_B, HPG_B))
    return o.transpose(0, 3, 1, 2, 4).reshape(B, S, Q_B_W)


def moba_mixer(q, k, v):
    B, S, _ = q.shape
    f32 = jnp.float32
    s_pad = -(-S // BLK_C) * BLK_C
    nb = s_pad // BLK_C
    padw = ((0, 0), (0, 0), (0, s_pad - S), (0, 0))
    q = jnp.pad(q.reshape(B, S, H_C, HD_C).transpose(0, 2, 1, 3), padw)
    k = jnp.pad(k.reshape(B, S, H_C, HD_C).transpose(0, 2, 1, 3), padw)
    v = jnp.pad(v.reshape(B, S, H_C, HD_C).transpose(0, 2, 1, 3), padw)
    kb = k.reshape(B, H_C, nb, BLK_C, HD_C)
    vb = v.reshape(B, H_C, nb, BLK_C, HD_C)
    k_mean = jnp.mean(kb.astype(f32), axis=3)
    score = jnp.einsum('bhtd,bhnd->bhtn', q, k_mean, preferred_element_type=f32)
    blk_t = np.arange(s_pad) // BLK_C
    past = jnp.asarray(np.arange(nb)[None, :] < blk_t[:, None])
    _, sel = lax.top_k(jnp.where(past, score, -jnp.inf), min(TOPK_C, nb))
    sel_ok = sel < jnp.asarray(blk_t)[:, None]
    o = gathered_block_attention(q[:, :, None], kb, vb, sel, sel_ok, alibi_slopes(H_C).reshape(H_C, 1), True)
    return o[:, :, 0, :S].transpose(0, 2, 1, 3).reshape(B, S, C_W)


def mixer_sublayer(x, w_in, cmp_pos, cmp_w, sink, w_br_a, w_br_b, w_br_c, w_out):
    B, S, D = x.shape
    z = jnp.einsum('bsd,dc->bsc', x, w_in)
    offsets = np.cumsum(IN_WIDTHS)[:-1].tolist()
    q_a, kv_a, gate_a, q_b, k_b, v_b, q_c, k_c, v_c, gate_m = jnp.split(z, offsets, axis=-1)
    o_a = nsa_mixer(q_a, kv_a, gate_a, cmp_pos, cmp_w)
    o_b = swa_sink_mixer(q_b, k_b, v_b, sink)
    o_c = moba_mixer(q_c, k_c, v_c)
    gm = jax.nn.sigmoid(gate_m.astype(jnp.float32)).reshape(B, S, 3, D)
    merged = gm[:, :, 0] * (o_a @ w_br_a) + gm[:, :, 1] * (o_b @ w_br_b) + gm[:, :, 2] * (o_c @ w_br_c)
    return merged.astype(x.dtype) @ w_out


def hierarchical_moe(h, w_group, b_group, w_router, b_router, w_gate, w_up, w_down):
    B, S, D = h.shape
    f32 = jnp.float32
    t = h.reshape(B * S, D)
    g_prob = jax.nn.softmax((t @ w_group).astype(f32) + b_group.astype(f32), -1)
    g_w, g_idx = lax.top_k(g_prob, 1)
    e_logits = ((t @ w_router).astype(f32) + b_router.astype(f32)).reshape(-1, N_GROUPS, EXP_PER_GROUP)
    e_in = jnp.take_along_axis(e_logits, g_idx[:, :, None], axis=1)[:, 0]
    e_top, e_idx = lax.top_k(e_in, TOPK_EXPERT)
    w = jax.nn.softmax(e_top, -1) * g_w
    combine = jnp.einsum('tk,tke->te', w, jax.nn.one_hot(g_idx * EXP_PER_GROUP + e_idx, N_EXPERTS, dtype=f32))
    a = jax.nn.silu(jnp.einsum('td,edf->tef', t, w_gate)) * jnp.einsum('td,edf->tef', t, w_up)
    y = jnp.einsum('tef,efd->td', a * combine[:, :, None].astype(a.dtype), w_down)
    return y.reshape(B, S, D).astype(h.dtype)


def setup_inputs(seed: int = 0) -> dict:
    key = jax.random.key(seed)
    ks = jax.random.split(key, 32)
    f32 = jnp.float32
    beta = (8.0 * DEPTH) ** -0.25
    s_d = D_MODEL ** -0.5

    def nrm(k, shape, scale):
        return jax.random.normal(k, shape, f32) * scale

    kv_a = nrm(ks[2], (DEPTH, D_MODEL, 3, 2, KV_A * HD_A), s_d) * jnp.asarray([1.0, beta], f32)[:, None]
    w_in = jnp.concatenate([
        nrm(ks[1], (DEPTH, D_MODEL, Q_A_W), s_d),
        kv_a.reshape(DEPTH, D_MODEL, KV_A_W),
        nrm(ks[3], (DEPTH, D_MODEL, GATE_A_W), s_d),
        nrm(ks[4], (DEPTH, D_MODEL, Q_B_W), s_d),
        nrm(ks[5], (DEPTH, D_MODEL, KV_B_W), s_d),
        nrm(ks[6], (DEPTH, D_MODEL, KV_B_W), s_d * beta),
        nrm(ks[7], (DEPTH, D_MODEL, C_W), s_d),
        nrm(ks[8], (DEPTH, D_MODEL, C_W), s_d),
        nrm(ks[9], (DEPTH, D_MODEL, C_W), s_d * beta),
        nrm(ks[10], (DEPTH, D_MODEL, MERGE_W), s_d)], axis=-1)
    return {
        'x': jax.random.normal(ks[0], (BATCH, SEQ, D_MODEL), f32),
        'w_in': w_in,
        'nsa_cmp_pos': nrm(ks[11], (DEPTH, 2, L_CMP, HD_A), 0.1),
        'nsa_cmp_w': nrm(ks[12], (DEPTH, 2, L_CMP, HD_A, HD_A), (L_CMP * HD_A) ** -0.5),
        'sink_b': nrm(ks[13], (DEPTH, H_B), 0.5),
        'w_br_a': nrm(ks[14], (DEPTH, Q_A_W, D_MODEL), Q_A_W ** -0.5),
        'w_br_b': nrm(ks[15], (DEPTH, Q_B_W, D_MODEL), Q_B_W ** -0.5),
        'w_br_c': nrm(ks[16], (DEPTH, C_W, D_MODEL), C_W ** -0.5),
        'w_out': nrm(ks[17], (DEPTH, D_MODEL, D_MODEL), s_d * beta),
        'ln1_g': 1.0 + nrm(ks[18], (DEPTH, D_MODEL), 0.02),
        'ln1_b': nrm(ks[19], (DEPTH, D_MODEL), 0.02),
        'w_group': nrm(ks[20], (DEPTH, D_MODEL, N_GROUPS), s_d),
        'b_group': nrm(ks[21], (DEPTH, N_GROUPS), 0.01),
        'w_router': nrm(ks[22], (DEPTH, D_MODEL, N_EXPERTS), s_d),
        'b_router': nrm(ks[23], (DEPTH, N_EXPERTS), 0.01),
        'w_gate': nrm(ks[24], (DEPTH, N_EXPERTS, D_MODEL, D_EXPERT), s_d),
        'w_up': nrm(ks[25], (DEPTH, N_EXPERTS, D_MODEL, D_EXPERT), s_d),
        'w_down': nrm(ks[26], (DEPTH, N_EXPERTS, D_EXPERT, D_MODEL), D_EXPERT ** -0.5 * beta),
        'ln2_g': 1.0 + nrm(ks[27], (DEPTH, D_MODEL), 0.02),
        'ln2_b': nrm(ks[28], (DEPTH, D_MODEL), 0.02),
    }


def reference(x, w_in, nsa_cmp_pos, nsa_cmp_w, sink_b, w_br_a, w_br_b, w_br_c, w_out,
              ln1_g, ln1_b, w_group, b_group, w_router, b_router, w_gate, w_up, w_down,
              ln2_g, ln2_b):
    alpha = (2.0 * DEPTH) ** 0.25
    for l in range(DEPTH):
        y = mixer_sublayer(x, w_in[l], nsa_cmp_pos[l], nsa_cmp_w[l], sink_b[l],
                           w_br_a[l], w_br_b[l], w_br_c[l], w_out[l])
        x = layer_norm(alpha * x + y, ln1_g[l], ln1_b[l]).astype(x.dtype)
        y = hierarchical_moe(x, w_group[l], b_group[l], w_router[l], b_router[l],
                             w_gate[l], w_up[l], w_down[l])
        x = layer_norm(alpha * x + y, ln2_g[l], ln2_b[l]).astype(x.dtype)
    return x
```

```cpp
#include <hip/hip_runtime.h>
#include <cstdio>
#include <cstdint>
namespace pg8 {
#define PG8_LAS __attribute__((address_space(3)))
typedef unsigned short bf16_t;
typedef short bf16x8 __attribute__((ext_vector_type(8)));
typedef float f32x4 __attribute__((ext_vector_type(4)));
typedef unsigned u32x4 __attribute__((ext_vector_type(4)));
constexpr int BM = 256, BK = 64, HALF = 128, HTB = HALF * BK * 2  , STAGE_BYTES = 8 * HTB, NXCD = 8, WGM = 8;

__host__ __device__ __forceinline__ int lds_byte(int r, int c) { const int st = (r >> 4) * 2 + (c >> 5), rr = r & 15, cc = c & 31, ob = rr * 64 + cc * 2; return st * 1024 + (ob ^ (((ob >> 9) & 1) << 5)); }
__host__ __device__ __forceinline__ void stage_rc(int b, int& R, int& C) { const int st = b / 1024, sb = b % 1024, swz = sb ^ (((sb >> 9) & 1) << 5); R = (st >> 1) * 16 + swz / 64; C = (st & 1) * 32 + (swz % 64) / 2; }
__host__ __device__ __forceinline__ int perm32(int rho) { const int n = rho >> 4, i = rho & 15; return 8 * (i >> 2) + 4 * n + (i & 3); }

struct Unit { int pm, pn; };
struct Gemm { const bf16_t* A; const bf16_t* Bt; int M, N, K, lda; int sca = 0x7f7f7f7f, scb = 0x7f7f7f7f; };
typedef int i32x8 __attribute__((ext_vector_type(8)));

struct StaticOrder {
    int nM, nN, nwg, G, c;
    __host__ __device__ void init(int M, int N, int G_, int c_) { nM = M / BM; nN = N / BM; nwg = nM * nN; G = G_; c = c_; }
    __host__ __device__ bool next(int i, Unit& u) const {
        const long L = (long)i * G + c; if (L >= nwg) return false;
        int wgid = (int)L; { const int q = nwg / NXCD, r = nwg % NXCD, xcd = wgid % NXCD, off = wgid / NXCD; wgid = (xcd < r ? xcd * (q + 1) : r * (q + 1) + (xcd - r) * q) + off; }
        const int nig = WGM * nN, gid = wgid / nig, fm = gid * WGM, gsz = (nM - fm) < WGM ? (nM - fm) : WGM;
        u.pm = fm + ((wgid % nig) % gsz); u.pn = (wgid % nig) / gsz; return true;
    }
    __device__ __forceinline__ void a_ready(const Unit&) const {}
    __device__ __forceinline__ void done(const Unit&) const {}
};
__device__ __forceinline__ unsigned cvt_pk_bf16(float lo, float hi) { unsigned r; asm volatile("v_cvt_pk_bf16_f32 %0, %1, %2" : "=v"(r) : "v"(lo), "v"(hi)); return r; }
__device__ __forceinline__ float bf_lo(unsigned w) { return __uint_as_float(w << 16); }
__device__ __forceinline__ float bf_hi(unsigned w) { return __uint_as_float(w & 0xffff0000u); }
__device__ __forceinline__ float sigmoidf_(float x) { return __builtin_amdgcn_rcpf(1.0f + __builtin_amdgcn_exp2f(-1.4426950408889634f * x)); }
typedef unsigned u32x2 __attribute__((ext_vector_type(2)));

struct EpiZ {
    static constexpr bool PERM = false, AFTER_DRAIN = false, HOOK = false; static constexpr int HK0 = -1, HK1 = -1;
    bf16_t* O; int ldc; int sig_from;
    __device__ __forceinline__ void operator()(const f32x4 (&acc)[2][2][4][2], const Unit& u, int wr, int wc, int, int) const {
        int t_ = threadIdx.x; asm volatile("" : "+v"(t_)); const int fr = t_ & 15, fq = (t_ >> 4) & 3;
        const int row0 = u.pm * BM + wr * 64 + fr, col0 = u.pn * BM + wc * 32 + 4 * fq; const bool sg = u.pn >= sig_from;
        unsigned eo = (unsigned)row0 * (unsigned)ldc + (unsigned)col0;
#pragma unroll
        for (int ai = 0; ai < 2; ++ai)
#pragma unroll
            for (int m = 0; m < 4; ++m) { asm volatile("" : "+v"(eo)); bf16_t* rowp = O + eo; eo += (unsigned)((m == 3 ? HALF - 48 : 16) * ldc);
#pragma unroll
                for (int bj = 0; bj < 2; ++bj)
#pragma unroll
                    for (int n = 0; n < 2; ++n) { f32x4 v = acc[ai][bj][m][n];
                        if (sg) {
#pragma unroll
                            for (int j = 0; j < 4; ++j) v[j] = sigmoidf_(v[j]); }
                        u32x2 w; w.x = cvt_pk_bf16(v[0], v[1]); w.y = cvt_pk_bf16(v[2], v[3]);
                        *(u32x2*)(rowp + bj * HALF + n * 16) = w; }
                asm volatile("" ::: "memory"); }
    }
};
struct EpiBrM {
    static constexpr bool PERM = false, AFTER_DRAIN = false, HOOK = true; static constexpr int HK0 = 16, HK1 = 24;
    bf16_t* MB; const bf16_t* Zg; int ldz;
    __device__ __forceinline__ void mid(f32x4 (&acc)[2][2][4][2], const Unit& u, int wr, int wc, int, int, int kt) const {
        int t_ = threadIdx.x; asm volatile("" : "+v"(t_)); const int fr = t_ & 15, fq = (t_ >> 4) & 3;
        const int row0 = u.pm * BM + wr * 64 + fr, col0 = u.pn * BM + wc * 32 + 4 * fq; const bf16_t* zs = Zg + (kt == HK0 ? 0 : 2048);
        unsigned eo = (unsigned)row0 * (unsigned)ldz + (unsigned)col0;
#pragma unroll
        for (int ai = 0; ai < 2; ++ai)
#pragma unroll
            for (int m = 0; m < 4; ++m) { asm volatile("" : "+v"(eo)); const bf16_t* zr = zs + eo; eo += (unsigned)((m == 3 ? HALF - 48 : 16) * ldz);
#pragma unroll
                for (int bj = 0; bj < 2; ++bj)
#pragma unroll
                    for (int n = 0; n < 2; ++n) { const u32x2 ga = *(const u32x2*)(zr + bj * HALF + n * 16), gb = *(const u32x2*)(zr + 2048 + bj * HALF + n * 16);
                        f32x4 v = acc[ai][bj][m][n];
                        v[0] *= bf_lo(ga.x) * __builtin_amdgcn_rcpf(fmaxf(bf_lo(gb.x), 1e-30f)); v[1] *= bf_hi(ga.x) * __builtin_amdgcn_rcpf(fmaxf(bf_hi(gb.x), 1e-30f));
                        v[2] *= bf_lo(ga.y) * __builtin_amdgcn_rcpf(fmaxf(bf_lo(gb.y), 1e-30f)); v[3] *= bf_hi(ga.y) * __builtin_amdgcn_rcpf(fmaxf(bf_hi(gb.y), 1e-30f));
                        acc[ai][bj][m][n] = v; }
                asm volatile("" ::: "memory"); }
    }
    __device__ __forceinline__ void operator()(const f32x4 (&acc)[2][2][4][2], const Unit& u, int wr, int wc, int, int) const {
        int t_ = threadIdx.x; asm volatile("" : "+v"(t_)); const int fr = t_ & 15, fq = (t_ >> 4) & 3;
        const int row0 = u.pm * BM + wr * 64 + fr, col0 = u.pn * BM + wc * 32 + 4 * fq;
#pragma unroll
        for (int ai = 0; ai < 2; ++ai)
#pragma unroll
            for (int m = 0; m < 4; ++m) { const int row = row0 + ai * HALF + m * 16;
#pragma unroll
                for (int bj = 0; bj < 2; ++bj)
#pragma unroll
                    for (int n = 0; n < 2; ++n) { const int col = col0 + bj * HALF + n * 16;
                        const u32x2 gw = *(const u32x2*)(Zg + (size_t)row * ldz + 4096 + col);
                        f32x4 v = acc[ai][bj][m][n]; v[0] *= bf_lo(gw.x); v[1] *= bf_hi(gw.x); v[2] *= bf_lo(gw.y); v[3] *= bf_hi(gw.y);
                        u32x2 w; w.x = cvt_pk_bf16(v[0], v[1]); w.y = cvt_pk_bf16(v[2], v[3]); *(u32x2*)(MB + (size_t)row * 2048 + col) = w; }
                asm volatile("" ::: "memory"); }
    }
};
struct EpiRes {
    static constexpr bool PERM = false, AFTER_DRAIN = false, HOOK = false; static constexpr int HK0 = -1, HK1 = -1;
    float* R; const float* xres; float alpha;
    __device__ __forceinline__ void operator()(const f32x4 (&acc)[2][2][4][2], const Unit& u, int wr, int wc, int, int) const {
        int t_ = threadIdx.x; asm volatile("" : "+v"(t_)); const int fr = t_ & 15, fq = (t_ >> 4) & 3;
        const int row0 = u.pm * BM + wr * 64 + fr, col0 = u.pn * BM + wc * 32 + 4 * fq;
#pragma unroll
        for (int ai = 0; ai < 2; ++ai)
#pragma unroll
            for (int m = 0; m < 4; ++m) { const size_t off = (size_t)(row0 + ai * HALF + m * 16) * 2048 + col0;
#pragma unroll
                for (int bj = 0; bj < 2; ++bj)
#pragma unroll
                    for (int n = 0; n < 2; ++n) { const f32x4 xr = *(const f32x4*)(xres + off + bj * HALF + n * 16);
                        *(f32x4*)(R + off + bj * HALF + n * 16) = xr * alpha + acc[ai][bj][m][n]; } }
    }
};
struct EpiGU {
    static constexpr bool PERM = true, AFTER_DRAIN = false, HOOK = false; static constexpr int HK0 = -1, HK1 = -1;
    bf16_t* H; const float* roww;
    __device__ __forceinline__ void operator()(const f32x4 (&acc)[2][2][4][2], const Unit& u, int wr, int wc, int, int) const {
        int t_ = threadIdx.x; asm volatile("" : "+v"(t_)); const int fr = t_ & 15, fq = (t_ >> 4) & 3;
        const int row0 = u.pm * BM + wr * 64 + fr, col0 = (u.pn & 1) * HALF + wc * 32 + 8 * fq;
#pragma unroll
        for (int ai = 0; ai < 2; ++ai)
#pragma unroll
            for (int m = 0; m < 4; ++m) { const int row = row0 + ai * HALF + m * 16; const float w = roww[row];
                const f32x4 g0 = acc[ai][0][m][0], g1 = acc[ai][0][m][1], u0 = acc[ai][1][m][0], u1 = acc[ai][1][m][1]; f32x4 h0, h1;
#pragma unroll
                for (int j = 0; j < 4; ++j) { h0[j] = g0[j] * sigmoidf_(g0[j]) * u0[j] * w; h1[j] = g1[j] * sigmoidf_(g1[j]) * u1[j] * w; }
                u32x4 o; o.x = cvt_pk_bf16(h0[0], h0[1]); o.y = cvt_pk_bf16(h0[2], h0[3]); o.z = cvt_pk_bf16(h1[0], h1[1]); o.w = cvt_pk_bf16(h1[2], h1[3]);
                *(u32x4*)(H + (size_t)row * 256 + col0) = o; }
    }
};
struct EpiDown {
    static constexpr bool PERM = true, AFTER_DRAIN = false, HOOK = false; static constexpr int HK0 = -1, HK1 = -1;
    bf16_t* dump; unsigned yoff; const int* rowts;
    __device__ __forceinline__ void operator()(const f32x4 (&acc)[2][2][4][2], const Unit& u, int wr, int wc, int, int) const {
        int t_ = threadIdx.x; asm volatile("" : "+v"(t_)); const int fr = t_ & 15, fq = (t_ >> 4) & 3;
        const int row0 = u.pm * BM + wr * 64 + fr, col0 = (u.pn & 7) * BM + wc * 32 + 8 * fq;
#pragma unroll
        for (int ai = 0; ai < 2; ++ai)
#pragma unroll
            for (int m = 0; m < 4; ++m) { const int row = row0 + ai * HALF + m * 16; const int ts = rowts[row];
                const unsigned eo = (ts >= 0 ? yoff + (unsigned)((ts & 1) * 8192 + (ts >> 1)) * 2048u : (unsigned)row * 2048u) + (unsigned)col0;
                bf16_t* rowp = dump + eo;
#pragma unroll
                for (int bj = 0; bj < 2; ++bj) { const f32x4 v0 = acc[ai][bj][m][0], v1 = acc[ai][bj][m][1];
                    u32x4 w; w.x = cvt_pk_bf16(v0[0], v0[1]); w.y = cvt_pk_bf16(v0[2], v0[3]); w.z = cvt_pk_bf16(v1[0], v1[1]); w.w = cvt_pk_bf16(v1[2], v1[3]);
                    *(u32x4*)(rowp + bj * HALF) = w; }
                asm volatile("" ::: "memory"); }
    }
};
template <int NPER> struct MoeOrder {
    int total, G, c; const int* panel_e;
    __device__ __forceinline__ bool next(int i, Unit& u) const { const int L = i * G + c; if (L >= total) return false; const int pm = L / NPER; u.pm = pm; u.pn = panel_e[pm] * NPER + (L % NPER); return true; }
    __device__ __forceinline__ void a_ready(const Unit&) const {}
    __device__ __forceinline__ void done(const Unit&) const {}
};

template <bool F8> struct Frags { bf16x8 At[4][2], B0[2][2], B1[2][2]; };
template <> struct Frags<true> { i32x8 At8[4], B08[2], B18[2]; };
template <class Epi, class Sched, bool ALIGN_EPI = false, bool SP2 = false, bool FP8 = false>
__device__ __forceinline__ void gemm_phase(PG8_LAS unsigned char* lds, const Gemm g, const Sched& S, const Epi& E) {
    int tid_ = threadIdx.x; asm volatile("" : "+v"(tid_));
    const int tid = tid_, wid = __builtin_amdgcn_readfirstlane(tid >> 6), lane = tid & 63, wr = wid >> 2, wc = wid & 3, fr = lane & 15, fq = lane >> 4;
    const int K = g.K, nt = K / BK, LDA = g.lda;
    unsigned voffA[2], voffB[2];
#pragma unroll
    for (int i = 0; i < 2; ++i) { int R, C; stage_rc(tid * 16 + i * 8192, R, C); const int Rb = Epi::PERM ? ((R & ~31) + perm32(R & 31)) : R;
        voffA[i] = (unsigned)(R * LDA + C) * 2u; voffB[i] = (unsigned)(Rb * K + C) * 2u; }
    const size_t kstep = (size_t)(BK * 2);
    const size_t hstep = (size_t)HALF * K * 2, hstepA = (size_t)HALF * LDA * 2;
    const size_t tstep = 2 * hstep, tstepA = 2 * hstepA;
    const unsigned ldsbase = (unsigned)__builtin_amdgcn_readfirstlane((int)(unsigned)(uintptr_t)lds + wid * 1024);
    const unsigned ldsw = (unsigned)wid * 1024u;
    const int aoff = lds_byte(wr * 64 + fr, fq * 8), boff = lds_byte(wc * 32 + fr, fq * 8);
#define PG8_CAT(x0, x1) __builtin_bit_cast(i32x8, __builtin_shufflevector(x0, x1, 0, 1, 2, 3, 4, 5, 6, 7, 8, 9, 10, 11, 12, 13, 14, 15))
#define PG8_SA(b, h) (((b) * 2 + (h)) * HTB)
#define PG8_SB(b, h) ((4 + (b) * 2 + (h)) * HTB)
#define PG8_STAGE(bufoff, gbase, voff) do { if constexpr (FP8) { _Pragma("unroll") for (int _i = 0; _i < 2; ++_i) { \
            asm volatile("s_mov_b32 m0, %2\n\ts_nop 0\n\tglobal_load_lds_dwordx4 %0, %1" :: "v"((voff)[_i]), "s"((const char*)(gbase)), "s"(ldsbase + (unsigned)((bufoff) + _i * 8192)) : "memory", "m0"); } } \
        else { _Pragma("unroll") for (int _i = 0; _i < 2; ++_i) \
        __builtin_amdgcn_global_load_lds((const unsigned*)((const char*)(gbase) + (voff)[_i]), (PG8_LAS unsigned*)(lds + (bufoff) + ldsw + _i * 8192), 16, 0, 0); } } while (0)
#define PG8_LDA(dst, b, h) do { if constexpr (FP8) { _Pragma("unroll") for (int m = 0; m < 4; ++m) fg.dst##8[m] = PG8_CAT(*(const PG8_LAS bf16x8*)(lds + PG8_SA(b, h) + aoff + m * 2048), *(const PG8_LAS bf16x8*)(lds + PG8_SA(b, h) + aoff + m * 2048 + 1024)); } \
        else { _Pragma("unroll") for (int m = 0; m < 4; ++m) _Pragma("unroll") for (int k = 0; k < 2; ++k) fg.dst[m][k] = *(const PG8_LAS bf16x8*)(lds + PG8_SA(b, h) + aoff + m * 2048 + k * 1024); } } while (0)
#define PG8_LDB(dst, b, h) do { if constexpr (FP8) { _Pragma("unroll") for (int n = 0; n < 2; ++n) fg.dst##8[n] = PG8_CAT(*(const PG8_LAS bf16x8*)(lds + PG8_SB(b, h) + boff + n * 2048), *(const PG8_LAS bf16x8*)(lds + PG8_SB(b, h) + boff + n * 2048 + 1024)); } \
        else { _Pragma("unroll") for (int n = 0; n < 2; ++n) _Pragma("unroll") for (int k = 0; k < 2; ++k) fg.dst[n][k] = *(const PG8_LAS bf16x8*)(lds + PG8_SB(b, h) + boff + n * 2048 + k * 1024); } } while (0)
#define PG8_MMA(ai, bj, At, Bt) do { __builtin_amdgcn_s_setprio(1); \
        if constexpr (FP8) { _Pragma("unroll") for (int m = 0; m < 4; ++m) _Pragma("unroll") for (int n = 0; n < 2; ++n) \
            acc[ai][bj][m][n] = __builtin_amdgcn_mfma_scale_f32_16x16x128_f8f6f4(fg.Bt##8[n], fg.At##8[m], acc[ai][bj][m][n], 0, 0, 0, g.scb, 0, g.sca); } \
        else { _Pragma("unroll") for (int m = 0; m < 4; ++m) _Pragma("unroll") for (int n = 0; n < 2; ++n) _Pragma("unroll") for (int k = 0; k < 2; ++k) \
            acc[ai][bj][m][n] = __builtin_amdgcn_mfma_f32_16x16x32_bf16(fg.Bt[n][k], fg.At[m][k], acc[ai][bj][m][n], 0, 0, 0); } \
        __builtin_amdgcn_s_setprio(0); } while (0)
#define PG8_WAIT_V(n) asm volatile("s_waitcnt vmcnt(" #n ")" ::: "memory")
#define PG8_WAIT_L(n) asm volatile("s_waitcnt lgkmcnt(" #n ")" ::: "memory")
#define PG8_BAR __builtin_amdgcn_s_barrier()
#define PG8_SCHED __builtin_amdgcn_sched_barrier(0)
    Unit cur, nxt; int ui = 0;
    if (!S.next(0, cur)) return;
    f32x4 acc[2][2][4][2];
#pragma unroll
    for (int a = 0; a < 2; ++a)
#pragma unroll
        for (int b = 0; b < 2; ++b)
#pragma unroll
            for (int m = 0; m < 4; ++m)
#pragma unroll
                for (int n = 0; n < 2; ++n) acc[a][b][m][n] = (f32x4){0.f, 0.f, 0.f, 0.f};
    Frags<FP8> fg;
    const char* cA = (const char*)g.A + (size_t)cur.pm * tstepA; const char* cB = (const char*)g.Bt + (size_t)cur.pn * tstep;
    S.a_ready(cur);
    if constexpr (SP2) {
        PG8_STAGE(PG8_SB(0, 0), cB, voffB); PG8_STAGE(PG8_SB(0, 1), cB + hstep, voffB); PG8_STAGE(PG8_SA(0, 0), cA, voffA); PG8_STAGE(PG8_SA(0, 1), cA + hstepA, voffA);
        if (wr == 1) PG8_BAR;
        PG8_WAIT_V(2); PG8_BAR;
        PG8_STAGE(PG8_SB(1, 0), cB + kstep, voffB); PG8_STAGE(PG8_SA(1, 0), cA + kstep, voffA); PG8_STAGE(PG8_SB(1, 1), cB + hstep + kstep, voffB);
        PG8_WAIT_V(6); PG8_BAR;
    } else {
        PG8_STAGE(PG8_SB(0, 0), cB, voffB); PG8_STAGE(PG8_SA(0, 0), cA, voffA); PG8_STAGE(PG8_SB(0, 1), cB + hstep, voffB); PG8_STAGE(PG8_SA(0, 1), cA + hstepA, voffA);
        if (wr == 1) PG8_BAR;
        PG8_WAIT_V(4); PG8_BAR;
        PG8_STAGE(PG8_SB(1, 0), cB + kstep, voffB); PG8_STAGE(PG8_SA(1, 0), cA + kstep, voffA); PG8_STAGE(PG8_SB(1, 1), cB + hstep + kstep, voffB);
        PG8_WAIT_V(6); PG8_BAR;
    }
    for (;;) {
        const bool has_next = S.next(ui + 1, nxt);
        const char* nA = has_next ? (const char*)g.A + (size_t)nxt.pm * tstepA : cA; const char* nB = has_next ? (const char*)g.Bt + (size_t)nxt.pn * tstep : cB;
#pragma nounroll
        for (int t = 0; t < nt; t += 2) {
            const bool last = (t == nt - 2);
            const char* a1 = cA + (size_t)(t + 1) * kstep;
            const char* a2 = last ? nA : cA + (size_t)(t + 2) * kstep; const char* b2 = last ? nB : cB + (size_t)(t + 2) * kstep;
            const char* a3 = a2 + kstep; const char* b3 = b2 + kstep;
            if (last && has_next) S.a_ready(nxt);
            if constexpr (SP2) {
            PG8_LDB(B0, 0, 0); PG8_LDB(B1, 0, 1); PG8_SCHED; PG8_LDA(At, 0, 0); PG8_STAGE(PG8_SA(1, 1), a1 + hstepA, voffA);
            PG8_WAIT_V(8); PG8_WAIT_L(0); PG8_BAR; PG8_MMA(0, 0, At, B0); PG8_MMA(0, 1, At, B1); PG8_BAR; PG8_SCHED;
            PG8_LDA(At, 0, 1); PG8_STAGE(PG8_SB(0, 0), b2, voffB); PG8_STAGE(PG8_SB(0, 1), b2 + hstep, voffB); PG8_STAGE(PG8_SA(0, 0), a2, voffA);
            PG8_WAIT_V(8); PG8_WAIT_L(0); PG8_BAR; PG8_MMA(1, 0, At, B0); PG8_MMA(1, 1, At, B1); PG8_BAR; PG8_SCHED;
            PG8_LDB(B0, 1, 0); PG8_LDB(B1, 1, 1); PG8_SCHED; PG8_LDA(At, 1, 0); PG8_STAGE(PG8_SA(0, 1), a2 + hstepA, voffA);
            PG8_WAIT_V(8); PG8_WAIT_L(0); PG8_BAR; PG8_MMA(0, 0, At, B0); PG8_MMA(0, 1, At, B1); PG8_BAR; PG8_SCHED;
            PG8_LDA(At, 1, 1); PG8_STAGE(PG8_SB(1, 0), b3, voffB); PG8_STAGE(PG8_SB(1, 1), b3 + hstep, voffB); PG8_STAGE(PG8_SA(1, 0), a3, voffA);
            PG8_WAIT_V(8); PG8_WAIT_L(0); PG8_BAR; PG8_MMA(1, 0, At, B0); PG8_MMA(1, 1, At, B1); PG8_BAR; PG8_SCHED;
            if constexpr (Epi::HOOK) { if (t + 2 == Epi::HK0 || t + 2 == Epi::HK1) E.mid(acc, cur, wr, wc, fr, fq, t + 2); }
            } else {
            PG8_LDB(B0, 0, 0); PG8_SCHED; PG8_LDA(At, 0, 0); PG8_STAGE(PG8_SA(1, 1), a1 + hstepA, voffA);
            PG8_WAIT_L(8); PG8_BAR; PG8_WAIT_L(0); PG8_MMA(0, 0, At, B0); PG8_BAR; PG8_SCHED;
            PG8_LDB(B1, 0, 1); PG8_STAGE(PG8_SB(0, 0), b2, voffB);
            PG8_BAR; PG8_WAIT_L(0); PG8_MMA(0, 1, At, B1); PG8_BAR;
            PG8_LDA(At, 0, 1); PG8_STAGE(PG8_SA(0, 0), a2, voffA);
            PG8_BAR; PG8_WAIT_L(0); PG8_MMA(1, 0, At, B0); PG8_BAR; PG8_SCHED;
            PG8_STAGE(PG8_SB(0, 1), b2 + hstep, voffB);
            PG8_WAIT_V(6); PG8_BAR; PG8_MMA(1, 1, At, B1); PG8_BAR;
            PG8_LDB(B0, 1, 0); PG8_SCHED; PG8_LDA(At, 1, 0); PG8_STAGE(PG8_SA(0, 1), a2 + hstepA, voffA);
            PG8_WAIT_L(8); PG8_BAR; PG8_WAIT_L(0); PG8_MMA(0, 0, At, B0); PG8_BAR; PG8_SCHED;
            PG8_LDB(B1, 1, 1); PG8_STAGE(PG8_SB(1, 0), b3, voffB);
            PG8_BAR; PG8_WAIT_L(0); PG8_MMA(0, 1, At, B1); PG8_BAR;
            PG8_LDA(At, 1, 1); PG8_STAGE(PG8_SA(1, 0), a3, voffA);
            PG8_BAR; PG8_WAIT_L(0); PG8_MMA(1, 0, At, B0); PG8_BAR; PG8_SCHED;
            PG8_STAGE(PG8_SB(1, 1), b3 + hstep, voffB);
            PG8_WAIT_V(6); PG8_BAR; PG8_MMA(1, 1, At, B1); PG8_BAR;
            }
        }
        if constexpr (ALIGN_EPI) { if (wr == 0) PG8_BAR; }
        if constexpr (!Epi::AFTER_DRAIN) { E(acc, cur, wr, wc, fr, fq); S.done(cur); }
        if (!has_next) break;
#pragma unroll
        for (int a = 0; a < 2; ++a)
#pragma unroll
            for (int b = 0; b < 2; ++b)
#pragma unroll
                for (int m = 0; m < 4; ++m)
#pragma unroll
                    for (int n = 0; n < 2; ++n) acc[a][b][m][n] = (f32x4){0.f, 0.f, 0.f, 0.f};
        cur = nxt; cA = nA; cB = nB; ++ui;
        if constexpr (ALIGN_EPI) { if (wr == 1) PG8_BAR; }
    }
    PG8_WAIT_V(0);
    if constexpr (!ALIGN_EPI) { if (wr == 0) PG8_BAR; }
    PG8_BAR;
    if constexpr (Epi::AFTER_DRAIN) { E.fused(acc, cur, wr, wc, fr, fq, lds, wid, lane); S.done(cur); }
#undef PG8_SA
#undef PG8_SB
#undef PG8_STAGE
#undef PG8_LDA
#undef PG8_LDB
#undef PG8_MMA
#undef PG8_CAT
#undef PG8_WAIT_V
#undef PG8_WAIT_L
#undef PG8_BAR
#undef PG8_SCHED
}
}

constexpr int NWAVES = 8, NTHR = 512;
constexpr int DM = 2048, NB = 4, SEQ = 2048, NT = NB * SEQ, DEPTH = 2;
constexpr int ZP = 11264;
constexpr int ZC_QA = 0, ZC_KVA = 1024, ZC_QB = 2560, ZC_KB = 3072, ZC_VB = 3200, ZC_QC = 3328, ZC_KC = 3840, ZC_VC = 4352, ZC_GM = 4864, ZC_GA = 11008;
constexpr int OC_A = 0, OC_B = 1024, OC_C = 1536;
constexpr int NEXP = 32, DEXP = 256, ROWCAP = 24576;
constexpr float LN_EPS = 1e-5f, LOG2E = 1.4426950408889634f;
constexpr size_t MiB = 1u << 20;
constexpr size_t WS_CTL = 0, CTL_ZERO_BYTES = 1 * MiB;
constexpr size_t WS_WIN = 2 * MiB, WS_WBRA = 46 * MiB, WS_WBRB = 50 * MiB, WS_WBRC = 52 * MiB, WS_WOUT = 54 * MiB, WS_WGU = 62 * MiB, WS_WD = 126 * MiB, WS_WCMP = 158 * MiB;
constexpr size_t WS_XB = 160 * MiB, WS_Z = 192 * MiB, WS_OA = 370 * MiB, WS_MG = 402 * MiB, WS_MB = 466 * MiB, WS_X1 = 498 * MiB, WS_H = 562 * MiB, WS_SMALL = 574 * MiB, WS_END = 576 * MiB;
constexpr size_t WS_XS = WS_Z, WS_Y = WS_Z + 96 * MiB;
constexpr size_t SM_KCMP = 0, SM_VCMP = 256 * 1024, SM_KMEAN = 512 * 1024, SM_TOKE = 640 * 1024, SM_TOKW = 704 * 1024, SM_TOKP = 768 * 1024, SM_ROWTS = 832 * 1024, SM_ROWW = 960 * 1024, SM_PANE = 1088 * 1024, SM_HIST = 1152 * 1024, SM_CNTG = 1200 * 1024;
constexpr int CW_TMO = 0, CW_BAR = 4096, CW_QUEUE = 8192, CW_ECNT = 9216, CW_NPAN = 16384;
constexpr int RING_OFF = 0, RING_BYTES = 131072, LDSCTL_OFF = RING_BYTES, MISC_OFF = LDSCTL_OFF + 320, LDS_BYTES = 147456;

#define GAS __attribute__((address_space(1)))
#define LAS __attribute__((address_space(3)))
typedef unsigned short bf16;
typedef unsigned v4u __attribute__((ext_vector_type(4)));
typedef unsigned v2u __attribute__((ext_vector_type(2)));
typedef float f32x4 __attribute__((ext_vector_type(4)));
typedef float f32x16 __attribute__((ext_vector_type(16)));
typedef short bf16x8 __attribute__((ext_vector_type(8)));
typedef short s16x4 __attribute__((ext_vector_type(4)));
typedef GAS unsigned gu32;
#define RLX_AGENT __ATOMIC_RELAXED, __HIP_MEMORY_SCOPE_AGENT
#define LDS_WAIT() asm volatile("s_waitcnt lgkmcnt(0)" ::: "memory")
#define VM_WAIT() asm volatile("s_waitcnt vmcnt(0)" ::: "memory")
__device__ __forceinline__ unsigned f2bf(float f) { unsigned u = __builtin_bit_cast(unsigned, f); return (u + 0x7fffu + ((u >> 16) & 1u)) >> 16; }
__device__ __forceinline__ unsigned pk2(float lo, float hi) { return f2bf(lo) | (f2bf(hi) << 16); }
__device__ __forceinline__ float bflo(unsigned w) { return __uint_as_float(w << 16); }
__device__ __forceinline__ float bfhi(unsigned w) { return __uint_as_float(w & 0xffff0000u); }
__device__ __forceinline__ float bf2f(bf16 b) { return __uint_as_float(((unsigned)b) << 16); }
__device__ __forceinline__ float shfl_xor_f(float v, int o, int lane) { return __int_as_float(__builtin_amdgcn_ds_bpermute((lane ^ o) << 2, __float_as_int(v))); }
__device__ __forceinline__ unsigned shfl_xor_u(unsigned v, int o, int lane) { return (unsigned)__builtin_amdgcn_ds_bpermute((lane ^ o) << 2, (int)v); }
__device__ __forceinline__ float wave_sum(float v, int lane) {
#pragma unroll
    for (int o = 1; o < 64; o <<= 1) v += shfl_xor_f(v, o, lane);
    return v;
}

#define XB_TMO      128
#define XB_XCNT(j)  (256  + 64 * (j))
#define XB_XSUB(j)  (1280 + 64 * (j))
#define XB_XGEN(j)  (2304 + 64 * (j))
#define XB_TOP      3328
#define XB_TOPGEN   3392
#define XCD_BAR_WORDS 3456
#define XB_SPIN_CAP (1u << 18)

__device__ __forceinline__ unsigned xb_ld(unsigned* p)              { return __hip_atomic_load(p, __ATOMIC_RELAXED, __HIP_MEMORY_SCOPE_AGENT); }
__device__ __forceinline__ unsigned xb_add(unsigned* p, unsigned v) { return __hip_atomic_fetch_add(p, v, __ATOMIC_RELAXED, __HIP_MEMORY_SCOPE_AGENT); }
__device__ __forceinline__ unsigned xb_xcc_id() { return (unsigned)__builtin_amdgcn_s_getreg((3 << 11) | 20) & 0xFu; }
#define XB_SPIN(cond, bar) do { unsigned _sp = 0; while (cond) { __builtin_amdgcn_s_sleep(1); \
    if ((++_sp & 255u) == 0u) { if (xb_ld(&(bar)[XB_TMO])) break; if (_sp > XB_SPIN_CAP) { atomicAdd(&(bar)[XB_TMO], 1u); break; } } } } while (0)

struct XcdBarrier {
    unsigned* bar; unsigned x;
    volatile LAS unsigned* st;
};

__device__ __forceinline__ XcdBarrier xcd_barrier_post(unsigned* bar, volatile LAS unsigned* st) {
    XcdBarrier b; b.bar = bar; b.x = xb_xcc_id(); b.st = st;
    if (threadIdx.x == 0) (void)xb_add(&bar[XB_XCNT(b.x)], 1u);
    return b;
}
__device__ __forceinline__ void xcd_barrier_complete(unsigned* bar, unsigned x, unsigned& nloc, unsigned& nx) {
    const unsigned G = gridDim.x * gridDim.y * gridDim.z;
    unsigned sum, cnt, mine, sp = 0u;
    for (;;) {
        sum = 0u; cnt = 0u; mine = 0u;
#pragma unroll
        for (unsigned j = 0; j < 16; ++j) { const unsigned c = xb_ld(&bar[XB_XCNT(j)]); sum += c; cnt += (c > 0u) ? 1u : 0u; mine = (j == x) ? c : mine; }
        if (sum == G) break;
        __builtin_amdgcn_s_sleep(1);
        if ((++sp & 255u) == 0u) { if (xb_ld(&bar[XB_TMO])) break; if (sp > XB_SPIN_CAP) { atomicAdd(&bar[XB_TMO], 1u); break; } }
    }
    nloc = mine > 0u ? mine : 1u; nx = cnt > 0u ? cnt : 1u;
}

__device__ __forceinline__ void xcd_barrier(const XcdBarrier& b) {
    asm volatile("s_waitcnt vmcnt(0)" ::: "memory");
    __syncthreads();
    if (threadIdx.x == 0) {
        unsigned* bar = b.bar;
        __builtin_amdgcn_s_waitcnt(0);
        unsigned nloc = b.st[0], nx = b.st[1];
        if (nloc == 0u) { xcd_barrier_complete(bar, b.x, nloc, nx); b.st[0] = nloc; b.st[1] = nx; }
        const unsigned old = xb_add(&bar[XB_XSUB(b.x)], 1u);
        const unsigned gen = old / nloc;
        if (old + 1u == (gen + 1u) * nloc) {
            __builtin_amdgcn_fence(__ATOMIC_RELEASE, "agent");
            asm volatile("s_waitcnt vmcnt(0)" ::: "memory");
            const unsigned og = xb_add(&bar[XB_TOP], 1u);
            const unsigned tg = og / nx;
            if (og + 1u == (tg + 1u) * nx) xb_add(&bar[XB_TOPGEN], 1u);
            else XB_SPIN(xb_ld(&bar[XB_TOPGEN]) == tg, bar);
            __builtin_amdgcn_fence(__ATOMIC_ACQUIRE, "agent");
            xb_add(&bar[XB_XGEN(b.x)], 1u);
            asm volatile("s_waitcnt vmcnt(0)" ::: "memory");
        } else {
            XB_SPIN(xb_ld(&bar[XB_XGEN(b.x)]) == gen, bar);
            __builtin_amdgcn_fence(__ATOMIC_ACQUIRE, "agent");
            asm volatile("s_waitcnt vmcnt(0)" ::: "memory");
        }
    }
    __syncthreads();
}

namespace att {
__device__ __forceinline__ int crow(int r, int hi) { return (r & 3) + 8 * (r >> 2) + 4 * hi; }
__device__ __forceinline__ f32x16 zero16() { float z = 0.f; asm volatile("" : "+v"(z)); f32x16 r;
#pragma unroll
    for (int i = 0; i < 16; ++i) r[i] = z;
    return r; }
__device__ __forceinline__ unsigned cvtpk(float lo, float hi) { unsigned r; asm volatile("v_cvt_pk_bf16_f32 %0, %1, %2" : "=v"(r) : "v"(lo), "v"(hi)); return r; }
template <int HD> __device__ __forceinline__ int kswz(int row, int colB) { return row * (HD * 2) + (colB ^ ((row & 7) << 4)); }
template <int HD> __device__ __forceinline__ int v_st(int k, int c) { const int kk = (k & ~0xC) | ((k & 4) << 1) | ((k & 8) >> 1); return ((kk >> 3) * (HD / 32) + (c >> 5)) * 512 + ((kk & 7) * 32 + (c & 31)) * 2; }
__device__ __forceinline__ int v_rd_base(int lane) { return ((lane & 3) << 3) | (((lane >> 2) & 3) << 6) | (((lane >> 4) & 1) << 5) | (((lane >> 5) & 1) << 8); }
template <int HD> constexpr int v_rd_off(int d0, int ks, int half) { return d0 * 512 + (2 * ks + half) * (HD / 32) * 512; }
template <int OFF> __device__ __forceinline__ s16x4 tr_read(int vb) { s16x4 r; asm volatile("ds_read_b64_tr_b16 %0, %1 offset:%2" : "=&v"(r) : "v"(vb), "i"(OFF) : "memory"); return r; }

template <int HD> __device__ __forceinline__ void qkt(f32x16& p0, f32x16& p1, const LAS char* Ks, const bf16x8 (&qr)[HD / 16], int r32, int hi) {
    p0 = zero16(); p1 = zero16();
#pragma unroll
    for (int d0 = 0; d0 < HD / 16; ++d0) { const int cb = (d0 * 16 + hi * 8) * 2;
        const bf16x8 b0 = *(const LAS bf16x8*)(Ks + kswz<HD>(r32, cb));
        const bf16x8 b1 = *(const LAS bf16x8*)(Ks + kswz<HD>(32 + r32, cb));
        p0 = __builtin_amdgcn_mfma_f32_32x32x16_bf16(b0, qr[d0], p0, 0, 0, 0);
        p1 = __builtin_amdgcn_mfma_f32_32x32x16_bf16(b1, qr[d0], p1, 0, 0, 0); }
}
#define ATT_PK(L, H) (bf16x8){L[0], L[1], L[2], L[3], H[0], H[1], H[2], H[3]}
template <int HD, int D0> __device__ __forceinline__ void pv_one(f32x16& od, int vb, bf16x8 pa0, bf16x8 pa1, bf16x8 pa2, bf16x8 pa3) {
    const s16x4 l0 = tr_read<v_rd_off<HD>(D0, 0, 0)>(vb), h0 = tr_read<v_rd_off<HD>(D0, 0, 1)>(vb), l1 = tr_read<v_rd_off<HD>(D0, 1, 0)>(vb), h1 = tr_read<v_rd_off<HD>(D0, 1, 1)>(vb);
    const s16x4 l2 = tr_read<v_rd_off<HD>(D0, 2, 0)>(vb), h2 = tr_read<v_rd_off<HD>(D0, 2, 1)>(vb), l3 = tr_read<v_rd_off<HD>(D0, 3, 0)>(vb), h3 = tr_read<v_rd_off<HD>(D0, 3, 1)>(vb);
    asm volatile("s_waitcnt lgkmcnt(0)" ::: "memory"); __builtin_amdgcn_sched_barrier(0);
    od = __builtin_amdgcn_mfma_f32_32x32x16_bf16(pa0, ATT_PK(l0, h0), od, 0, 0, 0);
    od = __builtin_amdgcn_mfma_f32_32x32x16_bf16(pa1, ATT_PK(l1, h1), od, 0, 0, 0);
    od = __builtin_amdgcn_mfma_f32_32x32x16_bf16(pa2, ATT_PK(l2, h2), od, 0, 0, 0);
    od = __builtin_amdgcn_mfma_f32_32x32x16_bf16(pa3, ATT_PK(l3, h3), od, 0, 0, 0);
}
template <int HD> __device__ __forceinline__ void pv_all(f32x16 (&o)[HD / 32], int vb, bf16x8 pa0, bf16x8 pa1, bf16x8 pa2, bf16x8 pa3) {
    pv_one<HD, 0>(o[0], vb, pa0, pa1, pa2, pa3); pv_one<HD, 1>(o[1], vb, pa0, pa1, pa2, pa3);
    if constexpr (HD == 128) { pv_one<HD, 2>(o[2], vb, pa0, pa1, pa2, pa3); pv_one<HD, 3>(o[3], vb, pa0, pa1, pa2, pa3); }
}
#define ATT_PK4(P, BASE, OUT) do { const unsigned a0_ = cvtpk(P[BASE + 0], P[BASE + 1]), a1_ = cvtpk(P[BASE + 2], P[BASE + 3]);   \
    const unsigned b0_ = cvtpk(P[BASE + 4], P[BASE + 5]), b1_ = cvtpk(P[BASE + 6], P[BASE + 7]);                              \
    auto r0_ = __builtin_amdgcn_permlane32_swap(a0_, b0_, false, false); auto r1_ = __builtin_amdgcn_permlane32_swap(a1_, b1_, false, false); \
    v4u w_ = {r0_[0], r1_[0], r0_[1], r1_[1]}; OUT = __builtin_bit_cast(bf16x8, w_); } while (0)
__device__ __forceinline__ float xmax32(float v) { auto rr = __builtin_amdgcn_permlane32_swap(__float_as_uint(v), __float_as_uint(v), false, false); return fmaxf(__uint_as_float(rr[0]), __uint_as_float(rr[1])); }
__device__ __forceinline__ float xsum32(float v) { auto rr = __builtin_amdgcn_permlane32_swap(__float_as_uint(v), __float_as_uint(v), false, false); return __uint_as_float(rr[0]) + __uint_as_float(rr[1]); }

struct MaskGen {
    float C, slC, dq, W; bool ok; bool inner;
    __device__ __forceinline__ void operator()(f32x16& p0, f32x16& p1) const {
        const float base = -slC * dq;
        if (inner) {
#pragma unroll
            for (int r = 0; r < 16; ++r) { const float kr = (float)((r & 3) + 8 * (r >> 2));
                const float v0 = fmaf(p0[r], C, fmaf(slC, kr, base)), v1 = fmaf(p1[r], C, fmaf(slC, kr + 32.f, base));
                p0[r] = ok ? v0 : -INFINITY; p1[r] = ok ? v1 : -INFINITY; }
        } else {
#pragma unroll
            for (int r = 0; r < 16; ++r) { const float kr = (float)((r & 3) + 8 * (r >> 2));
                const float v0 = fmaf(p0[r], C, fmaf(slC, kr, base)), v1 = fmaf(p1[r], C, fmaf(slC, kr + 32.f, base));
                p0[r] = (ok && dq >= kr && dq < W + kr) ? v0 : -INFINITY;
                p1[r] = (ok && dq >= kr + 32.f && dq < W + kr + 32.f) ? v1 : -INFINITY; }
        }
    }
};
template <int HD> __device__ __forceinline__ void softmax_pv(f32x16& p0, f32x16& p1, f32x16 (&o)[HD / 32], float& m_reg, float& l_reg, int vb, LAS float* al_l, int r32, int hi) {
    float pmax = p0[0];
#pragma unroll
    for (int r = 1; r < 16; ++r) pmax = fmaxf(pmax, p0[r]);
#pragma unroll
    for (int r = 0; r < 16; ++r) pmax = fmaxf(pmax, p1[r]);
    pmax = xmax32(pmax);
    float mn = m_reg, alpha = 1.f;
    if (!__all(pmax - m_reg <= 8.0f)) { mn = fmaxf(m_reg, pmax); alpha = __builtin_amdgcn_exp2f(m_reg - mn); m_reg = mn; }
    float ps = 0.f;
#pragma unroll
    for (int r = 0; r < 16; ++r) { p0[r] = __builtin_amdgcn_exp2f(p0[r] - mn); p1[r] = __builtin_amdgcn_exp2f(p1[r] - mn); ps += p0[r] + p1[r]; }
    ps = xsum32(ps); l_reg = l_reg * alpha + ps;
    bf16x8 pa0, pa1, pa2, pa3; ATT_PK4(p0, 0, pa0); ATT_PK4(p0, 8, pa1); ATT_PK4(p1, 0, pa2); ATT_PK4(p1, 8, pa3);
    if (__any(alpha < 1.f)) { if (hi == 0) al_l[r32] = alpha; LDS_WAIT();
#pragma unroll
        for (int r = 0; r < 16; ++r) { const float a = al_l[crow(r, hi)];
#pragma unroll
            for (int d = 0; d < HD / 32; ++d) o[d][r] *= a; }
        LDS_WAIT(); }
    pv_all<HD>(o, vb, pa0, pa1, pa2, pa3);
}
template <int HD> struct Stg { v4u k0, k1, v0, v1; };
template <int HD> __device__ __forceinline__ void sload(Stg<HD>& s, const bf16* Kp, const bf16* Vp, size_t pitch, int tid) {
    if constexpr (HD == 128) { const int sr = tid >> 4, sc = (tid & 15) * 8;
        s.k0 = *(const v4u*)(Kp + (size_t)sr * pitch + sc); s.k1 = *(const v4u*)(Kp + (size_t)(32 + sr) * pitch + sc);
        s.v0 = *(const v4u*)(Vp + (size_t)sr * pitch + sc); s.v1 = *(const v4u*)(Vp + (size_t)(32 + sr) * pitch + sc); }
    else { const int sr = tid >> 3, sc = (tid & 7) * 8; s.k0 = *(const v4u*)(Kp + (size_t)sr * pitch + sc); s.v0 = *(const v4u*)(Vp + (size_t)sr * pitch + sc); }
}
template <int HD> __device__ __forceinline__ void swrite(const Stg<HD>& s, LAS char* Kt, LAS char* Vt, int tid) {
    if constexpr (HD == 128) { const int sr = tid >> 4, sc = (tid & 15) * 8;
        *(LAS v4u*)(Kt + kswz<HD>(sr, sc * 2)) = s.k0; *(LAS v4u*)(Kt + kswz<HD>(32 + sr, sc * 2)) = s.k1;
        *(LAS v4u*)(Vt + v_st<HD>(sr, sc)) = s.v0; *(LAS v4u*)(Vt + v_st<HD>(32 + sr, sc)) = s.v1; }
    else { const int sr = tid >> 3, sc = (tid & 7) * 8; *(LAS v4u*)(Kt + kswz<HD>(sr, sc * 2)) = s.k0; *(LAS v4u*)(Vt + v_st<HD>(sr, sc)) = s.v0; }
}
constexpr int A_K0 = 0, A_K1 = 16384, A_V0 = 32768, A_V1 = 49152, A_WS = 65536, A_SEL = 67584, A_UNI = 68608, A_IMP = 68864, A_KM = 77312, A_END = 81408;

template <int HD, class TF, class SK, class FIN>
__device__ __forceinline__ void run_tiles(unsigned mask0, unsigned mask1, const bf16* Kb0, const bf16* Vb0, const bf16* Kb1, const bf16* Vb1, size_t pitch, LAS char* lds, int tid, int lane,
                                          const bf16x8 (&qr)[HD / 16], f32x16 (&o)[HD / 32], float& m_reg, float& l_reg, LAS float* al_l, const TF& tf, const SK& sk, const FIN& fin) {
    const int r32 = lane & 31, hi = lane >> 5;
    const int vb0 = (int)(uintptr_t)(lds + A_V0) + v_rd_base(lane);
    int ph = 0; unsigned m = mask0; if (m == 0u) { ph = 1; m = mask1; }
    if (m == 0u) return;
    int j = __builtin_ctz(m); m &= m - 1u;
    Stg<HD> st;
    sload<HD>(st, (ph ? Kb1 : Kb0) + (size_t)j * 64 * pitch, (ph ? Vb1 : Vb0) + (size_t)j * 64 * pitch, pitch, tid);
    swrite<HD>(st, lds + A_K0, lds + A_V0, tid);
    __syncthreads();
    int buf = 0;
    for (;;) {
        int phn = ph; unsigned mn = m; if (mn == 0u && ph == 0) { phn = 1; mn = mask1; }
        const int jn = mn ? __builtin_ctz(mn) : -1; mn &= mn - 1u;
        if (jn >= 0) sload<HD>(st, (phn ? Kb1 : Kb0) + (size_t)jn * 64 * pitch, (phn ? Vb1 : Vb0) + (size_t)jn * 64 * pitch, pitch, tid);
        if (!sk(ph, j)) { f32x16 p0, p1; qkt<HD>(p0, p1, lds + (buf ? A_K1 : A_K0), qr, r32, hi);
            const MaskGen mg = tf(ph, j); mg(p0, p1);
            softmax_pv<HD>(p0, p1, o, m_reg, l_reg, vb0 + buf * 16384, al_l, r32, hi); }
        if (jn < 0 || phn != ph) fin(ph);
        if (jn >= 0) swrite<HD>(st, lds + (buf ? A_K0 : A_K1), lds + (buf ? A_V0 : A_V1), tid);
        __syncthreads();
        if (jn < 0) break;
        ph = phn; m = mn; j = jn; buf ^= 1;
    }
}
}

constexpr int N_ATT_UNITS = 256 + 128 + 256;
struct UnitTab { unsigned short u[N_ATT_UNITS]; };
constexpr UnitTab make_units() {
    UnitTab t{}; int n = 0;
    for (int cost = 64; cost >= 0; --cost) {
        for (int c = 0; c < 32; ++c) if (c + 12 == cost) for (int bg = 0; bg < 8; ++bg) t.u[n++] = (unsigned short)((bg << 5) | c);
        for (int kb = 0; kb < 8; ++kb) if (4 * kb + 3 == cost) for (int bh = 0; bh < 16; ++bh) t.u[n++] = (unsigned short)((1 << 12) | (bh << 3) | kb);
        if (cost == 2) for (int c = 0; c < 32; ++c) for (int bg = 0; bg < 8; ++bg) t.u[n++] = (unsigned short)((2 << 12) | (bg << 5) | c);
    }
    return t;
}
__constant__ UnitTab g_units = make_units();

#define ATT_STORE_O(ND, OVAL) do { unsigned off_ = (unsigned)((4 * hi) * DM + r32) * 2u; _Pragma("unroll") for (int r_ = 0; r_ < 16; ++r_) { asm volatile("" : "+v"(off_)); \
        bf16* op_ = (bf16*)((char*)obase + off_ + (unsigned)(((r_ & 3) + 8 * (r_ >> 2)) * DM * 2)); \
        _Pragma("unroll") for (int d_ = 0; d_ < ND; ++d_) op_[32 * d_] = (bf16)f2bf(OVAL); asm volatile("" ::: "memory"); } } while (0)

#define ATT_ACC_O(FIRST) do { unsigned off_ = (unsigned)((4 * hi) * DM + r32) * 2u; _Pragma("unroll") for (int r_ = 0; r_ < 16; ++r_) { asm volatile("" : "+v"(off_)); \
        const float f_ = fac_l[att::crow(r_, hi)]; bf16* op_ = (bf16*)((char*)obase + off_ + (unsigned)(((r_ & 3) + 8 * (r_ >> 2)) * DM * 2)); \
        _Pragma("unroll") for (int d_ = 0; d_ < 4; ++d_) { float v_ = o[d_][r_] * f_; if (!(FIRST)) v_ += bf2f(op_[32 * d_]); op_[32 * d_] = (bf16)f2bf(v_); } asm volatile("" ::: "memory"); } } while (0)

__device__ __forceinline__ void nsa_loop(int code, const bf16* Z, bf16* OA, LAS char* lds, int tid_in, int wid, unsigned mysel, unsigned uni);
__device__ __forceinline__ void nsa_unit(int code, const bf16* Z, const bf16* KCMP, const bf16* VCMP, bf16* OA, LAS char* lds, int tid_in, int wid) {
    using namespace att;
    int tid = tid_in; asm volatile("" : "+v"(tid)); const int lane = tid & 63;
    const int bg = (code >> 5) & 7, c = code & 31, b = bg >> 1, g = bg & 1;
    const int r32 = lane & 31, hi = lane >> 5, hh = wid & 3, tb = wid >> 2, head = g * 4 + hh;
    const int tl = tb * 32 + r32, tpos = c * 64 + tl;
    const size_t trow = (size_t)b * SEQ + tpos;
    const float slC = __builtin_amdgcn_exp2f(-(float)(head + 1)) * LOG2E, C = 0.08838834764831845f * LOG2E;
    LAS float* al_l = (LAS float*)(lds + A_WS) + wid * 64; LAS float* fac_l = al_l + 32;
    LAS unsigned* sel_l = (LAS unsigned*)(lds + A_SEL); LAS unsigned* uni_l = (LAS unsigned*)(lds + A_UNI); LAS float* imp_l = (LAS float*)(lds + A_IMP);
    const bf16* qp = Z + trow * ZP + ZC_QA + head * 128 + hi * 8;
    const bf16* gp = Z + trow * ZP + ZC_GA + head * 3;
    const float g0 = bf2f(gp[0]);
    for (int i = tid; i < 64 * 33; i += NTHR) imp_l[i] = 0.f;
    bf16* obase = OA + ((size_t)b * SEQ + c * 64 + tb * 32) * DM + OC_A + head * 128;
    {
        const bf16* kc = KCMP + (size_t)bg * 128 * 128; const bf16* vc = VCMP + (size_t)bg * 128 * 128;
        { Stg<128> s0, s1; sload<128>(s0, kc, vc, 128, tid); sload<128>(s1, kc + 64 * 128, vc + 64 * 128, 128, tid);
          swrite<128>(s0, lds + A_K0, lds + A_V0, tid); swrite<128>(s1, lds + A_K1, lds + A_V1, tid); }
        __syncthreads();
        bf16x8 qc[8];
#pragma unroll
        for (int d0 = 0; d0 < 8; ++d0) qc[d0] = *(const bf16x8*)(qp + d0 * 16);
        const float dq = (float)(tpos - 31 - 64 * hi);
#define NSA_CMP_SCORES(T) do { qkt<128>(a0, a1, lds + ((T) ? A_K1 : A_K0), qc, r32, hi); \
        _Pragma("unroll") for (int r = 0; r < 16; ++r) { const float kr = 16.f * (float)((r & 3) + 8 * (r >> 2)) + 1024.f * (T); const float d0_ = dq - kr, d1_ = dq - kr - 512.f; \
            a0[r] = d0_ >= 0.f ? fmaf(a0[r], C, -slC * d0_) : -INFINITY; a1[r] = d1_ >= 0.f ? fmaf(a1[r], C, -slC * d1_) : -INFINITY; } } while (0)
        f32x16 a0, a1;
        float mx = -INFINITY, ps = 0.f;
        { NSA_CMP_SCORES(0);
#pragma unroll
          for (int r = 0; r < 16; ++r) mx = fmaxf(mx, fmaxf(a0[r], a1[r]));
          float s0 = 0.f; const float m0 = (mx == -INFINITY) ? 0.f : mx;
#pragma unroll
          for (int r = 0; r < 16; ++r) s0 += __builtin_amdgcn_exp2f(a0[r] - m0) + __builtin_amdgcn_exp2f(a1[r] - m0);
          NSA_CMP_SCORES(1);
          float mx1 = mx;
#pragma unroll
          for (int r = 0; r < 16; ++r) mx1 = fmaxf(mx1, fmaxf(a0[r], a1[r]));
          const float m1 = (mx1 == -INFINITY) ? 0.f : mx1;
          float s1 = 0.f;
#pragma unroll
          for (int r = 0; r < 16; ++r) s1 += __builtin_amdgcn_exp2f(a0[r] - m1) + __builtin_amdgcn_exp2f(a1[r] - m1);
          float mh = mx1, sh = s0 * __builtin_amdgcn_exp2f(m0 - m1) + s1;
          const float mo = shfl_xor_f(mh, 32, lane), so = shfl_xor_f(sh, 32, lane);
          const float mf = fmaxf(mh, mo); const float mfz = (mf == -INFINITY) ? 0.f : mf;
          const float mhz = (mh == -INFINITY) ? 0.f : mh, moz = (mo == -INFINITY) ? 0.f : mo;
          ps = sh * __builtin_amdgcn_exp2f(mhz - mfz) + so * __builtin_amdgcn_exp2f(moz - mfz); mx = mfz; }
        const float mm = mx, inv = ps > 0.f ? 1.0f / ps : 0.f;
        LAS float* impr = imp_l + tl * 33;
#define NSA_IMP(X, GRP) do { _Pragma("unroll") for (int q4 = 0; q4 < 4; ++q4) { const int j_ = 8 * (GRP) + 2 * q4 + hi; const float hb_ = 0.5f * X[4 * q4 + 3] * inv; \
            const float aa_ = (X[4 * q4] + X[4 * q4 + 1] + X[4 * q4 + 2]) * inv + hb_; \
            (void)__hip_atomic_fetch_add(impr + j_, aa_, __ATOMIC_RELAXED, __HIP_MEMORY_SCOPE_WORKGROUP); \
            if (j_ + 1 < 32) (void)__hip_atomic_fetch_add(impr + j_ + 1, hb_, __ATOMIC_RELAXED, __HIP_MEMORY_SCOPE_WORKGROUP); } } while (0)
        f32x16 o[4];
#pragma unroll
      for (int d = 0; d < 4; ++d) o[d] = att::zero16();
        const int vb0 = (int)(uintptr_t)(lds + A_V0) + v_rd_base(lane);
        { NSA_CMP_SCORES(0);
#pragma unroll
          for (int r = 0; r < 16; ++r) { a0[r] = __builtin_amdgcn_exp2f(a0[r] - mm); a1[r] = __builtin_amdgcn_exp2f(a1[r] - mm); }
          NSA_IMP(a0, 0); NSA_IMP(a1, 1);
          bf16x8 pa0, pa1, pa2, pa3; ATT_PK4(a0, 0, pa0); ATT_PK4(a0, 8, pa1); ATT_PK4(a1, 0, pa2); ATT_PK4(a1, 8, pa3); pv_all<128>(o, vb0, pa0, pa1, pa2, pa3); }
        { NSA_CMP_SCORES(1);
#pragma unroll
          for (int r = 0; r < 16; ++r) { a0[r] = __builtin_amdgcn_exp2f(a0[r] - mm); a1[r] = __builtin_amdgcn_exp2f(a1[r] - mm); }
          NSA_IMP(a0, 2); NSA_IMP(a1, 3);
          bf16x8 pa0, pa1, pa2, pa3; ATT_PK4(a0, 0, pa0); ATT_PK4(a0, 8, pa1); ATT_PK4(a1, 0, pa2); ATT_PK4(a1, 8, pa3); pv_all<128>(o, vb0 + 16384, pa0, pa1, pa2, pa3); }
#undef NSA_IMP
#undef NSA_CMP_SCORES
        if (hi == 0) fac_l[r32] = g0 * inv; LDS_WAIT();
        ATT_ACC_O(true);
        LDS_WAIT();
    }
    __syncthreads();
    if (wid == 0) {
        unsigned sel;
        if (c <= 7) sel = (2u << c) - 1u;
        else { sel = 1u | (1u << c) | (1u << (c - 1)); unsigned cand = ((1u << (c - 1)) - 1u) & ~1u;
            const LAS float* ir = imp_l + lane * 33;
            for (int k = 0; k < 5; ++k) { int best = -1; float bv = -INFINITY;
                for (int j = 1; j <= c - 2; ++j) { const float v = ir[j]; if (((cand >> j) & 1u) && v > bv) { bv = v; best = j; } }
                if (best < 0) best = __builtin_ctz(cand);
                sel |= 1u << best; cand &= ~(1u << best); } }
        sel_l[lane] = sel;
        unsigned un = sel;
#pragma unroll
        for (int o_ = 1; o_ < 64; o_ <<= 1) un |= shfl_xor_u(un, o_, lane);
        if (lane == 0) uni_l[0] = un;
    }
    __syncthreads();
    const unsigned mysel = sel_l[tl], uni = uni_l[0];
    asm volatile("" ::: "memory");
    nsa_loop(code, Z, OA, lds, tid, wid, mysel, uni);
}
__device__ __forceinline__ void nsa_loop(int code, const bf16* Z, bf16* OA, LAS char* lds, int tid_in, int wid, unsigned mysel, unsigned uni) {
    using namespace att;
    int tid = tid_in; asm volatile("" : "+v"(tid));
    const int lane = tid & 63;
    const int bg = (code >> 5) & 7, c = code & 31, b = bg >> 1, g = bg & 1;
    const int r32 = lane & 31, hi = lane >> 5, hh = wid & 3, tb = wid >> 2, head = g * 4 + hh;
    const int tl = tb * 32 + r32, tpos = c * 64 + tl;
    const size_t trow = (size_t)b * SEQ + tpos;
    const float slC = __builtin_amdgcn_exp2f(-(float)(head + 1)) * LOG2E, C = 0.08838834764831845f * LOG2E;
    LAS float* al_l = (LAS float*)(lds + A_WS) + wid * 64; LAS float* fac_l = al_l + 32;
    const bf16* qp = Z + trow * ZP + ZC_QA + head * 128 + hi * 8;
    const bf16* gp = Z + trow * ZP + ZC_GA + head * 3;
    const float g1 = bf2f(gp[1]), g2 = bf2f(gp[2]);
    bf16* obase = OA + ((size_t)b * SEQ + c * 64 + tb * 32) * DM + OC_A + head * 128;
    const bf16* zb = Z + (size_t)b * SEQ * ZP;
    bf16x8 qr[8];
#pragma unroll
    for (int d0 = 0; d0 < 8; ++d0) qr[d0] = *(const bf16x8*)(qp + d0 * 16);
    { f32x16 o[4];
#pragma unroll
      for (int d = 0; d < 4; ++d) o[d] = att::zero16();
      float m_reg = -1e30f, l_reg = 0.f;
      const int jlo = c > 8 ? c - 8 : 0; const unsigned wmask = ((2u << c) - 1u) & ~((1u << jlo) - 1u);
      const int twmin = c * 64 + tb * 32;
      run_tiles<128>(uni, wmask, zb + ZC_KVA + 512 + g * 128, zb + ZC_KVA + 768 + g * 128, zb + ZC_KVA + 1024 + g * 128, zb + ZC_KVA + 1280 + g * 128, (size_t)ZP, lds, tid, lane, qr, o, m_reg, l_reg, al_l,
          [&](int ph, int j) { return MaskGen{C, slC, (float)(tpos - 64 * j - 4 * hi), ph ? 512.f : 1e9f, ph ? true : (((mysel >> j) & 1u) != 0u), ph ? (j < c && j >= c - 7) : (j < c)}; },
          [&](int ph, int j) { return ph ? (twmin - (64 * j + 63) >= 512) : !__any((mysel >> j) & 1u); },
          [&](int ph) { if (hi == 0) fac_l[r32] = (ph ? g2 : g1) / l_reg; LDS_WAIT();
              ATT_ACC_O(false);
              LDS_WAIT();
#pragma unroll
      for (int d = 0; d < 4; ++d) o[d] = att::zero16();
              m_reg = -1e30f; l_reg = 0.f; }); }
}

__device__ __forceinline__ void moba_unit(int code, const bf16* Z, const float* KMEAN, bf16* OA, LAS char* lds, int tid_in, int wid) {
    using namespace att;
    int tid = tid_in; asm volatile("" : "+v"(tid)); const int lane = tid & 63;
    const int bh = (code >> 3) & 15, kb = code & 7, b = bh >> 2, h = bh & 3;
    const int r32 = lane & 31, hi = lane >> 5, tl = wid * 32 + r32, tpos = kb * 256 + tl;
    const float slC = __builtin_amdgcn_exp2f(-2.0f * (float)(h + 1)) * LOG2E, C = 0.08838834764831845f * LOG2E;
    LAS float* al_l = (LAS float*)(lds + A_WS) + wid * 64; LAS float* fac_l = al_l + 32;
    LAS unsigned* sel_l = (LAS unsigned*)(lds + A_SEL); LAS unsigned* uni_l = (LAS unsigned*)(lds + A_UNI); LAS float* km_l = (LAS float*)(lds + A_KM);
    const bf16* zb = Z + (size_t)b * SEQ * ZP;
    for (int i = tid; i < 1024; i += NTHR) km_l[i] = KMEAN[(size_t)bh * 1024 + i];
    if (tid == 0) uni_l[0] = 0u;
    __syncthreads();
    if (tid < 256) {
        unsigned sel;
        if (kb <= 3) sel = (1u << kb) - 1u;
        else { float sc[7];
#pragma unroll
            for (int n = 0; n < 7; ++n) sc[n] = 0.f;
            const bf16* qp = zb + (size_t)(kb * 256 + tid) * ZP + ZC_QC + h * 128;
            for (int d8 = 0; d8 < 16; ++d8) { const v4u q = *(const v4u*)(qp + d8 * 8);
                const float qf[8] = {bflo(q.x), bfhi(q.x), bflo(q.y), bfhi(q.y), bflo(q.z), bfhi(q.z), bflo(q.w), bfhi(q.w)};
#pragma unroll
                for (int n = 0; n < 7; ++n) if (n < kb) { const LAS float* kp = km_l + n * 128 + d8 * 8;
#pragma unroll
                    for (int i = 0; i < 8; ++i) sc[n] = fmaf(qf[i], kp[i], sc[n]); } }
            sel = 0u;
#pragma unroll
            for (int k = 0; k < 3; ++k) { int best = -1; float bv = -INFINITY;
#pragma unroll
                for (int n = 0; n < 7; ++n) if (n < kb && !((sel >> n) & 1u) && sc[n] > bv) { bv = sc[n]; best = n; }
                if (best < 0) best = __builtin_ctz(~sel);
                sel |= 1u << best; } }
        sel_l[tid] = sel;
        (void)__hip_atomic_fetch_or(uni_l, sel, __ATOMIC_RELAXED, __HIP_MEMORY_SCOPE_WORKGROUP);
    }
    __syncthreads();
    const unsigned mysel = sel_l[tl], uni = uni_l[0];
    unsigned tmask = 0xFu << (4 * kb);
    for (int n = 0; n < kb; ++n) if ((uni >> n) & 1u) tmask |= 0xFu << (4 * n);
    bf16x8 qr[8];
    { const bf16* qp = zb + (size_t)tpos * ZP + ZC_QC + h * 128 + hi * 8;
#pragma unroll
      for (int d0 = 0; d0 < 8; ++d0) qr[d0] = *(const bf16x8*)(qp + d0 * 16); }
    f32x16 o[4];
#pragma unroll
      for (int d = 0; d < 4; ++d) o[d] = att::zero16();
    float m_reg = -1e30f, l_reg = 0.f;
    const int twmax = kb * 256 + wid * 32 + 31;
    run_tiles<128>(tmask, 0u, zb + ZC_KC + h * 128, zb + ZC_VC + h * 128, zb, zb, (size_t)ZP, lds, tid, lane, qr, o, m_reg, l_reg, al_l,
        [&](int, int j) { const int blk = j >> 2; return MaskGen{C, slC, (float)(tpos - 64 * j - 4 * hi), 1e9f, blk == kb ? true : (((mysel >> blk) & 1u) != 0u), blk != kb}; },
        [&](int, int j) { const int blk = j >> 2; return blk == kb ? (64 * j > twmax) : !__any((mysel >> blk) & 1u); },
        [&](int) {});
    if (hi == 0) fac_l[r32] = 1.0f / l_reg; LDS_WAIT();
    float fr_[16];
#pragma unroll
    for (int r = 0; r < 16; ++r) fr_[r] = fac_l[crow(r, hi)];
    LDS_WAIT();
    bf16* obase = OA + ((size_t)b * SEQ + kb * 256 + wid * 32) * DM + OC_C + h * 128;
    ATT_STORE_O(4, o[d_][r_] * fr_[r_]);
}

__device__ __forceinline__ void swa_unit(int code, const bf16* Z, const float* sink, bf16* OA, LAS char* lds, int tid_in, int wid) {
    using namespace att;
    int tid = tid_in; asm volatile("" : "+v"(tid)); const int lane = tid & 63;
    const int bg = (code >> 5) & 7, c = code & 31, b = bg >> 1, g = bg & 1;
    const int r32 = lane & 31, hi = lane >> 5, hh = wid & 3, tb = wid >> 2, head = g * 4 + hh;
    const int tl = tb * 32 + r32, tpos = c * 64 + tl;
    const float slC = __builtin_amdgcn_exp2f(-(float)(head + 1)) * LOG2E, C = 0.125f * LOG2E;
    LAS float* al_l = (LAS float*)(lds + A_WS) + wid * 64; LAS float* fac_l = al_l + 32;
    const bf16* zb = Z + (size_t)b * SEQ * ZP;
    bf16x8 qr[4];
    { const bf16* qp = zb + (size_t)tpos * ZP + ZC_QB + head * 64 + hi * 8;
#pragma unroll
      for (int d0 = 0; d0 < 4; ++d0) qr[d0] = *(const bf16x8*)(qp + d0 * 16); }
    f32x16 o[2];
#pragma unroll
      for (int d = 0; d < 2; ++d) o[d] = att::zero16();
    float m_reg = -1e30f, l_reg = 0.f;
    const int jlo = c > 2 ? c - 2 : 0; const unsigned tmask = ((2u << c) - 1u) & ~((1u << jlo) - 1u);
    const int twmin = c * 64 + tb * 32;
    run_tiles<64>(tmask, 0u, zb + ZC_KB + g * 64, zb + ZC_VB + g * 64, zb, zb, (size_t)ZP, lds, tid, lane, qr, o, m_reg, l_reg, al_l,
        [&](int, int j) { return MaskGen{C, slC, (float)(tpos - 64 * j - 4 * hi), 128.f, true, j == c - 1}; },
        [&](int, int j) { return twmin - (64 * j + 63) >= 128; },
        [&](int) {});
    l_reg += __builtin_amdgcn_exp2f(sink[head] * LOG2E - m_reg);
    if (hi == 0) fac_l[r32] = 1.0f / l_reg; LDS_WAIT();
    float fr_[16];
#pragma unroll
    for (int r = 0; r < 16; ++r) fr_[r] = fac_l[crow(r, hi)];
    LDS_WAIT();
    bf16* obase = OA + ((size_t)b * SEQ + c * 64 + tb * 32) * DM + OC_B + head * 64;
    ATT_STORE_O(2, o[d_][r_] * fr_[r_]);
}

__device__ __forceinline__ void cmp_unit(int u, const bf16* Z, const bf16* WCMP, const float* pos, bf16* KCMP, bf16* VCMP, LAS char* lds, int tid, int lane, int wid) {
    const int bg = u >> 5, kv = (u >> 4) & 1, nt = (u >> 2) & 3, et = u & 3, b = bg >> 1, g = bg & 1, r32 = lane & 31, hi = lane >> 5;
    const int n = nt * 32 + r32, nc = n < 126 ? n : 126;
    const bf16* arow = Z + ((size_t)b * SEQ + 16 * nc) * ZP + ZC_KVA + kv * 256 + g * 128 + hi * 8;
    const bf16* brow = WCMP + ((size_t)kv * 128 + et * 32 + r32) * 4096 + hi * 8;
    const float* prow = pos + kv * 4096 + hi * 8;
    f32x16 acc = att::zero16();
    for (int ll = 0; ll < 4; ++ll) { const int l = 4 * wid + ll;
#pragma unroll
        for (int ds = 0; ds < 8; ++ds) { const int d = ds * 16;
            const v4u a = *(const v4u*)(arow + (size_t)l * ZP + d); const f32x4 p0 = *(const f32x4*)(prow + l * 128 + d), p1 = *(const f32x4*)(prow + l * 128 + d + 4);
            v4u af; af.x = pk2(bflo(a.x) + p0[0], bfhi(a.x) + p0[1]); af.y = pk2(bflo(a.y) + p0[2], bfhi(a.y) + p0[3]); af.z = pk2(bflo(a.z) + p1[0], bfhi(a.z) + p1[1]); af.w = pk2(bflo(a.w) + p1[2], bfhi(a.w) + p1[3]);
            const bf16x8 bfg = *(const bf16x8*)(brow + l * 128 + d);
            acc = __builtin_amdgcn_mfma_f32_32x32x16_bf16(__builtin_bit_cast(bf16x8, af), bfg, acc, 0, 0, 0); } }
    LAS float* part = (LAS float*)lds;
#pragma unroll
    for (int r = 0; r < 16; ++r) part[(wid * 32 + att::crow(r, hi)) * 33 + r32] = acc[r];
    __syncthreads();
#pragma unroll
    for (int k2 = 0; k2 < 2; ++k2) { const int idx = tid + NTHR * k2, row = idx >> 5, col = idx & 31; float s = 0.f;
#pragma unroll
        for (int w = 0; w < 8; ++w) s += part[(w * 32 + row) * 33 + col];
        const int no = nt * 32 + row; if (no == 127) s = 0.f;
        (kv ? VCMP : KCMP)[((size_t)bg * 128 + no) * 128 + et * 32 + col] = (bf16)f2bf(s); }
    __syncthreads();
}
__device__ __forceinline__ void kmean_unit(int u, const bf16* Z, float* KMEAN, LAS char* lds, int tid, int lane, int wid) {
    const int bh = u >> 3, blk = u & 7, b = bh >> 2, h = bh & 3;
    const bf16* kp = Z + ((size_t)b * SEQ + blk * 256 + wid * 32) * ZP + ZC_KC + h * 128 + 2 * lane;
    float s0 = 0.f, s1 = 0.f;
#pragma unroll 8
    for (int i = 0; i < 32; ++i) { const unsigned w = *(const unsigned*)(kp + (size_t)i * ZP); s0 += bflo(w); s1 += bfhi(w); }
    LAS float* part = (LAS float*)lds;
    part[wid * 128 + 2 * lane] = s0; part[wid * 128 + 2 * lane + 1] = s1;
    __syncthreads();
    if (tid < 128) { float s = 0.f;
#pragma unroll
        for (int w = 0; w < 8; ++w) s += part[w * 128 + tid];
        KMEAN[((size_t)bh * 8 + blk) * 128 + tid] = s * (1.0f / 256.0f); }
    __syncthreads();
}

__device__ __forceinline__ void cvt_item64(const float* W, int ldw, int k0, int n_src0, int ncols, bf16* WT, int ldt, int n_dst0, LAS unsigned* scr, int lane) {
    const int nq = lane & 15, kq = lane >> 4; const bool act = 4 * nq < ncols;
    const float* wp = W + (size_t)(k0 + 2 * kq) * ldw + n_src0 + 4 * nq;
    f32x4 v0[8], v1[8];
#pragma unroll
    for (int i = 0; i < 8; ++i) { if (act) { v0[i] = *(const f32x4*)(wp + (size_t)(8 * i) * ldw); v1[i] = *(const f32x4*)(wp + (size_t)(8 * i + 1) * ldw); } else { v0[i] = (f32x4){0.f, 0.f, 0.f, 0.f}; v1[i] = v0[i]; } }
#pragma unroll
    for (int i = 0; i < 8; ++i) { const int a = kq + 4 * i;
#pragma unroll
        for (int j = 0; j < 4; ++j) scr[(4 * nq + j) * 33 + a] = pk2(v0[i][j], v1[i][j]); }
    LDS_WAIT(); asm volatile("" ::: "memory");
    const int c = lane & 7;
#pragma unroll
    for (int i = 0; i < 8; ++i) { const int n = (lane >> 3) + 8 * i; const LAS unsigned* s = scr + n * 33 + 4 * c;
        v4u o; o.x = s[0]; o.y = s[1]; o.z = s[2]; o.w = s[3];
        if (n < ncols) *(v4u*)(WT + (size_t)(n_dst0 + n) * ldt + k0 + 8 * c) = o; }
    LDS_WAIT(); asm volatile("" ::: "memory");
}
__device__ __forceinline__ void cvt_item64_fp8(const float* W, int ldw, int k0, int n_src0, int ncols, unsigned char* WT, int ldt, int n_dst0, float scale, LAS unsigned* scr, int lane) {
    const int nq = lane & 15, kq = lane >> 4; const bool act = 4 * nq < ncols;
    const float* wp = W + (size_t)(k0 + 4 * kq) * ldw + n_src0 + 4 * nq;
    f32x4 v[4][4];
#pragma unroll
    for (int i = 0; i < 4; ++i)
#pragma unroll
        for (int rr = 0; rr < 4; ++rr) v[i][rr] = act ? *(const f32x4*)(wp + (size_t)(16 * i + rr) * ldw) : (f32x4){0.f, 0.f, 0.f, 0.f};
#pragma unroll
    for (int i = 0; i < 4; ++i)
#pragma unroll
        for (int j = 0; j < 4; ++j) { int w = 0; w = __builtin_amdgcn_cvt_pk_fp8_f32(v[i][0][j] * scale, v[i][1][j] * scale, w, false); w = __builtin_amdgcn_cvt_pk_fp8_f32(v[i][2][j] * scale, v[i][3][j] * scale, w, true);
            scr[(4 * nq + j) * 17 + kq + 4 * i] = (unsigned)w; }
    LDS_WAIT(); asm volatile("" ::: "memory");
    const int c = lane & 3;
#pragma unroll
    for (int i = 0; i < 4; ++i) { const int n = (lane >> 2) + 16 * i; const LAS unsigned* s = scr + n * 17 + 4 * c;
        v4u o; o.x = s[0]; o.y = s[1]; o.z = s[2]; o.w = s[3];
        if (n < ncols) *(v4u*)(WT + (size_t)(n_dst0 + n) * ldt + k0 + 16 * c) = o; }
    LDS_WAIT(); asm volatile("" ::: "memory");
}
__device__ __forceinline__ unsigned pk4_fp8(f32x4 v, float scale) { int w = 0; w = __builtin_amdgcn_cvt_pk_fp8_f32(v[0] * scale, v[1] * scale, w, false); w = __builtin_amdgcn_cvt_pk_fp8_f32(v[2] * scale, v[3] * scale, w, true); return (unsigned)w; }
constexpr float FP8_XSCALE = 16.f, FP8_WSCALE = 64.f;
constexpr int FP8_SCA = 0x7b7b7b7b, FP8_SCB = 0x79797979;
constexpr int CI_IN = 173 * 32, CI_BRA = 512, CI_BRB = 256, CI_BRC = 256, CI_OUT = 1024, CI_GU = 8192, CI_D = 4096, CI_CMP = 256, CI_ZERO = 232;
constexpr int CI_TOTAL = CI_IN + CI_BRA + CI_BRB + CI_BRC + CI_OUT + CI_GU + CI_D + CI_CMP + CI_ZERO;

__device__ __forceinline__ void ln_row(f32x4 (&v)[8], const float* g, const float* bta, int lane) {
    float s = 0.f;
#pragma unroll
    for (int j = 0; j < 8; ++j) s += (v[j][0] + v[j][1]) + (v[j][2] + v[j][3]);
    const float mean = wave_sum(s, lane) * (1.0f / DM); float s2 = 0.f;
#pragma unroll
    for (int j = 0; j < 8; ++j) { v[j] = v[j] - mean; s2 += (v[j][0] * v[j][0] + v[j][1] * v[j][1]) + (v[j][2] * v[j][2] + v[j][3] * v[j][3]); }
    const float rstd = 1.0f / sqrtf(wave_sum(s2, lane) * (1.0f / DM) + LN_EPS);
#pragma unroll
    for (int j = 0; j < 8; ++j) { const f32x4 gg = ((const f32x4*)g)[lane + 64 * j], bb = ((const f32x4*)bta)[lane + 64 * j]; v[j] = v[j] * rstd * gg + bb; }
}

__device__ __forceinline__ void ln_router_tile(int tile, const float* R, const float* g, const float* bta, float* X1, bf16* XB, const float* wgrp, const float* bgrp, const float* wrt, const float* brt,
                                               int* hist, int* tok_e, float* tok_w, int* tok_p, LAS char* lds, int tid, int lane, int wid) {
    LAS float* glog = (LAS float*)lds;
    LAS float* part = (LAS float*)(lds + 1024);
    LAS float* elog = (LAS float*)(lds + 1024 + 33792);
    const int row0 = tile * 32;
    LAS f32x4* lg = (LAS f32x4*)(lds + 65536);
    LAS f32x4* lb = lg + 512;
    LAS f32x4* lw = lb + 512;
    { const f32x4 a = ((const f32x4*)g)[tid], b4 = ((const f32x4*)bta)[tid]; f32x4 w4[4];
#pragma unroll
      for (int q = 0; q < 4; ++q) w4[q] = ((const f32x4*)wgrp)[tid + 512 * q];
      lg[tid] = a; lb[tid] = b4;
#pragma unroll
      for (int q = 0; q < 4; ++q) { const int kk = tid + 512 * q; lw[(kk & 3) * 512 + (kk >> 2)] = w4[q]; } }
    __syncthreads();
#pragma unroll 1
    for (int hp = 0; hp < 2; ++hp) {
        f32x4 v[2][8]; const size_t rbase = (size_t)row0 + wid * 4 + hp * 2;
#pragma unroll
        for (int i = 0; i < 2; ++i)
#pragma unroll
            for (int j = 0; j < 8; ++j) v[i][j] = ((const f32x4*)(R + (rbase + i) * DM))[lane + 64 * j];
        float mean[2], rstd[2];
#pragma unroll
        for (int i = 0; i < 2; ++i) { float s = 0.f;
#pragma unroll
            for (int j = 0; j < 8; ++j) s += (v[i][j][0] + v[i][j][1]) + (v[i][j][2] + v[i][j][3]);
            mean[i] = s; }
#pragma unroll
        for (int o_ = 1; o_ < 64; o_ <<= 1) {
#pragma unroll
            for (int i = 0; i < 2; ++i) mean[i] += shfl_xor_f(mean[i], o_, lane); }
#pragma unroll
        for (int i = 0; i < 2; ++i) { mean[i] *= (1.0f / DM); float s2 = 0.f;
#pragma unroll
            for (int j = 0; j < 8; ++j) { v[i][j] = v[i][j] - mean[i]; s2 += (v[i][j][0] * v[i][j][0] + v[i][j][1] * v[i][j][1]) + (v[i][j][2] * v[i][j][2] + v[i][j][3] * v[i][j][3]); }
            rstd[i] = s2; }
#pragma unroll
        for (int o_ = 1; o_ < 64; o_ <<= 1) {
#pragma unroll
            for (int i = 0; i < 2; ++i) rstd[i] += shfl_xor_f(rstd[i], o_, lane); }
#pragma unroll
        for (int i = 0; i < 2; ++i) rstd[i] = 1.0f / sqrtf(rstd[i] * (1.0f / DM) + LN_EPS);
        float gl[2][4];
#pragma unroll
        for (int i = 0; i < 2; ++i)
#pragma unroll
            for (int cc = 0; cc < 4; ++cc) gl[i][cc] = 0.f;
#pragma unroll
        for (int j = 0; j < 8; ++j) { const f32x4 gg = lg[lane + 64 * j], bb = lb[lane + 64 * j];
            f32x4 wr[4];
#pragma unroll
            for (int e = 0; e < 4; ++e) wr[e] = lw[e * 512 + lane + 64 * j];
#pragma unroll
            for (int i = 0; i < 2; ++i) { const f32x4 y = v[i][j] * rstd[i] * gg + bb;
                ((f32x4*)(X1 + (rbase + i) * DM))[lane + 64 * j] = y;
                v2u w; w.x = pk2(y[0], y[1]); w.y = pk2(y[2], y[3]); ((v2u*)(XB + (rbase + i) * DM))[lane + 64 * j] = w;
#pragma unroll
                for (int e = 0; e < 4; ++e)
#pragma unroll
                    for (int cc = 0; cc < 4; ++cc) gl[i][cc] = fmaf(y[e], wr[e][cc], gl[i][cc]); }
            asm volatile("" ::: "memory"); }
#pragma unroll
        for (int o_ = 1; o_ < 64; o_ <<= 1) {
#pragma unroll
            for (int i = 0; i < 2; ++i)
#pragma unroll
                for (int cc = 0; cc < 4; ++cc) gl[i][cc] += shfl_xor_f(gl[i][cc], o_, lane); }
        if (lane == 0) {
#pragma unroll
            for (int i = 0; i < 2; ++i)
#pragma unroll
                for (int cc = 0; cc < 4; ++cc) glog[(wid * 4 + hp * 2 + i) * 4 + cc] = gl[i][cc] + bgrp[cc]; }
    }
    VM_WAIT(); __syncthreads();
    { f32x16 acc = att::zero16();
      const int i = lane & 31, kk = lane >> 5;
      const float* xa = X1 + (size_t)(row0 + i) * DM + 256 * wid + 4 * kk;
      const float* wb = wrt + (size_t)(256 * wid + 4 * kk) * 32 + i;
#pragma unroll 1
      for (int c8 = 0; c8 < 2; ++c8) { f32x4 a[16]; float bq[16][4];
#pragma unroll
          for (int q = 0; q < 16; ++q) { const int cch = c8 * 16 + q; a[q] = *(const f32x4*)(xa + 8 * cch);
#pragma unroll
              for (int s = 0; s < 4; ++s) bq[q][s] = wb[(8 * cch + s) * 32]; }
#pragma unroll
          for (int q = 0; q < 16; ++q)
#pragma unroll
              for (int s = 0; s < 4; ++s) acc = __builtin_amdgcn_mfma_f32_32x32x2f32(a[q][s], bq[q][s], acc, 0, 0, 0); }
#pragma unroll
      for (int r = 0; r < 16; ++r) part[(wid * 32 + att::crow(r, kk)) * 33 + i] = acc[r]; }
    __syncthreads();
#pragma unroll
    for (int k2 = 0; k2 < 2; ++k2) { const int idx = tid + NTHR * k2, row = idx >> 5, col = idx & 31; float s = brt[col];
#pragma unroll
        for (int w = 0; w < 8; ++w) s += part[(w * 32 + row) * 33 + col];
        elog[row * 33 + col] = s; }
    __syncthreads();
    if (tid < 32) { const int token = row0 + tid;
        int gi = 0; float gm = glog[tid * 4];
#pragma unroll
        for (int cc = 1; cc < 4; ++cc) { const float t = glog[tid * 4 + cc]; if (t > gm) { gm = t; gi = cc; } }
        float den = 0.f;
#pragma unroll
        for (int cc = 0; cc < 4; ++cc) den += __expf(glog[tid * 4 + cc] - gm);
        const float gw = 1.0f / den;
        int i0 = 0; float t0 = elog[tid * 33 + gi * 8];
#pragma unroll
        for (int k = 1; k < 8; ++k) { const float t = elog[tid * 33 + gi * 8 + k]; if (t > t0) { t0 = t; i0 = k; } }
        int i1 = -1; float t1 = -INFINITY;
#pragma unroll
        for (int k = 0; k < 8; ++k) { const float t = elog[tid * 33 + gi * 8 + k]; if (k != i0 && t > t1) { t1 = t; i1 = k; } }
        const float ex = __expf(t1 - t0), w0 = gw / (1.0f + ex), w1 = gw * ex / (1.0f + ex);
        const int e0 = gi * 8 + i0, e1 = gi * 8 + i1;
        LAS int* e_l = (LAS int*)(lds + 1024);
        e_l[2 * tid] = e0; e_l[2 * tid + 1] = e1; LDS_WAIT();
        int r0 = 0, r1 = 0, hc = 0;
        for (int q = 0; q < 64; ++q) { const int eq = e_l[q]; if (q < 2 * tid) { r0 += (eq == e0); r1 += (eq == e1); } hc += (eq == tid); }
        hist[tile * 32 + tid] = hc;
        tok_e[token * 2] = e0; tok_e[token * 2 + 1] = e1; tok_w[token * 2] = w0; tok_w[token * 2 + 1] = w1; tok_p[token * 2] = r0; tok_p[token * 2 + 1] = r1; }
    __syncthreads();
}
__device__ __forceinline__ int moe_offsets(const int* cntg, LAS char* lds, int tid) {
    LAS int* off_l = (LAS int*)lds; LAS int* cnt_l = (LAS int*)(lds + 256);
    if (tid < 32) cnt_l[tid] = cntg[tid];
    __syncthreads();
    if (tid == 0) { int o = 0; for (int e = 0; e < 32; ++e) { off_l[e] = o; o += (cnt_l[e] + 255) & ~255; } off_l[32] = o; }
    __syncthreads();
    return off_l[32];
}
__device__ __forceinline__ int moe_offsets_hist(const int* hist, int tile, LAS char* lds, int tid) {
    LAS int* off_l = (LAS int*)lds; LAS int* cnt_l = (LAS int*)(lds + 256); LAS int* pre_l = (LAS int*)(lds + 512); LAS int* pa = (LAS int*)(lds + 1024); LAS int* pb = (LAS int*)(lds + 1024 + 2048);
    const int e = tid & 31, part = tid >> 5; int sa = 0, sb = 0;
#pragma unroll 4
    for (int q = 0; q < 16; ++q) { const int t = part * 16 + q; const int h = hist[t * 32 + e]; sa += h; sb += (t < tile) ? h : 0; }
    pa[part * 32 + e] = sa; pb[part * 32 + e] = sb;
    __syncthreads();
    if (tid < 32) { int c = 0, p = 0;
#pragma unroll
        for (int q = 0; q < 16; ++q) { c += pa[q * 32 + tid]; p += pb[q * 32 + tid]; }
        cnt_l[tid] = c; pre_l[tid] = p; }
    __syncthreads();
    if (tid == 0) { int o = 0; for (int k = 0; k < 32; ++k) { off_l[k] = o; o += (cnt_l[k] + 255) & ~255; } off_l[32] = o; }
    __syncthreads();
    return off_l[32];
}

#ifndef DBL
#define DBL 0
#endif
#ifndef PHASES
#define PHASES 0x7FF
#endif
struct Args { const float* in[20]; float* out; unsigned char* ws; };
__global__ void __launch_bounds__(NTHR, 2) fwd_kernel(Args args) {
    extern __shared__ __attribute__((aligned(16))) unsigned char lds_raw[];
    LAS unsigned char* const lds = (LAS unsigned char*)lds_raw;
    LAS char* const ldc = (LAS char*)lds_raw;
    volatile LAS unsigned* MISC = (volatile LAS unsigned*)(lds + MISC_OFF);
    const int G = gridDim.x, bx = blockIdx.x, vcu = (G % 8 == 0) ? (bx % 8) * (G / 8) + bx / 8 : bx, NGW = G * NWAVES;
#define PHASE_IDS() int tid_ = threadIdx.x; asm volatile("" : "+v"(tid_)); const int tid = tid_, lane = tid & 63, wid = __builtin_amdgcn_readfirstlane(tid >> 6), gw = vcu * NWAVES + wid; (void)gw; (void)lane
    gu32* ctl0 = (gu32*)(args.ws + WS_CTL);
    for (int u = threadIdx.x; u < (LDS_BYTES - LDSCTL_OFF) / 4; u += NTHR) ((LAS unsigned*)(lds + LDSCTL_OFF))[u] = 0u;
    __syncthreads();
    XcdBarrier bar = xcd_barrier_post((unsigned*)(ctl0 + CW_BAR), MISC + 8);
#define GRID_BAR() xcd_barrier(bar)
#define PHASE_PTRS() GAS unsigned char* wsg_ = (GAS unsigned char*)args.ws; asm volatile("" : "+s"(wsg_)); unsigned char* ws = (unsigned char*)wsg_; gu32* ctl = (gu32*)(ws + WS_CTL); (void)ctl; const float* x_in = args.in[0]; (void)x_in; \
    bf16* WIN = (bf16*)(ws + WS_WIN); bf16* WBRA = (bf16*)(ws + WS_WBRA); bf16* WBRB = (bf16*)(ws + WS_WBRB); bf16* WBRC = (bf16*)(ws + WS_WBRC); bf16* WOUT = (bf16*)(ws + WS_WOUT); \
    bf16* WGU = (bf16*)(ws + WS_WGU); bf16* WD = (bf16*)(ws + WS_WD); bf16* WCMP = (bf16*)(ws + WS_WCMP); \
    bf16* XB = (bf16*)(ws + WS_XB); bf16* Z = (bf16*)(ws + WS_Z); bf16* OA = (bf16*)(ws + WS_OA); float* MG = (float*)(ws + WS_MG); bf16* MB = (bf16*)(ws + WS_MB); \
    float* X1 = (float*)(ws + WS_X1); bf16* HB = (bf16*)(ws + WS_H); bf16* XS = (bf16*)(ws + WS_XS); bf16* YB = (bf16*)(ws + WS_Y); \
    unsigned char* sm = ws + WS_SMALL; \
    bf16* KCMP = (bf16*)(sm + SM_KCMP); bf16* VCMP = (bf16*)(sm + SM_VCMP); float* KMEAN = (float*)(sm + SM_KMEAN); \
    int* tok_e = (int*)(sm + SM_TOKE); float* tok_w = (float*)(sm + SM_TOKW); int* tok_p = (int*)(sm + SM_TOKP); int* rowts = (int*)(sm + SM_ROWTS); float* roww = (float*)(sm + SM_ROWW); int* panel_e = (int*)(sm + SM_PANE); int* hist = (int*)(sm + SM_HIST); int* cntg = (int*)(sm + SM_CNTG); (void)hist; (void)cntg; \
    (void)WIN; (void)WBRA; (void)WBRB; (void)WBRC; (void)WOUT; (void)WGU; (void)WD; (void)WCMP; (void)XB; (void)Z; (void)OA; (void)MG; (void)MB; (void)X1; (void)HB; (void)XS; (void)YB; \
    (void)KCMP; (void)VCMP; (void)KMEAN; (void)tok_e; (void)tok_w; (void)tok_p; (void)rowts; (void)roww; (void)panel_e
    const float alpha = 1.4142135623730951f;

    for (int l = 0; l < DEPTH; ++l) {
#if PHASES & 1
        for (int rep = 0; rep < 1 + ((DBL >> 0) & 1); ++rep) {
        { PHASE_IDS(); PHASE_PTRS();
            LAS unsigned* scr = (LAS unsigned*)(lds + RING_OFF + wid * 16384);
            const float* w_in = args.in[1] + (size_t)l * DM * 11032; const float* cmpw = args.in[3] + (size_t)l * 2 * 4096 * 128;
            const float* wbra = args.in[5] + (size_t)l * 1024 * DM; const float* wbrb = args.in[6] + (size_t)l * 512 * DM; const float* wbrc = args.in[7] + (size_t)l * 512 * DM;
            const float* wout = args.in[8] + (size_t)l * DM * DM;
            const float* wgate = args.in[15] + (size_t)l * NEXP * DM * DEXP; const float* wup = args.in[16] + (size_t)l * NEXP * DM * DEXP; const float* wdown = args.in[17] + (size_t)l * NEXP * DEXP * DM;
            for (int it = gw; it < CI_TOTAL; it += NGW) {
                int r = it; const float* W; bf16* WT; int ldw, k0, ns, nc = 64, ldt, nd;
                if (r >= CI_TOTAL - CI_ZERO) { r -= CI_TOTAL - CI_ZERO; v4u* zp = (v4u*)((unsigned char*)WIN + (size_t)(11032 + r) * DM); const v4u z4 = {0u, 0u, 0u, 0u};
#pragma unroll
                    for (int q = 0; q < 2; ++q) zp[lane + 64 * q] = z4;
                    continue; }
                if (r < CI_IN) { const int kb = r / 173, nb = r % 173;
                    if (nb < 40) { ns = 64 * nb; nd = ns; } else if (nb < 172) { ns = 2584 + 64 * (nb - 40); nd = 2560 + 64 * (nb - 40); } else { ns = 2560; nd = ZC_GA; nc = 24; }
                    cvt_item64_fp8(w_in, 11032, 64 * kb, ns, nc, (unsigned char*)WIN, DM, nd, FP8_WSCALE, scr, lane); continue; }
                if ((r -= CI_IN) < CI_BRA) { W = wbra; ldw = DM; k0 = 64 * (r / 32); ns = 64 * (r % 32); WT = WBRA; ldt = DM; nd = ns; }
                else if ((r -= CI_BRA) < CI_BRB) { W = wbrb; ldw = DM; k0 = 64 * (r / 32); ns = 64 * (r % 32); WT = WBRA + 1024; ldt = DM; nd = ns; }
                else if ((r -= CI_BRB) < CI_BRC) { W = wbrc; ldw = DM; k0 = 64 * (r / 32); ns = 64 * (r % 32); WT = WBRA + 1536; ldt = DM; nd = ns; }
                else if ((r -= CI_BRC) < CI_OUT) { W = wout; ldw = DM; k0 = 64 * (r / 32); ns = 64 * (r % 32); WT = WOUT; ldt = DM; nd = ns; }
                else if ((r -= CI_OUT) < CI_GU) { const int mat = r >> 7, e = mat >> 1, which = mat & 1, rr = r & 127, f0 = 64 * (rr & 3);
                    W = (which ? wup : wgate) + (size_t)e * DM * DEXP; ldw = DEXP; k0 = 64 * (rr >> 2); ns = f0; WT = WGU; ldt = DM; nd = e * 512 + (f0 >> 7) * 256 + which * 128 + (f0 & 127); }
                else if ((r -= CI_GU) < CI_D) { const int e = r >> 7, rr = r & 127; W = wdown + (size_t)e * DEXP * DM; ldw = DM; k0 = 64 * (rr >> 5); ns = 64 * (rr & 31); WT = WD; ldt = DEXP; nd = e * DM + ns; }
                else { r -= CI_D; const int kv = r >> 7, rr = r & 127; W = cmpw + (size_t)kv * 4096 * 128; ldw = 128; k0 = 64 * (rr >> 1); ns = 64 * (rr & 1); WT = WCMP; ldt = 4096; nd = kv * 128 + ns; }
                cvt_item64(W, ldw, k0, ns, nc, WT, ldt, nd, scr, lane);
            }
            if (l == 0) for (int row = gw; row < NT; row += NGW) { const f32x4* xr = (const f32x4*)(x_in + (size_t)row * DM);
#pragma unroll
                for (int j = 0; j < 8; ++j) { const f32x4 v = xr[lane + 64 * j]; ((unsigned*)((unsigned char*)XB + (size_t)row * DM))[lane + 64 * j] = pk4_fp8(v, FP8_XSCALE); } }
        }
        GRID_BAR(); }
#endif
#if PHASES & 2
        for (int rep = 0; rep < 1 + ((DBL >> 1) & 1); ++rep) {
        { PHASE_IDS(); PHASE_PTRS(); pg8::Gemm gm{XB, WIN, NT, ZP, DM / 2, DM / 2, FP8_SCA, FP8_SCB}; pg8::StaticOrder S; S.init(NT, ZP, G, bx);
          pg8::EpiZ E{Z, ZP, ZC_GM / 256};
          pg8::gemm_phase<pg8::EpiZ, pg8::StaticOrder, true, true, true>(lds + RING_OFF, gm, S, E); }
        GRID_BAR(); }
#endif
#if PHASES & 4
        for (int rep = 0; rep < 1 + ((DBL >> 2) & 1); ++rep) {
        { PHASE_IDS(); PHASE_PTRS(); const float* pos = args.in[2] + (size_t)l * 2 * 4096;
          for (int u = bx; u < 256; u += G) cmp_unit(u, Z, WCMP, pos, KCMP, VCMP, ldc, tid, lane, wid);
          for (int u = bx; u < 128; u += G) kmean_unit(u, Z, KMEAN, ldc, tid, lane, wid); }
        GRID_BAR(); }
#endif
#if PHASES & 8
        for (int rep = 0; rep < 1 + ((DBL >> 3) & 1); ++rep) {
        { PHASE_IDS(); PHASE_PTRS(); gu32* qw = ctl + CW_QUEUE + 64 * (2 * l + rep); const float* sink = args.in[4] + l * 8;
          LAS unsigned* uw = (LAS unsigned*)(ldc + att::A_UNI) + 2;
          for (;;) {
              if (tid == 0) *uw = __hip_atomic_fetch_add(qw, 1u, RLX_AGENT);
              __syncthreads();
              const unsigned qi = *uw;
              __syncthreads();
              if (qi >= (unsigned)N_ATT_UNITS) break;
              const int code = g_units.u[qi], kind = code >> 12;
              if (kind == 0) nsa_unit(code, Z, KCMP, VCMP, OA, ldc, tid, wid);
              else if (kind == 1) moba_unit(code, Z, KMEAN, OA, ldc, tid, wid);
              else swa_unit(code, Z, sink, OA, ldc, tid, wid);
          } }
        GRID_BAR(); }
#endif
#if PHASES & 16
        for (int rep = 0; rep < 1 + ((DBL >> 4) & 1); ++rep) {
        { PHASE_IDS(); PHASE_PTRS(); pg8::StaticOrder S; S.init(NT, DM, G, bx);
          pg8::Gemm gm{OA, WBRA, NT, DM, DM, DM}; pg8::EpiBrM E{MB, Z + ZC_GM, ZP};
          pg8::gemm_phase<pg8::EpiBrM, pg8::StaticOrder, true, true>(lds + RING_OFF, gm, S, E); }
        GRID_BAR(); }
#endif
#if PHASES & 32
        for (int rep = 0; rep < 1 + ((DBL >> 5) & 1); ++rep) {
        { PHASE_IDS(); PHASE_PTRS(); pg8::Gemm gm{MB, WOUT, NT, DM, DM, DM}; pg8::StaticOrder S; S.init(NT, DM, G, bx);
          pg8::EpiRes E{MG, l == 0 ? x_in : (const float*)X1, alpha};
          pg8::gemm_phase<pg8::EpiRes, pg8::StaticOrder, true, true>(lds + RING_OFF, gm, S, E); }
        GRID_BAR(); }
#endif
#if PHASES & 64
        for (int rep = 0; rep < 1 + ((DBL >> 6) & 1); ++rep) {
        { PHASE_IDS(); PHASE_PTRS(); const float* g1 = args.in[9] + l * DM; const float* b1 = args.in[10] + l * DM;
          const float* wgrp = args.in[11] + (size_t)l * DM * 4; const float* bgrp = args.in[12] + l * 4; const float* wrt = args.in[13] + (size_t)l * DM * 32; const float* brt = args.in[14] + l * 32;
          for (int t = bx; t < NT / 32; t += G) ln_router_tile(t, MG, g1, b1, X1, MB, wgrp, bgrp, wrt, brt, hist, tok_e, tok_w, tok_p, ldc, tid, lane, wid); }
        GRID_BAR(); }
#endif
#if PHASES & 128
        for (int rep = 0; rep < 1 + ((DBL >> 7) & 1); ++rep) {
        { PHASE_IDS(); PHASE_PTRS();
          const LAS int* off_l = (const LAS int*)ldc; const LAS int* cnt_l = (const LAS int*)(ldc + 256); const LAS int* pre_l = (const LAS int*)(ldc + 512);
          for (int tile = bx; tile < NT / 32; tile += G) {
              const int total = moe_offsets_hist(hist, tile, ldc, tid);
              if (tile == bx) {
                  for (int r = bx * NTHR + tid; r < total; r += G * NTHR) { int e = 0;
                      for (int kk = 1; kk < 32; ++kk) if (off_l[kk] <= r) e = kk;
                      if (r >= off_l[e] + cnt_l[e]) { rowts[r] = -1; roww[r] = 0.f; }
                      if ((r & 255) == 0) panel_e[r >> 8] = e; }
                  if (bx == 0 && tid < 32) cntg[tid] = cnt_l[tid]; }
              for (int q = 0; q < 8; ++q) { const int p = tile * 64 + wid * 8 + q; const int e = tok_e[p], row = off_l[e] + pre_l[e] + tok_p[p]; const int token = p >> 1;
                  const v4u* src = (const v4u*)(MB + (size_t)token * DM); v4u* dst = (v4u*)(XS + (size_t)row * DM);
#pragma unroll
                  for (int qq = 0; qq < 4; ++qq) dst[lane + 64 * qq] = src[lane + 64 * qq];
                  if (lane == 0) { rowts[row] = p; roww[row] = tok_w[p]; } }
              __syncthreads(); }
          __syncthreads(); }
        GRID_BAR(); }
#endif
#if PHASES & 256
        for (int rep = 0; rep < 1 + ((DBL >> 8) & 1); ++rep) {
        { PHASE_IDS(); PHASE_PTRS();
          const int total = moe_offsets(cntg, ldc, tid);
          __syncthreads();
          pg8::Gemm gm{XS, WGU, ROWCAP, NEXP * 512, DM, DM}; pg8::MoeOrder<2> S{(total >> 8) * 2, G, bx, panel_e};
          pg8::EpiGU E{HB, roww};
          pg8::gemm_phase<pg8::EpiGU, pg8::MoeOrder<2>, true, true>(lds + RING_OFF, gm, S, E); }
        GRID_BAR(); }
#endif
#if PHASES & 512
        for (int rep = 0; rep < 1 + ((DBL >> 9) & 1); ++rep) {
        { PHASE_IDS(); PHASE_PTRS();
          const int total = moe_offsets(cntg, ldc, tid);
          __syncthreads();
          pg8::Gemm gm{HB, WD, ROWCAP, NEXP * DM, DEXP, DEXP}; pg8::MoeOrder<8> S{(total >> 8) * 8, G, bx, panel_e};
          pg8::EpiDown E{XS, (unsigned)((WS_Y - WS_XS) / 2), rowts};
          pg8::gemm_phase<pg8::EpiDown, pg8::MoeOrder<8>, true, true>(lds + RING_OFF, gm, S, E); }
        GRID_BAR(); }
#endif
#if PHASES & 1024
        for (int rep = 0; rep < 1 + (((DBL >> 10) & 1) && l == DEPTH - 1 ? 1 : 0); ++rep) {
        { PHASE_IDS(); PHASE_PTRS(); const float* g2 = args.in[18] + l * DM; const float* b2 = args.in[19] + l * DM; const bool last = (l == DEPTH - 1); float* xo = last ? args.out : X1;
          for (int row = gw; row < NT; row += NGW) { f32x4 v[8];
#pragma unroll
              for (int j = 0; j < 8; ++j) { const f32x4 a = ((const f32x4*)(X1 + (size_t)row * DM))[lane + 64 * j];
                  const v2u y0 = ((const v2u*)(YB + (size_t)row * DM))[lane + 64 * j], y1 = ((const v2u*)(YB + ((size_t)NT + row) * DM))[lane + 64 * j];
                  v[j][0] = a[0] * alpha + (bflo(y0.x) + bflo(y1.x)); v[j][1] = a[1] * alpha + (bfhi(y0.x) + bfhi(y1.x));
                  v[j][2] = a[2] * alpha + (bflo(y0.y) + bflo(y1.y)); v[j][3] = a[3] * alpha + (bfhi(y0.y) + bfhi(y1.y)); }
              ln_row(v, g2, b2, lane);
#pragma unroll
              for (int j = 0; j < 8; ++j) { ((f32x4*)(xo + (size_t)row * DM))[lane + 64 * j] = v[j];
                  if (!last) ((unsigned*)((unsigned char*)XB + (size_t)row * DM))[lane + 64 * j] = pk4_fp8(v[j], FP8_XSCALE); } } }
        if (l + 1 < DEPTH) GRID_BAR(); }
#endif
    }
}

extern "C" void kernel_launch(void* const* d_in, const int* in_sizes, int n_in, void* d_out, int out_size, void* d_ws, size_t ws_size, hipStream_t stream) {
    static int grid = 0;
    if (grid == 0) {
        if (n_in != 20 || in_sizes[0] != NT * DM || out_size != NT * DM || ws_size < WS_END) { fprintf(stderr, "kernel_launch: unexpected shapes (n_in %d, in0 %d, out %d, ws %zu < %zu?)\n", n_in, n_in > 0 ? in_sizes[0] : -1, out_size, ws_size, (size_t)WS_END); grid = -1; return; }
        int dev = 0, cus = 0, per_cu = 0;
        if (hipGetDevice(&dev) != hipSuccess || hipDeviceGetAttribute(&cus, hipDeviceAttributeMultiprocessorCount, dev) != hipSuccess) { grid = -1; return; }
        if (hipFuncSetAttribute((const void*)fwd_kernel, hipFuncAttributeMaxDynamicSharedMemorySize, LDS_BYTES) != hipSuccess) { fprintf(stderr, "kernel_launch: hipFuncSetAttribute failed\n"); grid = -1; return; }
        if (hipOccupancyMaxActiveBlocksPerMultiprocessor(&per_cu, (const void*)fwd_kernel, NTHR, LDS_BYTES) != hipSuccess || per_cu < 1) fprintf(stderr, "kernel_launch: occupancy query reports %d\n", per_cu);
        (void)hipGetLastError();
        grid = cus;
    }
    if (grid < 0) return;
    if (hipMemsetAsync((char*)d_ws + WS_CTL, 0, CTL_ZERO_BYTES, stream) != hipSuccess) return;
    Args a{};
    for (int i = 0; i < 20; ++i) a.in[i] = (const float*)d_in[i];
    a.out = (float*)d_out; a.ws = (unsigned char*)d_ws;
    hipLaunchKernelGGL(fwd_kernel, dim3(grid), dim3(NTHR), LDS_BYTES, stream, a);
    const hipError_t le = hipPeekAtLastError();
    if (le != hipSuccess) fprintf(stderr, "kernel_launch: launch failed: %s\n", hipGetErrorName(le));
}
```

```cpp
#include <hip/hip_runtime.h>
#include <cstdio>
#include <cstdint>
namespace pg8 {
#define PG8_LAS __attribute__((address_space(3)))
typedef unsigned short bf16_t;
typedef short bf16x8 __attribute__((ext_vector_type(8)));
typedef float f32x4 __attribute__((ext_vector_type(4)));
typedef unsigned u32x4 __attribute__((ext_vector_type(4)));
constexpr int BM = 256, BK = 64, HALF = 128, HTB = HALF * BK * 2  , STAGE_BYTES = 8 * HTB, NXCD = 8, WGM = 8;

__host__ __device__ __forceinline__ int lds_byte(int r, int c) { const int st = (r >> 4) * 2 + (c >> 5), rr = r & 15, cc = c & 31, ob = rr * 64 + cc * 2; return st * 1024 + (ob ^ (((ob >> 9) & 1) << 5)); }
__host__ __device__ __forceinline__ void stage_rc(int b, int& R, int& C) { const int st = b / 1024, sb = b % 1024, swz = sb ^ (((sb >> 9) & 1) << 5); R = (st >> 1) * 16 + swz / 64; C = (st & 1) * 32 + (swz % 64) / 2; }
__host__ __device__ __forceinline__ int perm32(int rho) { const int n = rho >> 4, i = rho & 15; return 8 * (i >> 2) + 4 * n + (i & 3); }

struct Unit { int pm, pn; };
struct Gemm { const bf16_t* A; const bf16_t* Bt; int M, N, K, lda; int sca = 0x7f7f7f7f, scb = 0x7f7f7f7f; };
typedef int i32x8 __attribute__((ext_vector_type(8)));

struct StaticOrder {
    int nM, nN, nwg, G, c;
    __host__ __device__ void init(int M, int N, int G_, int c_) { nM = M / BM; nN = N / BM; nwg = nM * nN; G = G_; c = c_; }
    __host__ __device__ bool next(int i, Unit& u) const {
        const long L = (long)i * G + c; if (L >= nwg) return false;
        int wgid = (int)L; { const int q = nwg / NXCD, r = nwg % NXCD, xcd = wgid % NXCD, off = wgid / NXCD; wgid = (xcd < r ? xcd * (q + 1) : r * (q + 1) + (xcd - r) * q) + off; }
        const int nig = WGM * nN, gid = wgid / nig, fm = gid * WGM, gsz = (nM - fm) < WGM ? (nM - fm) : WGM;
        u.pm = fm + ((wgid % nig) % gsz); u.pn = (wgid % nig) / gsz; return true;
    }
    __device__ __forceinline__ void a_ready(const Unit&) const {}
    __device__ __forceinline__ void done(const Unit&) const {}
};
__device__ __forceinline__ unsigned cvt_pk_bf16(float lo, float hi) { unsigned r; asm volatile("v_cvt_pk_bf16_f32 %0, %1, %2" : "=v"(r) : "v"(lo), "v"(hi)); return r; }
__device__ __forceinline__ float bf_lo(unsigned w) { return __uint_as_float(w << 16); }
__device__ __forceinline__ float bf_hi(unsigned w) { return __uint_as_float(w & 0xffff0000u); }
__device__ __forceinline__ float sigmoidf_(float x) { return __builtin_amdgcn_rcpf(1.0f + __builtin_amdgcn_exp2f(-1.4426950408889634f * x)); }
typedef unsigned u32x2 __attribute__((ext_vector_type(2)));

struct EpiZ {
    static constexpr bool PERM = false, AFTER_DRAIN = false, HOOK = false; static constexpr int HK0 = -1, HK1 = -1;
    bf16_t* O; int ldc; int sig_from;
    __device__ __forceinline__ void operator()(const f32x4 (&acc)[2][2][4][2], const Unit& u, int wr, int wc, int, int) const {
        int t_ = threadIdx.x; asm volatile("" : "+v"(t_)); const int fr = t_ & 15, fq = (t_ >> 4) & 3;
        const int row0 = u.pm * BM + wr * 64 + fr, col0 = u.pn * BM + wc * 32 + 4 * fq; const bool sg = u.pn >= sig_from;
        unsigned eo = (unsigned)row0 * (unsigned)ldc + (unsigned)col0;
#pragma unroll
        for (int ai = 0; ai < 2; ++ai)
#pragma unroll
            for (int m = 0; m < 4; ++m) { asm volatile("" : "+v"(eo)); bf16_t* rowp = O + eo; eo += (unsigned)((m == 3 ? HALF - 48 : 16) * ldc);
#pragma unroll
                for (int bj = 0; bj < 2; ++bj)
#pragma unroll
                    for (int n = 0; n < 2; ++n) { f32x4 v = acc[ai][bj][m][n];
                        if (sg) {
#pragma unroll
                            for (int j = 0; j < 4; ++j) v[j] = sigmoidf_(v[j]); }
                        u32x2 w; w.x = cvt_pk_bf16(v[0], v[1]); w.y = cvt_pk_bf16(v[2], v[3]);
                        *(u32x2*)(rowp + bj * HALF + n * 16) = w; }
                asm volatile("" ::: "memory"); }
    }
};
struct EpiBrM {
    static constexpr bool PERM = false, AFTER_DRAIN = false, HOOK = true; static constexpr int HK0 = 16, HK1 = 24;
    bf16_t* MB; const bf16_t* Zg; int ldz;
    __device__ __forceinline__ void mid(f32x4 (&acc)[2][2][4][2], const Unit& u, int wr, int wc, int, int, int kt) const {
        int t_ = threadIdx.x; asm volatile("" : "+v"(t_)); const int fr = t_ & 15, fq = (t_ >> 4) & 3;
        const int row0 = u.pm * BM + wr * 64 + fr, col0 = u.pn * BM + wc * 32 + 4 * fq; const bf16_t* zs = Zg + (kt == HK0 ? 0 : 2048);
        unsigned eo = (unsigned)row0 * (unsigned)ldz + (unsigned)col0;
#pragma unroll
        for (int ai = 0; ai < 2; ++ai)
#pragma unroll
            for (int m = 0; m < 4; ++m) { asm volatile("" : "+v"(eo)); const bf16_t* zr = zs + eo; eo += (unsigned)((m == 3 ? HALF - 48 : 16) * ldz);
#pragma unroll
                for (int bj = 0; bj < 2; ++bj)
#pragma unroll
                    for (int n = 0; n < 2; ++n) { const u32x2 ga = *(const u32x2*)(zr + bj * HALF + n * 16), gb = *(const u32x2*)(zr + 2048 + bj * HALF + n * 16);
                        f32x4 v = acc[ai][bj][m][n];
                        v[0] *= bf_lo(ga.x) * __builtin_amdgcn_rcpf(fmaxf(bf_lo(gb.x), 1e-30f)); v[1] *= bf_hi(ga.x) * __builtin_amdgcn_rcpf(fmaxf(bf_hi(gb.x), 1e-30f));
                        v[2] *= bf_lo(ga.y) * __builtin_amdgcn_rcpf(fmaxf(bf_lo(gb.y), 1e-30f)); v[3] *= bf_hi(ga.y) * __builtin_amdgcn_rcpf(fmaxf(bf_hi(gb.y), 1e-30f));
                        acc[ai][bj][m][n] = v; }
                asm volatile("" ::: "memory"); }
    }
    __device__ __forceinline__ void operator()(const f32x4 (&acc)[2][2][4][2], const Unit& u, int wr, int wc, int, int) const {
        int t_ = threadIdx.x; asm volatile("" : "+v"(t_)); const int fr = t_ & 15, fq = (t_ >> 4) & 3;
        const int row0 = u.pm * BM + wr * 64 + fr, col0 = u.pn * BM + wc * 32 + 4 * fq;
#pragma unroll
        for (int ai = 0; ai < 2; ++ai)
#pragma unroll
            for (int m = 0; m < 4; ++m) { const int row = row0 + ai * HALF + m * 16;
#pragma unroll
                for (int bj = 0; bj < 2; ++bj)
#pragma unroll
                    for (int n = 0; n < 2; ++n) { const int col = col0 + bj * HALF + n * 16;
                        const u32x2 gw = *(const u32x2*)(Zg + (size_t)row * ldz + 4096 + col);
                        f32x4 v = acc[ai][bj][m][n]; v[0] *= bf_lo(gw.x); v[1] *= bf_hi(gw.x); v[2] *= bf_lo(gw.y); v[3] *= bf_hi(gw.y);
                        u32x2 w; w.x = cvt_pk_bf16(v[0], v[1]); w.y = cvt_pk_bf16(v[2], v[3]); *(u32x2*)(MB + (size_t)row * 2048 + col) = w; }
                asm volatile("" ::: "memory"); }
    }
};
struct EpiRes {
    static constexpr bool PERM = false, AFTER_DRAIN = false, HOOK = false; static constexpr int HK0 = -1, HK1 = -1;
    float* R; const float* xres; float alpha;
    __device__ __forceinline__ void operator()(const f32x4 (&acc)[2][2][4][2], const Unit& u, int wr, int wc, int, int) const {
        int t_ = threadIdx.x; asm volatile("" : "+v"(t_)); const int fr = t_ & 15, fq = (t_ >> 4) & 3;
        const int row0 = u.pm * BM + wr * 64 + fr, col0 = u.pn * BM + wc * 32 + 4 * fq;
#pragma unroll
        for (int ai = 0; ai < 2; ++ai)
#pragma unroll
            for (int m = 0; m < 4; ++m) { const size_t off = (size_t)(row0 + ai * HALF + m * 16) * 2048 + col0;
#pragma unroll
                for (int bj = 0; bj < 2; ++bj)
#pragma unroll
                    for (int n = 0; n < 2; ++n) { const f32x4 xr = *(const f32x4*)(xres + off + bj * HALF + n * 16);
                        *(f32x4*)(R + off + bj * HALF + n * 16) = xr * alpha + acc[ai][bj][m][n]; } }
    }
};
struct EpiGU {
    static constexpr bool PERM = false, AFTER_DRAIN = false, HOOK = false; static constexpr int HK0 = -1, HK1 = -1;
    bf16_t* H; const float* roww;
    __device__ __forceinline__ void operator()(const f32x4 (&acc)[2][2][4][2], const Unit& u, int wr, int wc, int, int) const {
        int t_ = threadIdx.x; asm volatile("" : "+v"(t_)); const int fr = t_ & 15, fq = (t_ >> 4) & 3;
        const int row0 = u.pm * BM + wr * 64 + fr, col0 = (u.pn & 1) * HALF + wc * 32 + 4 * fq;
#pragma unroll
        for (int ai = 0; ai < 2; ++ai)
#pragma unroll
            for (int m = 0; m < 4; ++m) { const int row = row0 + ai * HALF + m * 16; const float w = roww[row];
#pragma unroll
                for (int n = 0; n < 2; ++n) { const f32x4 gt = acc[ai][0][m][n], up = acc[ai][1][m][n]; f32x4 h;
#pragma unroll
                    for (int j = 0; j < 4; ++j) h[j] = gt[j] * sigmoidf_(gt[j]) * up[j] * w;
                    u32x2 o; o.x = cvt_pk_bf16(h[0], h[1]); o.y = cvt_pk_bf16(h[2], h[3]);
                    *(u32x2*)(H + (size_t)row * 256 + col0 + n * 16) = o; }
                asm volatile("" ::: "memory"); }
    }
};
struct EpiDown {
    static constexpr bool PERM = true, AFTER_DRAIN = false, HOOK = false; static constexpr int HK0 = -1, HK1 = -1;
    bf16_t* dump; unsigned yoff; const int* rowts;
    __device__ __forceinline__ void operator()(const f32x4 (&acc)[2][2][4][2], const Unit& u, int wr, int wc, int, int) const {
        int t_ = threadIdx.x; asm volatile("" : "+v"(t_)); const int fr = t_ & 15, fq = (t_ >> 4) & 3;
        const int row0 = u.pm * BM + wr * 64 + fr, col0 = (u.pn & 7) * BM + wc * 32 + 8 * fq;
#pragma unroll
        for (int ai = 0; ai < 2; ++ai)
#pragma unroll
            for (int m = 0; m < 4; ++m) { const int row = row0 + ai * HALF + m * 16; const int ts = rowts[row];
                const unsigned eo = (ts >= 0 ? yoff + (unsigned)((ts & 1) * 8192 + (ts >> 1)) * 2048u : (unsigned)row * 2048u) + (unsigned)col0;
                bf16_t* rowp = dump + eo;
#pragma unroll
                for (int bj = 0; bj < 2; ++bj) { const f32x4 v0 = acc[ai][bj][m][0], v1 = acc[ai][bj][m][1];
                    u32x4 w; w.x = cvt_pk_bf16(v0[0], v0[1]); w.y = cvt_pk_bf16(v0[2], v0[3]); w.z = cvt_pk_bf16(v1[0], v1[1]); w.w = cvt_pk_bf16(v1[2], v1[3]);
                    *(u32x4*)(rowp + bj * HALF) = w; }
                asm volatile("" ::: "memory"); }
    }
};
template <int NPER> struct MoeOrder {
    int total, G, c; const int* panel_e;
    __device__ __forceinline__ bool next(int i, Unit& u) const { const int L = i * G + c; if (L >= total) return false; const int pm = L / NPER; u.pm = pm; u.pn = panel_e[pm] * NPER + (L % NPER); return true; }
    __device__ __forceinline__ void a_ready(const Unit&) const {}
    __device__ __forceinline__ void done(const Unit&) const {}
};

template <bool F8> struct Frags { bf16x8 At[4][2], B0[2][2], B1[2][2]; };
template <> struct Frags<true> { i32x8 At8[4], B08[2], B18[2]; };
template <class Epi, class Sched, bool ALIGN_EPI = false, bool SP2 = false, bool FP8 = false>
__device__ __forceinline__ void gemm_phase(PG8_LAS unsigned char* lds, const Gemm g, const Sched& S, const Epi& E) {
    int tid_ = threadIdx.x; asm volatile("" : "+v"(tid_));
    const int tid = tid_, wid = __builtin_amdgcn_readfirstlane(tid >> 6), lane = tid & 63, wr = wid >> 2, wc = wid & 3, fr = lane & 15, fq = lane >> 4;
    const int K = g.K, nt = K / BK, LDA = g.lda;
    unsigned voffA[2], voffB[2];
#pragma unroll
    for (int i = 0; i < 2; ++i) { int R, C; stage_rc(tid * 16 + i * 8192, R, C); const int Rb = Epi::PERM ? ((R & ~31) + perm32(R & 31)) : R;
        voffA[i] = (unsigned)(R * LDA + C) * 2u; voffB[i] = (unsigned)(Rb * K + C) * 2u; }
    const size_t kstep = (size_t)(BK * 2);
    const size_t hstep = (size_t)HALF * K * 2, hstepA = (size_t)HALF * LDA * 2;
    const size_t tstep = 2 * hstep, tstepA = 2 * hstepA;
    const unsigned ldsbase = (unsigned)__builtin_amdgcn_readfirstlane((int)(unsigned)(uintptr_t)lds + wid * 1024);
    const unsigned ldsw = (unsigned)wid * 1024u;
    const int aoff = lds_byte(wr * 64 + fr, fq * 8), boff = lds_byte(wc * 32 + fr, fq * 8);
#define PG8_CAT(x0, x1) __builtin_bit_cast(i32x8, __builtin_shufflevector(x0, x1, 0, 1, 2, 3, 4, 5, 6, 7, 8, 9, 10, 11, 12, 13, 14, 15))
#define PG8_SA(b, h) (((b) * 2 + (h)) * HTB)
#define PG8_SB(b, h) ((4 + (b) * 2 + (h)) * HTB)
#define PG8_STAGE(bufoff, gbase, voff) do { if constexpr (FP8) { _Pragma("unroll") for (int _i = 0; _i < 2; ++_i) { \
            asm volatile("s_mov_b32 m0, %2\n\ts_nop 0\n\tglobal_load_lds_dwordx4 %0, %1" :: "v"((voff)[_i]), "s"((const char*)(gbase)), "s"(ldsbase + (unsigned)((bufoff) + _i * 8192)) : "memory", "m0"); } } \
        else { _Pragma("unroll") for (int _i = 0; _i < 2; ++_i) \
        __builtin_amdgcn_global_load_lds((const unsigned*)((const char*)(gbase) + (voff)[_i]), (PG8_LAS unsigned*)(lds + (bufoff) + ldsw + _i * 8192), 16, 0, 0); } } while (0)
#define PG8_LDA(dst, b, h) do { if constexpr (FP8) { _Pragma("unroll") for (int m = 0; m < 4; ++m) fg.dst##8[m] = PG8_CAT(*(const PG8_LAS bf16x8*)(lds + PG8_SA(b, h) + aoff + m * 2048), *(const PG8_LAS bf16x8*)(lds + PG8_SA(b, h) + aoff + m * 2048 + 1024)); } \
        else { _Pragma("unroll") for (int m = 0; m < 4; ++m) _Pragma("unroll") for (int k = 0; k < 2; ++k) fg.dst[m][k] = *(const PG8_LAS bf16x8*)(lds + PG8_SA(b, h) + aoff + m * 2048 + k * 1024); } } while (0)
#define PG8_LDB(dst, b, h) do { if constexpr (FP8) { _Pragma("unroll") for (int n = 0; n < 2; ++n) fg.dst##8[n] = PG8_CAT(*(const PG8_LAS bf16x8*)(lds + PG8_SB(b, h) + boff + n * 2048), *(const PG8_LAS bf16x8*)(lds + PG8_SB(b, h) + boff + n * 2048 + 1024)); } \
        else { _Pragma("unroll") for (int n = 0; n < 2; ++n) _Pragma("unroll") for (int k = 0; k < 2; ++k) fg.dst[n][k] = *(const PG8_LAS bf16x8*)(lds + PG8_SB(b, h) + boff + n * 2048 + k * 1024); } } while (0)
#define PG8_MMA(ai, bj, At, Bt) do { __builtin_amdgcn_s_setprio(1); \
        if constexpr (FP8) { _Pragma("unroll") for (int m = 0; m < 4; ++m) _Pragma("unroll") for (int n = 0; n < 2; ++n) \
            acc[ai][bj][m][n] = __builtin_amdgcn_mfma_scale_f32_16x16x128_f8f6f4(fg.Bt##8[n], fg.At##8[m], acc[ai][bj][m][n], 0, 0, 0, g.scb, 0, g.sca); } \
        else { _Pragma("unroll") for (int m = 0; m < 4; ++m) _Pragma("unroll") for (int n = 0; n < 2; ++n) _Pragma("unroll") for (int k = 0; k < 2; ++k) \
            acc[ai][bj][m][n] = __builtin_amdgcn_mfma_f32_16x16x32_bf16(fg.Bt[n][k], fg.At[m][k], acc[ai][bj][m][n], 0, 0, 0); } \
        __builtin_amdgcn_s_setprio(0); } while (0)
#define PG8_WAIT_V(n) asm volatile("s_waitcnt vmcnt(" #n ")" ::: "memory")
#define PG8_WAIT_L(n) asm volatile("s_waitcnt lgkmcnt(" #n ")" ::: "memory")
#define PG8_BAR __builtin_amdgcn_s_barrier()
#define PG8_SCHED __builtin_amdgcn_sched_barrier(0)
    Unit cur, nxt; int ui = 0;
    if (!S.next(0, cur)) return;
    f32x4 acc[2][2][4][2];
#pragma unroll
    for (int a = 0; a < 2; ++a)
#pragma unroll
        for (int b = 0; b < 2; ++b)
#pragma unroll
            for (int m = 0; m < 4; ++m)
#pragma unroll
                for (int n = 0; n < 2; ++n) acc[a][b][m][n] = (f32x4){0.f, 0.f, 0.f, 0.f};
    Frags<FP8> fg;
    const char* cA = (const char*)g.A + (size_t)cur.pm * tstepA; const char* cB = (const char*)g.Bt + (size_t)cur.pn * tstep;
    S.a_ready(cur);
    if constexpr (SP2) {
        PG8_STAGE(PG8_SB(0, 0), cB, voffB); PG8_STAGE(PG8_SB(0, 1), cB + hstep, voffB); PG8_STAGE(PG8_SA(0, 0), cA, voffA); PG8_STAGE(PG8_SA(0, 1), cA + hstepA, voffA);
        if (wr == 1) PG8_BAR;
        PG8_WAIT_V(2); PG8_BAR;
        PG8_STAGE(PG8_SB(1, 0), cB + kstep, voffB); PG8_STAGE(PG8_SA(1, 0), cA + kstep, voffA); PG8_STAGE(PG8_SB(1, 1), cB + hstep + kstep, voffB);
        PG8_WAIT_V(6); PG8_BAR;
    } else {
        PG8_STAGE(PG8_SB(0, 0), cB, voffB); PG8_STAGE(PG8_SA(0, 0), cA, voffA); PG8_STAGE(PG8_SB(0, 1), cB + hstep, voffB); PG8_STAGE(PG8_SA(0, 1), cA + hstepA, voffA);
        if (wr == 1) PG8_BAR;
        PG8_WAIT_V(4); PG8_BAR;
        PG8_STAGE(PG8_SB(1, 0), cB + kstep, voffB); PG8_STAGE(PG8_SA(1, 0), cA + kstep, voffA); PG8_STAGE(PG8_SB(1, 1), cB + hstep + kstep, voffB);
        PG8_WAIT_V(6); PG8_BAR;
    }
    for (;;) {
        const bool has_next = S.next(ui + 1, nxt);
        const char* nA = has_next ? (const char*)g.A + (size_t)nxt.pm * tstepA : cA; const char* nB = has_next ? (const char*)g.Bt + (size_t)nxt.pn * tstep : cB;
#pragma nounroll
        for (int t = 0; t < nt; t += 2) {
            const bool last = (t == nt - 2);
            const char* a1 = cA + (size_t)(t + 1) * kstep;
            const char* a2 = last ? nA : cA + (size_t)(t + 2) * kstep; const char* b2 = last ? nB : cB + (size_t)(t + 2) * kstep;
            const char* a3 = a2 + kstep; const char* b3 = b2 + kstep;
            if (last && has_next) S.a_ready(nxt);
            if constexpr (SP2) {
            PG8_LDB(B0, 0, 0); PG8_LDB(B1, 0, 1); PG8_SCHED; PG8_LDA(At, 0, 0); PG8_STAGE(PG8_SA(1, 1), a1 + hstepA, voffA);
            PG8_WAIT_V(8); PG8_WAIT_L(0); PG8_BAR; PG8_MMA(0, 0, At, B0); PG8_MMA(0, 1, At, B1); PG8_BAR; PG8_SCHED;
            PG8_LDA(At, 0, 1); PG8_STAGE(PG8_SB(0, 0), b2, voffB); PG8_STAGE(PG8_SB(0, 1), b2 + hstep, voffB); PG8_STAGE(PG8_SA(0, 0), a2, voffA);
            PG8_WAIT_V(8); PG8_WAIT_L(0); PG8_BAR; PG8_MMA(1, 0, At, B0); PG8_MMA(1, 1, At, B1); PG8_BAR; PG8_SCHED;
            PG8_LDB(B0, 1, 0); PG8_LDB(B1, 1, 1); PG8_SCHED; PG8_LDA(At, 1, 0); PG8_STAGE(PG8_SA(0, 1), a2 + hstepA, voffA);
            PG8_WAIT_V(8); PG8_WAIT_L(0); PG8_BAR; PG8_MMA(0, 0, At, B0); PG8_MMA(0, 1, At, B1); PG8_BAR; PG8_SCHED;
            PG8_LDA(At, 1, 1); PG8_STAGE(PG8_SB(1, 0), b3, voffB); PG8_STAGE(PG8_SB(1, 1), b3 + hstep, voffB); PG8_STAGE(PG8_SA(1, 0), a3, voffA);
            PG8_WAIT_V(8); PG8_WAIT_L(0); PG8_BAR; PG8_MMA(1, 0, At, B0); PG8_MMA(1, 1, At, B1); PG8_BAR; PG8_SCHED;
            if constexpr (Epi::HOOK) { if (t + 2 == Epi::HK0 || t + 2 == Epi::HK1) E.mid(acc, cur, wr, wc, fr, fq, t + 2); }
            } else {
            PG8_LDB(B0, 0, 0); PG8_SCHED; PG8_LDA(At, 0, 0); PG8_STAGE(PG8_SA(1, 1), a1 + hstepA, voffA);
            PG8_WAIT_L(8); PG8_BAR; PG8_WAIT_L(0); PG8_MMA(0, 0, At, B0); PG8_BAR; PG8_SCHED;
            PG8_LDB(B1, 0, 1); PG8_STAGE(PG8_SB(0, 0), b2, voffB);
            PG8_BAR; PG8_WAIT_L(0); PG8_MMA(0, 1, At, B1); PG8_BAR;
            PG8_LDA(At, 0, 1); PG8_STAGE(PG8_SA(0, 0), a2, voffA);
            PG8_BAR; PG8_WAIT_L(0); PG8_MMA(1, 0, At, B0); PG8_BAR; PG8_SCHED;
            PG8_STAGE(PG8_SB(0, 1), b2 + hstep, voffB);
            PG8_WAIT_V(6); PG8_BAR; PG8_MMA(1, 1, At, B1); PG8_BAR;
            PG8_LDB(B0, 1, 0); PG8_SCHED; PG8_LDA(At, 1, 0); PG8_STAGE(PG8_SA(0, 1), a2 + hstepA, voffA);
            PG8_WAIT_L(8); PG8_BAR; PG8_WAIT_L(0); PG8_MMA(0, 0, At, B0); PG8_BAR; PG8_SCHED;
            PG8_LDB(B1, 1, 1); PG8_STAGE(PG8_SB(1, 0), b3, voffB);
            PG8_BAR; PG8_WAIT_L(0); PG8_MMA(0, 1, At, B1); PG8_BAR;
            PG8_LDA(At, 1, 1); PG8_STAGE(PG8_SA(1, 0), a3, voffA);
            PG8_BAR; PG8_WAIT_L(0); PG8_MMA(1, 0, At, B0); PG8_BAR; PG8_SCHED;
            PG8_STAGE(PG8_SB(1, 1), b3 + hstep, voffB);
            PG8_WAIT_V(6); PG8_BAR; PG8_MMA(1, 1, At, B1); PG8_BAR;
            }
        }
        if constexpr (ALIGN_EPI) { if (wr == 0) PG8_BAR; }
        if constexpr (!Epi::AFTER_DRAIN) { E(acc, cur, wr, wc, fr, fq); S.done(cur); }
        if (!has_next) break;
#pragma unroll
        for (int a = 0; a < 2; ++a)
#pragma unroll
            for (int b = 0; b < 2; ++b)
#pragma unroll
                for (int m = 0; m < 4; ++m)
#pragma unroll
                    for (int n = 0; n < 2; ++n) acc[a][b][m][n] = (f32x4){0.f, 0.f, 0.f, 0.f};
        cur = nxt; cA = nA; cB = nB; ++ui;
        if constexpr (ALIGN_EPI) { if (wr == 1) PG8_BAR; }
    }
    PG8_WAIT_V(0);
    if constexpr (!ALIGN_EPI) { if (wr == 0) PG8_BAR; }
    PG8_BAR;
    if constexpr (Epi::AFTER_DRAIN) { E.fused(acc, cur, wr, wc, fr, fq, lds, wid, lane); S.done(cur); }
#undef PG8_SA
#undef PG8_SB
#undef PG8_STAGE
#undef PG8_LDA
#undef PG8_LDB
#undef PG8_MMA
#undef PG8_CAT
#undef PG8_WAIT_V
#undef PG8_WAIT_L
#undef PG8_BAR
#undef PG8_SCHED
}
}

constexpr int NWAVES = 8, NTHR = 512;
constexpr int DM = 2048, NB = 4, SEQ = 2048, NT = NB * SEQ, DEPTH = 2;
constexpr int ZP = 11264;
constexpr int ZC_QA = 0, ZC_KVA = 1024, ZC_QB = 2560, ZC_KB = 3072, ZC_VB = 3200, ZC_QC = 3328, ZC_KC = 3840, ZC_VC = 4352, ZC_GM = 4864, ZC_GA = 11008;
constexpr int OC_A = 0, OC_B = 1024, OC_C = 1536;
constexpr int NEXP = 32, DEXP = 256, ROWCAP = 24576;
constexpr float LN_EPS = 1e-5f, LOG2E = 1.4426950408889634f;
constexpr size_t MiB = 1u << 20;
constexpr size_t WS_CTL = 0, CTL_ZERO_BYTES = 1 * MiB;
constexpr size_t WS_WIN = 2 * MiB, WS_WBRA = 46 * MiB, WS_WBRB = 50 * MiB, WS_WBRC = 52 * MiB, WS_WOUT = 54 * MiB, WS_WGU = 62 * MiB, WS_WD = 126 * MiB, WS_WCMP = 158 * MiB;
constexpr size_t WS_XB = 160 * MiB, WS_Z = 192 * MiB, WS_OA = 370 * MiB, WS_MG = 402 * MiB, WS_MB = 466 * MiB, WS_X1 = 498 * MiB, WS_H = 562 * MiB, WS_SMALL = 574 * MiB, WS_END = 576 * MiB;
constexpr size_t WS_XS = WS_Z, WS_Y = WS_Z + 96 * MiB;
constexpr size_t SM_KCMP = 0, SM_VCMP = 256 * 1024, SM_KMEAN = 512 * 1024, SM_TOKE = 640 * 1024, SM_TOKW = 704 * 1024, SM_TOKP = 768 * 1024, SM_ROWTS = 832 * 1024, SM_ROWW = 960 * 1024, SM_PANE = 1088 * 1024, SM_HIST = 1152 * 1024, SM_CNTG = 1200 * 1024;
constexpr int CW_TMO = 0, CW_BAR = 4096, CW_QUEUE = 8192, CW_ECNT = 9216, CW_NPAN = 16384;
constexpr int RING_OFF = 0, RING_BYTES = 131072, LDSCTL_OFF = RING_BYTES, MISC_OFF = LDSCTL_OFF + 320, LDS_BYTES = 147456;

#define GAS __attribute__((address_space(1)))
#define LAS __attribute__((address_space(3)))
typedef unsigned short bf16;
typedef unsigned v4u __attribute__((ext_vector_type(4)));
typedef unsigned v2u __attribute__((ext_vector_type(2)));
typedef float f32x4 __attribute__((ext_vector_type(4)));
typedef float f32x16 __attribute__((ext_vector_type(16)));
typedef short bf16x8 __attribute__((ext_vector_type(8)));
typedef short s16x4 __attribute__((ext_vector_type(4)));
typedef GAS unsigned gu32;
#define RLX_AGENT __ATOMIC_RELAXED, __HIP_MEMORY_SCOPE_AGENT
#define LDS_WAIT() asm volatile("s_waitcnt lgkmcnt(0)" ::: "memory")
#define VM_WAIT() asm volatile("s_waitcnt vmcnt(0)" ::: "memory")
__device__ __forceinline__ unsigned f2bf(float f) { unsigned u = __builtin_bit_cast(unsigned, f); return (u + 0x7fffu + ((u >> 16) & 1u)) >> 16; }
__device__ __forceinline__ unsigned pk2(float lo, float hi) { return f2bf(lo) | (f2bf(hi) << 16); }
__device__ __forceinline__ float bflo(unsigned w) { return __uint_as_float(w << 16); }
__device__ __forceinline__ float bfhi(unsigned w) { return __uint_as_float(w & 0xffff0000u); }
__device__ __forceinline__ float bf2f(bf16 b) { return __uint_as_float(((unsigned)b) << 16); }
__device__ __forceinline__ float shfl_xor_f(float v, int o, int lane) { return __int_as_float(__builtin_amdgcn_ds_bpermute((lane ^ o) << 2, __float_as_int(v))); }
__device__ __forceinline__ unsigned shfl_xor_u(unsigned v, int o, int lane) { return (unsigned)__builtin_amdgcn_ds_bpermute((lane ^ o) << 2, (int)v); }
__device__ __forceinline__ float wave_sum(float v, int lane) {
#pragma unroll
    for (int o = 1; o < 64; o <<= 1) v += shfl_xor_f(v, o, lane);
    return v;
}

#define XB_TMO      128
#define XB_XCNT(j)  (256  + 64 * (j))
#define XB_XSUB(j)  (1280 + 64 * (j))
#define XB_XGEN(j)  (2304 + 64 * (j))
#define XB_TOP      3328
#define XB_TOPGEN   3392
#define XCD_BAR_WORDS 3456
#define XB_SPIN_CAP (1u << 18)

__device__ __forceinline__ unsigned xb_ld(unsigned* p)              { return __hip_atomic_load(p, __ATOMIC_RELAXED, __HIP_MEMORY_SCOPE_AGENT); }
__device__ __forceinline__ unsigned xb_add(unsigned* p, unsigned v) { return __hip_atomic_fetch_add(p, v, __ATOMIC_RELAXED, __HIP_MEMORY_SCOPE_AGENT); }
__device__ __forceinline__ unsigned xb_xcc_id() { return (unsigned)__builtin_amdgcn_s_getreg((3 << 11) | 20) & 0xFu; }
#define XB_SPIN(cond, bar) do { unsigned _sp = 0; while (cond) { __builtin_amdgcn_s_sleep(1); \
    if ((++_sp & 255u) == 0u) { if (xb_ld(&(bar)[XB_TMO])) break; if (_sp > XB_SPIN_CAP) { atomicAdd(&(bar)[XB_TMO], 1u); break; } } } } while (0)

struct XcdBarrier {
    unsigned* bar; unsigned x;
    volatile LAS unsigned* st;
};

__device__ __forceinline__ XcdBarrier xcd_barrier_post(unsigned* bar, volatile LAS unsigned* st) {
    XcdBarrier b; b.bar = bar; b.x = xb_xcc_id(); b.st = st;
    if (threadIdx.x == 0) (void)xb_add(&bar[XB_XCNT(b.x)], 1u);
    return b;
}
__device__ __forceinline__ void xcd_barrier_complete(unsigned* bar, unsigned x, unsigned& nloc, unsigned& nx) {
    const unsigned G = gridDim.x * gridDim.y * gridDim.z;
    unsigned sum, cnt, mine, sp = 0u;
    for (;;) {
        sum = 0u; cnt = 0u; mine = 0u;
#pragma unroll
        for (unsigned j = 0; j < 16; ++j) { const unsigned c = xb_ld(&bar[XB_XCNT(j)]); sum += c; cnt += (c > 0u) ? 1u : 0u; mine = (j == x) ? c : mine; }
        if (sum == G) break;
        __builtin_amdgcn_s_sleep(1);
        if ((++sp & 255u) == 0u) { if (xb_ld(&bar[XB_TMO])) break; if (sp > XB_SPIN_CAP) { atomicAdd(&bar[XB_TMO], 1u); break; } }
    }
    nloc = mine > 0u ? mine : 1u; nx = cnt > 0u ? cnt : 1u;
}

__device__ __forceinline__ void xcd_barrier(const XcdBarrier& b) {
    asm volatile("s_waitcnt vmcnt(0)" ::: "memory");
    __syncthreads();
    if (threadIdx.x == 0) {
        unsigned* bar = b.bar;
        __builtin_amdgcn_s_waitcnt(0);
        unsigned nloc = b.st[0], nx = b.st[1];
        if (nloc == 0u) { xcd_barrier_complete(bar, b.x, nloc, nx); b.st[0] = nloc; b.st[1] = nx; }
        const unsigned old = xb_add(&bar[XB_XSUB(b.x)], 1u);
        const unsigned gen = old / nloc;
        if (old + 1u == (gen + 1u) * nloc) {
            __builtin_amdgcn_fence(__ATOMIC_RELEASE, "agent");
            asm volatile("s_waitcnt vmcnt(0)" ::: "memory");
            const unsigned og = xb_add(&bar[XB_TOP], 1u);
            const unsigned tg = og / nx;
            if (og + 1u == (tg + 1u) * nx) xb_add(&bar[XB_TOPGEN], 1u);
            else XB_SPIN(xb_ld(&bar[XB_TOPGEN]) == tg, bar);
            __builtin_amdgcn_fence(__ATOMIC_ACQUIRE, "agent");
            xb_add(&bar[XB_XGEN(b.x)], 1u);
            asm volatile("s_waitcnt vmcnt(0)" ::: "memory");
        } else {
            XB_SPIN(xb_ld(&bar[XB_XGEN(b.x)]) == gen, bar);
            __builtin_amdgcn_fence(__ATOMIC_ACQUIRE, "agent");
            asm volatile("s_waitcnt vmcnt(0)" ::: "memory");
        }
    }
    __syncthreads();
}

namespace att {
__device__ __forceinline__ int crow(int r, int hi) { return (r & 3) + 8 * (r >> 2) + 4 * hi; }
__device__ __forceinline__ f32x16 zero16() { float z = 0.f; asm volatile("" : "+v"(z)); f32x16 r;
#pragma unroll
    for (int i = 0; i < 16; ++i) r[i] = z;
    return r; }
__device__ __forceinline__ unsigned cvtpk(float lo, float hi) { unsigned r; asm volatile("v_cvt_pk_bf16_f32 %0, %1, %2" : "=v"(r) : "v"(lo), "v"(hi)); return r; }
template <int HD> __device__ __forceinline__ int kswz(int row, int colB) { return row * (HD * 2) + (colB ^ ((row & 7) << 4)); }
template <int HD> __device__ __forceinline__ int v_st(int k, int c) { const int kk = (k & ~0xC) | ((k & 4) << 1) | ((k & 8) >> 1); return ((kk >> 3) * (HD / 32) + (c >> 5)) * 512 + ((kk & 7) * 32 + (c & 31)) * 2; }
__device__ __forceinline__ int v_rd_base(int lane) { return ((lane & 3) << 3) | (((lane >> 2) & 3) << 6) | (((lane >> 4) & 1) << 5) | (((lane >> 5) & 1) << 8); }
template <int HD> constexpr int v_rd_off(int d0, int ks, int half) { return d0 * 512 + (2 * ks + half) * (HD / 32) * 512; }
template <int OFF> __device__ __forceinline__ s16x4 tr_read(int vb) { s16x4 r; asm volatile("ds_read_b64_tr_b16 %0, %1 offset:%2" : "=&v"(r) : "v"(vb), "i"(OFF) : "memory"); return r; }

template <int HD> __device__ __forceinline__ void qkt(f32x16& p0, f32x16& p1, const LAS char* Ks, const bf16x8 (&qr)[HD / 16], int r32, int hi) {
    p0 = zero16(); p1 = zero16();
#pragma unroll
    for (int d0 = 0; d0 < HD / 16; ++d0) { const int cb = (d0 * 16 + hi * 8) * 2;
        const bf16x8 b0 = *(const LAS bf16x8*)(Ks + kswz<HD>(r32, cb));
        const bf16x8 b1 = *(const LAS bf16x8*)(Ks + kswz<HD>(32 + r32, cb));
        p0 = __builtin_amdgcn_mfma_f32_32x32x16_bf16(b0, qr[d0], p0, 0, 0, 0);
        p1 = __builtin_amdgcn_mfma_f32_32x32x16_bf16(b1, qr[d0], p1, 0, 0, 0); }
}
#define ATT_PK(L, H) (bf16x8){L[0], L[1], L[2], L[3], H[0], H[1], H[2], H[3]}
template <int HD, int D0> __device__ __forceinline__ void pv_one(f32x16& od, int vb, bf16x8 pa0, bf16x8 pa1, bf16x8 pa2, bf16x8 pa3) {
    const s16x4 l0 = tr_read<v_rd_off<HD>(D0, 0, 0)>(vb), h0 = tr_read<v_rd_off<HD>(D0, 0, 1)>(vb), l1 = tr_read<v_rd_off<HD>(D0, 1, 0)>(vb), h1 = tr_read<v_rd_off<HD>(D0, 1, 1)>(vb);
    const s16x4 l2 = tr_read<v_rd_off<HD>(D0, 2, 0)>(vb), h2 = tr_read<v_rd_off<HD>(D0, 2, 1)>(vb), l3 = tr_read<v_rd_off<HD>(D0, 3, 0)>(vb), h3 = tr_read<v_rd_off<HD>(D0, 3, 1)>(vb);
    asm volatile("s_waitcnt lgkmcnt(0)" ::: "memory"); __builtin_amdgcn_sched_barrier(0);
    od = __builtin_amdgcn_mfma_f32_32x32x16_bf16(pa0, ATT_PK(l0, h0), od, 0, 0, 0);
    od = __builtin_amdgcn_mfma_f32_32x32x16_bf16(pa1, ATT_PK(l1, h1), od, 0, 0, 0);
    od = __builtin_amdgcn_mfma_f32_32x32x16_bf16(pa2, ATT_PK(l2, h2), od, 0, 0, 0);
    od = __builtin_amdgcn_mfma_f32_32x32x16_bf16(pa3, ATT_PK(l3, h3), od, 0, 0, 0);
}
template <int HD> __device__ __forceinline__ void pv_all(f32x16 (&o)[HD / 32], int vb, bf16x8 pa0, bf16x8 pa1, bf16x8 pa2, bf16x8 pa3) {
    pv_one<HD, 0>(o[0], vb, pa0, pa1, pa2, pa3); pv_one<HD, 1>(o[1], vb, pa0, pa1, pa2, pa3);
    if constexpr (HD == 128) { pv_one<HD, 2>(o[2], vb, pa0, pa1, pa2, pa3); pv_one<HD, 3>(o[3], vb, pa0, pa1, pa2, pa3); }
}
#define ATT_PK4(P, BASE, OUT) do { const unsigned a0_ = cvtpk(P[BASE + 0], P[BASE + 1]), a1_ = cvtpk(P[BASE + 2], P[BASE + 3]);   \
    const unsigned b0_ = cvtpk(P[BASE + 4], P[BASE + 5]), b1_ = cvtpk(P[BASE + 6], P[BASE + 7]);                              \
    auto r0_ = __builtin_amdgcn_permlane32_swap(a0_, b0_, false, false); auto r1_ = __builtin_amdgcn_permlane32_swap(a1_, b1_, false, false); \
    v4u w_ = {r0_[0], r1_[0], r0_[1], r1_[1]}; OUT = __builtin_bit_cast(bf16x8, w_); } while (0)
__device__ __forceinline__ float xmax32(float v) { auto rr = __builtin_amdgcn_permlane32_swap(__float_as_uint(v), __float_as_uint(v), false, false); return fmaxf(__uint_as_float(rr[0]), __uint_as_float(rr[1])); }
__device__ __forceinline__ float xsum32(float v) { auto rr = __builtin_amdgcn_permlane32_swap(__float_as_uint(v), __float_as_uint(v), false, false); return __uint_as_float(rr[0]) + __uint_as_float(rr[1]); }

struct MaskGen {
    float C, slC, dq, W; bool ok; bool inner;
    __device__ __forceinline__ void operator()(f32x16& p0, f32x16& p1) const {
        const float base = -slC * dq;
        if (inner) {
#pragma unroll
            for (int r = 0; r < 16; ++r) { const float kr = (float)((r & 3) + 8 * (r >> 2));
                const float v0 = fmaf(p0[r], C, fmaf(slC, kr, base)), v1 = fmaf(p1[r], C, fmaf(slC, kr + 32.f, base));
                p0[r] = ok ? v0 : -INFINITY; p1[r] = ok ? v1 : -INFINITY; }
        } else {
#pragma unroll
            for (int r = 0; r < 16; ++r) { const float kr = (float)((r & 3) + 8 * (r >> 2));
                const float v0 = fmaf(p0[r], C, fmaf(slC, kr, base)), v1 = fmaf(p1[r], C, fmaf(slC, kr + 32.f, base));
                p0[r] = (ok && dq >= kr && dq < W + kr) ? v0 : -INFINITY;
                p1[r] = (ok && dq >= kr + 32.f && dq < W + kr + 32.f) ? v1 : -INFINITY; }
        }
    }
};
template <int HD> __device__ __forceinline__ void softmax_pv(f32x16& p0, f32x16& p1, f32x16 (&o)[HD / 32], float& m_reg, float& l_reg, int vb, LAS float* al_l, int r32, int hi) {
    float pmax = p0[0];
#pragma unroll
    for (int r = 1; r < 16; ++r) pmax = fmaxf(pmax, p0[r]);
#pragma unroll
    for (int r = 0; r < 16; ++r) pmax = fmaxf(pmax, p1[r]);
    pmax = xmax32(pmax);
    float mn = m_reg, alpha = 1.f;
    if (!__all(pmax - m_reg <= 8.0f)) { mn = fmaxf(m_reg, pmax); alpha = __builtin_amdgcn_exp2f(m_reg - mn); m_reg = mn; }
    float ps = 0.f;
#pragma unroll
    for (int r = 0; r < 16; ++r) { p0[r] = __builtin_amdgcn_exp2f(p0[r] - mn); p1[r] = __builtin_amdgcn_exp2f(p1[r] - mn); ps += p0[r] + p1[r]; }
    ps = xsum32(ps); l_reg = l_reg * alpha + ps;
    bf16x8 pa0, pa1, pa2, pa3; ATT_PK4(p0, 0, pa0); ATT_PK4(p0, 8, pa1); ATT_PK4(p1, 0, pa2); ATT_PK4(p1, 8, pa3);
    if (__any(alpha < 1.f)) { if (hi == 0) al_l[r32] = alpha; LDS_WAIT();
#pragma unroll
        for (int r = 0; r < 16; ++r) { const float a = al_l[crow(r, hi)];
#pragma unroll
            for (int d = 0; d < HD / 32; ++d) o[d][r] *= a; }
        LDS_WAIT(); }
    pv_all<HD>(o, vb, pa0, pa1, pa2, pa3);
}
template <int HD> struct Stg { v4u k0, k1, v0, v1; };
template <int HD> __device__ __forceinline__ void sload(Stg<HD>& s, const bf16* Kp, const bf16* Vp, size_t pitch, int tid) {
    if constexpr (HD == 128) { const int sr = tid >> 4, sc = (tid & 15) * 8;
        s.k0 = *(const v4u*)(Kp + (size_t)sr * pitch + sc); s.k1 = *(const v4u*)(Kp + (size_t)(32 + sr) * pitch + sc);
        s.v0 = *(const v4u*)(Vp + (size_t)sr * pitch + sc); s.v1 = *(const v4u*)(Vp + (size_t)(32 + sr) * pitch + sc); }
    else { const int sr = tid >> 3, sc = (tid & 7) * 8; s.k0 = *(const v4u*)(Kp + (size_t)sr * pitch + sc); s.v0 = *(const v4u*)(Vp + (size_t)sr * pitch + sc); }
}
template <int HD> __device__ __forceinline__ void swrite(const Stg<HD>& s, LAS char* Kt, LAS char* Vt, int tid) {
    if constexpr (HD == 128) { const int sr = tid >> 4, sc = (tid & 15) * 8;
        *(LAS v4u*)(Kt + kswz<HD>(sr, sc * 2)) = s.k0; *(LAS v4u*)(Kt + kswz<HD>(32 + sr, sc * 2)) = s.k1;
        *(LAS v4u*)(Vt + v_st<HD>(sr, sc)) = s.v0; *(LAS v4u*)(Vt + v_st<HD>(32 + sr, sc)) = s.v1; }
    else { const int sr = tid >> 3, sc = (tid & 7) * 8; *(LAS v4u*)(Kt + kswz<HD>(sr, sc * 2)) = s.k0; *(LAS v4u*)(Vt + v_st<HD>(sr, sc)) = s.v0; }
}
constexpr int A_K0 = 0, A_K1 = 16384, A_V0 = 32768, A_V1 = 49152, A_WS = 65536, A_SEL = 67584, A_UNI = 68608, A_IMP = 68864, A_KM = 77312, A_END = 81408;

template <int HD, class TF, class SK, class FIN>
__device__ __forceinline__ void run_tiles(unsigned mask0, unsigned mask1, const bf16* Kb0, const bf16* Vb0, const bf16* Kb1, const bf16* Vb1, size_t pitch, LAS char* lds, int tid, int lane,
                                          const bf16x8 (&qr)[HD / 16], f32x16 (&o)[HD / 32], float& m_reg, float& l_reg, LAS float* al_l, const TF& tf, const SK& sk, const FIN& fin) {
    const int r32 = lane & 31, hi = lane >> 5;
    const int vb0 = (int)(uintptr_t)(lds + A_V0) + v_rd_base(lane);
    int ph = 0; unsigned m = mask0; if (m == 0u) { ph = 1; m = mask1; }
    if (m == 0u) return;
    int j = __builtin_ctz(m); m &= m - 1u;
    Stg<HD> st;
    sload<HD>(st, (ph ? Kb1 : Kb0) + (size_t)j * 64 * pitch, (ph ? Vb1 : Vb0) + (size_t)j * 64 * pitch, pitch, tid);
    swrite<HD>(st, lds + A_K0, lds + A_V0, tid);
    __syncthreads();
    int buf = 0;
    for (;;) {
        int phn = ph; unsigned mn = m; if (mn == 0u && ph == 0) { phn = 1; mn = mask1; }
        const int jn = mn ? __builtin_ctz(mn) : -1; mn &= mn - 1u;
        if (jn >= 0) sload<HD>(st, (phn ? Kb1 : Kb0) + (size_t)jn * 64 * pitch, (phn ? Vb1 : Vb0) + (size_t)jn * 64 * pitch, pitch, tid);
        if (!sk(ph, j)) { f32x16 p0, p1; qkt<HD>(p0, p1, lds + (buf ? A_K1 : A_K0), qr, r32, hi);
            const MaskGen mg = tf(ph, j); mg(p0, p1);
            softmax_pv<HD>(p0, p1, o, m_reg, l_reg, vb0 + buf * 16384, al_l, r32, hi); }
        if (jn < 0 || phn != ph) fin(ph);
        if (jn >= 0) swrite<HD>(st, lds + (buf ? A_K0 : A_K1), lds + (buf ? A_V0 : A_V1), tid);
        __syncthreads();
        if (jn < 0) break;
        ph = phn; m = mn; j = jn; buf ^= 1;
    }
}
}

constexpr int N_ATT_UNITS = 256 + 128 + 256;
struct UnitTab { unsigned short u[N_ATT_UNITS]; };
constexpr UnitTab make_units() {
    UnitTab t{}; int n = 0;
    for (int cost = 64; cost >= 0; --cost) {
        for (int c = 0; c < 32; ++c) if (c + 12 == cost) for (int bg = 0; bg < 8; ++bg) t.u[n++] = (unsigned short)((bg << 5) | c);
        for (int kb = 0; kb < 8; ++kb) if (4 * kb + 3 == cost) for (int bh = 0; bh < 16; ++bh) t.u[n++] = (unsigned short)((1 << 12) | (bh << 3) | kb);
        if (cost == 2) for (int c = 0; c < 32; ++c) for (int bg = 0; bg < 8; ++bg) t.u[n++] = (unsigned short)((2 << 12) | (bg << 5) | c);
    }
    return t;
}
__constant__ UnitTab g_units = make_units();

#define ATT_STORE_O(ND, OVAL) do { unsigned off_ = (unsigned)((4 * hi) * DM + r32) * 2u; _Pragma("unroll") for (int r_ = 0; r_ < 16; ++r_) { asm volatile("" : "+v"(off_)); \
        bf16* op_ = (bf16*)((char*)obase + off_ + (unsigned)(((r_ & 3) + 8 * (r_ >> 2)) * DM * 2)); \
        _Pragma("unroll") for (int d_ = 0; d_ < ND; ++d_) op_[32 * d_] = (bf16)f2bf(OVAL); asm volatile("" ::: "memory"); } } while (0)

#define ATT_ACC_O(FIRST) do { unsigned off_ = (unsigned)((4 * hi) * DM + r32) * 2u; _Pragma("unroll") for (int r_ = 0; r_ < 16; ++r_) { asm volatile("" : "+v"(off_)); \
        const float f_ = fac_l[att::crow(r_, hi)]; bf16* op_ = (bf16*)((char*)obase + off_ + (unsigned)(((r_ & 3) + 8 * (r_ >> 2)) * DM * 2)); \
        _Pragma("unroll") for (int d_ = 0; d_ < 4; ++d_) { float v_ = o[d_][r_] * f_; if (!(FIRST)) v_ += bf2f(op_[32 * d_]); op_[32 * d_] = (bf16)f2bf(v_); } asm volatile("" ::: "memory"); } } while (0)

__device__ __forceinline__ void nsa_loop(int code, const bf16* Z, bf16* OA, LAS char* lds, int tid_in, int wid, unsigned mysel, unsigned uni);
__device__ __forceinline__ void nsa_unit(int code, const bf16* Z, const bf16* KCMP, const bf16* VCMP, bf16* OA, LAS char* lds, int tid_in, int wid) {
    using namespace att;
    int tid = tid_in; asm volatile("" : "+v"(tid)); const int lane = tid & 63;
    const int bg = (code >> 5) & 7, c = code & 31, b = bg >> 1, g = bg & 1;
    const int r32 = lane & 31, hi = lane >> 5, hh = wid & 3, tb = wid >> 2, head = g * 4 + hh;
    const int tl = tb * 32 + r32, tpos = c * 64 + tl;
    const size_t trow = (size_t)b * SEQ + tpos;
    const float slC = __builtin_amdgcn_exp2f(-(float)(head + 1)) * LOG2E, C = 0.08838834764831845f * LOG2E;
    LAS float* al_l = (LAS float*)(lds + A_WS) + wid * 64; LAS float* fac_l = al_l + 32;
    LAS unsigned* sel_l = (LAS unsigned*)(lds + A_SEL); LAS unsigned* uni_l = (LAS unsigned*)(lds + A_UNI); LAS float* imp_l = (LAS float*)(lds + A_IMP);
    const bf16* qp = Z + trow * ZP + ZC_QA + head * 128 + hi * 8;
    const bf16* gp = Z + trow * ZP + ZC_GA + head * 3;
    const float g0 = bf2f(gp[0]);
    for (int i = tid; i < 64 * 33; i += NTHR) imp_l[i] = 0.f;
    bf16* obase = OA + ((size_t)b * SEQ + c * 64 + tb * 32) * DM + OC_A + head * 128;
    {
        const bf16* kc = KCMP + (size_t)bg * 128 * 128; const bf16* vc = VCMP + (size_t)bg * 128 * 128;
        { Stg<128> s0, s1; sload<128>(s0, kc, vc, 128, tid); sload<128>(s1, kc + 64 * 128, vc + 64 * 128, 128, tid);
          swrite<128>(s0, lds + A_K0, lds + A_V0, tid); swrite<128>(s1, lds + A_K1, lds + A_V1, tid); }
        __syncthreads();
        bf16x8 qc[8];
#pragma unroll
        for (int d0 = 0; d0 < 8; ++d0) qc[d0] = *(const bf16x8*)(qp + d0 * 16);
        const float dq = (float)(tpos - 31 - 64 * hi);
#define NSA_CMP_SCORES(T) do { qkt<128>(a0, a1, lds + ((T) ? A_K1 : A_K0), qc, r32, hi); \
        _Pragma("unroll") for (int r = 0; r < 16; ++r) { const float kr = 16.f * (float)((r & 3) + 8 * (r >> 2)) + 1024.f * (T); const float d0_ = dq - kr, d1_ = dq - kr - 512.f; \
            a0[r] = d0_ >= 0.f ? fmaf(a0[r], C, -slC * d0_) : -INFINITY; a1[r] = d1_ >= 0.f ? fmaf(a1[r], C, -slC * d1_) : -INFINITY; } } while (0)
        f32x16 a0, a1;
        float mx = -INFINITY, ps = 0.f;
        { NSA_CMP_SCORES(0);
#pragma unroll
          for (int r = 0; r < 16; ++r) mx = fmaxf(mx, fmaxf(a0[r], a1[r]));
          float s0 = 0.f; const float m0 = (mx == -INFINITY) ? 0.f : mx;
#pragma unroll
          for (int r = 0; r < 16; ++r) s0 += __builtin_amdgcn_exp2f(a0[r] - m0) + __builtin_amdgcn_exp2f(a1[r] - m0);
          NSA_CMP_SCORES(1);
          float mx1 = mx;
#pragma unroll
          for (int r = 0; r < 16; ++r) mx1 = fmaxf(mx1, fmaxf(a0[r], a1[r]));
          const float m1 = (mx1 == -INFINITY) ? 0.f : mx1;
          float s1 = 0.f;
#pragma unroll
          for (int r = 0; r < 16; ++r) s1 += __builtin_amdgcn_exp2f(a0[r] - m1) + __builtin_amdgcn_exp2f(a1[r] - m1);
          float mh = mx1, sh = s0 * __builtin_amdgcn_exp2f(m0 - m1) + s1;
          const float mo = shfl_xor_f(mh, 32, lane), so = shfl_xor_f(sh, 32, lane);
          const float mf = fmaxf(mh, mo); const float mfz = (mf == -INFINITY) ? 0.f : mf;
          const float mhz = (mh == -INFINITY) ? 0.f : mh, moz = (mo == -INFINITY) ? 0.f : mo;
          ps = sh * __builtin_amdgcn_exp2f(mhz - mfz) + so * __builtin_amdgcn_exp2f(moz - mfz); mx = mfz; }
        const float mm = mx, inv = ps > 0.f ? 1.0f / ps : 0.f;
        LAS float* impr = imp_l + tl * 33;
#define NSA_IMP(X, GRP) do { _Pragma("unroll") for (int q4 = 0; q4 < 4; ++q4) { const int j_ = 8 * (GRP) + 2 * q4 + hi; const float hb_ = 0.5f * X[4 * q4 + 3] * inv; \
            const float aa_ = (X[4 * q4] + X[4 * q4 + 1] + X[4 * q4 + 2]) * inv + hb_; \
            (void)__hip_atomic_fetch_add(impr + j_, aa_, __ATOMIC_RELAXED, __HIP_MEMORY_SCOPE_WORKGROUP); \
            if (j_ + 1 < 32) (void)__hip_atomic_fetch_add(impr + j_ + 1, hb_, __ATOMIC_RELAXED, __HIP_MEMORY_SCOPE_WORKGROUP); } } while (0)
        f32x16 o[4];
#pragma unroll
      for (int d = 0; d < 4; ++d) o[d] = att::zero16();
        const int vb0 = (int)(uintptr_t)(lds + A_V0) + v_rd_base(lane);
        { NSA_CMP_SCORES(0);
#pragma unroll
          for (int r = 0; r < 16; ++r) { a0[r] = __builtin_amdgcn_exp2f(a0[r] - mm); a1[r] = __builtin_amdgcn_exp2f(a1[r] - mm); }
          NSA_IMP(a0, 0); NSA_IMP(a1, 1);
          bf16x8 pa0, pa1, pa2, pa3; ATT_PK4(a0, 0, pa0); ATT_PK4(a0, 8, pa1); ATT_PK4(a1, 0, pa2); ATT_PK4(a1, 8, pa3); pv_all<128>(o, vb0, pa0, pa1, pa2, pa3); }
        { NSA_CMP_SCORES(1);
#pragma unroll
          for (int r = 0; r < 16; ++r) { a0[r] = __builtin_amdgcn_exp2f(a0[r] - mm); a1[r] = __builtin_amdgcn_exp2f(a1[r] - mm); }
          NSA_IMP(a0, 2); NSA_IMP(a1, 3);
          bf16x8 pa0, pa1, pa2, pa3; ATT_PK4(a0, 0, pa0); ATT_PK4(a0, 8, pa1); ATT_PK4(a1, 0, pa2); ATT_PK4(a1, 8, pa3); pv_all<128>(o, vb0 + 16384, pa0, pa1, pa2, pa3); }
#undef NSA_IMP
#undef NSA_CMP_SCORES
        if (hi == 0) fac_l[r32] = g0 * inv; LDS_WAIT();
        ATT_ACC_O(true);
        LDS_WAIT();
    }
    __syncthreads();
    if (wid == 0) {
        unsigned sel;
        if (c <= 7) sel = (2u << c) - 1u;
        else { sel = 1u | (1u << c) | (1u << (c - 1)); unsigned cand = ((1u << (c - 1)) - 1u) & ~1u;
            const LAS float* ir = imp_l + lane * 33;
            for (int k = 0; k < 5; ++k) { int best = -1; float bv = -INFINITY;
                for (int j = 1; j <= c - 2; ++j) { const float v = ir[j]; if (((cand >> j) & 1u) && v > bv) { bv = v; best = j; } }
                if (best < 0) best = __builtin_ctz(cand);
                sel |= 1u << best; cand &= ~(1u << best); } }
        sel_l[lane] = sel;
        unsigned un = sel;
#pragma unroll
        for (int o_ = 1; o_ < 64; o_ <<= 1) un |= shfl_xor_u(un, o_, lane);
        if (lane == 0) uni_l[0] = un;
    }
    __syncthreads();
    const unsigned mysel = sel_l[tl], uni = uni_l[0];
    asm volatile("" ::: "memory");
    nsa_loop(code, Z, OA, lds, tid, wid, mysel, uni);
}
__device__ __forceinline__ void nsa_loop(int code, const bf16* Z, bf16* OA, LAS char* lds, int tid_in, int wid, unsigned mysel, unsigned uni) {
    using namespace att;
    int tid = tid_in; asm volatile("" : "+v"(tid));
    const int lane = tid & 63;
    const int bg = (code >> 5) & 7, c = code & 31, b = bg >> 1, g = bg & 1;
    const int r32 = lane & 31, hi = lane >> 5, hh = wid & 3, tb = wid >> 2, head = g * 4 + hh;
    const int tl = tb * 32 + r32, tpos = c * 64 + tl;
    const size_t trow = (size_t)b * SEQ + tpos;
    const float slC = __builtin_amdgcn_exp2f(-(float)(head + 1)) * LOG2E, C = 0.08838834764831845f * LOG2E;
    LAS float* al_l = (LAS float*)(lds + A_WS) + wid * 64; LAS float* fac_l = al_l + 32;
    const bf16* qp = Z + trow * ZP + ZC_QA + head * 128 + hi * 8;
    const bf16* gp = Z + trow * ZP + ZC_GA + head * 3;
    const float g1 = bf2f(gp[1]), g2 = bf2f(gp[2]);
    bf16* obase = OA + ((size_t)b * SEQ + c * 64 + tb * 32) * DM + OC_A + head * 128;
    const bf16* zb = Z + (size_t)b * SEQ * ZP;
    bf16x8 qr[8];
#pragma unroll
    for (int d0 = 0; d0 < 8; ++d0) qr[d0] = *(const bf16x8*)(qp + d0 * 16);
    { f32x16 o[4];
#pragma unroll
      for (int d = 0; d < 4; ++d) o[d] = att::zero16();
      float m_reg = -1e30f, l_reg = 0.f;
      const int jlo = c > 8 ? c - 8 : 0; const unsigned wmask = ((2u << c) - 1u) & ~((1u << jlo) - 1u);
      const int twmin = c * 64 + tb * 32;
      run_tiles<128>(uni, wmask, zb + ZC_KVA + 512 + g * 128, zb + ZC_KVA + 768 + g * 128, zb + ZC_KVA + 1024 + g * 128, zb + ZC_KVA + 1280 + g * 128, (size_t)ZP, lds, tid, lane, qr, o, m_reg, l_reg, al_l,
          [&](int ph, int j) { return MaskGen{C, slC, (float)(tpos - 64 * j - 4 * hi), ph ? 512.f : 1e9f, ph ? true : (((mysel >> j) & 1u) != 0u), ph ? (j < c && j >= c - 7) : (j < c)}; },
          [&](int ph, int j) { return ph ? (twmin - (64 * j + 63) >= 512) : !__any((mysel >> j) & 1u); },
          [&](int ph) { if (hi == 0) fac_l[r32] = (ph ? g2 : g1) / l_reg; LDS_WAIT();
              ATT_ACC_O(false);
              LDS_WAIT();
#pragma unroll
      for (int d = 0; d < 4; ++d) o[d] = att::zero16();
              m_reg = -1e30f; l_reg = 0.f; }); }
}

__device__ __forceinline__ void moba_unit(int code, const bf16* Z, const float* KMEAN, bf16* OA, LAS char* lds, int tid_in, int wid) {
    using namespace att;
    int tid = tid_in; asm volatile("" : "+v"(tid)); const int lane = tid & 63;
    const int bh = (code >> 3) & 15, kb = code & 7, b = bh >> 2, h = bh & 3;
    const int r32 = lane & 31, hi = lane >> 5, tl = wid * 32 + r32, tpos = kb * 256 + tl;
    const float slC = __builtin_amdgcn_exp2f(-2.0f * (float)(h + 1)) * LOG2E, C = 0.08838834764831845f * LOG2E;
    LAS float* al_l = (LAS float*)(lds + A_WS) + wid * 64; LAS float* fac_l = al_l + 32;
    LAS unsigned* sel_l = (LAS unsigned*)(lds + A_SEL); LAS unsigned* uni_l = (LAS unsigned*)(lds + A_UNI); LAS float* km_l = (LAS float*)(lds + A_KM);
    const bf16* zb = Z + (size_t)b * SEQ * ZP;
    for (int i = tid; i < 1024; i += NTHR) km_l[i] = KMEAN[(size_t)bh * 1024 + i];
    if (tid == 0) uni_l[0] = 0u;
    __syncthreads();
    if (tid < 256) {
        unsigned sel;
        if (kb <= 3) sel = (1u << kb) - 1u;
        else { float sc[7];
#pragma unroll
            for (int n = 0; n < 7; ++n) sc[n] = 0.f;
            const bf16* qp = zb + (size_t)(kb * 256 + tid) * ZP + ZC_QC + h * 128;
            for (int d8 = 0; d8 < 16; ++d8) { const v4u q = *(const v4u*)(qp + d8 * 8);
                const float qf[8] = {bflo(q.x), bfhi(q.x), bflo(q.y), bfhi(q.y), bflo(q.z), bfhi(q.z), bflo(q.w), bfhi(q.w)};
#pragma unroll
                for (int n = 0; n < 7; ++n) if (n < kb) { const LAS float* kp = km_l + n * 128 + d8 * 8;
#pragma unroll
                    for (int i = 0; i < 8; ++i) sc[n] = fmaf(qf[i], kp[i], sc[n]); } }
            sel = 0u;
#pragma unroll
            for (int k = 0; k < 3; ++k) { int best = -1; float bv = -INFINITY;
#pragma unroll
                for (int n = 0; n < 7; ++n) if (n < kb && !((sel >> n) & 1u) && sc[n] > bv) { bv = sc[n]; best = n; }
                if (best < 0) best = __builtin_ctz(~sel);
                sel |= 1u << best; } }
        sel_l[tid] = sel;
        (void)__hip_atomic_fetch_or(uni_l, sel, __ATOMIC_RELAXED, __HIP_MEMORY_SCOPE_WORKGROUP);
    }
    __syncthreads();
    const unsigned mysel = sel_l[tl], uni = uni_l[0];
    unsigned tmask = 0xFu << (4 * kb);
    for (int n = 0; n < kb; ++n) if ((uni >> n) & 1u) tmask |= 0xFu << (4 * n);
    bf16x8 qr[8];
    { const bf16* qp = zb + (size_t)tpos * ZP + ZC_QC + h * 128 + hi * 8;
#pragma unroll
      for (int d0 = 0; d0 < 8; ++d0) qr[d0] = *(const bf16x8*)(qp + d0 * 16); }
    f32x16 o[4];
#pragma unroll
      for (int d = 0; d < 4; ++d) o[d] = att::zero16();
    float m_reg = -1e30f, l_reg = 0.f;
    const int twmax = kb * 256 + wid * 32 + 31;
    run_tiles<128>(tmask, 0u, zb + ZC_KC + h * 128, zb + ZC_VC + h * 128, zb, zb, (size_t)ZP, lds, tid, lane, qr, o, m_reg, l_reg, al_l,
        [&](int, int j) { const int blk = j >> 2; return MaskGen{C, slC, (float)(tpos - 64 * j - 4 * hi), 1e9f, blk == kb ? true : (((mysel >> blk) & 1u) != 0u), blk != kb}; },
        [&](int, int j) { const int blk = j >> 2; return blk == kb ? (64 * j > twmax) : !__any((mysel >> blk) & 1u); },
        [&](int) {});
    if (hi == 0) fac_l[r32] = 1.0f / l_reg; LDS_WAIT();
    float fr_[16];
#pragma unroll
    for (int r = 0; r < 16; ++r) fr_[r] = fac_l[crow(r, hi)];
    LDS_WAIT();
    bf16* obase = OA + ((size_t)b * SEQ + kb * 256 + wid * 32) * DM + OC_C + h * 128;
    ATT_STORE_O(4, o[d_][r_] * fr_[r_]);
}

__device__ __forceinline__ void swa_unit(int code, const bf16* Z, const float* sink, bf16* OA, LAS char* lds, int tid_in, int wid) {
    using namespace att;
    int tid = tid_in; asm volatile("" : "+v"(tid)); const int lane = tid & 63;
    const int bg = (code >> 5) & 7, c = code & 31, b = bg >> 1, g = bg & 1;
    const int r32 = lane & 31, hi = lane >> 5, hh = wid & 3, tb = wid >> 2, head = g * 4 + hh;
    const int tl = tb * 32 + r32, tpos = c * 64 + tl;
    const float slC = __builtin_amdgcn_exp2f(-(float)(head + 1)) * LOG2E, C = 0.125f * LOG2E;
    LAS float* al_l = (LAS float*)(lds + A_WS) + wid * 64; LAS float* fac_l = al_l + 32;
    const bf16* zb = Z + (size_t)b * SEQ * ZP;
    bf16x8 qr[4];
    { const bf16* qp = zb + (size_t)tpos * ZP + ZC_QB + head * 64 + hi * 8;
#pragma unroll
      for (int d0 = 0; d0 < 4; ++d0) qr[d0] = *(const bf16x8*)(qp + d0 * 16); }
    f32x16 o[2];
#pragma unroll
      for (int d = 0; d < 2; ++d) o[d] = att::zero16();
    float m_reg = -1e30f, l_reg = 0.f;
    const int jlo = c > 2 ? c - 2 : 0; const unsigned tmask = ((2u << c) - 1u) & ~((1u << jlo) - 1u);
    const int twmin = c * 64 + tb * 32;
    run_tiles<64>(tmask, 0u, zb + ZC_KB + g * 64, zb + ZC_VB + g * 64, zb, zb, (size_t)ZP, lds, tid, lane, qr, o, m_reg, l_reg, al_l,
        [&](int, int j) { return MaskGen{C, slC, (float)(tpos - 64 * j - 4 * hi), 128.f, true, j == c - 1}; },
        [&](int, int j) { return twmin - (64 * j + 63) >= 128; },
        [&](int) {});
    l_reg += __builtin_amdgcn_exp2f(sink[head] * LOG2E - m_reg);
    if (hi == 0) fac_l[r32] = 1.0f / l_reg; LDS_WAIT();
    float fr_[16];
#pragma unroll
    for (int r = 0; r < 16; ++r) fr_[r] = fac_l[crow(r, hi)];
    LDS_WAIT();
    bf16* obase = OA + ((size_t)b * SEQ + c * 64 + tb * 32) * DM + OC_B + head * 64;
    ATT_STORE_O(2, o[d_][r_] * fr_[r_]);
}

__device__ __forceinline__ void cmp_unit(int u, const bf16* Z, const bf16* WCMP, const float* pos, bf16* KCMP, bf16* VCMP, LAS char* lds, int tid, int lane, int wid) {
    const int bg = u >> 5, kv = (u >> 4) & 1, nt = (u >> 2) & 3, et = u & 3, b = bg >> 1, g = bg & 1, r32 = lane & 31, hi = lane >> 5;
    const int n = nt * 32 + r32, nc = n < 126 ? n : 126;
    const bf16* arow = Z + ((size_t)b * SEQ + 16 * nc) * ZP + ZC_KVA + kv * 256 + g * 128 + hi * 8;
    const bf16* brow = WCMP + ((size_t)kv * 128 + et * 32 + r32) * 4096 + hi * 8;
    const float* prow = pos + kv * 4096 + hi * 8;
    f32x16 acc = att::zero16();
    for (int ll = 0; ll < 4; ++ll) { const int l = 4 * wid + ll;
#pragma unroll
        for (int ds = 0; ds < 8; ++ds) { const int d = ds * 16;
            const v4u a = *(const v4u*)(arow + (size_t)l * ZP + d); const f32x4 p0 = *(const f32x4*)(prow + l * 128 + d), p1 = *(const f32x4*)(prow + l * 128 + d + 4);
            v4u af; af.x = pk2(bflo(a.x) + p0[0], bfhi(a.x) + p0[1]); af.y = pk2(bflo(a.y) + p0[2], bfhi(a.y) + p0[3]); af.z = pk2(bflo(a.z) + p1[0], bfhi(a.z) + p1[1]); af.w = pk2(bflo(a.w) + p1[2], bfhi(a.w) + p1[3]);
            const bf16x8 bfg = *(const bf16x8*)(brow + l * 128 + d);
            acc = __builtin_amdgcn_mfma_f32_32x32x16_bf16(__builtin_bit_cast(bf16x8, af), bfg, acc, 0, 0, 0); } }
    LAS float* part = (LAS float*)lds;
#pragma unroll
    for (int r = 0; r < 16; ++r) part[(wid * 32 + att::crow(r, hi)) * 33 + r32] = acc[r];
    __syncthreads();
#pragma unroll
    for (int k2 = 0; k2 < 2; ++k2) { const int idx = tid + NTHR * k2, row = idx >> 5, col = idx & 31; float s = 0.f;
#pragma unroll
        for (int w = 0; w < 8; ++w) s += part[(w * 32 + row) * 33 + col];
        const int no = nt * 32 + row; if (no == 127) s = 0.f;
        (kv ? VCMP : KCMP)[((size_t)bg * 128 + no) * 128 + et * 32 + col] = (bf16)f2bf(s); }
    __syncthreads();
}
__device__ __forceinline__ void kmean_unit(int u, const bf16* Z, float* KMEAN, LAS char* lds, int tid, int lane, int wid) {
    const int bh = u >> 3, blk = u & 7, b = bh >> 2, h = bh & 3;
    const bf16* kp = Z + ((size_t)b * SEQ + blk * 256 + wid * 32) * ZP + ZC_KC + h * 128 + 2 * lane;
    float s0 = 0.f, s1 = 0.f;
#pragma unroll 8
    for (int i = 0; i < 32; ++i) { const unsigned w = *(const unsigned*)(kp + (size_t)i * ZP); s0 += bflo(w); s1 += bfhi(w); }
    LAS float* part = (LAS float*)lds;
    part[wid * 128 + 2 * lane] = s0; part[wid * 128 + 2 * lane + 1] = s1;
    __syncthreads();
    if (tid < 128) { float s = 0.f;
#pragma unroll
        for (int w = 0; w < 8; ++w) s += part[w * 128 + tid];
        KMEAN[((size_t)bh * 8 + blk) * 128 + tid] = s * (1.0f / 256.0f); }
    __syncthreads();
}

__device__ __forceinline__ void cvt_item64(const float* W, int ldw, int k0, int n_src0, int ncols, bf16* WT, int ldt, int n_dst0, LAS unsigned* scr, int lane) {
    const int nq = lane & 15, kq = lane >> 4; const bool act = 4 * nq < ncols;
    const float* wp = W + (size_t)(k0 + 2 * kq) * ldw + n_src0 + 4 * nq;
    f32x4 v0[8], v1[8];
#pragma unroll
    for (int i = 0; i < 8; ++i) { if (act) { v0[i] = *(const f32x4*)(wp + (size_t)(8 * i) * ldw); v1[i] = *(const f32x4*)(wp + (size_t)(8 * i + 1) * ldw); } else { v0[i] = (f32x4){0.f, 0.f, 0.f, 0.f}; v1[i] = v0[i]; } }
#pragma unroll
    for (int i = 0; i < 8; ++i) { const int a = kq + 4 * i;
#pragma unroll
        for (int j = 0; j < 4; ++j) scr[(4 * nq + j) * 33 + a] = pk2(v0[i][j], v1[i][j]); }
    LDS_WAIT(); asm volatile("" ::: "memory");
    const int c = lane & 7;
#pragma unroll
    for (int i = 0; i < 8; ++i) { const int n = (lane >> 3) + 8 * i; const LAS unsigned* s = scr + n * 33 + 4 * c;
        v4u o; o.x = s[0]; o.y = s[1]; o.z = s[2]; o.w = s[3];
        if (n < ncols) *(v4u*)(WT + (size_t)(n_dst0 + n) * ldt + k0 + 8 * c) = o; }
    LDS_WAIT(); asm volatile("" ::: "memory");
}
__device__ __forceinline__ void cvt_item64_fp8(const float* W, int ldw, int k0, int n_src0, int ncols, unsigned char* WT, int ldt, int n_dst0, float scale, LAS unsigned* scr, int lane) {
    const int nq = lane & 15, kq = lane >> 4; const bool act = 4 * nq < ncols;
    const float* wp = W + (size_t)(k0 + 4 * kq) * ldw + n_src0 + 4 * nq;
    f32x4 v[4][4];
#pragma unroll
    for (int i = 0; i < 4; ++i)
#pragma unroll
        for (int rr = 0; rr < 4; ++rr) v[i][rr] = act ? *(const f32x4*)(wp + (size_t)(16 * i + rr) * ldw) : (f32x4){0.f, 0.f, 0.f, 0.f};
#pragma unroll
    for (int i = 0; i < 4; ++i)
#pragma unroll
        for (int j = 0; j < 4; ++j) { int w = 0; w = __builtin_amdgcn_cvt_pk_fp8_f32(v[i][0][j] * scale, v[i][1][j] * scale, w, false); w = __builtin_amdgcn_cvt_pk_fp8_f32(v[i][2][j] * scale, v[i][3][j] * scale, w, true);
            scr[(4 * nq + j) * 17 + kq + 4 * i] = (unsigned)w; }
    LDS_WAIT(); asm volatile("" ::: "memory");
    const int c = lane & 3;
#pragma unroll
    for (int i = 0; i < 4; ++i) { const int n = (lane >> 2) + 16 * i; const LAS unsigned* s = scr + n * 17 + 4 * c;
        v4u o; o.x = s[0]; o.y = s[1]; o.z = s[2]; o.w = s[3];
        if (n < ncols) *(v4u*)(WT + (size_t)(n_dst0 + n) * ldt + k0 + 16 * c) = o; }
    LDS_WAIT(); asm volatile("" ::: "memory");
}
__device__ __forceinline__ unsigned pk4_fp8(f32x4 v, float scale) { int w = 0; w = __builtin_amdgcn_cvt_pk_fp8_f32(v[0] * scale, v[1] * scale, w, false); w = __builtin_amdgcn_cvt_pk_fp8_f32(v[2] * scale, v[3] * scale, w, true); return (unsigned)w; }
constexpr float FP8_XSCALE = 16.f, FP8_WSCALE = 64.f;
constexpr int FP8_SCA = 0x7b7b7b7b, FP8_SCB = 0x79797979;
constexpr int CI_IN = 173 * 32, CI_BRA = 512, CI_BRB = 256, CI_BRC = 256, CI_OUT = 1024, CI_GU = 8192, CI_D = 4096, CI_CMP = 256, CI_ZERO = 232;
constexpr int CI_TOTAL = CI_IN + CI_BRA + CI_BRB + CI_BRC + CI_OUT + CI_GU + CI_D + CI_CMP + CI_ZERO;

__device__ __forceinline__ void ln_row(f32x4 (&v)[8], const float* g, const float* bta, int lane) {
    float s = 0.f;
#pragma unroll
    for (int j = 0; j < 8; ++j) s += (v[j][0] + v[j][1]) + (v[j][2] + v[j][3]);
    const float mean = wave_sum(s, lane) * (1.0f / DM); float s2 = 0.f;
#pragma unroll
    for (int j = 0; j < 8; ++j) { v[j] = v[j] - mean; s2 += (v[j][0] * v[j][0] + v[j][1] * v[j][1]) + (v[j][2] * v[j][2] + v[j][3] * v[j][3]); }
    const float rstd = 1.0f / sqrtf(wave_sum(s2, lane) * (1.0f / DM) + LN_EPS);
#pragma unroll
    for (int j = 0; j < 8; ++j) { const f32x4 gg = ((const f32x4*)g)[lane + 64 * j], bb = ((const f32x4*)bta)[lane + 64 * j]; v[j] = v[j] * rstd * gg + bb; }
}

__device__ __forceinline__ void ln_router_tile(int tile, const float* R, const float* g, const float* bta, float* X1, bf16* XB, const float* wgrp, const float* bgrp, const float* wrt, const float* brt,
                                               int* hist, int* tok_e, float* tok_w, int* tok_p, LAS char* lds, int tid, int lane, int wid) {
    LAS float* glog = (LAS float*)lds;
    LAS float* part = (LAS float*)(lds + 1024);
    LAS float* elog = (LAS float*)(lds + 1024 + 33792);
    const int row0 = tile * 32;
    LAS f32x4* lg = (LAS f32x4*)(lds + 65536);
    LAS f32x4* lb = lg + 512;
    LAS f32x4* lw = lb + 512;
    { const f32x4 a = ((const f32x4*)g)[tid], b4 = ((const f32x4*)bta)[tid]; f32x4 w4[4];
#pragma unroll
      for (int q = 0; q < 4; ++q) w4[q] = ((const f32x4*)wgrp)[tid + 512 * q];
      lg[tid] = a; lb[tid] = b4;
#pragma unroll
      for (int q = 0; q < 4; ++q) { const int kk = tid + 512 * q; lw[(kk & 3) * 512 + (kk >> 2)] = w4[q]; } }
    __syncthreads();
#pragma unroll 1
    for (int hp = 0; hp < 2; ++hp) {
        f32x4 v[2][8]; const size_t rbase = (size_t)row0 + wid * 4 + hp * 2;
#pragma unroll
        for (int i = 0; i < 2; ++i)
#pragma unroll
            for (int j = 0; j < 8; ++j) v[i][j] = ((const f32x4*)(R + (rbase + i) * DM))[lane + 64 * j];
        float mean[2], rstd[2];
#pragma unroll
        for (int i = 0; i < 2; ++i) { float s = 0.f;
#pragma unroll
            for (int j = 0; j < 8; ++j) s += (v[i][j][0] + v[i][j][1]) + (v[i][j][2] + v[i][j][3]);
            mean[i] = s; }
#pragma unroll
        for (int o_ = 1; o_ < 64; o_ <<= 1) {
#pragma unroll
            for (int i = 0; i < 2; ++i) mean[i] += shfl_xor_f(mean[i], o_, lane); }
#pragma unroll
        for (int i = 0; i < 2; ++i) { mean[i] *= (1.0f / DM); float s2 = 0.f;
#pragma unroll
            for (int j = 0; j < 8; ++j) { v[i][j] = v[i][j] - mean[i]; s2 += (v[i][j][0] * v[i][j][0] + v[i][j][1] * v[i][j][1]) + (v[i][j][2] * v[i][j][2] + v[i][j][3] * v[i][j][3]); }
            rstd[i] = s2; }
#pragma unroll
        for (int o_ = 1; o_ < 64; o_ <<= 1) {
#pragma unroll
            for (int i = 0; i < 2; ++i) rstd[i] += shfl_xor_f(rstd[i], o_, lane); }
#pragma unroll
        for (int i = 0; i < 2; ++i) rstd[i] = 1.0f / sqrtf(rstd[i] * (1.0f / DM) + LN_EPS);
        float gl[2][4];
#pragma unroll
        for (int i = 0; i < 2; ++i)
#pragma unroll
            for (int cc = 0; cc < 4; ++cc) gl[i][cc] = 0.f;
#pragma unroll
        for (int j = 0; j < 8; ++j) { const f32x4 gg = lg[lane + 64 * j], bb = lb[lane + 64 * j];
            f32x4 wr[4];
#pragma unroll
            for (int e = 0; e < 4; ++e) wr[e] = lw[e * 512 + lane + 64 * j];
#pragma unroll
            for (int i = 0; i < 2; ++i) { const f32x4 y = v[i][j] * rstd[i] * gg + bb;
                ((f32x4*)(X1 + (rbase + i) * DM))[lane + 64 * j] = y;
                ((unsigned*)((unsigned char*)XB + (rbase + i) * DM))[lane + 64 * j] = pk4_fp8(y, FP8_XSCALE);
#pragma unroll
                for (int e = 0; e < 4; ++e)
#pragma unroll
                    for (int cc = 0; cc < 4; ++cc) gl[i][cc] = fmaf(y[e], wr[e][cc], gl[i][cc]); }
            asm volatile("" ::: "memory"); }
#pragma unroll
        for (int o_ = 1; o_ < 64; o_ <<= 1) {
#pragma unroll
            for (int i = 0; i < 2; ++i)
#pragma unroll
                for (int cc = 0; cc < 4; ++cc) gl[i][cc] += shfl_xor_f(gl[i][cc], o_, lane); }
        if (lane == 0) {
#pragma unroll
            for (int i = 0; i < 2; ++i)
#pragma unroll
                for (int cc = 0; cc < 4; ++cc) glog[(wid * 4 + hp * 2 + i) * 4 + cc] = gl[i][cc] + bgrp[cc]; }
    }
    VM_WAIT(); __syncthreads();
    { f32x16 acc = att::zero16();
      const int i = lane & 31, kk = lane >> 5;
      const float* xa = X1 + (size_t)(row0 + i) * DM + 256 * wid + 4 * kk;
      const float* wb = wrt + (size_t)(256 * wid + 4 * kk) * 32 + i;
#pragma unroll 1
      for (int c8 = 0; c8 < 2; ++c8) { f32x4 a[16]; float bq[16][4];
#pragma unroll
          for (int q = 0; q < 16; ++q) { const int cch = c8 * 16 + q; a[q] = *(const f32x4*)(xa + 8 * cch);
#pragma unroll
              for (int s = 0; s < 4; ++s) bq[q][s] = wb[(8 * cch + s) * 32]; }
#pragma unroll
          for (int q = 0; q < 16; ++q)
#pragma unroll
              for (int s = 0; s < 4; ++s) acc = __builtin_amdgcn_mfma_f32_32x32x2f32(a[q][s], bq[q][s], acc, 0, 0, 0); }
#pragma unroll
      for (int r = 0; r < 16; ++r) part[(wid * 32 + att::crow(r, kk)) * 33 + i] = acc[r]; }
    __syncthreads();
#pragma unroll
    for (int k2 = 0; k2 < 2; ++k2) { const int idx = tid + NTHR * k2, row = idx >> 5, col = idx & 31; float s = brt[col];
#pragma unroll
        for (int w = 0; w < 8; ++w) s += part[(w * 32 + row) * 33 + col];
        elog[row * 33 + col] = s; }
    __syncthreads();
    if (tid < 32) { const int token = row0 + tid;
        int gi = 0; float gm = glog[tid * 4];
#pragma unroll
        for (int cc = 1; cc < 4; ++cc) { const float t = glog[tid * 4 + cc]; if (t > gm) { gm = t; gi = cc; } }
        float den = 0.f;
#pragma unroll
        for (int cc = 0; cc < 4; ++cc) den += __expf(glog[tid * 4 + cc] - gm);
        const float gw = 1.0f / den;
        int i0 = 0; float t0 = elog[tid * 33 + gi * 8];
#pragma unroll
        for (int k = 1; k < 8; ++k) { const float t = elog[tid * 33 + gi * 8 + k]; if (t > t0) { t0 = t; i0 = k; } }
        int i1 = -1; float t1 = -INFINITY;
#pragma unroll
        for (int k = 0; k < 8; ++k) { const float t = elog[tid * 33 + gi * 8 + k]; if (k != i0 && t > t1) { t1 = t; i1 = k; } }
        const float ex = __expf(t1 - t0), w0 = gw / (1.0f + ex), w1 = gw * ex / (1.0f + ex);
        const int e0 = gi * 8 + i0, e1 = gi * 8 + i1;
        LAS int* e_l = (LAS int*)(lds + 1024);
        e_l[2 * tid] = e0; e_l[2 * tid + 1] = e1; LDS_WAIT();
        int r0 = 0, r1 = 0, hc = 0;
        for (int q = 0; q < 64; ++q) { const int eq = e_l[q]; if (q < 2 * tid) { r0 += (eq == e0); r1 += (eq == e1); } hc += (eq == tid); }
        hist[tile * 32 + tid] = hc;
        tok_e[token * 2] = e0; tok_e[token * 2 + 1] = e1; tok_w[token * 2] = w0; tok_w[token * 2 + 1] = w1; tok_p[token * 2] = r0; tok_p[token * 2 + 1] = r1; }
    __syncthreads();
}
__device__ __forceinline__ int moe_offsets(const int* cntg, LAS char* lds, int tid) {
    LAS int* off_l = (LAS int*)lds; LAS int* cnt_l = (LAS int*)(lds + 256);
    if (tid < 32) cnt_l[tid] = cntg[tid];
    __syncthreads();
    if (tid == 0) { int o = 0; for (int e = 0; e < 32; ++e) { off_l[e] = o; o += (cnt_l[e] + 255) & ~255; } off_l[32] = o; }
    __syncthreads();
    return off_l[32];
}
__device__ __forceinline__ int moe_offsets_hist(const int* hist, int tile, LAS char* lds, int tid) {
    LAS int* off_l = (LAS int*)lds; LAS int* cnt_l = (LAS int*)(lds + 256); LAS int* pre_l = (LAS int*)(lds + 512); LAS int* pa = (LAS int*)(lds + 1024); LAS int* pb = (LAS int*)(lds + 1024 + 2048);
    const int e = tid & 31, part = tid >> 5; int sa = 0, sb = 0;
#pragma unroll 4
    for (int q = 0; q < 16; ++q) { const int t = part * 16 + q; const int h = hist[t * 32 + e]; sa += h; sb += (t < tile) ? h : 0; }
    pa[part * 32 + e] = sa; pb[part * 32 + e] = sb;
    __syncthreads();
    if (tid < 32) { int c = 0, p = 0;
#pragma unroll
        for (int q = 0; q < 16; ++q) { c += pa[q * 32 + tid]; p += pb[q * 32 + tid]; }
        cnt_l[tid] = c; pre_l[tid] = p; }
    __syncthreads();
    if (tid == 0) { int o = 0; for (int k = 0; k < 32; ++k) { off_l[k] = o; o += (cnt_l[k] + 255) & ~255; } off_l[32] = o; }
    __syncthreads();
    return off_l[32];
}

#ifndef DBL
#define DBL 0
#endif
#ifndef PHASES
#define PHASES 0x7FF
#endif
struct Args { const float* in[20]; float* out; unsigned char* ws; };
__global__ void __launch_bounds__(NTHR, 2) fwd_kernel(Args args) {
    extern __shared__ __attribute__((aligned(16))) unsigned char lds_raw[];
    LAS unsigned char* const lds = (LAS unsigned char*)lds_raw;
    LAS char* const ldc = (LAS char*)lds_raw;
    volatile LAS unsigned* MISC = (volatile LAS unsigned*)(lds + MISC_OFF);
    const int G = gridDim.x, bx = blockIdx.x, vcu = (G % 8 == 0) ? (bx % 8) * (G / 8) + bx / 8 : bx, NGW = G * NWAVES;
#define PHASE_IDS() int tid_ = threadIdx.x; asm volatile("" : "+v"(tid_)); const int tid = tid_, lane = tid & 63, wid = __builtin_amdgcn_readfirstlane(tid >> 6), gw = vcu * NWAVES + wid; (void)gw; (void)lane
    gu32* ctl0 = (gu32*)(args.ws + WS_CTL);
    for (int u = threadIdx.x; u < (LDS_BYTES - LDSCTL_OFF) / 4; u += NTHR) ((LAS unsigned*)(lds + LDSCTL_OFF))[u] = 0u;
    __syncthreads();
    XcdBarrier bar = xcd_barrier_post((unsigned*)(ctl0 + CW_BAR), MISC + 8);
#define GRID_BAR() xcd_barrier(bar)
#define PHASE_PTRS() GAS unsigned char* wsg_ = (GAS unsigned char*)args.ws; asm volatile("" : "+s"(wsg_)); unsigned char* ws = (unsigned char*)wsg_; gu32* ctl = (gu32*)(ws + WS_CTL); (void)ctl; const float* x_in = args.in[0]; (void)x_in; \
    bf16* WIN = (bf16*)(ws + WS_WIN); bf16* WBRA = (bf16*)(ws + WS_WBRA); bf16* WBRB = (bf16*)(ws + WS_WBRB); bf16* WBRC = (bf16*)(ws + WS_WBRC); bf16* WOUT = (bf16*)(ws + WS_WOUT); \
    bf16* WGU = (bf16*)(ws + WS_WGU); bf16* WD = (bf16*)(ws + WS_WD); bf16* WCMP = (bf16*)(ws + WS_WCMP); \
    bf16* XB = (bf16*)(ws + WS_XB); bf16* Z = (bf16*)(ws + WS_Z); bf16* OA = (bf16*)(ws + WS_OA); float* MG = (float*)(ws + WS_MG); bf16* MB = (bf16*)(ws + WS_MB); \
    float* X1 = (float*)(ws + WS_X1); bf16* HB = (bf16*)(ws + WS_H); bf16* XS = (bf16*)(ws + WS_XS); bf16* YB = (bf16*)(ws + WS_Y); \
    unsigned char* sm = ws + WS_SMALL; \
    bf16* KCMP = (bf16*)(sm + SM_KCMP); bf16* VCMP = (bf16*)(sm + SM_VCMP); float* KMEAN = (float*)(sm + SM_KMEAN); \
    int* tok_e = (int*)(sm + SM_TOKE); float* tok_w = (float*)(sm + SM_TOKW); int* tok_p = (int*)(sm + SM_TOKP); int* rowts = (int*)(sm + SM_ROWTS); float* roww = (float*)(sm + SM_ROWW); int* panel_e = (int*)(sm + SM_PANE); int* hist = (int*)(sm + SM_HIST); int* cntg = (int*)(sm + SM_CNTG); (void)hist; (void)cntg; \
    (void)WIN; (void)WBRA; (void)WBRB; (void)WBRC; (void)WOUT; (void)WGU; (void)WD; (void)WCMP; (void)XB; (void)Z; (void)OA; (void)MG; (void)MB; (void)X1; (void)HB; (void)XS; (void)YB; \
    (void)KCMP; (void)VCMP; (void)KMEAN; (void)tok_e; (void)tok_w; (void)tok_p; (void)rowts; (void)roww; (void)panel_e
    const float alpha = 1.4142135623730951f;

    for (int l = 0; l < DEPTH; ++l) {
#if PHASES & 1
        for (int rep = 0; rep < 1 + ((DBL >> 0) & 1); ++rep) {
        { PHASE_IDS(); PHASE_PTRS();
            LAS unsigned* scr = (LAS unsigned*)(lds + RING_OFF + wid * 16384);
            const float* w_in = args.in[1] + (size_t)l * DM * 11032; const float* cmpw = args.in[3] + (size_t)l * 2 * 4096 * 128;
            const float* wbra = args.in[5] + (size_t)l * 1024 * DM; const float* wbrb = args.in[6] + (size_t)l * 512 * DM; const float* wbrc = args.in[7] + (size_t)l * 512 * DM;
            const float* wout = args.in[8] + (size_t)l * DM * DM;
            const float* wgate = args.in[15] + (size_t)l * NEXP * DM * DEXP; const float* wup = args.in[16] + (size_t)l * NEXP * DM * DEXP; const float* wdown = args.in[17] + (size_t)l * NEXP * DEXP * DM;
            for (int it = gw; it < CI_TOTAL; it += NGW) {
                int r = it; const float* W; bf16* WT; int ldw, k0, ns, nc = 64, ldt, nd;
                if (r >= CI_TOTAL - CI_ZERO) { r -= CI_TOTAL - CI_ZERO; v4u* zp = (v4u*)((unsigned char*)WIN + (size_t)(11032 + r) * DM); const v4u z4 = {0u, 0u, 0u, 0u};
#pragma unroll
                    for (int q = 0; q < 2; ++q) zp[lane + 64 * q] = z4;
                    continue; }
                if (r < CI_IN) { const int kb = r / 173, nb = r % 173;
                    if (nb < 40) { ns = 64 * nb; nd = ns; } else if (nb < 172) { ns = 2584 + 64 * (nb - 40); nd = 2560 + 64 * (nb - 40); } else { ns = 2560; nd = ZC_GA; nc = 24; }
                    cvt_item64_fp8(w_in, 11032, 64 * kb, ns, nc, (unsigned char*)WIN, DM, nd, FP8_WSCALE, scr, lane); continue; }
                if ((r -= CI_IN) < CI_BRA) { W = wbra; ldw = DM; k0 = 64 * (r / 32); ns = 64 * (r % 32); WT = WBRA; ldt = DM; nd = ns; }
                else if ((r -= CI_BRA) < CI_BRB) { W = wbrb; ldw = DM; k0 = 64 * (r / 32); ns = 64 * (r % 32); WT = WBRA + 1024; ldt = DM; nd = ns; }
                else if ((r -= CI_BRB) < CI_BRC) { W = wbrc; ldw = DM; k0 = 64 * (r / 32); ns = 64 * (r % 32); WT = WBRA + 1536; ldt = DM; nd = ns; }
                else if ((r -= CI_BRC) < CI_OUT) { W = wout; ldw = DM; k0 = 64 * (r / 32); ns = 64 * (r % 32); WT = WOUT; ldt = DM; nd = ns; }
                else if ((r -= CI_OUT) < CI_GU) { const int mat = r >> 7, e = mat >> 1, which = mat & 1, rr = r & 127, f0 = 64 * (rr & 3);
                    cvt_item64_fp8((which ? wup : wgate) + (size_t)e * DM * DEXP, DEXP, 64 * (rr >> 2), f0, 64, (unsigned char*)WGU, DM, e * 512 + (f0 >> 7) * 256 + which * 128 + (f0 & 127), FP8_WSCALE, scr, lane); continue; }
                else if ((r -= CI_GU) < CI_D) { const int e = r >> 7, rr = r & 127; W = wdown + (size_t)e * DEXP * DM; ldw = DM; k0 = 64 * (rr >> 5); ns = 64 * (rr & 31); WT = WD; ldt = DEXP; nd = e * DM + ns; }
                else { r -= CI_D; const int kv = r >> 7, rr = r & 127; W = cmpw + (size_t)kv * 4096 * 128; ldw = 128; k0 = 64 * (rr >> 1); ns = 64 * (rr & 1); WT = WCMP; ldt = 4096; nd = kv * 128 + ns; }
                cvt_item64(W, ldw, k0, ns, nc, WT, ldt, nd, scr, lane);
            }
            if (l == 0) for (int row = gw; row < NT; row += NGW) { const f32x4* xr = (const f32x4*)(x_in + (size_t)row * DM);
#pragma unroll
                for (int j = 0; j < 8; ++j) { const f32x4 v = xr[lane + 64 * j]; ((unsigned*)((unsigned char*)XB + (size_t)row * DM))[lane + 64 * j] = pk4_fp8(v, FP8_XSCALE); } }
        }
        GRID_BAR(); }
#endif
#if PHASES & 2
        for (int rep = 0; rep < 1 + ((DBL >> 1) & 1); ++rep) {
        { PHASE_IDS(); PHASE_PTRS(); pg8::Gemm gm{XB, WIN, NT, ZP, DM / 2, DM / 2, FP8_SCA, FP8_SCB}; pg8::StaticOrder S; S.init(NT, ZP, G, bx);
          pg8::EpiZ E{Z, ZP, ZC_GM / 256};
          pg8::gemm_phase<pg8::EpiZ, pg8::StaticOrder, true, true, true>(lds + RING_OFF, gm, S, E); }
        GRID_BAR(); }
#endif
#if PHASES & 4
        for (int rep = 0; rep < 1 + ((DBL >> 2) & 1); ++rep) {
        { PHASE_IDS(); PHASE_PTRS(); const float* pos = args.in[2] + (size_t)l * 2 * 4096;
          for (int u = bx; u < 256; u += G) cmp_unit(u, Z, WCMP, pos, KCMP, VCMP, ldc, tid, lane, wid);
          for (int u = bx; u < 128; u += G) kmean_unit(u, Z, KMEAN, ldc, tid, lane, wid); }
        GRID_BAR(); }
#endif
#if PHASES & 8
        for (int rep = 0; rep < 1 + ((DBL >> 3) & 1); ++rep) {
        { PHASE_IDS(); PHASE_PTRS(); gu32* qw = ctl + CW_QUEUE + 64 * (2 * l + rep); const float* sink = args.in[4] + l * 8;
          LAS unsigned* uw = (LAS unsigned*)(ldc + att::A_UNI) + 2;
          for (;;) {
              if (tid == 0) *uw = __hip_atomic_fetch_add(qw, 1u, RLX_AGENT);
              __syncthreads();
              const unsigned qi = *uw;
              __syncthreads();
              if (qi >= (unsigned)N_ATT_UNITS) break;
              const int code = g_units.u[qi], kind = code >> 12;
              if (kind == 0) nsa_unit(code, Z, KCMP, VCMP, OA, ldc, tid, wid);
              else if (kind == 1) moba_unit(code, Z, KMEAN, OA, ldc, tid, wid);
              else swa_unit(code, Z, sink, OA, ldc, tid, wid);
          } }
        GRID_BAR(); }
#endif
#if PHASES & 16
        for (int rep = 0; rep < 1 + ((DBL >> 4) & 1); ++rep) {
        { PHASE_IDS(); PHASE_PTRS(); pg8::StaticOrder S; S.init(NT, DM, G, bx);
          pg8::Gemm gm{OA, WBRA, NT, DM, DM, DM}; pg8::EpiBrM E{MB, Z + ZC_GM, ZP};
          pg8::gemm_phase<pg8::EpiBrM, pg8::StaticOrder, true, true>(lds + RING_OFF, gm, S, E); }
        GRID_BAR(); }
#endif
#if PHASES & 32
        for (int rep = 0; rep < 1 + ((DBL >> 5) & 1); ++rep) {
        { PHASE_IDS(); PHASE_PTRS(); pg8::Gemm gm{MB, WOUT, NT, DM, DM, DM}; pg8::StaticOrder S; S.init(NT, DM, G, bx);
          pg8::EpiRes E{MG, l == 0 ? x_in : (const float*)X1, alpha};
          pg8::gemm_phase<pg8::EpiRes, pg8::StaticOrder, true, true>(lds + RING_OFF, gm, S, E); }
        GRID_BAR(); }
#endif
#if PHASES & 64
        for (int rep = 0; rep < 1 + ((DBL >> 6) & 1); ++rep) {
        { PHASE_IDS(); PHASE_PTRS(); const float* g1 = args.in[9] + l * DM; const float* b1 = args.in[10] + l * DM;
          const float* wgrp = args.in[11] + (size_t)l * DM * 4; const float* bgrp = args.in[12] + l * 4; const float* wrt = args.in[13] + (size_t)l * DM * 32; const float* brt = args.in[14] + l * 32;
          for (int t = bx; t < NT / 32; t += G) ln_router_tile(t, MG, g1, b1, X1, MB, wgrp, bgrp, wrt, brt, hist, tok_e, tok_w, tok_p, ldc, tid, lane, wid); }
        GRID_BAR(); }
#endif
#if PHASES & 128
        for (int rep = 0; rep < 1 + ((DBL >> 7) & 1); ++rep) {
        { PHASE_IDS(); PHASE_PTRS();
          const LAS int* off_l = (const LAS int*)ldc; const LAS int* cnt_l = (const LAS int*)(ldc + 256); const LAS int* pre_l = (const LAS int*)(ldc + 512);
          for (int tile = bx; tile < NT / 32; tile += G) {
              const int total = moe_offsets_hist(hist, tile, ldc, tid);
              if (tile == bx) {
                  for (int r = bx * NTHR + tid; r < total; r += G * NTHR) { int e = 0;
                      for (int kk = 1; kk < 32; ++kk) if (off_l[kk] <= r) e = kk;
                      if (r >= off_l[e] + cnt_l[e]) { rowts[r] = -1; roww[r] = 0.f; }
                      if ((r & 255) == 0) panel_e[r >> 8] = e; }
                  if (bx == 0 && tid < 32) cntg[tid] = cnt_l[tid]; }
              for (int q = 0; q < 8; ++q) { const int p = tile * 64 + wid * 8 + q; const int e = tok_e[p], row = off_l[e] + pre_l[e] + tok_p[p]; const int token = p >> 1;
                  const v4u* src = (const v4u*)((const unsigned char*)MB + (size_t)token * DM); v4u* dst = (v4u*)((unsigned char*)XS + (size_t)row * DM);
#pragma unroll
                  for (int qq = 0; qq < 2; ++qq) dst[lane + 64 * qq] = src[lane + 64 * qq];
                  if (lane == 0) { rowts[row] = p; roww[row] = tok_w[p]; } }
              __syncthreads(); }
          __syncthreads(); }
        GRID_BAR(); }
#endif
#if PHASES & 256
        for (int rep = 0; rep < 1 + ((DBL >> 8) & 1); ++rep) {
        { PHASE_IDS(); PHASE_PTRS();
          const int total = moe_offsets(cntg, ldc, tid);
          __syncthreads();
          pg8::Gemm gm{XS, WGU, ROWCAP, NEXP * 512, DM / 2, DM / 2, FP8_SCA, FP8_SCB}; pg8::MoeOrder<2> S{(total >> 8) * 2, G, bx, panel_e};
          pg8::EpiGU E{HB, roww};
          pg8::gemm_phase<pg8::EpiGU, pg8::MoeOrder<2>, true, true, true>(lds + RING_OFF, gm, S, E); }
        GRID_BAR(); }
#endif
#if PHASES & 512
        for (int rep = 0; rep < 1 + ((DBL >> 9) & 1); ++rep) {
        { PHASE_IDS(); PHASE_PTRS();
          const int total = moe_offsets(cntg, ldc, tid);
          __syncthreads();
          pg8::Gemm gm{HB, WD, ROWCAP, NEXP * DM, DEXP, DEXP}; pg8::MoeOrder<8> S{(total >> 8) * 8, G, bx, panel_e};
          pg8::EpiDown E{XS, (unsigned)((WS_Y - WS_XS) / 2), rowts};
          pg8::gemm_phase<pg8::EpiDown, pg8::MoeOrder<8>, true, true>(lds + RING_OFF, gm, S, E); }
        GRID_BAR(); }
#endif
#if PHASES & 1024
        for (int rep = 0; rep < 1 + (((DBL >> 10) & 1) && l == DEPTH - 1 ? 1 : 0); ++rep) {
        { PHASE_IDS(); PHASE_PTRS(); const float* g2 = args.in[18] + l * DM; const float* b2 = args.in[19] + l * DM; const bool last = (l == DEPTH - 1); float* xo = last ? args.out : X1;
          for (int row = gw; row < NT; row += NGW) { f32x4 v[8];
#pragma unroll
              for (int j = 0; j < 8; ++j) { const f32x4 a = ((const f32x4*)(X1 + (size_t)row * DM))[lane + 64 * j];
                  const v2u y0 = ((const v2u*)(YB + (size_t)row * DM))[lane + 64 * j], y1 = ((const v2u*)(YB + ((size_t)NT + row) * DM))[lane + 64 * j];
                  v[j][0] = a[0] * alpha + (bflo(y0.x) + bflo(y1.x)); v[j][1] = a[1] * alpha + (bfhi(y0.x) + bfhi(y1.x));
                  v[j][2] = a[2] * alpha + (bflo(y0.y) + bflo(y1.y)); v[j][3] = a[3] * alpha + (bfhi(y0.y) + bfhi(y1.y)); }
              ln_row(v, g2, b2, lane);
#pragma unroll
              for (int j = 0; j < 8; ++j) { ((f32x4*)(xo + (size_t)row * DM))[lane + 64 * j] = v[j];
                  if (!last) ((unsigned*)((unsigned char*)XB + (size_t)row * DM))[lane + 64 * j] = pk4_fp8(v[j], FP8_XSCALE); } } }
        if (l + 1 < DEPTH) GRID_BAR(); }
#endif
    }
}

extern "C" void kernel_launch(void* const* d_in, const int* in_sizes, int n_in, void* d_out, int out_size, void* d_ws, size_t ws_size, hipStream_t stream) {
    static int grid = 0;
    if (grid == 0) {
        if (n_in != 20 || in_sizes[0] != NT * DM || out_size != NT * DM || ws_size < WS_END) { fprintf(stderr, "kernel_launch: unexpected shapes (n_in %d, in0 %d, out %d, ws %zu < %zu?)\n", n_in, n_in > 0 ? in_sizes[0] : -1, out_size, ws_size, (size_t)WS_END); grid = -1; return; }
        int dev = 0, cus = 0, per_cu = 0;
        if (hipGetDevice(&dev) != hipSuccess || hipDeviceGetAttribute(&cus, hipDeviceAttributeMultiprocessorCount, dev) != hipSuccess) { grid = -1; return; }
        if (hipFuncSetAttribute((const void*)fwd_kernel, hipFuncAttributeMaxDynamicSharedMemorySize, LDS_BYTES) != hipSuccess) { fprintf(stderr, "kernel_launch: hipFuncSetAttribute failed\n"); grid = -1; return; }
        if (hipOccupancyMaxActiveBlocksPerMultiprocessor(&per_cu, (const void*)fwd_kernel, NTHR, LDS_BYTES) != hipSuccess || per_cu < 1) fprintf(stderr, "kernel_launch: occupancy query reports %d\n", per_cu);
        (void)hipGetLastError();
        grid = cus;
    }
    if (grid < 0) return;
    if (hipMemsetAsync((char*)d_ws + WS_CTL, 0, CTL_ZERO_BYTES, stream) != hipSuccess) return;
    Args a{};
    for (int i = 0; i < 20; ++i) a.in[i] = (const float*)d_in[i];
    a.out = (float*)d_out; a.ws = (unsigned char*)d_ws;
    hipLaunchKernelGGL(fwd_kernel, dim3(grid), dim3(NTHR), LDS_BYTES, stream, a);
    const hipError_t le = hipPeekAtLastError();
    if (le != hipSuccess) fprintf(stderr, "kernel_launch: launch failed: %s\n", hipGetErrorName(le));
}
```

```cpp
#include <hip/hip_runtime.h>
#include <cstdio>
#include <cstdint>
namespace pg8 {
#define PG8_LAS __attribute__((address_space(3)))
typedef unsigned short bf16_t;
typedef short bf16x8 __attribute__((ext_vector_type(8)));
typedef float f32x4 __attribute__((ext_vector_type(4)));
typedef unsigned u32x4 __attribute__((ext_vector_type(4)));
constexpr int BM = 256, BK = 64, HALF = 128, HTB = HALF * BK * 2  , STAGE_BYTES = 8 * HTB, NXCD = 8, WGM = 8;

__host__ __device__ __forceinline__ int lds_byte(int r, int c) { const int st = (r >> 4) * 2 + (c >> 5), rr = r & 15, cc = c & 31, ob = rr * 64 + cc * 2; return st * 1024 + (ob ^ (((ob >> 9) & 1) << 5)); }
__host__ __device__ __forceinline__ void stage_rc(int b, int& R, int& C) { const int st = b / 1024, sb = b % 1024, swz = sb ^ (((sb >> 9) & 1) << 5); R = (st >> 1) * 16 + swz / 64; C = (st & 1) * 32 + (swz % 64) / 2; }
__host__ __device__ __forceinline__ int perm32(int rho) { const int n = rho >> 4, i = rho & 15; return 8 * (i >> 2) + 4 * n + (i & 3); }

struct Unit { int pm, pn; };
struct Gemm { const bf16_t* A; const bf16_t* Bt; int M, N, K, lda; int sca = 0x7f7f7f7f, scb = 0x7f7f7f7f; };
typedef int i32x8 __attribute__((ext_vector_type(8)));

struct StaticOrder {
    int nM, nN, nwg, G, c;
    __host__ __device__ void init(int M, int N, int G_, int c_) { nM = M / BM; nN = N / BM; nwg = nM * nN; G = G_; c = c_; }
    __host__ __device__ bool next(int i, Unit& u) const {
        const long L = (long)i * G + c; if (L >= nwg) return false;
        int wgid = (int)L; { const int q = nwg / NXCD, r = nwg % NXCD, xcd = wgid % NXCD, off = wgid / NXCD; wgid = (xcd < r ? xcd * (q + 1) : r * (q + 1) + (xcd - r) * q) + off; }
        const int nig = WGM * nN, gid = wgid / nig, fm = gid * WGM, gsz = (nM - fm) < WGM ? (nM - fm) : WGM;
        u.pm = fm + ((wgid % nig) % gsz); u.pn = (wgid % nig) / gsz; return true;
    }
    __device__ __forceinline__ void a_ready(const Unit&) const {}
    __device__ __forceinline__ void done(const Unit&) const {}
};
__device__ __forceinline__ unsigned cvt_pk_bf16(float lo, float hi) { unsigned r; asm volatile("v_cvt_pk_bf16_f32 %0, %1, %2" : "=v"(r) : "v"(lo), "v"(hi)); return r; }
__device__ __forceinline__ float bf_lo(unsigned w) { return __uint_as_float(w << 16); }
__device__ __forceinline__ float bf_hi(unsigned w) { return __uint_as_float(w & 0xffff0000u); }
__device__ __forceinline__ float sigmoidf_(float x) { return __builtin_amdgcn_rcpf(1.0f + __builtin_amdgcn_exp2f(-1.4426950408889634f * x)); }
typedef unsigned u32x2 __attribute__((ext_vector_type(2)));

struct EpiZ {
    static constexpr bool PERM = false, AFTER_DRAIN = false, HOOK = false; static constexpr int HK0 = -1, HK1 = -1;
    bf16_t* O; int ldc; int sig_from;
    __device__ __forceinline__ void operator()(const f32x4 (&acc)[2][2][4][2], const Unit& u, int wr, int wc, int, int) const {
        int t_ = threadIdx.x; asm volatile("" : "+v"(t_)); const int fr = t_ & 15, fq = (t_ >> 4) & 3;
        const int row0 = u.pm * BM + wr * 64 + fr, col0 = u.pn * BM + wc * 32 + 4 * fq; const bool sg = u.pn >= sig_from;
        unsigned eo = (unsigned)row0 * (unsigned)ldc + (unsigned)col0;
#pragma unroll
        for (int ai = 0; ai < 2; ++ai)
#pragma unroll
            for (int m = 0; m < 4; ++m) { asm volatile("" : "+v"(eo)); bf16_t* rowp = O + eo; eo += (unsigned)((m == 3 ? HALF - 48 : 16) * ldc);
#pragma unroll
                for (int bj = 0; bj < 2; ++bj)
#pragma unroll
                    for (int n = 0; n < 2; ++n) { f32x4 v = acc[ai][bj][m][n];
                        if (sg) {
#pragma unroll
                            for (int j = 0; j < 4; ++j) v[j] = sigmoidf_(v[j]); }
                        u32x2 w; w.x = cvt_pk_bf16(v[0], v[1]); w.y = cvt_pk_bf16(v[2], v[3]);
                        *(u32x2*)(rowp + bj * HALF + n * 16) = w; }
                asm volatile("" ::: "memory"); }
    }
};
struct EpiBrM {
    static constexpr bool PERM = false, AFTER_DRAIN = false, HOOK = true; static constexpr int HK0 = 16, HK1 = 24;
    bf16_t* MB; const bf16_t* Zg; int ldz;
    __device__ __forceinline__ void mid(f32x4 (&acc)[2][2][4][2], const Unit& u, int wr, int wc, int, int, int kt) const {
        int t_ = threadIdx.x; asm volatile("" : "+v"(t_)); const int fr = t_ & 15, fq = (t_ >> 4) & 3;
        const int row0 = u.pm * BM + wr * 64 + fr, col0 = u.pn * BM + wc * 32 + 4 * fq; const bf16_t* zs = Zg + (kt == HK0 ? 0 : 2048);
        unsigned eo = (unsigned)row0 * (unsigned)ldz + (unsigned)col0;
#pragma unroll
        for (int ai = 0; ai < 2; ++ai)
#pragma unroll
            for (int m = 0; m < 4; ++m) { asm volatile("" : "+v"(eo)); const bf16_t* zr = zs + eo; eo += (unsigned)((m == 3 ? HALF - 48 : 16) * ldz);
#pragma unroll
                for (int bj = 0; bj < 2; ++bj)
#pragma unroll
                    for (int n = 0; n < 2; ++n) { const u32x2 ga = *(const u32x2*)(zr + bj * HALF + n * 16), gb = *(const u32x2*)(zr + 2048 + bj * HALF + n * 16);
                        f32x4 v = acc[ai][bj][m][n];
                        v[0] *= bf_lo(ga.x) * __builtin_amdgcn_rcpf(fmaxf(bf_lo(gb.x), 1e-30f)); v[1] *= bf_hi(ga.x) * __builtin_amdgcn_rcpf(fmaxf(bf_hi(gb.x), 1e-30f));
                        v[2] *= bf_lo(ga.y) * __builtin_amdgcn_rcpf(fmaxf(bf_lo(gb.y), 1e-30f)); v[3] *= bf_hi(ga.y) * __builtin_amdgcn_rcpf(fmaxf(bf_hi(gb.y), 1e-30f));
                        acc[ai][bj][m][n] = v; }
                asm volatile("" ::: "memory"); }
    }
    __device__ __forceinline__ void operator()(const f32x4 (&acc)[2][2][4][2], const Unit& u, int wr, int wc, int, int) const {
        int t_ = threadIdx.x; asm volatile("" : "+v"(t_)); const int fr = t_ & 15, fq = (t_ >> 4) & 3;
        const int row0 = u.pm * BM + wr * 64 + fr, col0 = u.pn * BM + wc * 32 + 4 * fq;
#pragma unroll
        for (int ai = 0; ai < 2; ++ai)
#pragma unroll
            for (int m = 0; m < 4; ++m) { const int row = row0 + ai * HALF + m * 16;
#pragma unroll
                for (int bj = 0; bj < 2; ++bj)
#pragma unroll
                    for (int n = 0; n < 2; ++n) { const int col = col0 + bj * HALF + n * 16;
                        const u32x2 gw = *(const u32x2*)(Zg + (size_t)row * ldz + 4096 + col);
                        f32x4 v = acc[ai][bj][m][n]; v[0] *= bf_lo(gw.x); v[1] *= bf_hi(gw.x); v[2] *= bf_lo(gw.y); v[3] *= bf_hi(gw.y);
                        u32x2 w; w.x = cvt_pk_bf16(v[0], v[1]); w.y = cvt_pk_bf16(v[2], v[3]); *(u32x2*)(MB + (size_t)row * 2048 + col) = w; }
                asm volatile("" ::: "memory"); }
    }
};
struct EpiRes {
    static constexpr bool PERM = false, AFTER_DRAIN = false, HOOK = false; static constexpr int HK0 = -1, HK1 = -1;
    float* R; const float* xres; float alpha;
    __device__ __forceinline__ void operator()(const f32x4 (&acc)[2][2][4][2], const Unit& u, int wr, int wc, int, int) const {
        int t_ = threadIdx.x; asm volatile("" : "+v"(t_)); const int fr = t_ & 15, fq = (t_ >> 4) & 3;
        const int row0 = u.pm * BM + wr * 64 + fr, col0 = u.pn * BM + wc * 32 + 4 * fq;
#pragma unroll
        for (int ai = 0; ai < 2; ++ai)
#pragma unroll
            for (int m = 0; m < 4; ++m) { const size_t off = (size_t)(row0 + ai * HALF + m * 16) * 2048 + col0;
#pragma unroll
                for (int bj = 0; bj < 2; ++bj)
#pragma unroll
                    for (int n = 0; n < 2; ++n) { const f32x4 xr = *(const f32x4*)(xres + off + bj * HALF + n * 16);
                        *(f32x4*)(R + off + bj * HALF + n * 16) = xr * alpha + acc[ai][bj][m][n]; } }
    }
};
struct EpiGU {
    static constexpr bool PERM = false, AFTER_DRAIN = false, HOOK = false; static constexpr int HK0 = -1, HK1 = -1;
    bf16_t* H; const float* roww;
    __device__ __forceinline__ void operator()(const f32x4 (&acc)[2][2][4][2], const Unit& u, int wr, int wc, int, int) const {
        int t_ = threadIdx.x; asm volatile("" : "+v"(t_)); const int fr = t_ & 15, fq = (t_ >> 4) & 3;
        const int row0 = u.pm * BM + wr * 64 + fr, col0 = (u.pn & 1) * HALF + wc * 32 + 4 * fq;
#pragma unroll
        for (int ai = 0; ai < 2; ++ai)
#pragma unroll
            for (int m = 0; m < 4; ++m) { const int row = row0 + ai * HALF + m * 16; const float w = roww[row];
#pragma unroll
                for (int n = 0; n < 2; ++n) { const f32x4 gt = acc[ai][0][m][n], up = acc[ai][1][m][n]; f32x4 h;
#pragma unroll
                    for (int j = 0; j < 4; ++j) h[j] = gt[j] * sigmoidf_(gt[j]) * up[j] * w;
                    u32x2 o; o.x = cvt_pk_bf16(h[0], h[1]); o.y = cvt_pk_bf16(h[2], h[3]);
                    *(u32x2*)(H + (size_t)row * 256 + col0 + n * 16) = o; }
                asm volatile("" ::: "memory"); }
    }
};
struct EpiDown {
    static constexpr bool PERM = true, AFTER_DRAIN = false, HOOK = false; static constexpr int HK0 = -1, HK1 = -1;
    bf16_t* dump; unsigned yoff; const int* rowts;
    __device__ __forceinline__ void operator()(const f32x4 (&acc)[2][2][4][2], const Unit& u, int wr, int wc, int, int) const {
        int t_ = threadIdx.x; asm volatile("" : "+v"(t_)); const int fr = t_ & 15, fq = (t_ >> 4) & 3;
        const int row0 = u.pm * BM + wr * 64 + fr, col0 = (u.pn & 7) * BM + wc * 32 + 8 * fq;
#pragma unroll
        for (int ai = 0; ai < 2; ++ai)
#pragma unroll
            for (int m = 0; m < 4; ++m) { const int row = row0 + ai * HALF + m * 16; const int ts = rowts[row];
                const unsigned eo = (ts >= 0 ? yoff + (unsigned)((ts & 1) * 8192 + (ts >> 1)) * 2048u : (unsigned)row * 2048u) + (unsigned)col0;
                bf16_t* rowp = dump + eo;
#pragma unroll
                for (int bj = 0; bj < 2; ++bj) { const f32x4 v0 = acc[ai][bj][m][0], v1 = acc[ai][bj][m][1];
                    u32x4 w; w.x = cvt_pk_bf16(v0[0], v0[1]); w.y = cvt_pk_bf16(v0[2], v0[3]); w.z = cvt_pk_bf16(v1[0], v1[1]); w.w = cvt_pk_bf16(v1[2], v1[3]);
                    *(u32x4*)(rowp + bj * HALF) = w; }
                asm volatile("" ::: "memory"); }
    }
};
template <int NPER> struct MoeOrder {
    int total, G, c; const int* panel_e;
    __device__ __forceinline__ bool next(int i, Unit& u) const { const int L = i * G + c; if (L >= total) return false; const int pm = L / NPER; u.pm = pm; u.pn = panel_e[pm] * NPER + (L % NPER); return true; }
    __device__ __forceinline__ void a_ready(const Unit&) const {}
    __device__ __forceinline__ void done(const Unit&) const {}
};

template <bool F8> struct Frags { bf16x8 At[4][2], B0[2][2], B1[2][2]; };
template <> struct Frags<true> { i32x8 At8[4], B08[2], B18[2]; };
template <class Epi, class Sched, bool ALIGN_EPI = false, bool SP2 = false, bool FP8 = false>
__device__ __forceinline__ void gemm_phase(PG8_LAS unsigned char* lds, const Gemm g, const Sched& S, const Epi& E) {
    int tid_ = threadIdx.x; asm volatile("" : "+v"(tid_));
    const int tid = tid_, wid = __builtin_amdgcn_readfirstlane(tid >> 6), lane = tid & 63, wr = wid >> 2, wc = wid & 3, fr = lane & 15, fq = lane >> 4;
    const int K = g.K, nt = K / BK, LDA = g.lda;
    unsigned voffA[2], voffB[2];
#pragma unroll
    for (int i = 0; i < 2; ++i) { int R, C; stage_rc(tid * 16 + i * 8192, R, C); const int Rb = Epi::PERM ? ((R & ~31) + perm32(R & 31)) : R;
        voffA[i] = (unsigned)(R * LDA + C) * 2u; voffB[i] = (unsigned)(Rb * K + C) * 2u; }
    const size_t kstep = (size_t)(BK * 2);
    const size_t hstep = (size_t)HALF * K * 2, hstepA = (size_t)HALF * LDA * 2;
    const size_t tstep = 2 * hstep, tstepA = 2 * hstepA;
    const unsigned ldsbase = (unsigned)__builtin_amdgcn_readfirstlane((int)(unsigned)(uintptr_t)lds + wid * 1024);
    const unsigned ldsw = (unsigned)wid * 1024u;
    const int aoff = lds_byte(wr * 64 + fr, fq * 8), boff = lds_byte(wc * 32 + fr, fq * 8);
#define PG8_CAT(x0, x1) __builtin_bit_cast(i32x8, __builtin_shufflevector(x0, x1, 0, 1, 2, 3, 4, 5, 6, 7, 8, 9, 10, 11, 12, 13, 14, 15))
#define PG8_SA(b, h) (((b) * 2 + (h)) * HTB)
#define PG8_SB(b, h) ((4 + (b) * 2 + (h)) * HTB)
#define PG8_STAGE(bufoff, gbase, voff) do { if constexpr (FP8) { _Pragma("unroll") for (int _i = 0; _i < 2; ++_i) { \
            asm volatile("s_mov_b32 m0, %2\n\ts_nop 0\n\tglobal_load_lds_dwordx4 %0, %1" :: "v"((voff)[_i]), "s"((const char*)(gbase)), "s"(ldsbase + (unsigned)((bufoff) + _i * 8192)) : "memory", "m0"); } } \
        else { _Pragma("unroll") for (int _i = 0; _i < 2; ++_i) \
        __builtin_amdgcn_global_load_lds((const unsigned*)((const char*)(gbase) + (voff)[_i]), (PG8_LAS unsigned*)(lds + (bufoff) + ldsw + _i * 8192), 16, 0, 0); } } while (0)
#define PG8_LDA(dst, b, h) do { if constexpr (FP8) { _Pragma("unroll") for (int m = 0; m < 4; ++m) fg.dst##8[m] = PG8_CAT(*(const PG8_LAS bf16x8*)(lds + PG8_SA(b, h) + aoff + m * 2048), *(const PG8_LAS bf16x8*)(lds + PG8_SA(b, h) + aoff + m * 2048 + 1024)); } \
        else { _Pragma("unroll") for (int m = 0; m < 4; ++m) _Pragma("unroll") for (int k = 0; k < 2; ++k) fg.dst[m][k] = *(const PG8_LAS bf16x8*)(lds + PG8_SA(b, h) + aoff + m * 2048 + k * 1024); } } while (0)
#define PG8_LDB(dst, b, h) do { if constexpr (FP8) { _Pragma("unroll") for (int n = 0; n < 2; ++n) fg.dst##8[n] = PG8_CAT(*(const PG8_LAS bf16x8*)(lds + PG8_SB(b, h) + boff + n * 2048), *(const PG8_LAS bf16x8*)(lds + PG8_SB(b, h) + boff + n * 2048 + 1024)); } \
        else { _Pragma("unroll") for (int n = 0; n < 2; ++n) _Pragma("unroll") for (int k = 0; k < 2; ++k) fg.dst[n][k] = *(const PG8_LAS bf16x8*)(lds + PG8_SB(b, h) + boff + n * 2048 + k * 1024); } } while (0)
#define PG8_MMA(ai, bj, At, Bt) do { __builtin_amdgcn_s_setprio(1); \
        if constexpr (FP8) { _Pragma("unroll") for (int m = 0; m < 4; ++m) _Pragma("unroll") for (int n = 0; n < 2; ++n) \
            acc[ai][bj][m][n] = __builtin_amdgcn_mfma_scale_f32_16x16x128_f8f6f4(fg.Bt##8[n], fg.At##8[m], acc[ai][bj][m][n], 0, 0, 0, g.scb, 0, g.sca); } \
        else { _Pragma("unroll") for (int m = 0; m < 4; ++m) _Pragma("unroll") for (int n = 0; n < 2; ++n) _Pragma("unroll") for (int k = 0; k < 2; ++k) \
            acc[ai][bj][m][n] = __builtin_amdgcn_mfma_f32_16x16x32_bf16(fg.Bt[n][k], fg.At[m][k], acc[ai][bj][m][n], 0, 0, 0); } \
        __builtin_amdgcn_s_setprio(0); } while (0)
#define PG8_WAIT_V(n) asm volatile("s_waitcnt vmcnt(" #n ")" ::: "memory")
#define PG8_WAIT_L(n) asm volatile("s_waitcnt lgkmcnt(" #n ")" ::: "memory")
#define PG8_BAR __builtin_amdgcn_s_barrier()
#define PG8_SCHED __builtin_amdgcn_sched_barrier(0)
    Unit cur, nxt; int ui = 0;
    if (!S.next(0, cur)) return;
    f32x4 acc[2][2][4][2];
#pragma unroll
    for (int a = 0; a < 2; ++a)
#pragma unroll
        for (int b = 0; b < 2; ++b)
#pragma unroll
            for (int m = 0; m < 4; ++m)
#pragma unroll
                for (int n = 0; n < 2; ++n) acc[a][b][m][n] = (f32x4){0.f, 0.f, 0.f, 0.f};
    Frags<FP8> fg;
    const char* cA = (const char*)g.A + (size_t)cur.pm * tstepA; const char* cB = (const char*)g.Bt + (size_t)cur.pn * tstep;
    S.a_ready(cur);
    if constexpr (SP2) {
        PG8_STAGE(PG8_SB(0, 0), cB, voffB); PG8_STAGE(PG8_SB(0, 1), cB + hstep, voffB); PG8_STAGE(PG8_SA(0, 0), cA, voffA); PG8_STAGE(PG8_SA(0, 1), cA + hstepA, voffA);
        if (wr == 1) PG8_BAR;
        PG8_WAIT_V(2); PG8_BAR;
        PG8_STAGE(PG8_SB(1, 0), cB + kstep, voffB); PG8_STAGE(PG8_SA(1, 0), cA + kstep, voffA); PG8_STAGE(PG8_SB(1, 1), cB + hstep + kstep, voffB);
        PG8_WAIT_V(6); PG8_BAR;
    } else {
        PG8_STAGE(PG8_SB(0, 0), cB, voffB); PG8_STAGE(PG8_SA(0, 0), cA, voffA); PG8_STAGE(PG8_SB(0, 1), cB + hstep, voffB); PG8_STAGE(PG8_SA(0, 1), cA + hstepA, voffA);
        if (wr == 1) PG8_BAR;
        PG8_WAIT_V(4); PG8_BAR;
        PG8_STAGE(PG8_SB(1, 0), cB + kstep, voffB); PG8_STAGE(PG8_SA(1, 0), cA + kstep, voffA); PG8_STAGE(PG8_SB(1, 1), cB + hstep + kstep, voffB);
        PG8_WAIT_V(6); PG8_BAR;
    }
    for (;;) {
        const bool has_next = S.next(ui + 1, nxt);
        const char* nA = has_next ? (const char*)g.A + (size_t)nxt.pm * tstepA : cA; const char* nB = has_next ? (const char*)g.Bt + (size_t)nxt.pn * tstep : cB;
#pragma nounroll
        for (int t = 0; t < nt; t += 2) {
            const bool last = (t == nt - 2);
            const char* a1 = cA + (size_t)(t + 1) * kstep;
            const char* a2 = last ? nA : cA + (size_t)(t + 2) * kstep; const char* b2 = last ? nB : cB + (size_t)(t + 2) * kstep;
            const char* a3 = a2 + kstep; const char* b3 = b2 + kstep;
            if (last && has_next) S.a_ready(nxt);
            if constexpr (SP2) {
            PG8_LDB(B0, 0, 0); PG8_LDB(B1, 0, 1); PG8_SCHED; PG8_LDA(At, 0, 0); PG8_STAGE(PG8_SA(1, 1), a1 + hstepA, voffA);
            PG8_WAIT_V(8); PG8_WAIT_L(0); PG8_BAR; PG8_MMA(0, 0, At, B0); PG8_MMA(0, 1, At, B1); PG8_BAR; PG8_SCHED;
            PG8_LDA(At, 0, 1); PG8_STAGE(PG8_SB(0, 0), b2, voffB); PG8_STAGE(PG8_SB(0, 1), b2 + hstep, voffB); PG8_STAGE(PG8_SA(0, 0), a2, voffA);
            PG8_WAIT_V(8); PG8_WAIT_L(0); PG8_BAR; PG8_MMA(1, 0, At, B0); PG8_MMA(1, 1, At, B1); PG8_BAR; PG8_SCHED;
            PG8_LDB(B0, 1, 0); PG8_LDB(B1, 1, 1); PG8_SCHED; PG8_LDA(At, 1, 0); PG8_STAGE(PG8_SA(0, 1), a2 + hstepA, voffA);
            PG8_WAIT_V(8); PG8_WAIT_L(0); PG8_BAR; PG8_MMA(0, 0, At, B0); PG8_MMA(0, 1, At, B1); PG8_BAR; PG8_SCHED;
            PG8_LDA(At, 1, 1); PG8_STAGE(PG8_SB(1, 0), b3, voffB); PG8_STAGE(PG8_SB(1, 1), b3 + hstep, voffB); PG8_STAGE(PG8_SA(1, 0), a3, voffA);
            PG8_WAIT_V(8); PG8_WAIT_L(0); PG8_BAR; PG8_MMA(1, 0, At, B0); PG8_MMA(1, 1, At, B1); PG8_BAR; PG8_SCHED;
            if constexpr (Epi::HOOK) { if (t + 2 == Epi::HK0 || t + 2 == Epi::HK1) E.mid(acc, cur, wr, wc, fr, fq, t + 2); }
            } else {
            PG8_LDB(B0, 0, 0); PG8_SCHED; PG8_LDA(At, 0, 0); PG8_STAGE(PG8_SA(1, 1), a1 + hstepA, voffA);
            PG8_WAIT_L(8); PG8_BAR; PG8_WAIT_L(0); PG8_MMA(0, 0, At, B0); PG8_BAR; PG8_SCHED;
            PG8_LDB(B1, 0, 1); PG8_STAGE(PG8_SB(0, 0), b2, voffB);
            PG8_BAR; PG8_WAIT_L(0); PG8_MMA(0, 1, At, B1); PG8_BAR;
            PG8_LDA(At, 0, 1); PG8_STAGE(PG8_SA(0, 0), a2, voffA);
            PG8_BAR; PG8_WAIT_L(0); PG8_MMA(1, 0, At, B0); PG8_BAR; PG8_SCHED;
            PG8_STAGE(PG8_SB(0, 1), b2 + hstep, voffB);
            PG8_WAIT_V(6); PG8_BAR; PG8_MMA(1, 1, At, B1); PG8_BAR;
            PG8_LDB(B0, 1, 0); PG8_SCHED; PG8_LDA(At, 1, 0); PG8_STAGE(PG8_SA(0, 1), a2 + hstepA, voffA);
            PG8_WAIT_L(8); PG8_BAR; PG8_WAIT_L(0); PG8_MMA(0, 0, At, B0); PG8_BAR; PG8_SCHED;
            PG8_LDB(B1, 1, 1); PG8_STAGE(PG8_SB(1, 0), b3, voffB);
            PG8_BAR; PG8_WAIT_L(0); PG8_MMA(0, 1, At, B1); PG8_BAR;
            PG8_LDA(At, 1, 1); PG8_STAGE(PG8_SA(1, 0), a3, voffA);
            PG8_BAR; PG8_WAIT_L(0); PG8_MMA(1, 0, At, B0); PG8_BAR; PG8_SCHED;
            PG8_STAGE(PG8_SB(1, 1), b3 + hstep, voffB);
            PG8_WAIT_V(6); PG8_BAR; PG8_MMA(1, 1, At, B1); PG8_BAR;
            }
        }
        if constexpr (ALIGN_EPI) { if (wr == 0) PG8_BAR; }
        if constexpr (!Epi::AFTER_DRAIN) { E(acc, cur, wr, wc, fr, fq); S.done(cur); }
        if (!has_next) break;
#pragma unroll
        for (int a = 0; a < 2; ++a)
#pragma unroll
            for (int b = 0; b < 2; ++b)
#pragma unroll
                for (int m = 0; m < 4; ++m)
#pragma unroll
                    for (int n = 0; n < 2; ++n) acc[a][b][m][n] = (f32x4){0.f, 0.f, 0.f, 0.f};
        cur = nxt; cA = nA; cB = nB; ++ui;
        if constexpr (ALIGN_EPI) { if (wr == 1) PG8_BAR; }
    }
    PG8_WAIT_V(0);
    if constexpr (!ALIGN_EPI) { if (wr == 0) PG8_BAR; }
    PG8_BAR;
    if constexpr (Epi::AFTER_DRAIN) { E.fused(acc, cur, wr, wc, fr, fq, lds, wid, lane); S.done(cur); }
#undef PG8_SA
#undef PG8_SB
#undef PG8_STAGE
#undef PG8_LDA
#undef PG8_LDB
#undef PG8_MMA
#undef PG8_CAT
#undef PG8_WAIT_V
#undef PG8_WAIT_L
#undef PG8_BAR
#undef PG8_SCHED
}
}

constexpr int NWAVES = 8, NTHR = 512;
constexpr int DM = 2048, NB = 4, SEQ = 2048, NT = NB * SEQ, DEPTH = 2;
constexpr int ZP = 11264;
constexpr int ZC_QA = 0, ZC_KVA = 1024, ZC_QB = 2560, ZC_KB = 3072, ZC_VB = 3200, ZC_QC = 3328, ZC_KC = 3840, ZC_VC = 4352, ZC_GM = 4864, ZC_GA = 11008;
constexpr int OC_A = 0, OC_B = 1024, OC_C = 1536;
constexpr int NEXP = 32, DEXP = 256, ROWCAP = 24576;
constexpr float LN_EPS = 1e-5f, LOG2E = 1.4426950408889634f;
constexpr size_t MiB = 1u << 20;
constexpr size_t WS_CTL = 0, CTL_ZERO_BYTES = 1 * MiB;
constexpr size_t WS_WIN = 2 * MiB, WS_WBRA = 46 * MiB, WS_WBRB = 50 * MiB, WS_WBRC = 52 * MiB, WS_WOUT = 54 * MiB, WS_WGU = 62 * MiB, WS_WD = 126 * MiB, WS_WCMP = 158 * MiB;
constexpr size_t WS_XB = 160 * MiB, WS_Z = 192 * MiB, WS_OA = 370 * MiB, WS_MG = 402 * MiB, WS_MB = 466 * MiB, WS_X1 = 498 * MiB, WS_H = 562 * MiB, WS_SMALL = 574 * MiB, WS_END = 576 * MiB;
constexpr size_t WS_XS = WS_Z, WS_Y = WS_Z + 96 * MiB;
constexpr size_t SM_KCMP = 0, SM_VCMP = 256 * 1024, SM_KMEAN = 512 * 1024, SM_TOKE = 640 * 1024, SM_TOKW = 704 * 1024, SM_TOKP = 768 * 1024, SM_ROWTS = 832 * 1024, SM_ROWW = 960 * 1024, SM_PANE = 1088 * 1024, SM_HIST = 1152 * 1024, SM_CNTG = 1200 * 1024;
constexpr int CW_TMO = 0, CW_BAR = 4096, CW_QUEUE = 8192, CW_ECNT = 9216, CW_NPAN = 16384;
constexpr int RING_OFF = 0, RING_BYTES = 131072, LDSCTL_OFF = RING_BYTES, MISC_OFF = LDSCTL_OFF + 320, LDS_BYTES = 147456;

#define GAS __attribute__((address_space(1)))
#define LAS __attribute__((address_space(3)))
typedef unsigned short bf16;
typedef unsigned v4u __attribute__((ext_vector_type(4)));
typedef unsigned v2u __attribute__((ext_vector_type(2)));
typedef float f32x4 __attribute__((ext_vector_type(4)));
typedef float f32x16 __attribute__((ext_vector_type(16)));
typedef short bf16x8 __attribute__((ext_vector_type(8)));
typedef short s16x4 __attribute__((ext_vector_type(4)));
typedef GAS unsigned gu32;
#define RLX_AGENT __ATOMIC_RELAXED, __HIP_MEMORY_SCOPE_AGENT
#define LDS_WAIT() asm volatile("s_waitcnt lgkmcnt(0)" ::: "memory")
#define VM_WAIT() asm volatile("s_waitcnt vmcnt(0)" ::: "memory")
__device__ __forceinline__ unsigned f2bf(float f) { unsigned u = __builtin_bit_cast(unsigned, f); return (u + 0x7fffu + ((u >> 16) & 1u)) >> 16; }
__device__ __forceinline__ unsigned pk2(float lo, float hi) { return f2bf(lo) | (f2bf(hi) << 16); }
__device__ __forceinline__ float bflo(unsigned w) { return __uint_as_float(w << 16); }
__device__ __forceinline__ float bfhi(unsigned w) { return __uint_as_float(w & 0xffff0000u); }
__device__ __forceinline__ float bf2f(bf16 b) { return __uint_as_float(((unsigned)b) << 16); }
__device__ __forceinline__ float shfl_xor_f(float v, int o, int lane) { return __int_as_float(__builtin_amdgcn_ds_bpermute((lane ^ o) << 2, __float_as_int(v))); }
__device__ __forceinline__ unsigned shfl_xor_u(unsigned v, int o, int lane) { return (unsigned)__builtin_amdgcn_ds_bpermute((lane ^ o) << 2, (int)v); }
__device__ __forceinline__ float wave_sum(float v, int lane) {
#pragma unroll
    for (int o = 1; o < 64; o <<= 1) v += shfl_xor_f(v, o, lane);
    return v;
}

#define XB_TMO      128
#define XB_XCNT(j)  (256  + 64 * (j))
#define XB_XSUB(j)  (1280 + 64 * (j))
#define XB_XGEN(j)  (2304 + 64 * (j))
#define XB_TOP      3328
#define XB_TOPGEN   3392
#define XCD_BAR_WORDS 3456
#define XB_SPIN_CAP (1u << 18)

__device__ __forceinline__ unsigned xb_ld(unsigned* p)              { return __hip_atomic_load(p, __ATOMIC_RELAXED, __HIP_MEMORY_SCOPE_AGENT); }
__device__ __forceinline__ unsigned xb_add(unsigned* p, unsigned v) { return __hip_atomic_fetch_add(p, v, __ATOMIC_RELAXED, __HIP_MEMORY_SCOPE_AGENT); }
__device__ __forceinline__ unsigned xb_xcc_id() { return (unsigned)__builtin_amdgcn_s_getreg((3 << 11) | 20) & 0xFu; }
#define XB_SPIN(cond, bar) do { unsigned _sp = 0; while (cond) { __builtin_amdgcn_s_sleep(1); \
    if ((++_sp & 255u) == 0u) { if (xb_ld(&(bar)[XB_TMO])) break; if (_sp > XB_SPIN_CAP) { atomicAdd(&(bar)[XB_TMO], 1u); break; } } } } while (0)

struct XcdBarrier {
    unsigned* bar; unsigned x;
    volatile LAS unsigned* st;
};

__device__ __forceinline__ XcdBarrier xcd_barrier_post(unsigned* bar, volatile LAS unsigned* st) {
    XcdBarrier b; b.bar = bar; b.x = xb_xcc_id(); b.st = st;
    if (threadIdx.x == 0) (void)xb_add(&bar[XB_XCNT(b.x)], 1u);
    return b;
}
__device__ __forceinline__ void xcd_barrier_complete(unsigned* bar, unsigned x, unsigned& nloc, unsigned& nx) {
    const unsigned G = gridDim.x * gridDim.y * gridDim.z;
    unsigned sum, cnt, mine, sp = 0u;
    for (;;) {
        sum = 0u; cnt = 0u; mine = 0u;
#pragma unroll
        for (unsigned j = 0; j < 16; ++j) { const unsigned c = xb_ld(&bar[XB_XCNT(j)]); sum += c; cnt += (c > 0u) ? 1u : 0u; mine = (j == x) ? c : mine; }
        if (sum == G) break;
        __builtin_amdgcn_s_sleep(1);
        if ((++sp & 255u) == 0u) { if (xb_ld(&bar[XB_TMO])) break; if (sp > XB_SPIN_CAP) { atomicAdd(&bar[XB_TMO], 1u); break; } }
    }
    nloc = mine > 0u ? mine : 1u; nx = cnt > 0u ? cnt : 1u;
}

__device__ __forceinline__ void xcd_barrier(const XcdBarrier& b) {
    asm volatile("s_waitcnt vmcnt(0)" ::: "memory");
    __syncthreads();
    if (threadIdx.x == 0) {
        unsigned* bar = b.bar;
        __builtin_amdgcn_s_waitcnt(0);
        unsigned nloc = b.st[0], nx = b.st[1];
        if (nloc == 0u) { xcd_barrier_complete(bar, b.x, nloc, nx); b.st[0] = nloc; b.st[1] = nx; }
        const unsigned old = xb_add(&bar[XB_XSUB(b.x)], 1u);
        const unsigned gen = old / nloc;
        if (old + 1u == (gen + 1u) * nloc) {
            __builtin_amdgcn_fence(__ATOMIC_RELEASE, "agent");
            asm volatile("s_waitcnt vmcnt(0)" ::: "memory");
            const unsigned og = xb_add(&bar[XB_TOP], 1u);
            const unsigned tg = og / nx;
            if (og + 1u == (tg + 1u) * nx) xb_add(&bar[XB_TOPGEN], 1u);
            else XB_SPIN(xb_ld(&bar[XB_TOPGEN]) == tg, bar);
            __builtin_amdgcn_fence(__ATOMIC_ACQUIRE, "agent");
            xb_add(&bar[XB_XGEN(b.x)], 1u);
            asm volatile("s_waitcnt vmcnt(0)" ::: "memory");
        } else {
            XB_SPIN(xb_ld(&bar[XB_XGEN(b.x)]) == gen, bar);
            __builtin_amdgcn_fence(__ATOMIC_ACQUIRE, "agent");
            asm volatile("s_waitcnt vmcnt(0)" ::: "memory");
        }
    }
    __syncthreads();
}

namespace att {
__device__ __forceinline__ int crow(int r, int hi) { return (r & 3) + 8 * (r >> 2) + 4 * hi; }
__device__ __forceinline__ f32x16 zero16() { float z = 0.f; asm volatile("" : "+v"(z)); f32x16 r;
#pragma unroll
    for (int i = 0; i < 16; ++i) r[i] = z;
    return r; }
__device__ __forceinline__ unsigned cvtpk(float lo, float hi) { unsigned r; asm volatile("v_cvt_pk_bf16_f32 %0, %1, %2" : "=v"(r) : "v"(lo), "v"(hi)); return r; }
template <int HD> __device__ __forceinline__ int kswz(int row, int colB) { return row * (HD * 2) + (colB ^ ((row & 7) << 4)); }
template <int HD> __device__ __forceinline__ int v_st(int k, int c) { const int kk = (k & ~0xC) | ((k & 4) << 1) | ((k & 8) >> 1); return ((kk >> 3) * (HD / 32) + (c >> 5)) * 512 + ((kk & 7) * 32 + (c & 31)) * 2; }
__device__ __forceinline__ int v_rd_base(int lane) { return ((lane & 3) << 3) | (((lane >> 2) & 3) << 6) | (((lane >> 4) & 1) << 5) | (((lane >> 5) & 1) << 8); }
template <int HD> constexpr int v_rd_off(int d0, int ks, int half) { return d0 * 512 + (2 * ks + half) * (HD / 32) * 512; }
template <int OFF> __device__ __forceinline__ s16x4 tr_read(int vb) { s16x4 r; asm volatile("ds_read_b64_tr_b16 %0, %1 offset:%2" : "=&v"(r) : "v"(vb), "i"(OFF) : "memory"); return r; }

template <int HD> __device__ __forceinline__ void qkt(f32x16& p0, f32x16& p1, const LAS char* Ks, const bf16x8 (&qr)[HD / 16], int r32, int hi) {
    p0 = zero16(); p1 = zero16();
#pragma unroll
    for (int d0 = 0; d0 < HD / 16; ++d0) { const int cb = (d0 * 16 + hi * 8) * 2;
        const bf16x8 b0 = *(const LAS bf16x8*)(Ks + kswz<HD>(r32, cb));
        const bf16x8 b1 = *(const LAS bf16x8*)(Ks + kswz<HD>(32 + r32, cb));
        p0 = __builtin_amdgcn_mfma_f32_32x32x16_bf16(b0, qr[d0], p0, 0, 0, 0);
        p1 = __builtin_amdgcn_mfma_f32_32x32x16_bf16(b1, qr[d0], p1, 0, 0, 0); }
}
#define ATT_PK(L, H) (bf16x8){L[0], L[1], L[2], L[3], H[0], H[1], H[2], H[3]}
template <int HD, int D0> __device__ __forceinline__ void pv_one(f32x16& od, int vb, bf16x8 pa0, bf16x8 pa1, bf16x8 pa2, bf16x8 pa3) {
    const s16x4 l0 = tr_read<v_rd_off<HD>(D0, 0, 0)>(vb), h0 = tr_read<v_rd_off<HD>(D0, 0, 1)>(vb), l1 = tr_read<v_rd_off<HD>(D0, 1, 0)>(vb), h1 = tr_read<v_rd_off<HD>(D0, 1, 1)>(vb);
    const s16x4 l2 = tr_read<v_rd_off<HD>(D0, 2, 0)>(vb), h2 = tr_read<v_rd_off<HD>(D0, 2, 1)>(vb), l3 = tr_read<v_rd_off<HD>(D0, 3, 0)>(vb), h3 = tr_read<v_rd_off<HD>(D0, 3, 1)>(vb);
    asm volatile("s_waitcnt lgkmcnt(0)" ::: "memory"); __builtin_amdgcn_sched_barrier(0);
    od = __builtin_amdgcn_mfma_f32_32x32x16_bf16(pa0, ATT_PK(l0, h0), od, 0, 0, 0);
    od = __builtin_amdgcn_mfma_f32_32x32x16_bf16(pa1, ATT_PK(l1, h1), od, 0, 0, 0);
    od = __builtin_amdgcn_mfma_f32_32x32x16_bf16(pa2, ATT_PK(l2, h2), od, 0, 0, 0);
    od = __builtin_amdgcn_mfma_f32_32x32x16_bf16(pa3, ATT_PK(l3, h3), od, 0, 0, 0);
}
template <int HD> __device__ __forceinline__ void pv_all(f32x16 (&o)[HD / 32], int vb, bf16x8 pa0, bf16x8 pa1, bf16x8 pa2, bf16x8 pa3) {
    pv_one<HD, 0>(o[0], vb, pa0, pa1, pa2, pa3); pv_one<HD, 1>(o[1], vb, pa0, pa1, pa2, pa3);
    if constexpr (HD == 128) { pv_one<HD, 2>(o[2], vb, pa0, pa1, pa2, pa3); pv_one<HD, 3>(o[3], vb, pa0, pa1, pa2, pa3); }
}
#define ATT_PK4(P, BASE, OUT) do { const unsigned a0_ = cvtpk(P[BASE + 0], P[BASE + 1]), a1_ = cvtpk(P[BASE + 2], P[BASE + 3]);   \
    const unsigned b0_ = cvtpk(P[BASE + 4], P[BASE + 5]), b1_ = cvtpk(P[BASE + 6], P[BASE + 7]);                              \
    auto r0_ = __builtin_amdgcn_permlane32_swap(a0_, b0_, false, false); auto r1_ = __builtin_amdgcn_permlane32_swap(a1_, b1_, false, false); \
    v4u w_ = {r0_[0], r1_[0], r0_[1], r1_[1]}; OUT = __builtin_bit_cast(bf16x8, w_); } while (0)
__device__ __forceinline__ float xmax32(float v) { auto rr = __builtin_amdgcn_permlane32_swap(__float_as_uint(v), __float_as_uint(v), false, false); return fmaxf(__uint_as_float(rr[0]), __uint_as_float(rr[1])); }
__device__ __forceinline__ float xsum32(float v) { auto rr = __builtin_amdgcn_permlane32_swap(__float_as_uint(v), __float_as_uint(v), false, false); return __uint_as_float(rr[0]) + __uint_as_float(rr[1]); }

struct MaskGen {
    float C, slC, dq, W; bool ok; bool inner;
    __device__ __forceinline__ void operator()(f32x16& p0, f32x16& p1) const {
        const float base = -slC * dq;
        if (inner) {
#pragma unroll
            for (int r = 0; r < 16; ++r) { const float kr = (float)((r & 3) + 8 * (r >> 2));
                const float v0 = fmaf(p0[r], C, fmaf(slC, kr, base)), v1 = fmaf(p1[r], C, fmaf(slC, kr + 32.f, base));
                p0[r] = ok ? v0 : -INFINITY; p1[r] = ok ? v1 : -INFINITY; }
        } else {
#pragma unroll
            for (int r = 0; r < 16; ++r) { const float kr = (float)((r & 3) + 8 * (r >> 2));
                const float v0 = fmaf(p0[r], C, fmaf(slC, kr, base)), v1 = fmaf(p1[r], C, fmaf(slC, kr + 32.f, base));
                p0[r] = (ok && dq >= kr && dq < W + kr) ? v0 : -INFINITY;
                p1[r] = (ok && dq >= kr + 32.f && dq < W + kr + 32.f) ? v1 : -INFINITY; }
        }
    }
};
template <int HD> __device__ __forceinline__ void softmax_pv(f32x16& p0, f32x16& p1, f32x16 (&o)[HD / 32], float& m_reg, float& l_reg, int vb, LAS float* al_l, int r32, int hi) {
    float pmax = p0[0];
#pragma unroll
    for (int r = 1; r < 16; ++r) pmax = fmaxf(pmax, p0[r]);
#pragma unroll
    for (int r = 0; r < 16; ++r) pmax = fmaxf(pmax, p1[r]);
    pmax = xmax32(pmax);
    float mn = m_reg, alpha = 1.f;
    if (!__all(pmax - m_reg <= 8.0f)) { mn = fmaxf(m_reg, pmax); alpha = __builtin_amdgcn_exp2f(m_reg - mn); m_reg = mn; }
    float ps = 0.f;
#pragma unroll
    for (int r = 0; r < 16; ++r) { p0[r] = __builtin_amdgcn_exp2f(p0[r] - mn); p1[r] = __builtin_amdgcn_exp2f(p1[r] - mn); ps += p0[r] + p1[r]; }
    ps = xsum32(ps); l_reg = l_reg * alpha + ps;
    bf16x8 pa0, pa1, pa2, pa3; ATT_PK4(p0, 0, pa0); ATT_PK4(p0, 8, pa1); ATT_PK4(p1, 0, pa2); ATT_PK4(p1, 8, pa3);
    if (__any(alpha < 1.f)) { if (hi == 0) al_l[r32] = alpha; LDS_WAIT();
#pragma unroll
        for (int r = 0; r < 16; ++r) { const float a = al_l[crow(r, hi)];
#pragma unroll
            for (int d = 0; d < HD / 32; ++d) o[d][r] *= a; }
        LDS_WAIT(); }
    pv_all<HD>(o, vb, pa0, pa1, pa2, pa3);
}
template <int HD> struct Stg { v4u k0, k1, v0, v1; };
template <int HD> __device__ __forceinline__ void sload(Stg<HD>& s, const bf16* Kp, const bf16* Vp, size_t pitch, int tid) {
    if constexpr (HD == 128) { const int sr = tid >> 4, sc = (tid & 15) * 8;
        s.k0 = *(const v4u*)(Kp + (size_t)sr * pitch + sc); s.k1 = *(const v4u*)(Kp + (size_t)(32 + sr) * pitch + sc);
        s.v0 = *(const v4u*)(Vp + (size_t)sr * pitch + sc); s.v1 = *(const v4u*)(Vp + (size_t)(32 + sr) * pitch + sc); }
    else { const int sr = tid >> 3, sc = (tid & 7) * 8; s.k0 = *(const v4u*)(Kp + (size_t)sr * pitch + sc); s.v0 = *(const v4u*)(Vp + (size_t)sr * pitch + sc); }
}
template <int HD> __device__ __forceinline__ void swrite(const Stg<HD>& s, LAS char* Kt, LAS char* Vt, int tid) {
    if constexpr (HD == 128) { const int sr = tid >> 4, sc = (tid & 15) * 8;
        *(LAS v4u*)(Kt + kswz<HD>(sr, sc * 2)) = s.k0; *(LAS v4u*)(Kt + kswz<HD>(32 + sr, sc * 2)) = s.k1;
        *(LAS v4u*)(Vt + v_st<HD>(sr, sc)) = s.v0; *(LAS v4u*)(Vt + v_st<HD>(32 + sr, sc)) = s.v1; }
    else { const int sr = tid >> 3, sc = (tid & 7) * 8; *(LAS v4u*)(Kt + kswz<HD>(sr, sc * 2)) = s.k0; *(LAS v4u*)(Vt + v_st<HD>(sr, sc)) = s.v0; }
}
constexpr int A_K0 = 0, A_K1 = 16384, A_V0 = 32768, A_V1 = 49152, A_WS = 65536, A_SEL = 67584, A_UNI = 68608, A_IMP = 68864, A_KM = 77312, A_END = 81408;

template <int HD, class TF, class SK, class FIN>
__device__ __forceinline__ void run_tiles(unsigned mask0, unsigned mask1, const bf16* Kb0, const bf16* Vb0, const bf16* Kb1, const bf16* Vb1, size_t pitch, LAS char* lds, int tid, int lane,
                                          const bf16x8 (&qr)[HD / 16], f32x16 (&o)[HD / 32], float& m_reg, float& l_reg, LAS float* al_l, const TF& tf, const SK& sk, const FIN& fin) {
    const int r32 = lane & 31, hi = lane >> 5;
    const int vb0 = (int)(uintptr_t)(lds + A_V0) + v_rd_base(lane);
    int ph = 0; unsigned m = mask0; if (m == 0u) { ph = 1; m = mask1; }
    if (m == 0u) return;
    int j = __builtin_ctz(m); m &= m - 1u;
    Stg<HD> st;
    sload<HD>(st, (ph ? Kb1 : Kb0) + (size_t)j * 64 * pitch, (ph ? Vb1 : Vb0) + (size_t)j * 64 * pitch, pitch, tid);
    swrite<HD>(st, lds + A_K0, lds + A_V0, tid);
    __syncthreads();
    int buf = 0;
    for (;;) {
        int phn = ph; unsigned mn = m; if (mn == 0u && ph == 0) { phn = 1; mn = mask1; }
        const int jn = mn ? __builtin_ctz(mn) : -1; mn &= mn - 1u;
        if (jn >= 0) sload<HD>(st, (phn ? Kb1 : Kb0) + (size_t)jn * 64 * pitch, (phn ? Vb1 : Vb0) + (size_t)jn * 64 * pitch, pitch, tid);
        if (!sk(ph, j)) { f32x16 p0, p1; qkt<HD>(p0, p1, lds + (buf ? A_K1 : A_K0), qr, r32, hi);
            const MaskGen mg = tf(ph, j); mg(p0, p1);
            softmax_pv<HD>(p0, p1, o, m_reg, l_reg, vb0 + buf * 16384, al_l, r32, hi); }
        if (jn < 0 || phn != ph) fin(ph);
        if (jn >= 0) swrite<HD>(st, lds + (buf ? A_K0 : A_K1), lds + (buf ? A_V0 : A_V1), tid);
        __syncthreads();
        if (jn < 0) break;
        ph = phn; m = mn; j = jn; buf ^= 1;
    }
}
}

constexpr int N_ATT_UNITS = 256 + 128 + 256;
struct UnitTab { unsigned short u[N_ATT_UNITS]; };
constexpr UnitTab make_units() {
    UnitTab t{}; int n = 0;
    for (int cost = 64; cost >= 0; --cost) {
        for (int c = 0; c < 32; ++c) if (c + 12 == cost) for (int bg = 0; bg < 8; ++bg) t.u[n++] = (unsigned short)((bg << 5) | c);
        for (int kb = 0; kb < 8; ++kb) if (4 * kb + 3 == cost) for (int bh = 0; bh < 16; ++bh) t.u[n++] = (unsigned short)((1 << 12) | (bh << 3) | kb);
        if (cost == 2) for (int c = 0; c < 32; ++c) for (int bg = 0; bg < 8; ++bg) t.u[n++] = (unsigned short)((2 << 12) | (bg << 5) | c);
    }
    return t;
}
__constant__ UnitTab g_units = make_units();

#define ATT_STORE_O(ND, OVAL) do { unsigned off_ = (unsigned)((4 * hi) * DM + r32) * 2u; _Pragma("unroll") for (int r_ = 0; r_ < 16; ++r_) { asm volatile("" : "+v"(off_)); \
        bf16* op_ = (bf16*)((char*)obase + off_ + (unsigned)(((r_ & 3) + 8 * (r_ >> 2)) * DM * 2)); \
        _Pragma("unroll") for (int d_ = 0; d_ < ND; ++d_) op_[32 * d_] = (bf16)f2bf(OVAL); asm volatile("" ::: "memory"); } } while (0)

#define ATT_ACC_O(FIRST) do { unsigned off_ = (unsigned)((4 * hi) * DM + r32) * 2u; \
        _Pragma("unroll") for (int g_ = 0; g_ < 2; ++g_) { asm volatile("" : "+v"(off_)); unsigned short old_[8][4]; \
            if (!(FIRST)) { _Pragma("unroll") for (int q_ = 0; q_ < 8; ++q_) { const int r_ = 8 * g_ + q_; const bf16* op_ = (const bf16*)((const char*)obase + off_ + (unsigned)(((r_ & 3) + 8 * (r_ >> 2)) * DM * 2)); \
                _Pragma("unroll") for (int d_ = 0; d_ < 4; ++d_) old_[q_][d_] = op_[32 * d_]; } } \
            _Pragma("unroll") for (int q_ = 0; q_ < 8; ++q_) { const int r_ = 8 * g_ + q_; const float f_ = fac_l[att::crow(r_, hi)]; bf16* op_ = (bf16*)((char*)obase + off_ + (unsigned)(((r_ & 3) + 8 * (r_ >> 2)) * DM * 2)); \
                _Pragma("unroll") for (int d_ = 0; d_ < 4; ++d_) { float v_ = o[d_][r_] * f_; if (!(FIRST)) v_ += bf2f(old_[q_][d_]); op_[32 * d_] = (bf16)f2bf(v_); } } \
            asm volatile("" ::: "memory"); } } while (0)

__device__ __forceinline__ void nsa_loop(int code, const bf16* Z, bf16* OA, LAS char* lds, int tid_in, int wid, unsigned mysel, unsigned uni);
__device__ __forceinline__ void nsa_unit(int code, const bf16* Z, const bf16* KCMP, const bf16* VCMP, bf16* OA, LAS char* lds, int tid_in, int wid) {
    using namespace att;
    int tid = tid_in; asm volatile("" : "+v"(tid)); const int lane = tid & 63;
    const int bg = (code >> 5) & 7, c = code & 31, b = bg >> 1, g = bg & 1;
    const int r32 = lane & 31, hi = lane >> 5, hh = wid & 3, tb = wid >> 2, head = g * 4 + hh;
    const int tl = tb * 32 + r32, tpos = c * 64 + tl;
    const size_t trow = (size_t)b * SEQ + tpos;
    const float slC = __builtin_amdgcn_exp2f(-(float)(head + 1)) * LOG2E, C = 0.08838834764831845f * LOG2E;
    LAS float* al_l = (LAS float*)(lds + A_WS) + wid * 64; LAS float* fac_l = al_l + 32;
    LAS unsigned* sel_l = (LAS unsigned*)(lds + A_SEL); LAS unsigned* uni_l = (LAS unsigned*)(lds + A_UNI); LAS float* imp_l = (LAS float*)(lds + A_IMP);
    const bf16* qp = Z + trow * ZP + ZC_QA + head * 128 + hi * 8;
    const bf16* gp = Z + trow * ZP + ZC_GA + head * 3;
    const float g0 = bf2f(gp[0]);
    for (int i = tid; i < 64 * 33; i += NTHR) imp_l[i] = 0.f;
    bf16* obase = OA + ((size_t)b * SEQ + c * 64 + tb * 32) * DM + OC_A + head * 128;
    {
        const bf16* kc = KCMP + (size_t)bg * 128 * 128; const bf16* vc = VCMP + (size_t)bg * 128 * 128;
        { Stg<128> s0, s1; sload<128>(s0, kc, vc, 128, tid); sload<128>(s1, kc + 64 * 128, vc + 64 * 128, 128, tid);
          swrite<128>(s0, lds + A_K0, lds + A_V0, tid); swrite<128>(s1, lds + A_K1, lds + A_V1, tid); }
        __syncthreads();
        bf16x8 qc[8];
#pragma unroll
        for (int d0 = 0; d0 < 8; ++d0) qc[d0] = *(const bf16x8*)(qp + d0 * 16);
        const float dq = (float)(tpos - 31 - 64 * hi);
#define NSA_CMP_SCORES(T) do { qkt<128>(a0, a1, lds + ((T) ? A_K1 : A_K0), qc, r32, hi); \
        _Pragma("unroll") for (int r = 0; r < 16; ++r) { const float kr = 16.f * (float)((r & 3) + 8 * (r >> 2)) + 1024.f * (T); const float d0_ = dq - kr, d1_ = dq - kr - 512.f; \
            a0[r] = d0_ >= 0.f ? fmaf(a0[r], C, -slC * d0_) : -INFINITY; a1[r] = d1_ >= 0.f ? fmaf(a1[r], C, -slC * d1_) : -INFINITY; } } while (0)
        f32x16 a0, a1;
        float mx = -INFINITY, ps = 0.f;
        { NSA_CMP_SCORES(0);
#pragma unroll
          for (int r = 0; r < 16; ++r) mx = fmaxf(mx, fmaxf(a0[r], a1[r]));
          float s0 = 0.f; const float m0 = (mx == -INFINITY) ? 0.f : mx;
#pragma unroll
          for (int r = 0; r < 16; ++r) s0 += __builtin_amdgcn_exp2f(a0[r] - m0) + __builtin_amdgcn_exp2f(a1[r] - m0);
          NSA_CMP_SCORES(1);
          float mx1 = mx;
#pragma unroll
          for (int r = 0; r < 16; ++r) mx1 = fmaxf(mx1, fmaxf(a0[r], a1[r]));
          const float m1 = (mx1 == -INFINITY) ? 0.f : mx1;
          float s1 = 0.f;
#pragma unroll
          for (int r = 0; r < 16; ++r) s1 += __builtin_amdgcn_exp2f(a0[r] - m1) + __builtin_amdgcn_exp2f(a1[r] - m1);
          float mh = mx1, sh = s0 * __builtin_amdgcn_exp2f(m0 - m1) + s1;
          const float mo = shfl_xor_f(mh, 32, lane), so = shfl_xor_f(sh, 32, lane);
          const float mf = fmaxf(mh, mo); const float mfz = (mf == -INFINITY) ? 0.f : mf;
          const float mhz = (mh == -INFINITY) ? 0.f : mh, moz = (mo == -INFINITY) ? 0.f : mo;
          ps = sh * __builtin_amdgcn_exp2f(mhz - mfz) + so * __builtin_amdgcn_exp2f(moz - mfz); mx = mfz; }
        const float mm = mx, inv = ps > 0.f ? 1.0f / ps : 0.f;
        LAS float* impr = imp_l + tl * 33;
#define NSA_IMP(X, GRP) do { _Pragma("unroll") for (int q4 = 0; q4 < 4; ++q4) { const int j_ = 8 * (GRP) + 2 * q4 + hi; const float hb_ = 0.5f * X[4 * q4 + 3] * inv; \
            const float aa_ = (X[4 * q4] + X[4 * q4 + 1] + X[4 * q4 + 2]) * inv + hb_; \
            (void)__hip_atomic_fetch_add(impr + j_, aa_, __ATOMIC_RELAXED, __HIP_MEMORY_SCOPE_WORKGROUP); \
            if (j_ + 1 < 32) (void)__hip_atomic_fetch_add(impr + j_ + 1, hb_, __ATOMIC_RELAXED, __HIP_MEMORY_SCOPE_WORKGROUP); } } while (0)
        f32x16 o[4];
#pragma unroll
      for (int d = 0; d < 4; ++d) o[d] = att::zero16();
        const int vb0 = (int)(uintptr_t)(lds + A_V0) + v_rd_base(lane);
        { NSA_CMP_SCORES(0);
#pragma unroll
          for (int r = 0; r < 16; ++r) { a0[r] = __builtin_amdgcn_exp2f(a0[r] - mm); a1[r] = __builtin_amdgcn_exp2f(a1[r] - mm); }
          NSA_IMP(a0, 0); NSA_IMP(a1, 1);
          bf16x8 pa0, pa1, pa2, pa3; ATT_PK4(a0, 0, pa0); ATT_PK4(a0, 8, pa1); ATT_PK4(a1, 0, pa2); ATT_PK4(a1, 8, pa3); pv_all<128>(o, vb0, pa0, pa1, pa2, pa3); }
        { NSA_CMP_SCORES(1);
#pragma unroll
          for (int r = 0; r < 16; ++r) { a0[r] = __builtin_amdgcn_exp2f(a0[r] - mm); a1[r] = __builtin_amdgcn_exp2f(a1[r] - mm); }
          NSA_IMP(a0, 2); NSA_IMP(a1, 3);
          bf16x8 pa0, pa1, pa2, pa3; ATT_PK4(a0, 0, pa0); ATT_PK4(a0, 8, pa1); ATT_PK4(a1, 0, pa2); ATT_PK4(a1, 8, pa3); pv_all<128>(o, vb0 + 16384, pa0, pa1, pa2, pa3); }
#undef NSA_IMP
#undef NSA_CMP_SCORES
        if (hi == 0) fac_l[r32] = g0 * inv; LDS_WAIT();
        ATT_ACC_O(true);
        LDS_WAIT();
    }
    __syncthreads();
    if (wid == 0) {
        unsigned sel;
        if (c <= 7) sel = (2u << c) - 1u;
        else { sel = 1u | (1u << c) | (1u << (c - 1)); unsigned cand = ((1u << (c - 1)) - 1u) & ~1u;
            const LAS float* ir = imp_l + lane * 33; float iv[30];
#pragma unroll
            for (int j = 1; j <= 29; ++j) iv[j] = ir[j];
#pragma unroll
            for (int k = 0; k < 5; ++k) { int best = -1; float bv = -INFINITY;
#pragma unroll
                for (int j = 1; j <= 29; ++j) { if (((cand >> j) & 1u) && iv[j] > bv) { bv = iv[j]; best = j; } }
                if (best < 0) best = __builtin_ctz(cand);
                sel |= 1u << best; cand &= ~(1u << best); } }
        sel_l[lane] = sel;
        unsigned un = sel;
#pragma unroll
        for (int o_ = 1; o_ < 64; o_ <<= 1) un |= shfl_xor_u(un, o_, lane);
        if (lane == 0) uni_l[0] = un;
    }
    __syncthreads();
    const unsigned mysel = sel_l[tl], uni = uni_l[0];
    asm volatile("" ::: "memory");
    nsa_loop(code, Z, OA, lds, tid, wid, mysel, uni);
}
__device__ __forceinline__ void nsa_loop(int code, const bf16* Z, bf16* OA, LAS char* lds, int tid_in, int wid, unsigned mysel, unsigned uni) {
    using namespace att;
    int tid = tid_in; asm volatile("" : "+v"(tid));
    const int lane = tid & 63;
    const int bg = (code >> 5) & 7, c = code & 31, b = bg >> 1, g = bg & 1;
    const int r32 = lane & 31, hi = lane >> 5, hh = wid & 3, tb = wid >> 2, head = g * 4 + hh;
    const int tl = tb * 32 + r32, tpos = c * 64 + tl;
    const size_t trow = (size_t)b * SEQ + tpos;
    const float slC = __builtin_amdgcn_exp2f(-(float)(head + 1)) * LOG2E, C = 0.08838834764831845f * LOG2E;
    LAS float* al_l = (LAS float*)(lds + A_WS) + wid * 64; LAS float* fac_l = al_l + 32;
    const bf16* qp = Z + trow * ZP + ZC_QA + head * 128 + hi * 8;
    const bf16* gp = Z + trow * ZP + ZC_GA + head * 3;
    const float g1 = bf2f(gp[1]), g2 = bf2f(gp[2]);
    bf16* obase = OA + ((size_t)b * SEQ + c * 64 + tb * 32) * DM + OC_A + head * 128;
    const bf16* zb = Z + (size_t)b * SEQ * ZP;
    bf16x8 qr[8];
#pragma unroll
    for (int d0 = 0; d0 < 8; ++d0) qr[d0] = *(const bf16x8*)(qp + d0 * 16);
    { f32x16 o[4];
#pragma unroll
      for (int d = 0; d < 4; ++d) o[d] = att::zero16();
      float m_reg = -1e30f, l_reg = 0.f;
      const int jlo = c > 8 ? c - 8 : 0; const unsigned wmask = ((2u << c) - 1u) & ~((1u << jlo) - 1u);
      const int twmin = c * 64 + tb * 32;
      run_tiles<128>(uni, wmask, zb + ZC_KVA + 512 + g * 128, zb + ZC_KVA + 768 + g * 128, zb + ZC_KVA + 1024 + g * 128, zb + ZC_KVA + 1280 + g * 128, (size_t)ZP, lds, tid, lane, qr, o, m_reg, l_reg, al_l,
          [&](int ph, int j) { return MaskGen{C, slC, (float)(tpos - 64 * j - 4 * hi), ph ? 512.f : 1e9f, ph ? true : (((mysel >> j) & 1u) != 0u), ph ? (j < c && j >= c - 7) : (j < c)}; },
          [&](int ph, int j) { return ph ? (twmin - (64 * j + 63) >= 512) : !__any((mysel >> j) & 1u); },
          [&](int ph) { if (hi == 0) fac_l[r32] = (ph ? g2 : g1) / l_reg; LDS_WAIT();
              ATT_ACC_O(false);
              LDS_WAIT();
#pragma unroll
      for (int d = 0; d < 4; ++d) o[d] = att::zero16();
              m_reg = -1e30f; l_reg = 0.f; }); }
}

__device__ __forceinline__ void moba_unit(int code, const bf16* Z, const float* KMEAN, bf16* OA, LAS char* lds, int tid_in, int wid) {
    using namespace att;
    int tid = tid_in; asm volatile("" : "+v"(tid)); const int lane = tid & 63;
    const int bh = (code >> 3) & 15, kb = code & 7, b = bh >> 2, h = bh & 3;
    const int r32 = lane & 31, hi = lane >> 5, tl = wid * 32 + r32, tpos = kb * 256 + tl;
    const float slC = __builtin_amdgcn_exp2f(-2.0f * (float)(h + 1)) * LOG2E, C = 0.08838834764831845f * LOG2E;
    LAS float* al_l = (LAS float*)(lds + A_WS) + wid * 64; LAS float* fac_l = al_l + 32;
    LAS unsigned* sel_l = (LAS unsigned*)(lds + A_SEL); LAS unsigned* uni_l = (LAS unsigned*)(lds + A_UNI); LAS float* km_l = (LAS float*)(lds + A_KM);
    const bf16* zb = Z + (size_t)b * SEQ * ZP;
    for (int i = tid; i < 1024; i += NTHR) km_l[i] = KMEAN[(size_t)bh * 1024 + i];
    if (tid == 0) uni_l[0] = 0u;
    __syncthreads();
    if (tid < 256) {
        unsigned sel;
        if (kb <= 3) sel = (1u << kb) - 1u;
        else { float sc[7];
#pragma unroll
            for (int n = 0; n < 7; ++n) sc[n] = 0.f;
            const bf16* qp = zb + (size_t)(kb * 256 + tid) * ZP + ZC_QC + h * 128;
            for (int d8 = 0; d8 < 16; ++d8) { const v4u q = *(const v4u*)(qp + d8 * 8);
                const float qf[8] = {bflo(q.x), bfhi(q.x), bflo(q.y), bfhi(q.y), bflo(q.z), bfhi(q.z), bflo(q.w), bfhi(q.w)};
#pragma unroll
                for (int n = 0; n < 7; ++n) if (n < kb) { const LAS float* kp = km_l + n * 128 + d8 * 8;
#pragma unroll
                    for (int i = 0; i < 8; ++i) sc[n] = fmaf(qf[i], kp[i], sc[n]); } }
            sel = 0u;
#pragma unroll
            for (int k = 0; k < 3; ++k) { int best = -1; float bv = -INFINITY;
#pragma unroll
                for (int n = 0; n < 7; ++n) if (n < kb && !((sel >> n) & 1u) && sc[n] > bv) { bv = sc[n]; best = n; }
                if (best < 0) best = __builtin_ctz(~sel);
                sel |= 1u << best; } }
        sel_l[tid] = sel;
        (void)__hip_atomic_fetch_or(uni_l, sel, __ATOMIC_RELAXED, __HIP_MEMORY_SCOPE_WORKGROUP);
    }
    __syncthreads();
    const unsigned mysel = sel_l[tl], uni = uni_l[0];
    unsigned tmask = 0xFu << (4 * kb);
    for (int n = 0; n < kb; ++n) if ((uni >> n) & 1u) tmask |= 0xFu << (4 * n);
    bf16x8 qr[8];
    { const bf16* qp = zb + (size_t)tpos * ZP + ZC_QC + h * 128 + hi * 8;
#pragma unroll
      for (int d0 = 0; d0 < 8; ++d0) qr[d0] = *(const bf16x8*)(qp + d0 * 16); }
    f32x16 o[4];
#pragma unroll
      for (int d = 0; d < 4; ++d) o[d] = att::zero16();
    float m_reg = -1e30f, l_reg = 0.f;
    const int twmax = kb * 256 + wid * 32 + 31;
    run_tiles<128>(tmask, 0u, zb + ZC_KC + h * 128, zb + ZC_VC + h * 128, zb, zb, (size_t)ZP, lds, tid, lane, qr, o, m_reg, l_reg, al_l,
        [&](int, int j) { const int blk = j >> 2; return MaskGen{C, slC, (float)(tpos - 64 * j - 4 * hi), 1e9f, blk == kb ? true : (((mysel >> blk) & 1u) != 0u), blk != kb}; },
        [&](int, int j) { const int blk = j >> 2; return blk == kb ? (64 * j > twmax) : !__any((mysel >> blk) & 1u); },
        [&](int) {});
    if (hi == 0) fac_l[r32] = 1.0f / l_reg; LDS_WAIT();
    float fr_[16];
#pragma unroll
    for (int r = 0; r < 16; ++r) fr_[r] = fac_l[crow(r, hi)];
    LDS_WAIT();
    bf16* obase = OA + ((size_t)b * SEQ + kb * 256 + wid * 32) * DM + OC_C + h * 128;
    ATT_STORE_O(4, o[d_][r_] * fr_[r_]);
}

__device__ __forceinline__ void swa_unit(int code, const bf16* Z, const float* sink, bf16* OA, LAS char* lds, int tid_in, int wid) {
    using namespace att;
    int tid = tid_in; asm volatile("" : "+v"(tid)); const int lane = tid & 63;
    const int bg = (code >> 5) & 7, c = code & 31, b = bg >> 1, g = bg & 1;
    const int r32 = lane & 31, hi = lane >> 5, hh = wid & 3, tb = wid >> 2, head = g * 4 + hh;
    const int tl = tb * 32 + r32, tpos = c * 64 + tl;
    const float slC = __builtin_amdgcn_exp2f(-(float)(head + 1)) * LOG2E, C = 0.125f * LOG2E;
    LAS float* al_l = (LAS float*)(lds + A_WS) + wid * 64; LAS float* fac_l = al_l + 32;
    const bf16* zb = Z + (size_t)b * SEQ * ZP;
    bf16x8 qr[4];
    { const bf16* qp = zb + (size_t)tpos * ZP + ZC_QB + head * 64 + hi * 8;
#pragma unroll
      for (int d0 = 0; d0 < 4; ++d0) qr[d0] = *(const bf16x8*)(qp + d0 * 16); }
    f32x16 o[2];
#pragma unroll
      for (int d = 0; d < 2; ++d) o[d] = att::zero16();
    float m_reg = -1e30f, l_reg = 0.f;
    const int jlo = c > 2 ? c - 2 : 0; const unsigned tmask = ((2u << c) - 1u) & ~((1u << jlo) - 1u);
    const int twmin = c * 64 + tb * 32;
    run_tiles<64>(tmask, 0u, zb + ZC_KB + g * 64, zb + ZC_VB + g * 64, zb, zb, (size_t)ZP, lds, tid, lane, qr, o, m_reg, l_reg, al_l,
        [&](int, int j) { return MaskGen{C, slC, (float)(tpos - 64 * j - 4 * hi), 128.f, true, j == c - 1}; },
        [&](int, int j) { return twmin - (64 * j + 63) >= 128; },
        [&](int) {});
    l_reg += __builtin_amdgcn_exp2f(sink[head] * LOG2E - m_reg);
    if (hi == 0) fac_l[r32] = 1.0f / l_reg; LDS_WAIT();
    float fr_[16];
#pragma unroll
    for (int r = 0; r < 16; ++r) fr_[r] = fac_l[crow(r, hi)];
    LDS_WAIT();
    bf16* obase = OA + ((size_t)b * SEQ + c * 64 + tb * 32) * DM + OC_B + head * 64;
    ATT_STORE_O(2, o[d_][r_] * fr_[r_]);
}

__device__ __forceinline__ void cmp_unit(int u, const bf16* Z, const bf16* WCMP, const float* pos, bf16* KCMP, bf16* VCMP, LAS char* lds, int tid, int lane, int wid) {
    const int bg = u >> 5, kv = (u >> 4) & 1, nt = (u >> 2) & 3, et = u & 3, b = bg >> 1, g = bg & 1, r32 = lane & 31, hi = lane >> 5;
    const int n = nt * 32 + r32, nc = n < 126 ? n : 126;
    const bf16* arow = Z + ((size_t)b * SEQ + 16 * nc) * ZP + ZC_KVA + kv * 256 + g * 128 + hi * 8;
    const bf16* brow = WCMP + ((size_t)kv * 128 + et * 32 + r32) * 4096 + hi * 8;
    const float* prow = pos + kv * 4096 + hi * 8;
    f32x16 acc = att::zero16();
    for (int ll = 0; ll < 4; ++ll) { const int l = 4 * wid + ll;
#pragma unroll
        for (int ds = 0; ds < 8; ++ds) { const int d = ds * 16;
            const v4u a = *(const v4u*)(arow + (size_t)l * ZP + d); const f32x4 p0 = *(const f32x4*)(prow + l * 128 + d), p1 = *(const f32x4*)(prow + l * 128 + d + 4);
            v4u af; af.x = pk2(bflo(a.x) + p0[0], bfhi(a.x) + p0[1]); af.y = pk2(bflo(a.y) + p0[2], bfhi(a.y) + p0[3]); af.z = pk2(bflo(a.z) + p1[0], bfhi(a.z) + p1[1]); af.w = pk2(bflo(a.w) + p1[2], bfhi(a.w) + p1[3]);
            const bf16x8 bfg = *(const bf16x8*)(brow + l * 128 + d);
            acc = __builtin_amdgcn_mfma_f32_32x32x16_bf16(__builtin_bit_cast(bf16x8, af), bfg, acc, 0, 0, 0); } }
    LAS float* part = (LAS float*)lds;
#pragma unroll
    for (int r = 0; r < 16; ++r) part[(wid * 32 + att::crow(r, hi)) * 33 + r32] = acc[r];
    __syncthreads();
#pragma unroll
    for (int k2 = 0; k2 < 2; ++k2) { const int idx = tid + NTHR * k2, row = idx >> 5, col = idx & 31; float s = 0.f;
#pragma unroll
        for (int w = 0; w < 8; ++w) s += part[(w * 32 + row) * 33 + col];
        const int no = nt * 32 + row; if (no == 127) s = 0.f;
        (kv ? VCMP : KCMP)[((size_t)bg * 128 + no) * 128 + et * 32 + col] = (bf16)f2bf(s); }
    __syncthreads();
}
__device__ __forceinline__ void kmean_unit(int u, const bf16* Z, float* KMEAN, LAS char* lds, int tid, int lane, int wid) {
    const int bh = u >> 3, blk = u & 7, b = bh >> 2, h = bh & 3;
    const bf16* kp = Z + ((size_t)b * SEQ + blk * 256 + wid * 32) * ZP + ZC_KC + h * 128 + 2 * lane;
    float s0 = 0.f, s1 = 0.f;
#pragma unroll 8
    for (int i = 0; i < 32; ++i) { const unsigned w = *(const unsigned*)(kp + (size_t)i * ZP); s0 += bflo(w); s1 += bfhi(w); }
    LAS float* part = (LAS float*)lds;
    part[wid * 128 + 2 * lane] = s0; part[wid * 128 + 2 * lane + 1] = s1;
    __syncthreads();
    if (tid < 128) { float s = 0.f;
#pragma unroll
        for (int w = 0; w < 8; ++w) s += part[w * 128 + tid];
        KMEAN[((size_t)bh * 8 + blk) * 128 + tid] = s * (1.0f / 256.0f); }
    __syncthreads();
}

__device__ __forceinline__ void cvt_item64(const float* W, int ldw, int k0, int n_src0, int ncols, bf16* WT, int ldt, int n_dst0, LAS unsigned* scr, int lane) {
    const int nq = lane & 15, kq = lane >> 4; const bool act = 4 * nq < ncols;
    const float* wp = W + (size_t)(k0 + 2 * kq) * ldw + n_src0 + 4 * nq;
    f32x4 v0[8], v1[8];
#pragma unroll
    for (int i = 0; i < 8; ++i) { if (act) { v0[i] = *(const f32x4*)(wp + (size_t)(8 * i) * ldw); v1[i] = *(const f32x4*)(wp + (size_t)(8 * i + 1) * ldw); } else { v0[i] = (f32x4){0.f, 0.f, 0.f, 0.f}; v1[i] = v0[i]; } }
#pragma unroll
    for (int i = 0; i < 8; ++i) { const int a = kq + 4 * i;
#pragma unroll
        for (int j = 0; j < 4; ++j) scr[(4 * nq + j) * 33 + a] = pk2(v0[i][j], v1[i][j]); }
    LDS_WAIT(); asm volatile("" ::: "memory");
    const int c = lane & 7;
#pragma unroll
    for (int i = 0; i < 8; ++i) { const int n = (lane >> 3) + 8 * i; const LAS unsigned* s = scr + n * 33 + 4 * c;
        v4u o; o.x = s[0]; o.y = s[1]; o.z = s[2]; o.w = s[3];
        if (n < ncols) *(v4u*)(WT + (size_t)(n_dst0 + n) * ldt + k0 + 8 * c) = o; }
    LDS_WAIT(); asm volatile("" ::: "memory");
}
__device__ __forceinline__ void cvt_item64_fp8(const float* W, int ldw, int k0, int n_src0, int ncols, unsigned char* WT, int ldt, int n_dst0, float scale, LAS unsigned* scr, int lane) {
    const int nq = lane & 15, kq = lane >> 4; const bool act = 4 * nq < ncols;
    const float* wp = W + (size_t)(k0 + 4 * kq) * ldw + n_src0 + 4 * nq;
    f32x4 v[4][4];
#pragma unroll
    for (int i = 0; i < 4; ++i)
#pragma unroll
        for (int rr = 0; rr < 4; ++rr) v[i][rr] = act ? *(const f32x4*)(wp + (size_t)(16 * i + rr) * ldw) : (f32x4){0.f, 0.f, 0.f, 0.f};
#pragma unroll
    for (int i = 0; i < 4; ++i)
#pragma unroll
        for (int j = 0; j < 4; ++j) { int w = 0; w = __builtin_amdgcn_cvt_pk_fp8_f32(v[i][0][j] * scale, v[i][1][j] * scale, w, false); w = __builtin_amdgcn_cvt_pk_fp8_f32(v[i][2][j] * scale, v[i][3][j] * scale, w, true);
            scr[(4 * nq + j) * 17 + kq + 4 * i] = (unsigned)w; }
    LDS_WAIT(); asm volatile("" ::: "memory");
    const int c = lane & 3;
#pragma unroll
    for (int i = 0; i < 4; ++i) { const int n = (lane >> 2) + 16 * i; const LAS unsigned* s = scr + n * 17 + 4 * c;
        v4u o; o.x = s[0]; o.y = s[1]; o.z = s[2]; o.w = s[3];
        if (n < ncols) *(v4u*)(WT + (size_t)(n_dst0 + n) * ldt + k0 + 16 * c) = o; }
    LDS_WAIT(); asm volatile("" ::: "memory");
}
__device__ __forceinline__ unsigned pk4_fp8(f32x4 v, float scale) { int w = 0; w = __builtin_amdgcn_cvt_pk_fp8_f32(v[0] * scale, v[1] * scale, w, false); w = __builtin_amdgcn_cvt_pk_fp8_f32(v[2] * scale, v[3] * scale, w, true); return (unsigned)w; }
constexpr float FP8_XSCALE = 16.f, FP8_WSCALE = 64.f;
constexpr int FP8_SCA = 0x7b7b7b7b, FP8_SCB = 0x79797979;
constexpr int CI_IN = 173 * 32, CI_BRA = 512, CI_BRB = 256, CI_BRC = 256, CI_OUT = 1024, CI_GU = 8192, CI_D = 4096, CI_CMP = 256, CI_ZERO = 232;
constexpr int CI_TOTAL = CI_IN + CI_BRA + CI_BRB + CI_BRC + CI_OUT + CI_GU + CI_D + CI_CMP + CI_ZERO;

__device__ __forceinline__ void ln_row(f32x4 (&v)[8], const float* g, const float* bta, int lane) {
    float s = 0.f;
#pragma unroll
    for (int j = 0; j < 8; ++j) s += (v[j][0] + v[j][1]) + (v[j][2] + v[j][3]);
    const float mean = wave_sum(s, lane) * (1.0f / DM); float s2 = 0.f;
#pragma unroll
    for (int j = 0; j < 8; ++j) { v[j] = v[j] - mean; s2 += (v[j][0] * v[j][0] + v[j][1] * v[j][1]) + (v[j][2] * v[j][2] + v[j][3] * v[j][3]); }
    const float rstd = 1.0f / sqrtf(wave_sum(s2, lane) * (1.0f / DM) + LN_EPS);
#pragma unroll
    for (int j = 0; j < 8; ++j) { const f32x4 gg = ((const f32x4*)g)[lane + 64 * j], bb = ((const f32x4*)bta)[lane + 64 * j]; v[j] = v[j] * rstd * gg + bb; }
}

__device__ __forceinline__ void ln_router_tile(int tile, const float* R, const float* g, const float* bta, float* X1, bf16* XB, const float* wgrp, const float* bgrp, const float* wrt, const float* brt,
                                               int* hist, int* tok_e, float* tok_w, int* tok_p, LAS char* lds, int tid, int lane, int wid) {
    LAS float* glog = (LAS float*)lds;
    LAS float* part = (LAS float*)(lds + 1024);
    LAS float* elog = (LAS float*)(lds + 1024 + 33792);
    const int row0 = tile * 32;
    LAS f32x4* lg = (LAS f32x4*)(lds + 65536);
    LAS f32x4* lb = lg + 512;
    LAS f32x4* lw = lb + 512;
    { const f32x4 a = ((const f32x4*)g)[tid], b4 = ((const f32x4*)bta)[tid]; f32x4 w4[4];
#pragma unroll
      for (int q = 0; q < 4; ++q) w4[q] = ((const f32x4*)wgrp)[tid + 512 * q];
      lg[tid] = a; lb[tid] = b4;
#pragma unroll
      for (int q = 0; q < 4; ++q) { const int kk = tid + 512 * q; lw[(kk & 3) * 512 + (kk >> 2)] = w4[q]; } }
    __syncthreads();
#pragma unroll 1
    for (int hp = 0; hp < 2; ++hp) {
        f32x4 v[2][8]; const size_t rbase = (size_t)row0 + wid * 4 + hp * 2;
#pragma unroll
        for (int i = 0; i < 2; ++i)
#pragma unroll
            for (int j = 0; j < 8; ++j) v[i][j] = ((const f32x4*)(R + (rbase + i) * DM))[lane + 64 * j];
        float mean[2], rstd[2];
#pragma unroll
        for (int i = 0; i < 2; ++i) { float s = 0.f;
#pragma unroll
            for (int j = 0; j < 8; ++j) s += (v[i][j][0] + v[i][j][1]) + (v[i][j][2] + v[i][j][3]);
            mean[i] = s; }
#pragma unroll
        for (int o_ = 1; o_ < 64; o_ <<= 1) {
#pragma unroll
            for (int i = 0; i < 2; ++i) mean[i] += shfl_xor_f(mean[i], o_, lane); }
#pragma unroll
        for (int i = 0; i < 2; ++i) { mean[i] *= (1.0f / DM); float s2 = 0.f;
#pragma unroll
            for (int j = 0; j < 8; ++j) { v[i][j] = v[i][j] - mean[i]; s2 += (v[i][j][0] * v[i][j][0] + v[i][j][1] * v[i][j][1]) + (v[i][j][2] * v[i][j][2] + v[i][j][3] * v[i][j][3]); }
            rstd[i] = s2; }
#pragma unroll
        for (int o_ = 1; o_ < 64; o_ <<= 1) {
#pragma unroll
            for (int i = 0; i < 2; ++i) rstd[i] += shfl_xor_f(rstd[i], o_, lane); }
#pragma unroll
        for (int i = 0; i < 2; ++i) rstd[i] = 1.0f / sqrtf(rstd[i] * (1.0f / DM) + LN_EPS);
        float gl[2][4];
#pragma unroll
        for (int i = 0; i < 2; ++i)
#pragma unroll
            for (int cc = 0; cc < 4; ++cc) gl[i][cc] = 0.f;
#pragma unroll
        for (int j = 0; j < 8; ++j) { const f32x4 gg = lg[lane + 64 * j], bb = lb[lane + 64 * j];
            f32x4 wr[4];
#pragma unroll
            for (int e = 0; e < 4; ++e) wr[e] = lw[e * 512 + lane + 64 * j];
#pragma unroll
            for (int i = 0; i < 2; ++i) { const f32x4 y = v[i][j] * rstd[i] * gg + bb;
                ((f32x4*)(X1 + (rbase + i) * DM))[lane + 64 * j] = y;
                ((unsigned*)((unsigned char*)XB + (rbase + i) * DM))[lane + 64 * j] = pk4_fp8(y, FP8_XSCALE);
#pragma unroll
                for (int e = 0; e < 4; ++e)
#pragma unroll
                    for (int cc = 0; cc < 4; ++cc) gl[i][cc] = fmaf(y[e], wr[e][cc], gl[i][cc]); }
            asm volatile("" ::: "memory"); }
#pragma unroll
        for (int o_ = 1; o_ < 64; o_ <<= 1) {
#pragma unroll
            for (int i = 0; i < 2; ++i)
#pragma unroll
                for (int cc = 0; cc < 4; ++cc) gl[i][cc] += shfl_xor_f(gl[i][cc], o_, lane); }
        if (lane == 0) {
#pragma unroll
            for (int i = 0; i < 2; ++i)
#pragma unroll
                for (int cc = 0; cc < 4; ++cc) glog[(wid * 4 + hp * 2 + i) * 4 + cc] = gl[i][cc] + bgrp[cc]; }
    }
    VM_WAIT(); __syncthreads();
    { f32x16 acc = att::zero16();
      const int i = lane & 31, kk = lane >> 5;
      const float* xa = X1 + (size_t)(row0 + i) * DM + 256 * wid + 4 * kk;
      const float* wb = wrt + (size_t)(256 * wid + 4 * kk) * 32 + i;
#pragma unroll 1
      for (int c8 = 0; c8 < 2; ++c8) { f32x4 a[16]; float bq[16][4];
#pragma unroll
          for (int q = 0; q < 16; ++q) { const int cch = c8 * 16 + q; a[q] = *(const f32x4*)(xa + 8 * cch);
#pragma unroll
              for (int s = 0; s < 4; ++s) bq[q][s] = wb[(8 * cch + s) * 32]; }
#pragma unroll
          for (int q = 0; q < 16; ++q)
#pragma unroll
              for (int s = 0; s < 4; ++s) acc = __builtin_amdgcn_mfma_f32_32x32x2f32(a[q][s], bq[q][s], acc, 0, 0, 0); }
#pragma unroll
      for (int r = 0; r < 16; ++r) part[(wid * 32 + att::crow(r, kk)) * 33 + i] = acc[r]; }
    __syncthreads();
#pragma unroll
    for (int k2 = 0; k2 < 2; ++k2) { const int idx = tid + NTHR * k2, row = idx >> 5, col = idx & 31; float s = brt[col];
#pragma unroll
        for (int w = 0; w < 8; ++w) s += part[(w * 32 + row) * 33 + col];
        elog[row * 33 + col] = s; }
    __syncthreads();
    if (tid < 32) { const int token = row0 + tid;
        int gi = 0; float gm = glog[tid * 4];
#pragma unroll
        for (int cc = 1; cc < 4; ++cc) { const float t = glog[tid * 4 + cc]; if (t > gm) { gm = t; gi = cc; } }
        float den = 0.f;
#pragma unroll
        for (int cc = 0; cc < 4; ++cc) den += __expf(glog[tid * 4 + cc] - gm);
        const float gw = 1.0f / den;
        int i0 = 0; float t0 = elog[tid * 33 + gi * 8];
#pragma unroll
        for (int k = 1; k < 8; ++k) { const float t = elog[tid * 33 + gi * 8 + k]; if (t > t0) { t0 = t; i0 = k; } }
        int i1 = -1; float t1 = -INFINITY;
#pragma unroll
        for (int k = 0; k < 8; ++k) { const float t = elog[tid * 33 + gi * 8 + k]; if (k != i0 && t > t1) { t1 = t; i1 = k; } }
        const float ex = __expf(t1 - t0), w0 = gw / (1.0f + ex), w1 = gw * ex / (1.0f + ex);
        const int e0 = gi * 8 + i0, e1 = gi * 8 + i1;
        LAS int* e_l = (LAS int*)(lds + 1024);
        e_l[2 * tid] = e0; e_l[2 * tid + 1] = e1; LDS_WAIT();
        int r0 = 0, r1 = 0, hc = 0;
        for (int q = 0; q < 64; ++q) { const int eq = e_l[q]; if (q < 2 * tid) { r0 += (eq == e0); r1 += (eq == e1); } hc += (eq == tid); }
        hist[tile * 32 + tid] = hc;
        tok_e[token * 2] = e0; tok_e[token * 2 + 1] = e1; tok_w[token * 2] = w0; tok_w[token * 2 + 1] = w1; tok_p[token * 2] = r0; tok_p[token * 2 + 1] = r1; }
    __syncthreads();
}
__device__ __forceinline__ int moe_offsets(const int* cntg, LAS char* lds, int tid) {
    LAS int* off_l = (LAS int*)lds; LAS int* cnt_l = (LAS int*)(lds + 256);
    if (tid < 32) cnt_l[tid] = cntg[tid];
    __syncthreads();
    if (tid == 0) { int o = 0; for (int e = 0; e < 32; ++e) { off_l[e] = o; o += (cnt_l[e] + 255) & ~255; } off_l[32] = o; }
    __syncthreads();
    return off_l[32];
}
__device__ __forceinline__ int moe_offsets_hist(const int* hist, int tile, LAS char* lds, int tid) {
    LAS int* off_l = (LAS int*)lds; LAS int* cnt_l = (LAS int*)(lds + 256); LAS int* pre_l = (LAS int*)(lds + 512); LAS int* pa = (LAS int*)(lds + 1024); LAS int* pb = (LAS int*)(lds + 1024 + 2048);
    const int e = tid & 31, part = tid >> 5; int sa = 0, sb = 0;
#pragma unroll 4
    for (int q = 0; q < 16; ++q) { const int t = part * 16 + q; const int h = hist[t * 32 + e]; sa += h; sb += (t < tile) ? h : 0; }
    pa[part * 32 + e] = sa; pb[part * 32 + e] = sb;
    __syncthreads();
    if (tid < 32) { int c = 0, p = 0;
#pragma unroll
        for (int q = 0; q < 16; ++q) { c += pa[q * 32 + tid]; p += pb[q * 32 + tid]; }
        cnt_l[tid] = c; pre_l[tid] = p; }
    __syncthreads();
    if (tid == 0) { int o = 0; for (int k = 0; k < 32; ++k) { off_l[k] = o; o += (cnt_l[k] + 255) & ~255; } off_l[32] = o; }
    __syncthreads();
    return off_l[32];
}

#ifndef DBL
#define DBL 0
#endif
#ifndef PHASES
#define PHASES 0x7FF
#endif
struct Args { const float* in[20]; float* out; unsigned char* ws; };
__global__ void __launch_bounds__(NTHR, 2) fwd_kernel(Args args) {
    extern __shared__ __attribute__((aligned(16))) unsigned char lds_raw[];
    LAS unsigned char* const lds = (LAS unsigned char*)lds_raw;
    LAS char* const ldc = (LAS char*)lds_raw;
    volatile LAS unsigned* MISC = (volatile LAS unsigned*)(lds + MISC_OFF);
    const int G = gridDim.x, bx = blockIdx.x, vcu = (G % 8 == 0) ? (bx % 8) * (G / 8) + bx / 8 : bx, NGW = G * NWAVES;
#define PHASE_IDS() int tid_ = threadIdx.x; asm volatile("" : "+v"(tid_)); const int tid = tid_, lane = tid & 63, wid = __builtin_amdgcn_readfirstlane(tid >> 6), gw = vcu * NWAVES + wid; (void)gw; (void)lane
    gu32* ctl0 = (gu32*)(args.ws + WS_CTL);
    for (int u = threadIdx.x; u < (LDS_BYTES - LDSCTL_OFF) / 4; u += NTHR) ((LAS unsigned*)(lds + LDSCTL_OFF))[u] = 0u;
    __syncthreads();
    XcdBarrier bar = xcd_barrier_post((unsigned*)(ctl0 + CW_BAR), MISC + 8);
#define GRID_BAR() xcd_barrier(bar)
#define PHASE_PTRS() GAS unsigned char* wsg_ = (GAS unsigned char*)args.ws; asm volatile("" : "+s"(wsg_)); unsigned char* ws = (unsigned char*)wsg_; gu32* ctl = (gu32*)(ws + WS_CTL); (void)ctl; const float* x_in = args.in[0]; (void)x_in; \
    bf16* WIN = (bf16*)(ws + WS_WIN); bf16* WBRA = (bf16*)(ws + WS_WBRA); bf16* WBRB = (bf16*)(ws + WS_WBRB); bf16* WBRC = (bf16*)(ws + WS_WBRC); bf16* WOUT = (bf16*)(ws + WS_WOUT); \
    bf16* WGU = (bf16*)(ws + WS_WGU); bf16* WD = (bf16*)(ws + WS_WD); bf16* WCMP = (bf16*)(ws + WS_WCMP); \
    bf16* XB = (bf16*)(ws + WS_XB); bf16* Z = (bf16*)(ws + WS_Z); bf16* OA = (bf16*)(ws + WS_OA); float* MG = (float*)(ws + WS_MG); bf16* MB = (bf16*)(ws + WS_MB); \
    float* X1 = (float*)(ws + WS_X1); bf16* HB = (bf16*)(ws + WS_H); bf16* XS = (bf16*)(ws + WS_XS); bf16* YB = (bf16*)(ws + WS_Y); \
    unsigned char* sm = ws + WS_SMALL; \
    bf16* KCMP = (bf16*)(sm + SM_KCMP); bf16* VCMP = (bf16*)(sm + SM_VCMP); float* KMEAN = (float*)(sm + SM_KMEAN); \
    int* tok_e = (int*)(sm + SM_TOKE); float* tok_w = (float*)(sm + SM_TOKW); int* tok_p = (int*)(sm + SM_TOKP); int* rowts = (int*)(sm + SM_ROWTS); float* roww = (float*)(sm + SM_ROWW); int* panel_e = (int*)(sm + SM_PANE); int* hist = (int*)(sm + SM_HIST); int* cntg = (int*)(sm + SM_CNTG); (void)hist; (void)cntg; \
    (void)WIN; (void)WBRA; (void)WBRB; (void)WBRC; (void)WOUT; (void)WGU; (void)WD; (void)WCMP; (void)XB; (void)Z; (void)OA; (void)MG; (void)MB; (void)X1; (void)HB; (void)XS; (void)YB; \
    (void)KCMP; (void)VCMP; (void)KMEAN; (void)tok_e; (void)tok_w; (void)tok_p; (void)rowts; (void)roww; (void)panel_e
    const float alpha = 1.4142135623730951f;

    for (int l = 0; l < DEPTH; ++l) {
#if PHASES & 1
        for (int rep = 0; rep < 1 + ((DBL >> 0) & 1); ++rep) {
        { PHASE_IDS(); PHASE_PTRS();
            LAS unsigned* scr = (LAS unsigned*)(lds + RING_OFF + wid * 16384);
            const float* w_in = args.in[1] + (size_t)l * DM * 11032; const float* cmpw = args.in[3] + (size_t)l * 2 * 4096 * 128;
            const float* wbra = args.in[5] + (size_t)l * 1024 * DM; const float* wbrb = args.in[6] + (size_t)l * 512 * DM; const float* wbrc = args.in[7] + (size_t)l * 512 * DM;
            const float* wout = args.in[8] + (size_t)l * DM * DM;
            const float* wgate = args.in[15] + (size_t)l * NEXP * DM * DEXP; const float* wup = args.in[16] + (size_t)l * NEXP * DM * DEXP; const float* wdown = args.in[17] + (size_t)l * NEXP * DEXP * DM;
            for (int it = gw; it < CI_TOTAL; it += NGW) {
                int r = it; const float* W; bf16* WT; int ldw, k0, ns, nc = 64, ldt, nd;
                if (r >= CI_TOTAL - CI_ZERO) { r -= CI_TOTAL - CI_ZERO; v4u* zp = (v4u*)((unsigned char*)WIN + (size_t)(11032 + r) * DM); const v4u z4 = {0u, 0u, 0u, 0u};
#pragma unroll
                    for (int q = 0; q < 2; ++q) zp[lane + 64 * q] = z4;
                    continue; }
                if (r < CI_IN) { const int kb = r / 173, nb = r % 173;
                    if (nb < 40) { ns = 64 * nb; nd = ns; } else if (nb < 172) { ns = 2584 + 64 * (nb - 40); nd = 2560 + 64 * (nb - 40); } else { ns = 2560; nd = ZC_GA; nc = 24; }
                    cvt_item64_fp8(w_in, 11032, 64 * kb, ns, nc, (unsigned char*)WIN, DM, nd, FP8_WSCALE, scr, lane); continue; }
                if ((r -= CI_IN) < CI_BRA) { W = wbra; ldw = DM; k0 = 64 * (r / 32); ns = 64 * (r % 32); WT = WBRA; ldt = DM; nd = ns; }
                else if ((r -= CI_BRA) < CI_BRB) { W = wbrb; ldw = DM; k0 = 64 * (r / 32); ns = 64 * (r % 32); WT = WBRA + 1024; ldt = DM; nd = ns; }
                else if ((r -= CI_BRB) < CI_BRC) { W = wbrc; ldw = DM; k0 = 64 * (r / 32); ns = 64 * (r % 32); WT = WBRA + 1536; ldt = DM; nd = ns; }
                else if ((r -= CI_BRC) < CI_OUT) { W = wout; ldw = DM; k0 = 64 * (r / 32); ns = 64 * (r % 32); WT = WOUT; ldt = DM; nd = ns; }
                else if ((r -= CI_OUT) < CI_GU) { const int mat = r >> 7, e = mat >> 1, which = mat & 1, rr = r & 127, f0 = 64 * (rr & 3);
                    cvt_item64_fp8((which ? wup : wgate) + (size_t)e * DM * DEXP, DEXP, 64 * (rr >> 2), f0, 64, (unsigned char*)WGU, DM, e * 512 + (f0 >> 7) * 256 + which * 128 + (f0 & 127), FP8_WSCALE, scr, lane); continue; }
                else if ((r -= CI_GU) < CI_D) { const int e = r >> 7, rr = r & 127; W = wdown + (size_t)e * DEXP * DM; ldw = DM; k0 = 64 * (rr >> 5); ns = 64 * (rr & 31); WT = WD; ldt = DEXP; nd = e * DM + ns; }
                else { r -= CI_D; const int kv = r >> 7, rr = r & 127; W = cmpw + (size_t)kv * 4096 * 128; ldw = 128; k0 = 64 * (rr >> 1); ns = 64 * (rr & 1); WT = WCMP; ldt = 4096; nd = kv * 128 + ns; }
                cvt_item64(W, ldw, k0, ns, nc, WT, ldt, nd, scr, lane);
            }
            if (l == 0) for (int row = gw; row < NT; row += NGW) { const f32x4* xr = (const f32x4*)(x_in + (size_t)row * DM);
#pragma unroll
                for (int j = 0; j < 8; ++j) { const f32x4 v = xr[lane + 64 * j]; ((unsigned*)((unsigned char*)XB + (size_t)row * DM))[lane + 64 * j] = pk4_fp8(v, FP8_XSCALE); } }
        }
        GRID_BAR(); }
#endif
#if PHASES & 2
        for (int rep = 0; rep < 1 + ((DBL >> 1) & 1); ++rep) {
        { PHASE_IDS(); PHASE_PTRS(); pg8::Gemm gm{XB, WIN, NT, ZP, DM / 2, DM / 2, FP8_SCA, FP8_SCB}; pg8::StaticOrder S; S.init(NT, ZP, G, bx);
          pg8::EpiZ E{Z, ZP, ZC_GM / 256};
          pg8::gemm_phase<pg8::EpiZ, pg8::StaticOrder, true, true, true>(lds + RING_OFF, gm, S, E); }
        GRID_BAR(); }
#endif
#if PHASES & 4
        for (int rep = 0; rep < 1 + ((DBL >> 2) & 1); ++rep) {
        { PHASE_IDS(); PHASE_PTRS(); const float* pos = args.in[2] + (size_t)l * 2 * 4096;
          for (int u = bx; u < 256; u += G) cmp_unit(u, Z, WCMP, pos, KCMP, VCMP, ldc, tid, lane, wid);
          for (int u = bx; u < 128; u += G) kmean_unit(u, Z, KMEAN, ldc, tid, lane, wid); }
        GRID_BAR(); }
#endif
#if PHASES & 8
        for (int rep = 0; rep < 1 + ((DBL >> 3) & 1); ++rep) {
        { PHASE_IDS(); PHASE_PTRS(); gu32* qw = ctl + CW_QUEUE + 64 * (2 * l + rep); const float* sink = args.in[4] + l * 8;
          LAS unsigned* uw = (LAS unsigned*)(ldc + att::A_UNI) + 2;
          for (;;) {
              if (tid == 0) *uw = __hip_atomic_fetch_add(qw, 1u, RLX_AGENT);
              __syncthreads();
              const unsigned qi = *uw;
              __syncthreads();
              if (qi >= (unsigned)N_ATT_UNITS) break;
              const int code = g_units.u[qi], kind = code >> 12;
              if (kind == 0) nsa_unit(code, Z, KCMP, VCMP, OA, ldc, tid, wid);
              else if (kind == 1) moba_unit(code, Z, KMEAN, OA, ldc, tid, wid);
              else swa_unit(code, Z, sink, OA, ldc, tid, wid);
          } }
        GRID_BAR(); }
#endif
#if PHASES & 16
        for (int rep = 0; rep < 1 + ((DBL >> 4) & 1); ++rep) {
        { PHASE_IDS(); PHASE_PTRS(); pg8::StaticOrder S; S.init(NT, DM, G, bx);
          pg8::Gemm gm{OA, WBRA, NT, DM, DM, DM}; pg8::EpiBrM E{MB, Z + ZC_GM, ZP};
          pg8::gemm_phase<pg8::EpiBrM, pg8::StaticOrder, true, true>(lds + RING_OFF, gm, S, E); }
        GRID_BAR(); }
#endif
#if PHASES & 32
        for (int rep = 0; rep < 1 + ((DBL >> 5) & 1); ++rep) {
        { PHASE_IDS(); PHASE_PTRS(); pg8::Gemm gm{MB, WOUT, NT, DM, DM, DM}; pg8::StaticOrder S; S.init(NT, DM, G, bx);
          pg8::EpiRes E{MG, l == 0 ? x_in : (const float*)X1, alpha};
          pg8::gemm_phase<pg8::EpiRes, pg8::StaticOrder, true, true>(lds + RING_OFF, gm, S, E); }
        GRID_BAR(); }
#endif
#if PHASES & 64
        for (int rep = 0; rep < 1 + ((DBL >> 6) & 1); ++rep) {
        { PHASE_IDS(); PHASE_PTRS(); const float* g1 = args.in[9] + l * DM; const float* b1 = args.in[10] + l * DM;
          const float* wgrp = args.in[11] + (size_t)l * DM * 4; const float* bgrp = args.in[12] + l * 4; const float* wrt = args.in[13] + (size_t)l * DM * 32; const float* brt = args.in[14] + l * 32;
          for (int t = bx; t < NT / 32; t += G) ln_router_tile(t, MG, g1, b1, X1, MB, wgrp, bgrp, wrt, brt, hist, tok_e, tok_w, tok_p, ldc, tid, lane, wid); }
        GRID_BAR(); }
#endif
#if PHASES & 128
        for (int rep = 0; rep < 1 + ((DBL >> 7) & 1); ++rep) {
        { PHASE_IDS(); PHASE_PTRS();
          const LAS int* off_l = (const LAS int*)ldc; const LAS int* cnt_l = (const LAS int*)(ldc + 256); const LAS int* pre_l = (const LAS int*)(ldc + 512);
          for (int tile = bx; tile < NT / 32; tile += G) {
              const int total = moe_offsets_hist(hist, tile, ldc, tid);
              if (tile == bx) {
                  for (int r = bx * NTHR + tid; r < total; r += G * NTHR) { int e = 0;
                      for (int kk = 1; kk < 32; ++kk) if (off_l[kk] <= r) e = kk;
                      if (r >= off_l[e] + cnt_l[e]) { rowts[r] = -1; roww[r] = 0.f; }
                      if ((r & 255) == 0) panel_e[r >> 8] = e; }
                  if (bx == 0 && tid < 32) cntg[tid] = cnt_l[tid]; }
              for (int q = 0; q < 8; ++q) { const int p = tile * 64 + wid * 8 + q; const int e = tok_e[p], row = off_l[e] + pre_l[e] + tok_p[p]; const int token = p >> 1;
                  const v4u* src = (const v4u*)((const unsigned char*)MB + (size_t)token * DM); v4u* dst = (v4u*)((unsigned char*)XS + (size_t)row * DM);
#pragma unroll
                  for (int qq = 0; qq < 2; ++qq) dst[lane + 64 * qq] = src[lane + 64 * qq];
                  if (lane == 0) { rowts[row] = p; roww[row] = tok_w[p]; } }
              __syncthreads(); }
          __syncthreads(); }
        GRID_BAR(); }
#endif
#if PHASES & 256
        for (int rep = 0; rep < 1 + ((DBL >> 8) & 1); ++rep) {
        { PHASE_IDS(); PHASE_PTRS();
          const int total = moe_offsets(cntg, ldc, tid);
          __syncthreads();
          pg8::Gemm gm{XS, WGU, ROWCAP, NEXP * 512, DM / 2, DM / 2, FP8_SCA, FP8_SCB}; pg8::MoeOrder<2> S{(total >> 8) * 2, G, bx, panel_e};
          pg8::EpiGU E{HB, roww};
          pg8::gemm_phase<pg8::EpiGU, pg8::MoeOrder<2>, true, true, true>(lds + RING_OFF, gm, S, E); }
        GRID_BAR(); }
#endif
#if PHASES & 512
        for (int rep = 0; rep < 1 + ((DBL >> 9) & 1); ++rep) {
        { PHASE_IDS(); PHASE_PTRS();
          const int total = moe_offsets(cntg, ldc, tid);
          __syncthreads();
          pg8::Gemm gm{HB, WD, ROWCAP, NEXP * DM, DEXP, DEXP}; pg8::MoeOrder<8> S{(total >> 8) * 8, G, bx, panel_e};
          pg8::EpiDown E{XS, (unsigned)((WS_Y - WS_XS) / 2), rowts};
          pg8::gemm_phase<pg8::EpiDown, pg8::MoeOrder<8>, true, true>(lds + RING_OFF, gm, S, E); }
        GRID_BAR(); }
#endif
#if PHASES & 1024
        for (int rep = 0; rep < 1 + (((DBL >> 10) & 1) && l == DEPTH - 1 ? 1 : 0); ++rep) {
        { PHASE_IDS(); PHASE_PTRS(); const float* g2 = args.in[18] + l * DM; const float* b2 = args.in[19] + l * DM; const bool last = (l == DEPTH - 1); float* xo = last ? args.out : X1;
          for (int row = gw; row < NT; row += NGW) { f32x4 v[8];
#pragma unroll
              for (int j = 0; j < 8; ++j) { const f32x4 a = ((const f32x4*)(X1 + (size_t)row * DM))[lane + 64 * j];
                  const v2u y0 = ((const v2u*)(YB + (size_t)row * DM))[lane + 64 * j], y1 = ((const v2u*)(YB + ((size_t)NT + row) * DM))[lane + 64 * j];
                  v[j][0] = a[0] * alpha + (bflo(y0.x) + bflo(y1.x)); v[j][1] = a[1] * alpha + (bfhi(y0.x) + bfhi(y1.x));
                  v[j][2] = a[2] * alpha + (bflo(y0.y) + bflo(y1.y)); v[j][3] = a[3] * alpha + (bfhi(y0.y) + bfhi(y1.y)); }
              ln_row(v, g2, b2, lane);
#pragma unroll
              for (int j = 0; j < 8; ++j) { ((f32x4*)(xo + (size_t)row * DM))[lane + 64 * j] = v[j];
                  if (!last) ((unsigned*)((unsigned char*)XB + (size_t)row * DM))[lane + 64 * j] = pk4_fp8(v[j], FP8_XSCALE); } } }
        if (l + 1 < DEPTH) GRID_BAR(); }
#endif
    }
}

extern "C" void kernel_launch(void* const* d_in, const int* in_sizes, int n_in, void* d_out, int out_size, void* d_ws, size_t ws_size, hipStream_t stream) {
    static int grid = 0;
    if (grid == 0) {
        if (n_in != 20 || in_sizes[0] != NT * DM || out_size != NT * DM || ws_size < WS_END) { fprintf(stderr, "kernel_launch: unexpected shapes (n_in %d, in0 %d, out %d, ws %zu < %zu?)\n", n_in, n_in > 0 ? in_sizes[0] : -1, out_size, ws_size, (size_t)WS_END); grid = -1; return; }
        int dev = 0, cus = 0, per_cu = 0;
        if (hipGetDevice(&dev) != hipSuccess || hipDeviceGetAttribute(&cus, hipDeviceAttributeMultiprocessorCount, dev) != hipSuccess) { grid = -1; return; }
        if (hipFuncSetAttribute((const void*)fwd_kernel, hipFuncAttributeMaxDynamicSharedMemorySize, LDS_BYTES) != hipSuccess) { fprintf(stderr, "kernel_launch: hipFuncSetAttribute failed\n"); grid = -1; return; }
        if (hipOccupancyMaxActiveBlocksPerMultiprocessor(&per_cu, (const void*)fwd_kernel, NTHR, LDS_BYTES) != hipSuccess || per_cu < 1) fprintf(stderr, "kernel_launch: occupancy query reports %d\n", per_cu);
        (void)hipGetLastError();
        grid = cus;
    }
    if (grid < 0) return;
    if (hipMemsetAsync((char*)d_ws + WS_CTL, 0, CTL_ZERO_BYTES, stream) != hipSuccess) return;
    Args a{};
    for (int i = 0; i < 20; ++i) a.in[i] = (const float*)d_in[i];
    a.out = (float*)d_out; a.ws = (unsigned char*)d_ws;
    hipLaunchKernelGGL(fwd_kernel, dim3(grid), dim3(NTHR), LDS_BYTES, stream, a);
    const hipError_t le = hipPeekAtLastError();
    if (le != hipSuccess) fprintf(stderr, "kernel_launch: launch failed: %s\n", hipGetErrorName(le));
}
```

```cpp
#include <hip/hip_runtime.h>
#include <cstdio>
#include <cstdint>
namespace pg8 {
#define PG8_LAS __attribute__((address_space(3)))
typedef unsigned short bf16_t;
typedef short bf16x8 __attribute__((ext_vector_type(8)));
typedef float f32x4 __attribute__((ext_vector_type(4)));
typedef unsigned u32x4 __attribute__((ext_vector_type(4)));
constexpr int BM = 256, BK = 64, HALF = 128, HTB = HALF * BK * 2  , STAGE_BYTES = 8 * HTB, NXCD = 8, WGM = 8;

__host__ __device__ __forceinline__ int lds_byte(int r, int c) { const int st = (r >> 4) * 2 + (c >> 5), rr = r & 15, cc = c & 31, ob = rr * 64 + cc * 2; return st * 1024 + (ob ^ (((ob >> 9) & 1) << 5)); }
__host__ __device__ __forceinline__ void stage_rc(int b, int& R, int& C) { const int st = b / 1024, sb = b % 1024, swz = sb ^ (((sb >> 9) & 1) << 5); R = (st >> 1) * 16 + swz / 64; C = (st & 1) * 32 + (swz % 64) / 2; }
__host__ __device__ __forceinline__ int perm32(int rho) { const int n = rho >> 4, i = rho & 15; return 8 * (i >> 2) + 4 * n + (i & 3); }

struct Unit { int pm, pn; };
struct Gemm { const bf16_t* A; const bf16_t* Bt; int M, N, K, lda; int sca = 0x7f7f7f7f, scb = 0x7f7f7f7f; };
typedef int i32x8 __attribute__((ext_vector_type(8)));

struct StaticOrder {
    int nM, nN, nwg, G, c;
    __host__ __device__ void init(int M, int N, int G_, int c_) { nM = M / BM; nN = N / BM; nwg = nM * nN; G = G_; c = c_; }
    __host__ __device__ bool next(int i, Unit& u) const {
        const long L = (long)i * G + c; if (L >= nwg) return false;
        int wgid = (int)L; { const int q = nwg / NXCD, r = nwg % NXCD, xcd = wgid % NXCD, off = wgid / NXCD; wgid = (xcd < r ? xcd * (q + 1) : r * (q + 1) + (xcd - r) * q) + off; }
        const int nig = WGM * nN, gid = wgid / nig, fm = gid * WGM, gsz = (nM - fm) < WGM ? (nM - fm) : WGM;
        u.pm = fm + ((wgid % nig) % gsz); u.pn = (wgid % nig) / gsz; return true;
    }
    __device__ __forceinline__ void a_ready(const Unit&) const {}
    __device__ __forceinline__ void done(const Unit&) const {}
};
__device__ __forceinline__ unsigned cvt_pk_bf16(float lo, float hi) { unsigned r; asm volatile("v_cvt_pk_bf16_f32 %0, %1, %2" : "=v"(r) : "v"(lo), "v"(hi)); return r; }
__device__ __forceinline__ float bf_lo(unsigned w) { return __uint_as_float(w << 16); }
__device__ __forceinline__ float bf_hi(unsigned w) { return __uint_as_float(w & 0xffff0000u); }
__device__ __forceinline__ float sigmoidf_(float x) { return __builtin_amdgcn_rcpf(1.0f + __builtin_amdgcn_exp2f(-1.4426950408889634f * x)); }
typedef unsigned u32x2 __attribute__((ext_vector_type(2)));

struct EpiZ {
    static constexpr bool PERM = false, AFTER_DRAIN = false, HOOK = false; static constexpr int HK0 = -1, HK1 = -1;
    bf16_t* O; int ldc; int sig_from;
    __device__ __forceinline__ void operator()(const f32x4 (&acc)[2][2][4][2], const Unit& u, int wr, int wc, int, int) const {
        int t_ = threadIdx.x; asm volatile("" : "+v"(t_)); const int fr = t_ & 15, fq = (t_ >> 4) & 3;
        const int row0 = u.pm * BM + wr * 64 + fr, col0 = u.pn * BM + wc * 32 + 4 * fq; const bool sg = u.pn >= sig_from;
        unsigned eo = (unsigned)row0 * (unsigned)ldc + (unsigned)col0;
#pragma unroll
        for (int ai = 0; ai < 2; ++ai)
#pragma unroll
            for (int m = 0; m < 4; ++m) { asm volatile("" : "+v"(eo)); bf16_t* rowp = O + eo; eo += (unsigned)((m == 3 ? HALF - 48 : 16) * ldc);
#pragma unroll
                for (int bj = 0; bj < 2; ++bj)
#pragma unroll
                    for (int n = 0; n < 2; ++n) { f32x4 v = acc[ai][bj][m][n];
                        if (sg) {
#pragma unroll
                            for (int j = 0; j < 4; ++j) v[j] = sigmoidf_(v[j]); }
                        u32x2 w; w.x = cvt_pk_bf16(v[0], v[1]); w.y = cvt_pk_bf16(v[2], v[3]);
                        *(u32x2*)(rowp + bj * HALF + n * 16) = w; }
                asm volatile("" ::: "memory"); }
    }
};
struct EpiBrM {
    static constexpr bool PERM = false, AFTER_DRAIN = false, HOOK = true; static constexpr int HK0 = 16, HK1 = 24;
    bf16_t* MB; const bf16_t* Zg; int ldz;
    __device__ __forceinline__ void mid(f32x4 (&acc)[2][2][4][2], const Unit& u, int wr, int wc, int, int, int kt) const {
        int t_ = threadIdx.x; asm volatile("" : "+v"(t_)); const int fr = t_ & 15, fq = (t_ >> 4) & 3;
        const int row0 = u.pm * BM + wr * 64 + fr, col0 = u.pn * BM + wc * 32 + 4 * fq; const bf16_t* zs = Zg + (kt == HK0 ? 0 : 2048);
        unsigned eo = (unsigned)row0 * (unsigned)ldz + (unsigned)col0;
#pragma unroll
        for (int ai = 0; ai < 2; ++ai)
#pragma unroll
            for (int m = 0; m < 4; ++m) { asm volatile("" : "+v"(eo)); const bf16_t* zr = zs + eo; eo += (unsigned)((m == 3 ? HALF - 48 : 16) * ldz);
#pragma unroll
                for (int bj = 0; bj < 2; ++bj)
#pragma unroll
                    for (int n = 0; n < 2; ++n) { const u32x2 ga = *(const u32x2*)(zr + bj * HALF + n * 16), gb = *(const u32x2*)(zr + 2048 + bj * HALF + n * 16);
                        f32x4 v = acc[ai][bj][m][n];
                        v[0] *= bf_lo(ga.x) * __builtin_amdgcn_rcpf(fmaxf(bf_lo(gb.x), 1e-30f)); v[1] *= bf_hi(ga.x) * __builtin_amdgcn_rcpf(fmaxf(bf_hi(gb.x), 1e-30f));
                        v[2] *= bf_lo(ga.y) * __builtin_amdgcn_rcpf(fmaxf(bf_lo(gb.y), 1e-30f)); v[3] *= bf_hi(ga.y) * __builtin_amdgcn_rcpf(fmaxf(bf_hi(gb.y), 1e-30f));
                        acc[ai][bj][m][n] = v; }
                asm volatile("" ::: "memory"); }
    }
    __device__ __forceinline__ void operator()(const f32x4 (&acc)[2][2][4][2], const Unit& u, int wr, int wc, int, int) const {
        int t_ = threadIdx.x; asm volatile("" : "+v"(t_)); const int fr = t_ & 15, fq = (t_ >> 4) & 3;
        const int row0 = u.pm * BM + wr * 64 + fr, col0 = u.pn * BM + wc * 32 + 4 * fq;
#pragma unroll
        for (int ai = 0; ai < 2; ++ai)
#pragma unroll
            for (int m = 0; m < 4; ++m) { const int row = row0 + ai * HALF + m * 16;
#pragma unroll
                for (int bj = 0; bj < 2; ++bj)
#pragma unroll
                    for (int n = 0; n < 2; ++n) { const int col = col0 + bj * HALF + n * 16;
                        const u32x2 gw = *(const u32x2*)(Zg + (size_t)row * ldz + 4096 + col);
                        f32x4 v = acc[ai][bj][m][n]; v[0] *= bf_lo(gw.x); v[1] *= bf_hi(gw.x); v[2] *= bf_lo(gw.y); v[3] *= bf_hi(gw.y);
                        u32x2 w; w.x = cvt_pk_bf16(v[0], v[1]); w.y = cvt_pk_bf16(v[2], v[3]); *(u32x2*)(MB + (size_t)row * 2048 + col) = w; }
                asm volatile("" ::: "memory"); }
    }
};
struct EpiRes {
    static constexpr bool PERM = false, AFTER_DRAIN = false, HOOK = false; static constexpr int HK0 = -1, HK1 = -1;
    float* R; const float* xres; float alpha;
    __device__ __forceinline__ void operator()(const f32x4 (&acc)[2][2][4][2], const Unit& u, int wr, int wc, int, int) const {
        int t_ = threadIdx.x; asm volatile("" : "+v"(t_)); const int fr = t_ & 15, fq = (t_ >> 4) & 3;
        const int row0 = u.pm * BM + wr * 64 + fr, col0 = u.pn * BM + wc * 32 + 4 * fq;
#pragma unroll
        for (int ai = 0; ai < 2; ++ai)
#pragma unroll
            for (int m = 0; m < 4; ++m) { const size_t off = (size_t)(row0 + ai * HALF + m * 16) * 2048 + col0;
#pragma unroll
                for (int bj = 0; bj < 2; ++bj)
#pragma unroll
                    for (int n = 0; n < 2; ++n) { const f32x4 xr = *(const f32x4*)(xres + off + bj * HALF + n * 16);
                        *(f32x4*)(R + off + bj * HALF + n * 16) = xr * alpha + acc[ai][bj][m][n]; } }
    }
};
struct EpiGU {
    static constexpr bool PERM = false, AFTER_DRAIN = false, HOOK = false; static constexpr int HK0 = -1, HK1 = -1;
    bf16_t* H; const float* roww;
    __device__ __forceinline__ void operator()(const f32x4 (&acc)[2][2][4][2], const Unit& u, int wr, int wc, int, int) const {
        int t_ = threadIdx.x; asm volatile("" : "+v"(t_)); const int fr = t_ & 15, fq = (t_ >> 4) & 3;
        const int row0 = u.pm * BM + wr * 64 + fr, col0 = (u.pn & 1) * HALF + wc * 32 + 4 * fq;
#pragma unroll
        for (int ai = 0; ai < 2; ++ai)
#pragma unroll
            for (int m = 0; m < 4; ++m) { const int row = row0 + ai * HALF + m * 16; const float w = roww[row];
#pragma unroll
                for (int n = 0; n < 2; ++n) { const f32x4 gt = acc[ai][0][m][n], up = acc[ai][1][m][n]; f32x4 h;
#pragma unroll
                    for (int j = 0; j < 4; ++j) h[j] = gt[j] * sigmoidf_(gt[j]) * up[j] * w;
                    u32x2 o; o.x = cvt_pk_bf16(h[0], h[1]); o.y = cvt_pk_bf16(h[2], h[3]);
                    *(u32x2*)(H + (size_t)row * 256 + col0 + n * 16) = o; }
                asm volatile("" ::: "memory"); }
    }
};
struct EpiDown {
    static constexpr bool PERM = true, AFTER_DRAIN = false, HOOK = false; static constexpr int HK0 = -1, HK1 = -1;
    bf16_t* dump; unsigned yoff; const int* rowts;
    __device__ __forceinline__ void operator()(const f32x4 (&acc)[2][2][4][2], const Unit& u, int wr, int wc, int, int) const {
        int t_ = threadIdx.x; asm volatile("" : "+v"(t_)); const int fr = t_ & 15, fq = (t_ >> 4) & 3;
        const int row0 = u.pm * BM + wr * 64 + fr, col0 = (u.pn & 7) * BM + wc * 32 + 8 * fq;
#pragma unroll
        for (int ai = 0; ai < 2; ++ai)
#pragma unroll
            for (int m = 0; m < 4; ++m) { const int row = row0 + ai * HALF + m * 16; const int ts = rowts[row];
                const unsigned eo = (ts >= 0 ? yoff + (unsigned)((ts & 1) * 8192 + (ts >> 1)) * 2048u : (unsigned)row * 2048u) + (unsigned)col0;
                bf16_t* rowp = dump + eo;
#pragma unroll
                for (int bj = 0; bj < 2; ++bj) { const f32x4 v0 = acc[ai][bj][m][0], v1 = acc[ai][bj][m][1];
                    u32x4 w; w.x = cvt_pk_bf16(v0[0], v0[1]); w.y = cvt_pk_bf16(v0[2], v0[3]); w.z = cvt_pk_bf16(v1[0], v1[1]); w.w = cvt_pk_bf16(v1[2], v1[3]);
                    *(u32x4*)(rowp + bj * HALF) = w; }
                asm volatile("" ::: "memory"); }
    }
};
template <int NPER> struct MoeOrder {
    int total, G, c; const int* panel_e;
    __device__ __forceinline__ bool next(int i, Unit& u) const { const int L = i * G + c; if (L >= total) return false; const int pm = L / NPER; u.pm = pm; u.pn = panel_e[pm] * NPER + (L % NPER); return true; }
    __device__ __forceinline__ void a_ready(const Unit&) const {}
    __device__ __forceinline__ void done(const Unit&) const {}
};

template <bool F8> struct Frags { bf16x8 At[4][2], B0[2][2], B1[2][2]; };
template <> struct Frags<true> { i32x8 At8[4], B08[2], B18[2]; };
template <class Epi, class Sched, bool ALIGN_EPI = false, bool SP2 = false, bool FP8 = false>
__device__ __forceinline__ void gemm_phase(PG8_LAS unsigned char* lds, const Gemm g, const Sched& S, const Epi& E) {
    int tid_ = threadIdx.x; asm volatile("" : "+v"(tid_));
    const int tid = tid_, wid = __builtin_amdgcn_readfirstlane(tid >> 6), lane = tid & 63, wr = wid >> 2, wc = wid & 3, fr = lane & 15, fq = lane >> 4;
    const int K = g.K, nt = K / BK, LDA = g.lda;
    unsigned voffA[2], voffB[2];
#pragma unroll
    for (int i = 0; i < 2; ++i) { int R, C; stage_rc(tid * 16 + i * 8192, R, C); const int Rb = Epi::PERM ? ((R & ~31) + perm32(R & 31)) : R;
        voffA[i] = (unsigned)(R * LDA + C) * 2u; voffB[i] = (unsigned)(Rb * K + C) * 2u; }
    const size_t kstep = (size_t)(BK * 2);
    const size_t hstep = (size_t)HALF * K * 2, hstepA = (size_t)HALF * LDA * 2;
    const size_t tstep = 2 * hstep, tstepA = 2 * hstepA;
    const unsigned ldsbase = (unsigned)__builtin_amdgcn_readfirstlane((int)(unsigned)(uintptr_t)lds + wid * 1024);
    const unsigned ldsw = (unsigned)wid * 1024u;
    const int aoff = lds_byte(wr * 64 + fr, fq * 8), boff = lds_byte(wc * 32 + fr, fq * 8);
#define PG8_CAT(x0, x1) __builtin_bit_cast(i32x8, __builtin_shufflevector(x0, x1, 0, 1, 2, 3, 4, 5, 6, 7, 8, 9, 10, 11, 12, 13, 14, 15))
#define PG8_SA(b, h) (((b) * 2 + (h)) * HTB)
#define PG8_SB(b, h) ((4 + (b) * 2 + (h)) * HTB)
#define PG8_STAGE(bufoff, gbase, voff) do { if constexpr (FP8) { _Pragma("unroll") for (int _i = 0; _i < 2; ++_i) { \
            asm volatile("s_mov_b32 m0, %2\n\ts_nop 0\n\tglobal_load_lds_dwordx4 %0, %1" :: "v"((voff)[_i]), "s"((const char*)(gbase)), "s"(ldsbase + (unsigned)((bufoff) + _i * 8192)) : "memory", "m0"); } } \
        else { _Pragma("unroll") for (int _i = 0; _i < 2; ++_i) \
        __builtin_amdgcn_global_load_lds((const unsigned*)((const char*)(gbase) + (voff)[_i]), (PG8_LAS unsigned*)(lds + (bufoff) + ldsw + _i * 8192), 16, 0, 0); } } while (0)
#define PG8_LDA(dst, b, h) do { if constexpr (FP8) { _Pragma("unroll") for (int m = 0; m < 4; ++m) fg.dst##8[m] = PG8_CAT(*(const PG8_LAS bf16x8*)(lds + PG8_SA(b, h) + aoff + m * 2048), *(const PG8_LAS bf16x8*)(lds + PG8_SA(b, h) + aoff + m * 2048 + 1024)); } \
        else { _Pragma("unroll") for (int m = 0; m < 4; ++m) _Pragma("unroll") for (int k = 0; k < 2; ++k) fg.dst[m][k] = *(const PG8_LAS bf16x8*)(lds + PG8_SA(b, h) + aoff + m * 2048 + k * 1024); } } while (0)
#define PG8_LDB(dst, b, h) do { if constexpr (FP8) { _Pragma("unroll") for (int n = 0; n < 2; ++n) fg.dst##8[n] = PG8_CAT(*(const PG8_LAS bf16x8*)(lds + PG8_SB(b, h) + boff + n * 2048), *(const PG8_LAS bf16x8*)(lds + PG8_SB(b, h) + boff + n * 2048 + 1024)); } \
        else { _Pragma("unroll") for (int n = 0; n < 2; ++n) _Pragma("unroll") for (int k = 0; k < 2; ++k) fg.dst[n][k] = *(const PG8_LAS bf16x8*)(lds + PG8_SB(b, h) + boff + n * 2048 + k * 1024); } } while (0)
#define PG8_MMA(ai, bj, At, Bt) do { __builtin_amdgcn_s_setprio(1); \
        if constexpr (FP8) { _Pragma("unroll") for (int m = 0; m < 4; ++m) _Pragma("unroll") for (int n = 0; n < 2; ++n) \
            acc[ai][bj][m][n] = __builtin_amdgcn_mfma_scale_f32_16x16x128_f8f6f4(fg.Bt##8[n], fg.At##8[m], acc[ai][bj][m][n], 0, 0, 0, g.scb, 0, g.sca); } \
        else { _Pragma("unroll") for (int m = 0; m < 4; ++m) _Pragma("unroll") for (int n = 0; n < 2; ++n) _Pragma("unroll") for (int k = 0; k < 2; ++k) \
            acc[ai][bj][m][n] = __builtin_amdgcn_mfma_f32_16x16x32_bf16(fg.Bt[n][k], fg.At[m][k], acc[ai][bj][m][n], 0, 0, 0); } \
        __builtin_amdgcn_s_setprio(0); } while (0)
#define PG8_WAIT_V(n) asm volatile("s_waitcnt vmcnt(" #n ")" ::: "memory")
#define PG8_WAIT_L(n) asm volatile("s_waitcnt lgkmcnt(" #n ")" ::: "memory")
#define PG8_BAR __builtin_amdgcn_s_barrier()
#define PG8_SCHED __builtin_amdgcn_sched_barrier(0)
    Unit cur, nxt; int ui = 0;
    if (!S.next(0, cur)) return;
    f32x4 acc[2][2][4][2];
#pragma unroll
    for (int a = 0; a < 2; ++a)
#pragma unroll
        for (int b = 0; b < 2; ++b)
#pragma unroll
            for (int m = 0; m < 4; ++m)
#pragma unroll
                for (int n = 0; n < 2; ++n) acc[a][b][m][n] = (f32x4){0.f, 0.f, 0.f, 0.f};
    Frags<FP8> fg;
    const char* cA = (const char*)g.A + (size_t)cur.pm * tstepA; const char* cB = (const char*)g.Bt + (size_t)cur.pn * tstep;
    S.a_ready(cur);
    if constexpr (SP2) {
        PG8_STAGE(PG8_SB(0, 0), cB, voffB); PG8_STAGE(PG8_SB(0, 1), cB + hstep, voffB); PG8_STAGE(PG8_SA(0, 0), cA, voffA); PG8_STAGE(PG8_SA(0, 1), cA + hstepA, voffA);
        if (wr == 1) PG8_BAR;
        PG8_WAIT_V(2); PG8_BAR;
        PG8_STAGE(PG8_SB(1, 0), cB + kstep, voffB); PG8_STAGE(PG8_SA(1, 0), cA + kstep, voffA); PG8_STAGE(PG8_SB(1, 1), cB + hstep + kstep, voffB);
        PG8_WAIT_V(6); PG8_BAR;
    } else {
        PG8_STAGE(PG8_SB(0, 0), cB, voffB); PG8_STAGE(PG8_SA(0, 0), cA, voffA); PG8_STAGE(PG8_SB(0, 1), cB + hstep, voffB); PG8_STAGE(PG8_SA(0, 1), cA + hstepA, voffA);
        if (wr == 1) PG8_BAR;
        PG8_WAIT_V(4); PG8_BAR;
        PG8_STAGE(PG8_SB(1, 0), cB + kstep, voffB); PG8_STAGE(PG8_SA(1, 0), cA + kstep, voffA); PG8_STAGE(PG8_SB(1, 1), cB + hstep + kstep, voffB);
        PG8_WAIT_V(6); PG8_BAR;
    }
    for (;;) {
        const bool has_next = S.next(ui + 1, nxt);
        const char* nA = has_next ? (const char*)g.A + (size_t)nxt.pm * tstepA : cA; const char* nB = has_next ? (const char*)g.Bt + (size_t)nxt.pn * tstep : cB;
#pragma nounroll
        for (int t = 0; t < nt; t += 2) {
            const bool last = (t == nt - 2);
            const char* a1 = cA + (size_t)(t + 1) * kstep;
            const char* a2 = last ? nA : cA + (size_t)(t + 2) * kstep; const char* b2 = last ? nB : cB + (size_t)(t + 2) * kstep;
            const char* a3 = a2 + kstep; const char* b3 = b2 + kstep;
            if (last && has_next) S.a_ready(nxt);
            if constexpr (SP2) {
            PG8_LDB(B0, 0, 0); PG8_LDB(B1, 0, 1); PG8_SCHED; PG8_LDA(At, 0, 0); PG8_STAGE(PG8_SA(1, 1), a1 + hstepA, voffA);
            PG8_WAIT_V(8); PG8_WAIT_L(0); PG8_BAR; PG8_MMA(0, 0, At, B0); PG8_MMA(0, 1, At, B1); PG8_BAR; PG8_SCHED;
            PG8_LDA(At, 0, 1); PG8_STAGE(PG8_SB(0, 0), b2, voffB); PG8_STAGE(PG8_SB(0, 1), b2 + hstep, voffB); PG8_STAGE(PG8_SA(0, 0), a2, voffA);
            PG8_WAIT_V(8); PG8_WAIT_L(0); PG8_BAR; PG8_MMA(1, 0, At, B0); PG8_MMA(1, 1, At, B1); PG8_BAR; PG8_SCHED;
            PG8_LDB(B0, 1, 0); PG8_LDB(B1, 1, 1); PG8_SCHED; PG8_LDA(At, 1, 0); PG8_STAGE(PG8_SA(0, 1), a2 + hstepA, voffA);
            PG8_WAIT_V(8); PG8_WAIT_L(0); PG8_BAR; PG8_MMA(0, 0, At, B0); PG8_MMA(0, 1, At, B1); PG8_BAR; PG8_SCHED;
            PG8_LDA(At, 1, 1); PG8_STAGE(PG8_SB(1, 0), b3, voffB); PG8_STAGE(PG8_SB(1, 1), b3 + hstep, voffB); PG8_STAGE(PG8_SA(1, 0), a3, voffA);
            PG8_WAIT_V(8); PG8_WAIT_L(0); PG8_BAR; PG8_MMA(1, 0, At, B0); PG8_MMA(1, 1, At, B1); PG8_BAR; PG8_SCHED;
            if constexpr (Epi::HOOK) { if (t + 2 == Epi::HK0 || t + 2 == Epi::HK1) E.mid(acc, cur, wr, wc, fr, fq, t + 2); }
            } else {
            PG8_LDB(B0, 0, 0); PG8_SCHED; PG8_LDA(At, 0, 0); PG8_STAGE(PG8_SA(1, 1), a1 + hstepA, voffA);
            PG8_WAIT_L(8); PG8_BAR; PG8_WAIT_L(0); PG8_MMA(0, 0, At, B0); PG8_BAR; PG8_SCHED;
            PG8_LDB(B1, 0, 1); PG8_STAGE(PG8_SB(0, 0), b2, voffB);
            PG8_BAR; PG8_WAIT_L(0); PG8_MMA(0, 1, At, B1); PG8_BAR;
            PG8_LDA(At, 0, 1); PG8_STAGE(PG8_SA(0, 0), a2, voffA);
            PG8_BAR; PG8_WAIT_L(0); PG8_MMA(1, 0, At, B0); PG8_BAR; PG8_SCHED;
            PG8_STAGE(PG8_SB(0, 1), b2 + hstep, voffB);
            PG8_WAIT_V(6); PG8_BAR; PG8_MMA(1, 1, At, B1); PG8_BAR;
            PG8_LDB(B0, 1, 0); PG8_SCHED; PG8_LDA(At, 1, 0); PG8_STAGE(PG8_SA(0, 1), a2 + hstepA, voffA);
            PG8_WAIT_L(8); PG8_BAR; PG8_WAIT_L(0); PG8_MMA(0, 0, At, B0); PG8_BAR; PG8_SCHED;
            PG8_LDB(B1, 1, 1); PG8_STAGE(PG8_SB(1, 0), b3, voffB);
            PG8_BAR; PG8_WAIT_L(0); PG8_MMA(0, 1, At, B1); PG8_BAR;
            PG8_LDA(At, 1, 1); PG8_STAGE(PG8_SA(1, 0), a3, voffA);
            PG8_BAR; PG8_WAIT_L(0); PG8_MMA(1, 0, At, B0); PG8_BAR; PG8_SCHED;
            PG8_STAGE(PG8_SB(1, 1), b3 + hstep, voffB);
            PG8_WAIT_V(6); PG8_BAR; PG8_MMA(1, 1, At, B1); PG8_BAR;
            }
        }
        if constexpr (ALIGN_EPI) { if (wr == 0) PG8_BAR; }
        if constexpr (!Epi::AFTER_DRAIN) { E(acc, cur, wr, wc, fr, fq); S.done(cur); }
        if (!has_next) break;
#pragma unroll
        for (int a = 0; a < 2; ++a)
#pragma unroll
            for (int b = 0; b < 2; ++b)
#pragma unroll
                for (int m = 0; m < 4; ++m)
#pragma unroll
                    for (int n = 0; n < 2; ++n) acc[a][b][m][n] = (f32x4){0.f, 0.f, 0.f, 0.f};
        cur = nxt; cA = nA; cB = nB; ++ui;
        if constexpr (ALIGN_EPI) { if (wr == 1) PG8_BAR; }
    }
    PG8_WAIT_V(0);
    if constexpr (!ALIGN_EPI) { if (wr == 0) PG8_BAR; }
    PG8_BAR;
    if constexpr (Epi::AFTER_DRAIN) { E.fused(acc, cur, wr, wc, fr, fq, lds, wid, lane); S.done(cur); }
#undef PG8_SA
#undef PG8_SB
#undef PG8_STAGE
#undef PG8_LDA
#undef PG8_LDB
#undef PG8_MMA
#undef PG8_CAT
#undef PG8_WAIT_V
#undef PG8_WAIT_L
#undef PG8_BAR
#undef PG8_SCHED
}
}

constexpr int NWAVES = 8, NTHR = 512;
constexpr int DM = 2048, NB = 4, SEQ = 2048, NT = NB * SEQ, DEPTH = 2;
constexpr int ZP = 11264;
constexpr int ZC_QA = 0, ZC_KVA = 1024, ZC_QB = 2560, ZC_KB = 3072, ZC_VB = 3200, ZC_QC = 3328, ZC_KC = 3840, ZC_VC = 4352, ZC_GM = 4864, ZC_GA = 11008;
constexpr int OC_A = 0, OC_B = 1024, OC_C = 1536;
constexpr int NEXP = 32, DEXP = 256, ROWCAP = 24576;
constexpr float LN_EPS = 1e-5f, LOG2E = 1.4426950408889634f;
constexpr size_t MiB = 1u << 20;
constexpr size_t WS_CTL = 0, CTL_ZERO_BYTES = 1 * MiB;
constexpr size_t WS_WIN = 2 * MiB, WS_WBRA = 46 * MiB, WS_WBRB = 50 * MiB, WS_WBRC = 52 * MiB, WS_WOUT = 54 * MiB, WS_WGU = 62 * MiB, WS_WD = 126 * MiB, WS_WCMP = 158 * MiB;
constexpr size_t WS_XB = 160 * MiB, WS_Z = 192 * MiB, WS_OA = 370 * MiB, WS_MG = 402 * MiB, WS_MB = 466 * MiB, WS_X1 = 498 * MiB, WS_H = 562 * MiB, WS_SMALL = 574 * MiB, WS_END = 576 * MiB;
constexpr size_t WS_XS = WS_Z, WS_Y = WS_Z + 96 * MiB;
constexpr size_t SM_KCMP = 0, SM_VCMP = 256 * 1024, SM_KMEAN = 512 * 1024, SM_TOKE = 640 * 1024, SM_TOKW = 704 * 1024, SM_TOKP = 768 * 1024, SM_ROWTS = 832 * 1024, SM_ROWW = 960 * 1024, SM_PANE = 1088 * 1024, SM_HIST = 1152 * 1024, SM_CNTG = 1200 * 1024;
constexpr int CW_TMO = 0, CW_BAR = 4096, CW_QUEUE = 8192, CW_ECNT = 9216, CW_NPAN = 16384;
constexpr int RING_OFF = 0, RING_BYTES = 131072, LDSCTL_OFF = RING_BYTES, MISC_OFF = LDSCTL_OFF + 320, LDS_BYTES = 147456;

#define GAS __attribute__((address_space(1)))
#define LAS __attribute__((address_space(3)))
typedef unsigned short bf16;
typedef unsigned v4u __attribute__((ext_vector_type(4)));
typedef unsigned v2u __attribute__((ext_vector_type(2)));
typedef float f32x4 __attribute__((ext_vector_type(4)));
typedef float f32x16 __attribute__((ext_vector_type(16)));
typedef short bf16x8 __attribute__((ext_vector_type(8)));
typedef short s16x4 __attribute__((ext_vector_type(4)));
typedef GAS unsigned gu32;
#define RLX_AGENT __ATOMIC_RELAXED, __HIP_MEMORY_SCOPE_AGENT
#define LDS_WAIT() asm volatile("s_waitcnt lgkmcnt(0)" ::: "memory")
#define VM_WAIT() asm volatile("s_waitcnt vmcnt(0)" ::: "memory")
__device__ __forceinline__ unsigned f2bf(float f) { unsigned u = __builtin_bit_cast(unsigned, f); return (u + 0x7fffu + ((u >> 16) & 1u)) >> 16; }
__device__ __forceinline__ unsigned pk2(float lo, float hi) { return f2bf(lo) | (f2bf(hi) << 16); }
__device__ __forceinline__ float bflo(unsigned w) { return __uint_as_float(w << 16); }
__device__ __forceinline__ float bfhi(unsigned w) { return __uint_as_float(w & 0xffff0000u); }
__device__ __forceinline__ float bf2f(bf16 b) { return __uint_as_float(((unsigned)b) << 16); }
__device__ __forceinline__ float shfl_xor_f(float v, int o, int lane) { return __int_as_float(__builtin_amdgcn_ds_bpermute((lane ^ o) << 2, __float_as_int(v))); }
__device__ __forceinline__ unsigned shfl_xor_u(unsigned v, int o, int lane) { return (unsigned)__builtin_amdgcn_ds_bpermute((lane ^ o) << 2, (int)v); }
__device__ __forceinline__ float wave_sum(float v, int lane) {
#pragma unroll
    for (int o = 1; o < 64; o <<= 1) v += shfl_xor_f(v, o, lane);
    return v;
}

#define XB_TMO      128
#define XB_XCNT(j)  (256  + 64 * (j))
#define XB_XSUB(j)  (1280 + 64 * (j))
#define XB_XGEN(j)  (2304 + 64 * (j))
#define XB_TOP      3328
#define XB_TOPGEN   3392
#define XCD_BAR_WORDS 3456
#define XB_SPIN_CAP (1u << 18)

__device__ __forceinline__ unsigned xb_ld(unsigned* p)              { return __hip_atomic_load(p, __ATOMIC_RELAXED, __HIP_MEMORY_SCOPE_AGENT); }
__device__ __forceinline__ unsigned xb_add(unsigned* p, unsigned v) { return __hip_atomic_fetch_add(p, v, __ATOMIC_RELAXED, __HIP_MEMORY_SCOPE_AGENT); }
__device__ __forceinline__ unsigned xb_xcc_id() { return (unsigned)__builtin_amdgcn_s_getreg((3 << 11) | 20) & 0xFu; }
#define XB_SPIN(cond, bar) do { unsigned _sp = 0; while (cond) { __builtin_amdgcn_s_sleep(1); \
    if ((++_sp & 255u) == 0u) { if (xb_ld(&(bar)[XB_TMO])) break; if (_sp > XB_SPIN_CAP) { atomicAdd(&(bar)[XB_TMO], 1u); break; } } } } while (0)

struct XcdBarrier {
    unsigned* bar; unsigned x;
    volatile LAS unsigned* st;
};

__device__ __forceinline__ XcdBarrier xcd_barrier_post(unsigned* bar, volatile LAS unsigned* st) {
    XcdBarrier b; b.bar = bar; b.x = xb_xcc_id(); b.st = st;
    if (threadIdx.x == 0) (void)xb_add(&bar[XB_XCNT(b.x)], 1u);
    return b;
}
__device__ __forceinline__ void xcd_barrier_complete(unsigned* bar, unsigned x, unsigned& nloc, unsigned& nx) {
    const unsigned G = gridDim.x * gridDim.y * gridDim.z;
    unsigned sum, cnt, mine, sp = 0u;
    for (;;) {
        sum = 0u; cnt = 0u; mine = 0u;
#pragma unroll
        for (unsigned j = 0; j < 16; ++j) { const unsigned c = xb_ld(&bar[XB_XCNT(j)]); sum += c; cnt += (c > 0u) ? 1u : 0u; mine = (j == x) ? c : mine; }
        if (sum == G) break;
        __builtin_amdgcn_s_sleep(1);
        if ((++sp & 255u) == 0u) { if (xb_ld(&bar[XB_TMO])) break; if (sp > XB_SPIN_CAP) { atomicAdd(&bar[XB_TMO], 1u); break; } }
    }
    nloc = mine > 0u ? mine : 1u; nx = cnt > 0u ? cnt : 1u;
}

__device__ __forceinline__ void xcd_barrier(const XcdBarrier& b) {
    asm volatile("s_waitcnt vmcnt(0)" ::: "memory");
    __syncthreads();
    if (threadIdx.x == 0) {
        unsigned* bar = b.bar;
        __builtin_amdgcn_s_waitcnt(0);
        unsigned nloc = b.st[0], nx = b.st[1];
        if (nloc == 0u) { xcd_barrier_complete(bar, b.x, nloc, nx); b.st[0] = nloc; b.st[1] = nx; }
        const unsigned old = xb_add(&bar[XB_XSUB(b.x)], 1u);
        const unsigned gen = old / nloc;
        if (old + 1u == (gen + 1u) * nloc) {
            __builtin_amdgcn_fence(__ATOMIC_RELEASE, "agent");
            asm volatile("s_waitcnt vmcnt(0)" ::: "memory");
            const unsigned og = xb_add(&bar[XB_TOP], 1u);
            const unsigned tg = og / nx;
            if (og + 1u == (tg + 1u) * nx) xb_add(&bar[XB_TOPGEN], 1u);
            else XB_SPIN(xb_ld(&bar[XB_TOPGEN]) == tg, bar);
            __builtin_amdgcn_fence(__ATOMIC_ACQUIRE, "agent");
            xb_add(&bar[XB_XGEN(b.x)], 1u);
            asm volatile("s_waitcnt vmcnt(0)" ::: "memory");
        } else {
            XB_SPIN(xb_ld(&bar[XB_XGEN(b.x)]) == gen, bar);
            __builtin_amdgcn_fence(__ATOMIC_ACQUIRE, "agent");
            asm volatile("s_waitcnt vmcnt(0)" ::: "memory");
        }
    }
    __syncthreads();
}

namespace att {
__device__ __forceinline__ int crow(int r, int hi) { return (r & 3) + 8 * (r >> 2) + 4 * hi; }
__device__ __forceinline__ f32x16 zero16() { float z = 0.f; asm volatile("" : "+v"(z)); f32x16 r;
#pragma unroll
    for (int i = 0; i < 16; ++i) r[i] = z;
    return r; }
__device__ __forceinline__ unsigned cvtpk(float lo, float hi) { unsigned r; asm volatile("v_cvt_pk_bf16_f32 %0, %1, %2" : "=v"(r) : "v"(lo), "v"(hi)); return r; }
template <int HD> __device__ __forceinline__ int kswz(int row, int colB) { return row * (HD * 2) + (colB ^ ((row & 7) << 4)); }
template <int HD> __device__ __forceinline__ int v_st(int k, int c) { const int kk = (k & ~0xC) | ((k & 4) << 1) | ((k & 8) >> 1); return ((kk >> 3) * (HD / 32) + (c >> 5)) * 512 + ((kk & 7) * 32 + (c & 31)) * 2; }
__device__ __forceinline__ int v_rd_base(int lane) { return ((lane & 3) << 3) | (((lane >> 2) & 3) << 6) | (((lane >> 4) & 1) << 5) | (((lane >> 5) & 1) << 8); }
template <int HD> constexpr int v_rd_off(int d0, int ks, int half) { return d0 * 512 + (2 * ks + half) * (HD / 32) * 512; }
template <int OFF> __device__ __forceinline__ s16x4 tr_read(int vb) { s16x4 r; asm volatile("ds_read_b64_tr_b16 %0, %1 offset:%2" : "=&v"(r) : "v"(vb), "i"(OFF) : "memory"); return r; }

template <int HD> __device__ __forceinline__ void qkt(f32x16& p0, f32x16& p1, const LAS char* Ks, const bf16x8 (&qr)[HD / 16], int r32, int hi) {
    p0 = zero16(); p1 = zero16();
#pragma unroll
    for (int d0 = 0; d0 < HD / 16; ++d0) { const int cb = (d0 * 16 + hi * 8) * 2;
        const bf16x8 b0 = *(const LAS bf16x8*)(Ks + kswz<HD>(r32, cb));
        const bf16x8 b1 = *(const LAS bf16x8*)(Ks + kswz<HD>(32 + r32, cb));
        p0 = __builtin_amdgcn_mfma_f32_32x32x16_bf16(b0, qr[d0], p0, 0, 0, 0);
        p1 = __builtin_amdgcn_mfma_f32_32x32x16_bf16(b1, qr[d0], p1, 0, 0, 0); }
}
#define ATT_PK(L, H) (bf16x8){L[0], L[1], L[2], L[3], H[0], H[1], H[2], H[3]}
template <int HD, int D0> __device__ __forceinline__ void pv_one(f32x16& od, int vb, bf16x8 pa0, bf16x8 pa1, bf16x8 pa2, bf16x8 pa3) {
    const s16x4 l0 = tr_read<v_rd_off<HD>(D0, 0, 0)>(vb), h0 = tr_read<v_rd_off<HD>(D0, 0, 1)>(vb), l1 = tr_read<v_rd_off<HD>(D0, 1, 0)>(vb), h1 = tr_read<v_rd_off<HD>(D0, 1, 1)>(vb);
    const s16x4 l2 = tr_read<v_rd_off<HD>(D0, 2, 0)>(vb), h2 = tr_read<v_rd_off<HD>(D0, 2, 1)>(vb), l3 = tr_read<v_rd_off<HD>(D0, 3, 0)>(vb), h3 = tr_read<v_rd_off<HD>(D0, 3, 1)>(vb);
    asm volatile("s_waitcnt lgkmcnt(0)" ::: "memory"); __builtin_amdgcn_sched_barrier(0);
    od = __builtin_amdgcn_mfma_f32_32x32x16_bf16(pa0, ATT_PK(l0, h0), od, 0, 0, 0);
    od = __builtin_amdgcn_mfma_f32_32x32x16_bf16(pa1, ATT_PK(l1, h1), od, 0, 0, 0);
    od = __builtin_amdgcn_mfma_f32_32x32x16_bf16(pa2, ATT_PK(l2, h2), od, 0, 0, 0);
    od = __builtin_amdgcn_mfma_f32_32x32x16_bf16(pa3, ATT_PK(l3, h3), od, 0, 0, 0);
}
template <int HD> __device__ __forceinline__ void pv_all(f32x16 (&o)[HD / 32], int vb, bf16x8 pa0, bf16x8 pa1, bf16x8 pa2, bf16x8 pa3) {
    pv_one<HD, 0>(o[0], vb, pa0, pa1, pa2, pa3); pv_one<HD, 1>(o[1], vb, pa0, pa1, pa2, pa3);
    if constexpr (HD == 128) { pv_one<HD, 2>(o[2], vb, pa0, pa1, pa2, pa3); pv_one<HD, 3>(o[3], vb, pa0, pa1, pa2, pa3); }
}
#define ATT_PK4(P, BASE, OUT) do { const unsigned a0_ = cvtpk(P[BASE + 0], P[BASE + 1]), a1_ = cvtpk(P[BASE + 2], P[BASE + 3]);   \
    const unsigned b0_ = cvtpk(P[BASE + 4], P[BASE + 5]), b1_ = cvtpk(P[BASE + 6], P[BASE + 7]);                              \
    auto r0_ = __builtin_amdgcn_permlane32_swap(a0_, b0_, false, false); auto r1_ = __builtin_amdgcn_permlane32_swap(a1_, b1_, false, false); \
    v4u w_ = {r0_[0], r1_[0], r0_[1], r1_[1]}; OUT = __builtin_bit_cast(bf16x8, w_); } while (0)
__device__ __forceinline__ float xmax32(float v) { auto rr = __builtin_amdgcn_permlane32_swap(__float_as_uint(v), __float_as_uint(v), false, false); return fmaxf(__uint_as_float(rr[0]), __uint_as_float(rr[1])); }
__device__ __forceinline__ float xsum32(float v) { auto rr = __builtin_amdgcn_permlane32_swap(__float_as_uint(v), __float_as_uint(v), false, false); return __uint_as_float(rr[0]) + __uint_as_float(rr[1]); }

struct MaskGen {
    float C, slC, dq, W; bool ok; bool inner;
    __device__ __forceinline__ void operator()(f32x16& p0, f32x16& p1) const {
        const float base = -slC * dq;
        if (inner) {
#pragma unroll
            for (int r = 0; r < 16; ++r) { const float kr = (float)((r & 3) + 8 * (r >> 2));
                const float v0 = fmaf(p0[r], C, fmaf(slC, kr, base)), v1 = fmaf(p1[r], C, fmaf(slC, kr + 32.f, base));
                p0[r] = ok ? v0 : -INFINITY; p1[r] = ok ? v1 : -INFINITY; }
        } else {
#pragma unroll
            for (int r = 0; r < 16; ++r) { const float kr = (float)((r & 3) + 8 * (r >> 2));
                const float v0 = fmaf(p0[r], C, fmaf(slC, kr, base)), v1 = fmaf(p1[r], C, fmaf(slC, kr + 32.f, base));
                p0[r] = (ok && dq >= kr && dq < W + kr) ? v0 : -INFINITY;
                p1[r] = (ok && dq >= kr + 32.f && dq < W + kr + 32.f) ? v1 : -INFINITY; }
        }
    }
};
template <int HD> __device__ __forceinline__ void softmax_pv(f32x16& p0, f32x16& p1, f32x16 (&o)[HD / 32], float& m_reg, float& l_reg, int vb, LAS float* al_l, int r32, int hi) {
    float pmax = p0[0];
#pragma unroll
    for (int r = 1; r < 16; ++r) pmax = fmaxf(pmax, p0[r]);
#pragma unroll
    for (int r = 0; r < 16; ++r) pmax = fmaxf(pmax, p1[r]);
    pmax = xmax32(pmax);
    float mn = m_reg, alpha = 1.f;
    if (!__all(pmax - m_reg <= 8.0f)) { mn = fmaxf(m_reg, pmax); alpha = __builtin_amdgcn_exp2f(m_reg - mn); m_reg = mn; }
    float ps = 0.f;
#pragma unroll
    for (int r = 0; r < 16; ++r) { p0[r] = __builtin_amdgcn_exp2f(p0[r] - mn); p1[r] = __builtin_amdgcn_exp2f(p1[r] - mn); ps += p0[r] + p1[r]; }
    ps = xsum32(ps); l_reg = l_reg * alpha + ps;
    bf16x8 pa0, pa1, pa2, pa3; ATT_PK4(p0, 0, pa0); ATT_PK4(p0, 8, pa1); ATT_PK4(p1, 0, pa2); ATT_PK4(p1, 8, pa3);
    if (__any(alpha < 1.f)) { if (hi == 0) al_l[r32] = alpha; LDS_WAIT();
#pragma unroll
        for (int r = 0; r < 16; ++r) { const float a = al_l[crow(r, hi)];
#pragma unroll
            for (int d = 0; d < HD / 32; ++d) o[d][r] *= a; }
        LDS_WAIT(); }
    pv_all<HD>(o, vb, pa0, pa1, pa2, pa3);
}
template <int HD> struct Stg { v4u k0, k1, v0, v1; };
template <int HD> __device__ __forceinline__ void sload(Stg<HD>& s, const bf16* Kp, const bf16* Vp, size_t pitch, int tid) {
    if constexpr (HD == 128) { const int sr = tid >> 4, sc = (tid & 15) * 8;
        s.k0 = *(const v4u*)(Kp + (size_t)sr * pitch + sc); s.k1 = *(const v4u*)(Kp + (size_t)(32 + sr) * pitch + sc);
        s.v0 = *(const v4u*)(Vp + (size_t)sr * pitch + sc); s.v1 = *(const v4u*)(Vp + (size_t)(32 + sr) * pitch + sc); }
    else { const int sr = tid >> 3, sc = (tid & 7) * 8; s.k0 = *(const v4u*)(Kp + (size_t)sr * pitch + sc); s.v0 = *(const v4u*)(Vp + (size_t)sr * pitch + sc); }
}
template <int HD> __device__ __forceinline__ void swrite(const Stg<HD>& s, LAS char* Kt, LAS char* Vt, int tid) {
    if constexpr (HD == 128) { const int sr = tid >> 4, sc = (tid & 15) * 8;
        *(LAS v4u*)(Kt + kswz<HD>(sr, sc * 2)) = s.k0; *(LAS v4u*)(Kt + kswz<HD>(32 + sr, sc * 2)) = s.k1;
        *(LAS v4u*)(Vt + v_st<HD>(sr, sc)) = s.v0; *(LAS v4u*)(Vt + v_st<HD>(32 + sr, sc)) = s.v1; }
    else { const int sr = tid >> 3, sc = (tid & 7) * 8; *(LAS v4u*)(Kt + kswz<HD>(sr, sc * 2)) = s.k0; *(LAS v4u*)(Vt + v_st<HD>(sr, sc)) = s.v0; }
}
constexpr int A_K0 = 0, A_K1 = 16384, A_V0 = 32768, A_V1 = 49152, A_WS = 65536, A_SEL = 67584, A_UNI = 68608, A_IMP = 68864, A_KM = 77312, A_END = 81408;

template <int HD, class TF, class SK, class FIN>
__device__ __forceinline__ void run_tiles(unsigned mask0, unsigned mask1, const bf16* Kb0, const bf16* Vb0, const bf16* Kb1, const bf16* Vb1, size_t pitch, LAS char* lds, int tid, int lane,
                                          const bf16x8 (&qr)[HD / 16], f32x16 (&o)[HD / 32], float& m_reg, float& l_reg, LAS float* al_l, const TF& tf, const SK& sk, const FIN& fin) {
    const int r32 = lane & 31, hi = lane >> 5;
    const int vb0 = (int)(uintptr_t)(lds + A_V0) + v_rd_base(lane);
    int ph = 0; unsigned m = mask0; if (m == 0u) { ph = 1; m = mask1; }
    if (m == 0u) return;
    int j = __builtin_ctz(m); m &= m - 1u;
    Stg<HD> st;
    sload<HD>(st, (ph ? Kb1 : Kb0) + (size_t)j * 64 * pitch, (ph ? Vb1 : Vb0) + (size_t)j * 64 * pitch, pitch, tid);
    swrite<HD>(st, lds + A_K0, lds + A_V0, tid);
    __syncthreads();
    int buf = 0;
    for (;;) {
        int phn = ph; unsigned mn = m; if (mn == 0u && ph == 0) { phn = 1; mn = mask1; }
        const int jn = mn ? __builtin_ctz(mn) : -1; mn &= mn - 1u;
        if (jn >= 0) sload<HD>(st, (phn ? Kb1 : Kb0) + (size_t)jn * 64 * pitch, (phn ? Vb1 : Vb0) + (size_t)jn * 64 * pitch, pitch, tid);
        if (!sk(ph, j)) { f32x16 p0, p1; qkt<HD>(p0, p1, lds + (buf ? A_K1 : A_K0), qr, r32, hi);
            const MaskGen mg = tf(ph, j); mg(p0, p1);
            softmax_pv<HD>(p0, p1, o, m_reg, l_reg, vb0 + buf * 16384, al_l, r32, hi); }
        if (jn < 0 || phn != ph) fin(ph);
        if (jn >= 0) swrite<HD>(st, lds + (buf ? A_K0 : A_K1), lds + (buf ? A_V0 : A_V1), tid);
        __syncthreads();
        if (jn < 0) break;
        ph = phn; m = mn; j = jn; buf ^= 1;
    }
}
}

constexpr int N_ATT_UNITS = 256 + 128 + 256;
struct UnitTab { unsigned short u[N_ATT_UNITS]; };
constexpr UnitTab make_units() {
    UnitTab t{}; int n = 0;
    for (int cost = 64; cost >= 0; --cost) {
        for (int c = 0; c < 32; ++c) if (c + 12 == cost) for (int bg = 0; bg < 8; ++bg) t.u[n++] = (unsigned short)((bg << 5) | c);
        for (int kb = 0; kb < 8; ++kb) if (4 * kb + 3 == cost) for (int bh = 0; bh < 16; ++bh) t.u[n++] = (unsigned short)((1 << 12) | (bh << 3) | kb);
        if (cost == 2) for (int c = 0; c < 32; ++c) for (int bg = 0; bg < 8; ++bg) t.u[n++] = (unsigned short)((2 << 12) | (bg << 5) | c);
    }
    return t;
}
__constant__ UnitTab g_units = make_units();

#define ATT_STORE_O(ND, OVAL) do { unsigned off_ = (unsigned)((4 * hi) * DM + r32) * 2u; _Pragma("unroll") for (int r_ = 0; r_ < 16; ++r_) { asm volatile("" : "+v"(off_)); \
        bf16* op_ = (bf16*)((char*)obase + off_ + (unsigned)(((r_ & 3) + 8 * (r_ >> 2)) * DM * 2)); \
        _Pragma("unroll") for (int d_ = 0; d_ < ND; ++d_) op_[32 * d_] = (bf16)f2bf(OVAL); asm volatile("" ::: "memory"); } } while (0)

#define ATT_ACC_O(FIRST) do { unsigned off_ = (unsigned)((4 * hi) * DM + r32) * 2u; \
        _Pragma("unroll") for (int g_ = 0; g_ < 2; ++g_) { asm volatile("" : "+v"(off_)); unsigned short old_[8][4]; \
            if (!(FIRST)) { _Pragma("unroll") for (int q_ = 0; q_ < 8; ++q_) { const int r_ = 8 * g_ + q_; const bf16* op_ = (const bf16*)((const char*)obase + off_ + (unsigned)(((r_ & 3) + 8 * (r_ >> 2)) * DM * 2)); \
                _Pragma("unroll") for (int d_ = 0; d_ < 4; ++d_) old_[q_][d_] = op_[32 * d_]; } } \
            _Pragma("unroll") for (int q_ = 0; q_ < 8; ++q_) { const int r_ = 8 * g_ + q_; const float f_ = fac_l[att::crow(r_, hi)]; bf16* op_ = (bf16*)((char*)obase + off_ + (unsigned)(((r_ & 3) + 8 * (r_ >> 2)) * DM * 2)); \
                _Pragma("unroll") for (int d_ = 0; d_ < 4; ++d_) { float v_ = o[d_][r_] * f_; if (!(FIRST)) v_ += bf2f(old_[q_][d_]); op_[32 * d_] = (bf16)f2bf(v_); } } \
            asm volatile("" ::: "memory"); } } while (0)

__device__ __forceinline__ void nsa_loop(int code, const bf16* Z, bf16* OA, LAS char* lds, int tid_in, int wid, unsigned mysel, unsigned uni);
__device__ __forceinline__ void nsa_unit(int code, const bf16* Z, const bf16* KCMP, const bf16* VCMP, bf16* OA, LAS char* lds, int tid_in, int wid) {
    using namespace att;
    int tid = tid_in; asm volatile("" : "+v"(tid)); const int lane = tid & 63;
    const int bg = (code >> 5) & 7, c = code & 31, b = bg >> 1, g = bg & 1;
    const int r32 = lane & 31, hi = lane >> 5, hh = wid & 3, tb = wid >> 2, head = g * 4 + hh;
    const int tl = tb * 32 + r32, tpos = c * 64 + tl;
    const size_t trow = (size_t)b * SEQ + tpos;
    const float slC = __builtin_amdgcn_exp2f(-(float)(head + 1)) * LOG2E, C = 0.08838834764831845f * LOG2E;
    LAS float* al_l = (LAS float*)(lds + A_WS) + wid * 64; LAS float* fac_l = al_l + 32;
    LAS unsigned* sel_l = (LAS unsigned*)(lds + A_SEL); LAS unsigned* uni_l = (LAS unsigned*)(lds + A_UNI); LAS float* imp_l = (LAS float*)(lds + A_IMP);
    const bf16* qp = Z + trow * ZP + ZC_QA + head * 128 + hi * 8;
    const bf16* gp = Z + trow * ZP + ZC_GA + head * 3;
    const float g0 = bf2f(gp[0]);
    for (int i = tid; i < 64 * 33; i += NTHR) imp_l[i] = 0.f;
    bf16* obase = OA + ((size_t)b * SEQ + c * 64 + tb * 32) * DM + OC_A + head * 128;
    {
        const bf16* kc = KCMP + (size_t)bg * 128 * 128; const bf16* vc = VCMP + (size_t)bg * 128 * 128;
        { Stg<128> s0, s1; sload<128>(s0, kc, vc, 128, tid); sload<128>(s1, kc + 64 * 128, vc + 64 * 128, 128, tid);
          swrite<128>(s0, lds + A_K0, lds + A_V0, tid); swrite<128>(s1, lds + A_K1, lds + A_V1, tid); }
        __syncthreads();
        bf16x8 qc[8];
#pragma unroll
        for (int d0 = 0; d0 < 8; ++d0) qc[d0] = *(const bf16x8*)(qp + d0 * 16);
        const float dq = (float)(tpos - 31 - 64 * hi);
#define NSA_CMP_SCORES(T) do { qkt<128>(a0, a1, lds + ((T) ? A_K1 : A_K0), qc, r32, hi); \
        _Pragma("unroll") for (int r = 0; r < 16; ++r) { const float kr = 16.f * (float)((r & 3) + 8 * (r >> 2)) + 1024.f * (T); const float d0_ = dq - kr, d1_ = dq - kr - 512.f; \
            a0[r] = d0_ >= 0.f ? fmaf(a0[r], C, -slC * d0_) : -INFINITY; a1[r] = d1_ >= 0.f ? fmaf(a1[r], C, -slC * d1_) : -INFINITY; } } while (0)
        f32x16 a0, a1;
        float mx = -INFINITY, ps = 0.f;
        { NSA_CMP_SCORES(0);
#pragma unroll
          for (int r = 0; r < 16; ++r) mx = fmaxf(mx, fmaxf(a0[r], a1[r]));
          float s0 = 0.f; const float m0 = (mx == -INFINITY) ? 0.f : mx;
#pragma unroll
          for (int r = 0; r < 16; ++r) s0 += __builtin_amdgcn_exp2f(a0[r] - m0) + __builtin_amdgcn_exp2f(a1[r] - m0);
          NSA_CMP_SCORES(1);
          float mx1 = mx;
#pragma unroll
          for (int r = 0; r < 16; ++r) mx1 = fmaxf(mx1, fmaxf(a0[r], a1[r]));
          const float m1 = (mx1 == -INFINITY) ? 0.f : mx1;
          float s1 = 0.f;
#pragma unroll
          for (int r = 0; r < 16; ++r) s1 += __builtin_amdgcn_exp2f(a0[r] - m1) + __builtin_amdgcn_exp2f(a1[r] - m1);
          float mh = mx1, sh = s0 * __builtin_amdgcn_exp2f(m0 - m1) + s1;
          const float mo = shfl_xor_f(mh, 32, lane), so = shfl_xor_f(sh, 32, lane);
          const float mf = fmaxf(mh, mo); const float mfz = (mf == -INFINITY) ? 0.f : mf;
          const float mhz = (mh == -INFINITY) ? 0.f : mh, moz = (mo == -INFINITY) ? 0.f : mo;
          ps = sh * __builtin_amdgcn_exp2f(mhz - mfz) + so * __builtin_amdgcn_exp2f(moz - mfz); mx = mfz; }
        const float mm = mx, inv = ps > 0.f ? 1.0f / ps : 0.f;
        LAS float* impr = imp_l + tl * 33;
#define NSA_IMP(X, GRP) do { _Pragma("unroll") for (int q4 = 0; q4 < 4; ++q4) { const int j_ = 8 * (GRP) + 2 * q4 + hi; const float hb_ = 0.5f * X[4 * q4 + 3] * inv; \
            const float aa_ = (X[4 * q4] + X[4 * q4 + 1] + X[4 * q4 + 2]) * inv + hb_; \
            (void)__hip_atomic_fetch_add(impr + j_, aa_, __ATOMIC_RELAXED, __HIP_MEMORY_SCOPE_WORKGROUP); \
            if (j_ + 1 < 32) (void)__hip_atomic_fetch_add(impr + j_ + 1, hb_, __ATOMIC_RELAXED, __HIP_MEMORY_SCOPE_WORKGROUP); } } while (0)
        f32x16 o[4];
#pragma unroll
      for (int d = 0; d < 4; ++d) o[d] = att::zero16();
        const int vb0 = (int)(uintptr_t)(lds + A_V0) + v_rd_base(lane);
        { NSA_CMP_SCORES(0);
#pragma unroll
          for (int r = 0; r < 16; ++r) { a0[r] = __builtin_amdgcn_exp2f(a0[r] - mm); a1[r] = __builtin_amdgcn_exp2f(a1[r] - mm); }
          NSA_IMP(a0, 0); NSA_IMP(a1, 1);
          bf16x8 pa0, pa1, pa2, pa3; ATT_PK4(a0, 0, pa0); ATT_PK4(a0, 8, pa1); ATT_PK4(a1, 0, pa2); ATT_PK4(a1, 8, pa3); pv_all<128>(o, vb0, pa0, pa1, pa2, pa3); }
        { NSA_CMP_SCORES(1);
#pragma unroll
          for (int r = 0; r < 16; ++r) { a0[r] = __builtin_amdgcn_exp2f(a0[r] - mm); a1[r] = __builtin_amdgcn_exp2f(a1[r] - mm); }
          NSA_IMP(a0, 2); NSA_IMP(a1, 3);
          bf16x8 pa0, pa1, pa2, pa3; ATT_PK4(a0, 0, pa0); ATT_PK4(a0, 8, pa1); ATT_PK4(a1, 0, pa2); ATT_PK4(a1, 8, pa3); pv_all<128>(o, vb0 + 16384, pa0, pa1, pa2, pa3); }
#undef NSA_IMP
#undef NSA_CMP_SCORES
        if (hi == 0) fac_l[r32] = g0 * inv; LDS_WAIT();
        ATT_ACC_O(true);
        LDS_WAIT();
    }
    __syncthreads();
    if (wid == 0) {
        unsigned sel;
        if (c <= 7) sel = (2u << c) - 1u;
        else { sel = 1u | (1u << c) | (1u << (c - 1)); unsigned cand = ((1u << (c - 1)) - 1u) & ~1u;
            const LAS float* ir = imp_l + lane * 33; float iv[30];
#pragma unroll
            for (int j = 1; j <= 29; ++j) iv[j] = ir[j];
#pragma unroll
            for (int k = 0; k < 5; ++k) { int best = -1; float bv = -INFINITY;
#pragma unroll
                for (int j = 1; j <= 29; ++j) { if (((cand >> j) & 1u) && iv[j] > bv) { bv = iv[j]; best = j; } }
                if (best < 0) best = __builtin_ctz(cand);
                sel |= 1u << best; cand &= ~(1u << best); } }
        sel_l[lane] = sel;
        unsigned un = sel;
#pragma unroll
        for (int o_ = 1; o_ < 64; o_ <<= 1) un |= shfl_xor_u(un, o_, lane);
        if (lane == 0) uni_l[0] = un;
    }
    __syncthreads();
    const unsigned mysel = sel_l[tl], uni = uni_l[0];
    asm volatile("" ::: "memory");
    nsa_loop(code, Z, OA, lds, tid, wid, mysel, uni);
}
__device__ __forceinline__ void nsa_loop(int code, const bf16* Z, bf16* OA, LAS char* lds, int tid_in, int wid, unsigned mysel, unsigned uni) {
    using namespace att;
    int tid = tid_in; asm volatile("" : "+v"(tid));
    const int lane = tid & 63;
    const int bg = (code >> 5) & 7, c = code & 31, b = bg >> 1, g = bg & 1;
    const int r32 = lane & 31, hi = lane >> 5, hh = wid & 3, tb = wid >> 2, head = g * 4 + hh;
    const int tl = tb * 32 + r32, tpos = c * 64 + tl;
    const size_t trow = (size_t)b * SEQ + tpos;
    const float slC = __builtin_amdgcn_exp2f(-(float)(head + 1)) * LOG2E, C = 0.08838834764831845f * LOG2E;
    LAS float* al_l = (LAS float*)(lds + A_WS) + wid * 64; LAS float* fac_l = al_l + 32;
    const bf16* qp = Z + trow * ZP + ZC_QA + head * 128 + hi * 8;
    const bf16* gp = Z + trow * ZP + ZC_GA + head * 3;
    const float g1 = bf2f(gp[1]), g2 = bf2f(gp[2]);
    bf16* obase = OA + ((size_t)b * SEQ + c * 64 + tb * 32) * DM + OC_A + head * 128;
    const bf16* zb = Z + (size_t)b * SEQ * ZP;
    bf16x8 qr[8];
#pragma unroll
    for (int d0 = 0; d0 < 8; ++d0) qr[d0] = *(const bf16x8*)(qp + d0 * 16);
    { f32x16 o[4];
#pragma unroll
      for (int d = 0; d < 4; ++d) o[d] = att::zero16();
      float m_reg = -1e30f, l_reg = 0.f;
      const int jlo = c > 8 ? c - 8 : 0; const unsigned wmask = ((2u << c) - 1u) & ~((1u << jlo) - 1u);
      const int twmin = c * 64 + tb * 32;
      run_tiles<128>(uni, wmask, zb + ZC_KVA + 512 + g * 128, zb + ZC_KVA + 768 + g * 128, zb + ZC_KVA + 1024 + g * 128, zb + ZC_KVA + 1280 + g * 128, (size_t)ZP, lds, tid, lane, qr, o, m_reg, l_reg, al_l,
          [&](int ph, int j) { return MaskGen{C, slC, (float)(tpos - 64 * j - 4 * hi), ph ? 512.f : 1e9f, ph ? true : (((mysel >> j) & 1u) != 0u), ph ? (j < c && j >= c - 7) : (j < c)}; },
          [&](int ph, int j) { return ph ? (twmin - (64 * j + 63) >= 512) : !__any((mysel >> j) & 1u); },
          [&](int ph) { if (hi == 0) fac_l[r32] = (ph ? g2 : g1) / l_reg; LDS_WAIT();
              ATT_ACC_O(false);
              LDS_WAIT();
#pragma unroll
      for (int d = 0; d < 4; ++d) o[d] = att::zero16();
              m_reg = -1e30f; l_reg = 0.f; }); }
}

__device__ __forceinline__ void moba_unit(int code, const bf16* Z, const float* KMEAN, bf16* OA, LAS char* lds, int tid_in, int wid) {
    using namespace att;
    int tid = tid_in; asm volatile("" : "+v"(tid)); const int lane = tid & 63;
    const int bh = (code >> 3) & 15, kb = code & 7, b = bh >> 2, h = bh & 3;
    const int r32 = lane & 31, hi = lane >> 5, tl = wid * 32 + r32, tpos = kb * 256 + tl;
    const float slC = __builtin_amdgcn_exp2f(-2.0f * (float)(h + 1)) * LOG2E, C = 0.08838834764831845f * LOG2E;
    LAS float* al_l = (LAS float*)(lds + A_WS) + wid * 64; LAS float* fac_l = al_l + 32;
    LAS unsigned* sel_l = (LAS unsigned*)(lds + A_SEL); LAS unsigned* uni_l = (LAS unsigned*)(lds + A_UNI); LAS float* km_l = (LAS float*)(lds + A_KM);
    const bf16* zb = Z + (size_t)b * SEQ * ZP;
    for (int i = tid; i < 1024; i += NTHR) km_l[i] = KMEAN[(size_t)bh * 1024 + i];
    if (tid == 0) uni_l[0] = 0u;
    __syncthreads();
    if (tid < 256) {
        unsigned sel;
        if (kb <= 3) sel = (1u << kb) - 1u;
        else { float sc[7];
#pragma unroll
            for (int n = 0; n < 7; ++n) sc[n] = 0.f;
            const bf16* qp = zb + (size_t)(kb * 256 + tid) * ZP + ZC_QC + h * 128;
#pragma unroll 1
            for (int dh = 0; dh < 4; ++dh) { v4u qv[4];
#pragma unroll
            for (int d4 = 0; d4 < 4; ++d4) qv[d4] = *(const v4u*)(qp + (dh * 4 + d4) * 8);
#pragma unroll
            for (int d4 = 0; d4 < 4; ++d4) { const int d8 = dh * 4 + d4; const v4u q = qv[d4];
                const float qf[8] = {bflo(q.x), bfhi(q.x), bflo(q.y), bfhi(q.y), bflo(q.z), bfhi(q.z), bflo(q.w), bfhi(q.w)};
#pragma unroll
                for (int n = 0; n < 7; ++n) if (n < kb) { const LAS float* kp = km_l + n * 128 + d8 * 8;
#pragma unroll
                    for (int i = 0; i < 8; ++i) sc[n] = fmaf(qf[i], kp[i], sc[n]); } } }
            sel = 0u;
#pragma unroll
            for (int k = 0; k < 3; ++k) { int best = -1; float bv = -INFINITY;
#pragma unroll
                for (int n = 0; n < 7; ++n) if (n < kb && !((sel >> n) & 1u) && sc[n] > bv) { bv = sc[n]; best = n; }
                if (best < 0) best = __builtin_ctz(~sel);
                sel |= 1u << best; } }
        sel_l[tid] = sel;
        (void)__hip_atomic_fetch_or(uni_l, sel, __ATOMIC_RELAXED, __HIP_MEMORY_SCOPE_WORKGROUP);
    }
    __syncthreads();
    const unsigned mysel = sel_l[tl], uni = uni_l[0];
    unsigned tmask = 0xFu << (4 * kb);
    for (int n = 0; n < kb; ++n) if ((uni >> n) & 1u) tmask |= 0xFu << (4 * n);
    bf16x8 qr[8];
    { const bf16* qp = zb + (size_t)tpos * ZP + ZC_QC + h * 128 + hi * 8;
#pragma unroll
      for (int d0 = 0; d0 < 8; ++d0) qr[d0] = *(const bf16x8*)(qp + d0 * 16); }
    f32x16 o[4];
#pragma unroll
      for (int d = 0; d < 4; ++d) o[d] = att::zero16();
    float m_reg = -1e30f, l_reg = 0.f;
    const int twmax = kb * 256 + wid * 32 + 31;
    run_tiles<128>(tmask, 0u, zb + ZC_KC + h * 128, zb + ZC_VC + h * 128, zb, zb, (size_t)ZP, lds, tid, lane, qr, o, m_reg, l_reg, al_l,
        [&](int, int j) { const int blk = j >> 2; return MaskGen{C, slC, (float)(tpos - 64 * j - 4 * hi), 1e9f, blk == kb ? true : (((mysel >> blk) & 1u) != 0u), blk != kb}; },
        [&](int, int j) { const int blk = j >> 2; return blk == kb ? (64 * j > twmax) : !__any((mysel >> blk) & 1u); },
        [&](int) {});
    if (hi == 0) fac_l[r32] = 1.0f / l_reg; LDS_WAIT();
    float fr_[16];
#pragma unroll
    for (int r = 0; r < 16; ++r) fr_[r] = fac_l[crow(r, hi)];
    LDS_WAIT();
    bf16* obase = OA + ((size_t)b * SEQ + kb * 256 + wid * 32) * DM + OC_C + h * 128;
    ATT_STORE_O(4, o[d_][r_] * fr_[r_]);
}

__device__ __forceinline__ void swa_unit(int code, const bf16* Z, const float* sink, bf16* OA, LAS char* lds, int tid_in, int wid) {
    using namespace att;
    int tid = tid_in; asm volatile("" : "+v"(tid)); const int lane = tid & 63;
    const int bg = (code >> 5) & 7, c = code & 31, b = bg >> 1, g = bg & 1;
    const int r32 = lane & 31, hi = lane >> 5, hh = wid & 3, tb = wid >> 2, head = g * 4 + hh;
    const int tl = tb * 32 + r32, tpos = c * 64 + tl;
    const float slC = __builtin_amdgcn_exp2f(-(float)(head + 1)) * LOG2E, C = 0.125f * LOG2E;
    LAS float* al_l = (LAS float*)(lds + A_WS) + wid * 64; LAS float* fac_l = al_l + 32;
    const bf16* zb = Z + (size_t)b * SEQ * ZP;
    bf16x8 qr[4];
    { const bf16* qp = zb + (size_t)tpos * ZP + ZC_QB + head * 64 + hi * 8;
#pragma unroll
      for (int d0 = 0; d0 < 4; ++d0) qr[d0] = *(const bf16x8*)(qp + d0 * 16); }
    f32x16 o[2];
#pragma unroll
      for (int d = 0; d < 2; ++d) o[d] = att::zero16();
    float m_reg = -1e30f, l_reg = 0.f;
    const int jlo = c > 2 ? c - 2 : 0; const unsigned tmask = ((2u << c) - 1u) & ~((1u << jlo) - 1u);
    const int twmin = c * 64 + tb * 32;
    run_tiles<64>(tmask, 0u, zb + ZC_KB + g * 64, zb + ZC_VB + g * 64, zb, zb, (size_t)ZP, lds, tid, lane, qr, o, m_reg, l_reg, al_l,
        [&](int, int j) { return MaskGen{C, slC, (float)(tpos - 64 * j - 4 * hi), 128.f, true, j == c - 1}; },
        [&](int, int j) { return twmin - (64 * j + 63) >= 128; },
        [&](int) {});
    l_reg += __builtin_amdgcn_exp2f(sink[head] * LOG2E - m_reg);
    if (hi == 0) fac_l[r32] = 1.0f / l_reg; LDS_WAIT();
    float fr_[16];
#pragma unroll
    for (int r = 0; r < 16; ++r) fr_[r] = fac_l[crow(r, hi)];
    LDS_WAIT();
    bf16* obase = OA + ((size_t)b * SEQ + c * 64 + tb * 32) * DM + OC_B + head * 64;
    ATT_STORE_O(2, o[d_][r_] * fr_[r_]);
}

__device__ __forceinline__ void cmp_unit(int u, const bf16* Z, const bf16* WCMP, const float* pos, bf16* KCMP, bf16* VCMP, LAS char* lds, int tid, int lane, int wid) {
    const int bg = u >> 5, kv = (u >> 4) & 1, nt = (u >> 2) & 3, et = u & 3, b = bg >> 1, g = bg & 1, r32 = lane & 31, hi = lane >> 5;
    const int n = nt * 32 + r32, nc = n < 126 ? n : 126;
    const bf16* arow = Z + ((size_t)b * SEQ + 16 * nc) * ZP + ZC_KVA + kv * 256 + g * 128 + hi * 8;
    const bf16* brow = WCMP + ((size_t)kv * 128 + et * 32 + r32) * 4096 + hi * 8;
    const float* prow = pos + kv * 4096 + hi * 8;
    f32x16 acc = att::zero16();
    for (int ll = 0; ll < 4; ++ll) { const int l = 4 * wid + ll;
#pragma unroll
        for (int ds = 0; ds < 8; ++ds) { const int d = ds * 16;
            const v4u a = *(const v4u*)(arow + (size_t)l * ZP + d); const f32x4 p0 = *(const f32x4*)(prow + l * 128 + d), p1 = *(const f32x4*)(prow + l * 128 + d + 4);
            v4u af; af.x = pk2(bflo(a.x) + p0[0], bfhi(a.x) + p0[1]); af.y = pk2(bflo(a.y) + p0[2], bfhi(a.y) + p0[3]); af.z = pk2(bflo(a.z) + p1[0], bfhi(a.z) + p1[1]); af.w = pk2(bflo(a.w) + p1[2], bfhi(a.w) + p1[3]);
            const bf16x8 bfg = *(const bf16x8*)(brow + l * 128 + d);
            acc = __builtin_amdgcn_mfma_f32_32x32x16_bf16(__builtin_bit_cast(bf16x8, af), bfg, acc, 0, 0, 0); } }
    LAS float* part = (LAS float*)lds;
#pragma unroll
    for (int r = 0; r < 16; ++r) part[(wid * 32 + att::crow(r, hi)) * 33 + r32] = acc[r];
    __syncthreads();
#pragma unroll
    for (int k2 = 0; k2 < 2; ++k2) { const int idx = tid + NTHR * k2, row = idx >> 5, col = idx & 31; float s = 0.f;
#pragma unroll
        for (int w = 0; w < 8; ++w) s += part[(w * 32 + row) * 33 + col];
        const int no = nt * 32 + row; if (no == 127) s = 0.f;
        (kv ? VCMP : KCMP)[((size_t)bg * 128 + no) * 128 + et * 32 + col] = (bf16)f2bf(s); }
    __syncthreads();
}
__device__ __forceinline__ void kmean_unit(int u, const bf16* Z, float* KMEAN, LAS char* lds, int tid, int lane, int wid) {
    const int bh = u >> 3, blk = u & 7, b = bh >> 2, h = bh & 3;
    const bf16* kp = Z + ((size_t)b * SEQ + blk * 256 + wid * 32) * ZP + ZC_KC + h * 128 + 2 * lane;
    float s0 = 0.f, s1 = 0.f;
#pragma unroll 8
    for (int i = 0; i < 32; ++i) { const unsigned w = *(const unsigned*)(kp + (size_t)i * ZP); s0 += bflo(w); s1 += bfhi(w); }
    LAS float* part = (LAS float*)lds;
    part[wid * 128 + 2 * lane] = s0; part[wid * 128 + 2 * lane + 1] = s1;
    __syncthreads();
    if (tid < 128) { float s = 0.f;
#pragma unroll
        for (int w = 0; w < 8; ++w) s += part[w * 128 + tid];
        KMEAN[((size_t)bh * 8 + blk) * 128 + tid] = s * (1.0f / 256.0f); }
    __syncthreads();
}

__device__ __forceinline__ void cvt_item64(const float* W, int ldw, int k0, int n_src0, int ncols, bf16* WT, int ldt, int n_dst0, LAS unsigned* scr, int lane) {
    const int nq = lane & 15, kq = lane >> 4; const bool act = 4 * nq < ncols;
    const float* wp = W + (size_t)(k0 + 2 * kq) * ldw + n_src0 + 4 * nq;
    f32x4 v0[8], v1[8];
#pragma unroll
    for (int i = 0; i < 8; ++i) { if (act) { v0[i] = *(const f32x4*)(wp + (size_t)(8 * i) * ldw); v1[i] = *(const f32x4*)(wp + (size_t)(8 * i + 1) * ldw); } else { v0[i] = (f32x4){0.f, 0.f, 0.f, 0.f}; v1[i] = v0[i]; } }
#pragma unroll
    for (int i = 0; i < 8; ++i) { const int a = kq + 4 * i;
#pragma unroll
        for (int j = 0; j < 4; ++j) scr[(4 * nq + j) * 33 + a] = pk2(v0[i][j], v1[i][j]); }
    LDS_WAIT(); asm volatile("" ::: "memory");
    const int c = lane & 7;
#pragma unroll
    for (int i = 0; i < 8; ++i) { const int n = (lane >> 3) + 8 * i; const LAS unsigned* s = scr + n * 33 + 4 * c;
        v4u o; o.x = s[0]; o.y = s[1]; o.z = s[2]; o.w = s[3];
        if (n < ncols) *(v4u*)(WT + (size_t)(n_dst0 + n) * ldt + k0 + 8 * c) = o; }
    LDS_WAIT(); asm volatile("" ::: "memory");
}
__device__ __forceinline__ void cvt_item64_fp8(const float* W, int ldw, int k0, int n_src0, int ncols, unsigned char* WT, int ldt, int n_dst0, float scale, LAS unsigned* scr, int lane) {
    const int nq = lane & 15, kq = lane >> 4; const bool act = 4 * nq < ncols;
    const float* wp = W + (size_t)(k0 + 4 * kq) * ldw + n_src0 + 4 * nq;
    f32x4 v[4][4];
#pragma unroll
    for (int i = 0; i < 4; ++i)
#pragma unroll
        for (int rr = 0; rr < 4; ++rr) v[i][rr] = act ? *(const f32x4*)(wp + (size_t)(16 * i + rr) * ldw) : (f32x4){0.f, 0.f, 0.f, 0.f};
#pragma unroll
    for (int i = 0; i < 4; ++i)
#pragma unroll
        for (int j = 0; j < 4; ++j) { int w = 0; w = __builtin_amdgcn_cvt_pk_fp8_f32(v[i][0][j] * scale, v[i][1][j] * scale, w, false); w = __builtin_amdgcn_cvt_pk_fp8_f32(v[i][2][j] * scale, v[i][3][j] * scale, w, true);
            scr[(4 * nq + j) * 17 + kq + 4 * i] = (unsigned)w; }
    LDS_WAIT(); asm volatile("" ::: "memory");
    const int c = lane & 3;
#pragma unroll
    for (int i = 0; i < 4; ++i) { const int n = (lane >> 2) + 16 * i; const LAS unsigned* s = scr + n * 17 + 4 * c;
        v4u o; o.x = s[0]; o.y = s[1]; o.z = s[2]; o.w = s[3];
        if (n < ncols) *(v4u*)(WT + (size_t)(n_dst0 + n) * ldt + k0 + 16 * c) = o; }
    LDS_WAIT(); asm volatile("" ::: "memory");
}
__device__ __forceinline__ unsigned pk4_fp8(f32x4 v, float scale) { int w = 0; w = __builtin_amdgcn_cvt_pk_fp8_f32(v[0] * scale, v[1] * scale, w, false); w = __builtin_amdgcn_cvt_pk_fp8_f32(v[2] * scale, v[3] * scale, w, true); return (unsigned)w; }
constexpr float FP8_XSCALE = 16.f, FP8_WSCALE = 64.f;
constexpr int FP8_SCA = 0x7b7b7b7b, FP8_SCB = 0x79797979;
constexpr int CI_IN = 173 * 32, CI_BRA = 512, CI_BRB = 256, CI_BRC = 256, CI_OUT = 1024, CI_GU = 8192, CI_D = 4096, CI_CMP = 256, CI_ZERO = 232;
constexpr int CI_TOTAL = CI_IN + CI_BRA + CI_BRB + CI_BRC + CI_OUT + CI_GU + CI_D + CI_CMP + CI_ZERO;

__device__ __forceinline__ void ln_row(f32x4 (&v)[8], const float* g, const float* bta, int lane) {
    float s = 0.f;
#pragma unroll
    for (int j = 0; j < 8; ++j) s += (v[j][0] + v[j][1]) + (v[j][2] + v[j][3]);
    const float mean = wave_sum(s, lane) * (1.0f / DM); float s2 = 0.f;
#pragma unroll
    for (int j = 0; j < 8; ++j) { v[j] = v[j] - mean; s2 += (v[j][0] * v[j][0] + v[j][1] * v[j][1]) + (v[j][2] * v[j][2] + v[j][3] * v[j][3]); }
    const float rstd = 1.0f / sqrtf(wave_sum(s2, lane) * (1.0f / DM) + LN_EPS);
#pragma unroll
    for (int j = 0; j < 8; ++j) { const f32x4 gg = ((const f32x4*)g)[lane + 64 * j], bb = ((const f32x4*)bta)[lane + 64 * j]; v[j] = v[j] * rstd * gg + bb; }
}

__device__ __forceinline__ void ln_router_tile(int tile, const float* R, const float* g, const float* bta, float* X1, bf16* XB, const float* wgrp, const float* bgrp, const float* wrt, const float* brt,
                                               int* hist, int* tok_e, float* tok_w, int* tok_p, LAS char* lds, int tid, int lane, int wid) {
    LAS float* glog = (LAS float*)lds;
    LAS float* part = (LAS float*)(lds + 1024);
    LAS float* elog = (LAS float*)(lds + 1024 + 33792);
    const int row0 = tile * 32;
    LAS f32x4* lg = (LAS f32x4*)(lds + 65536);
    LAS f32x4* lb = lg + 512;
    LAS f32x4* lw = lb + 512;
    { const f32x4 a = ((const f32x4*)g)[tid], b4 = ((const f32x4*)bta)[tid]; f32x4 w4[4];
#pragma unroll
      for (int q = 0; q < 4; ++q) w4[q] = ((const f32x4*)wgrp)[tid + 512 * q];
      lg[tid] = a; lb[tid] = b4;
#pragma unroll
      for (int q = 0; q < 4; ++q) { const int kk = tid + 512 * q; lw[(kk & 3) * 512 + (kk >> 2)] = w4[q]; } }
    __syncthreads();
#pragma unroll 1
    for (int hp = 0; hp < 2; ++hp) {
        f32x4 v[2][8]; const size_t rbase = (size_t)row0 + wid * 4 + hp * 2;
#pragma unroll
        for (int i = 0; i < 2; ++i)
#pragma unroll
            for (int j = 0; j < 8; ++j) v[i][j] = ((const f32x4*)(R + (rbase + i) * DM))[lane + 64 * j];
        float mean[2], rstd[2];
#pragma unroll
        for (int i = 0; i < 2; ++i) { float s = 0.f;
#pragma unroll
            for (int j = 0; j < 8; ++j) s += (v[i][j][0] + v[i][j][1]) + (v[i][j][2] + v[i][j][3]);
            mean[i] = s; }
#pragma unroll
        for (int o_ = 1; o_ < 64; o_ <<= 1) {
#pragma unroll
            for (int i = 0; i < 2; ++i) mean[i] += shfl_xor_f(mean[i], o_, lane); }
#pragma unroll
        for (int i = 0; i < 2; ++i) { mean[i] *= (1.0f / DM); float s2 = 0.f;
#pragma unroll
            for (int j = 0; j < 8; ++j) { v[i][j] = v[i][j] - mean[i]; s2 += (v[i][j][0] * v[i][j][0] + v[i][j][1] * v[i][j][1]) + (v[i][j][2] * v[i][j][2] + v[i][j][3] * v[i][j][3]); }
            rstd[i] = s2; }
#pragma unroll
        for (int o_ = 1; o_ < 64; o_ <<= 1) {
#pragma unroll
            for (int i = 0; i < 2; ++i) rstd[i] += shfl_xor_f(rstd[i], o_, lane); }
#pragma unroll
        for (int i = 0; i < 2; ++i) rstd[i] = 1.0f / sqrtf(rstd[i] * (1.0f / DM) + LN_EPS);
        float gl[2][4];
#pragma unroll
        for (int i = 0; i < 2; ++i)
#pragma unroll
            for (int cc = 0; cc < 4; ++cc) gl[i][cc] = 0.f;
#pragma unroll
        for (int j = 0; j < 8; ++j) { const f32x4 gg = lg[lane + 64 * j], bb = lb[lane + 64 * j];
            f32x4 wr[4];
#pragma unroll
            for (int e = 0; e < 4; ++e) wr[e] = lw[e * 512 + lane + 64 * j];
#pragma unroll
            for (int i = 0; i < 2; ++i) { const f32x4 y = v[i][j] * rstd[i] * gg + bb;
                ((f32x4*)(X1 + (rbase + i) * DM))[lane + 64 * j] = y;
                ((unsigned*)((unsigned char*)XB + (rbase + i) * DM))[lane + 64 * j] = pk4_fp8(y, FP8_XSCALE);
#pragma unroll
                for (int e = 0; e < 4; ++e)
#pragma unroll
                    for (int cc = 0; cc < 4; ++cc) gl[i][cc] = fmaf(y[e], wr[e][cc], gl[i][cc]); }
            asm volatile("" ::: "memory"); }
#pragma unroll
        for (int o_ = 1; o_ < 64; o_ <<= 1) {
#pragma unroll
            for (int i = 0; i < 2; ++i)
#pragma unroll
                for (int cc = 0; cc < 4; ++cc) gl[i][cc] += shfl_xor_f(gl[i][cc], o_, lane); }
        if (lane == 0) {
#pragma unroll
            for (int i = 0; i < 2; ++i)
#pragma unroll
                for (int cc = 0; cc < 4; ++cc) glog[(wid * 4 + hp * 2 + i) * 4 + cc] = gl[i][cc] + bgrp[cc]; }
    }
    VM_WAIT(); __syncthreads();
    { f32x16 acc = att::zero16();
      const int i = lane & 31, kk = lane >> 5;
      const float* xa = X1 + (size_t)(row0 + i) * DM + 256 * wid + 4 * kk;
      const float* wb = wrt + (size_t)(256 * wid + 4 * kk) * 32 + i;
#pragma unroll 1
      for (int c8 = 0; c8 < 2; ++c8) { f32x4 a[16]; float bq[16][4];
#pragma unroll
          for (int q = 0; q < 16; ++q) { const int cch = c8 * 16 + q; a[q] = *(const f32x4*)(xa + 8 * cch);
#pragma unroll
              for (int s = 0; s < 4; ++s) bq[q][s] = wb[(8 * cch + s) * 32]; }
#pragma unroll
          for (int q = 0; q < 16; ++q)
#pragma unroll
              for (int s = 0; s < 4; ++s) acc = __builtin_amdgcn_mfma_f32_32x32x2f32(a[q][s], bq[q][s], acc, 0, 0, 0); }
#pragma unroll
      for (int r = 0; r < 16; ++r) part[(wid * 32 + att::crow(r, kk)) * 33 + i] = acc[r]; }
    __syncthreads();
#pragma unroll
    for (int k2 = 0; k2 < 2; ++k2) { const int idx = tid + NTHR * k2, row = idx >> 5, col = idx & 31; float s = brt[col];
#pragma unroll
        for (int w = 0; w < 8; ++w) s += part[(w * 32 + row) * 33 + col];
        elog[row * 33 + col] = s; }
    __syncthreads();
    if (tid < 32) { const int token = row0 + tid;
        int gi = 0; float gm = glog[tid * 4];
#pragma unroll
        for (int cc = 1; cc < 4; ++cc) { const float t = glog[tid * 4 + cc]; if (t > gm) { gm = t; gi = cc; } }
        float den = 0.f;
#pragma unroll
        for (int cc = 0; cc < 4; ++cc) den += __expf(glog[tid * 4 + cc] - gm);
        const float gw = 1.0f / den;
        int i0 = 0; float t0 = elog[tid * 33 + gi * 8];
#pragma unroll
        for (int k = 1; k < 8; ++k) { const float t = elog[tid * 33 + gi * 8 + k]; if (t > t0) { t0 = t; i0 = k; } }
        int i1 = -1; float t1 = -INFINITY;
#pragma unroll
        for (int k = 0; k < 8; ++k) { const float t = elog[tid * 33 + gi * 8 + k]; if (k != i0 && t > t1) { t1 = t; i1 = k; } }
        const float ex = __expf(t1 - t0), w0 = gw / (1.0f + ex), w1 = gw * ex / (1.0f + ex);
        const int e0 = gi * 8 + i0, e1 = gi * 8 + i1;
        LAS int* e_l = (LAS int*)(lds + 1024);
        e_l[2 * tid] = e0; e_l[2 * tid + 1] = e1; LDS_WAIT();
        int r0 = 0, r1 = 0, hc = 0;
        for (int q = 0; q < 64; ++q) { const int eq = e_l[q]; if (q < 2 * tid) { r0 += (eq == e0); r1 += (eq == e1); } hc += (eq == tid); }
        hist[tile * 32 + tid] = hc;
        tok_e[token * 2] = e0; tok_e[token * 2 + 1] = e1; tok_w[token * 2] = w0; tok_w[token * 2 + 1] = w1; tok_p[token * 2] = r0; tok_p[token * 2 + 1] = r1; }
    __syncthreads();
}
__device__ __forceinline__ int moe_offsets(const int* cntg, LAS char* lds, int tid) {
    LAS int* off_l = (LAS int*)lds; LAS int* cnt_l = (LAS int*)(lds + 256);
    if (tid < 32) cnt_l[tid] = cntg[tid];
    __syncthreads();
    if (tid == 0) { int o = 0; for (int e = 0; e < 32; ++e) { off_l[e] = o; o += (cnt_l[e] + 255) & ~255; } off_l[32] = o; }
    __syncthreads();
    return off_l[32];
}
__device__ __forceinline__ int moe_offsets_hist(const int* hist, int tile, LAS char* lds, int tid) {
    LAS int* off_l = (LAS int*)lds; LAS int* cnt_l = (LAS int*)(lds + 256); LAS int* pre_l = (LAS int*)(lds + 512); LAS int* pa = (LAS int*)(lds + 1024); LAS int* pb = (LAS int*)(lds + 1024 + 2048);
    const int e = tid & 31, part = tid >> 5; int sa = 0, sb = 0;
#pragma unroll 4
    for (int q = 0; q < 16; ++q) { const int t = part * 16 + q; const int h = hist[t * 32 + e]; sa += h; sb += (t < tile) ? h : 0; }
    pa[part * 32 + e] = sa; pb[part * 32 + e] = sb;
    __syncthreads();
    if (tid < 32) { int c = 0, p = 0;
#pragma unroll
        for (int q = 0; q < 16; ++q) { c += pa[q * 32 + tid]; p += pb[q * 32 + tid]; }
        cnt_l[tid] = c; pre_l[tid] = p; }
    __syncthreads();
    if (tid == 0) { int o = 0; for (int k = 0; k < 32; ++k) { off_l[k] = o; o += (cnt_l[k] + 255) & ~255; } off_l[32] = o; }
    __syncthreads();
    return off_l[32];
}

#ifndef DBL
#define DBL 0
#endif
#ifndef PHASES
#define PHASES 0x7FF
#endif
struct Args { const float* in[20]; float* out; unsigned char* ws; };
__global__ void __launch_bounds__(NTHR, 2) fwd_kernel(Args args) {
    extern __shared__ __attribute__((aligned(16))) unsigned char lds_raw[];
    LAS unsigned char* const lds = (LAS unsigned char*)lds_raw;
    LAS char* const ldc = (LAS char*)lds_raw;
    volatile LAS unsigned* MISC = (volatile LAS unsigned*)(lds + MISC_OFF);
    const int G = gridDim.x, bx = blockIdx.x, vcu = (G % 8 == 0) ? (bx % 8) * (G / 8) + bx / 8 : bx, NGW = G * NWAVES;
#define PHASE_IDS() int tid_ = threadIdx.x; asm volatile("" : "+v"(tid_)); const int tid = tid_, lane = tid & 63, wid = __builtin_amdgcn_readfirstlane(tid >> 6), gw = vcu * NWAVES + wid; (void)gw; (void)lane
    gu32* ctl0 = (gu32*)(args.ws + WS_CTL);
    for (int u = threadIdx.x; u < (LDS_BYTES - LDSCTL_OFF) / 4; u += NTHR) ((LAS unsigned*)(lds + LDSCTL_OFF))[u] = 0u;
    __syncthreads();
    XcdBarrier bar = xcd_barrier_post((unsigned*)(ctl0 + CW_BAR), MISC + 8);
#define GRID_BAR() xcd_barrier(bar)
#define PHASE_PTRS() GAS unsigned char* wsg_ = (GAS unsigned char*)args.ws; asm volatile("" : "+s"(wsg_)); unsigned char* ws = (unsigned char*)wsg_; gu32* ctl = (gu32*)(ws + WS_CTL); (void)ctl; const float* x_in = args.in[0]; (void)x_in; \
    bf16* WIN = (bf16*)(ws + WS_WIN); bf16* WBRA = (bf16*)(ws + WS_WBRA); bf16* WBRB = (bf16*)(ws + WS_WBRB); bf16* WBRC = (bf16*)(ws + WS_WBRC); bf16* WOUT = (bf16*)(ws + WS_WOUT); \
    bf16* WGU = (bf16*)(ws + WS_WGU); bf16* WD = (bf16*)(ws + WS_WD); bf16* WCMP = (bf16*)(ws + WS_WCMP); \
    bf16* XB = (bf16*)(ws + WS_XB); bf16* Z = (bf16*)(ws + WS_Z); bf16* OA = (bf16*)(ws + WS_OA); float* MG = (float*)(ws + WS_MG); bf16* MB = (bf16*)(ws + WS_MB); \
    float* X1 = (float*)(ws + WS_X1); bf16* HB = (bf16*)(ws + WS_H); bf16* XS = (bf16*)(ws + WS_XS); bf16* YB = (bf16*)(ws + WS_Y); \
    unsigned char* sm = ws + WS_SMALL; \
    bf16* KCMP = (bf16*)(sm + SM_KCMP); bf16* VCMP = (bf16*)(sm + SM_VCMP); float* KMEAN = (float*)(sm + SM_KMEAN); \
    int* tok_e = (int*)(sm + SM_TOKE); float* tok_w = (float*)(sm + SM_TOKW); int* tok_p = (int*)(sm + SM_TOKP); int* rowts = (int*)(sm + SM_ROWTS); float* roww = (float*)(sm + SM_ROWW); int* panel_e = (int*)(sm + SM_PANE); int* hist = (int*)(sm + SM_HIST); int* cntg = (int*)(sm + SM_CNTG); (void)hist; (void)cntg; \
    (void)WIN; (void)WBRA; (void)WBRB; (void)WBRC; (void)WOUT; (void)WGU; (void)WD; (void)WCMP; (void)XB; (void)Z; (void)OA; (void)MG; (void)MB; (void)X1; (void)HB; (void)XS; (void)YB; \
    (void)KCMP; (void)VCMP; (void)KMEAN; (void)tok_e; (void)tok_w; (void)tok_p; (void)rowts; (void)roww; (void)panel_e
    const float alpha = 1.4142135623730951f;

    for (int l = 0; l < DEPTH; ++l) {
#if PHASES & 1
        for (int rep = 0; rep < 1 + ((DBL >> 0) & 1); ++rep) {
        { PHASE_IDS(); PHASE_PTRS();
            LAS unsigned* scr = (LAS unsigned*)(lds + RING_OFF + wid * 16384);
            const float* w_in = args.in[1] + (size_t)l * DM * 11032; const float* cmpw = args.in[3] + (size_t)l * 2 * 4096 * 128;
            const float* wbra = args.in[5] + (size_t)l * 1024 * DM; const float* wbrb = args.in[6] + (size_t)l * 512 * DM; const float* wbrc = args.in[7] + (size_t)l * 512 * DM;
            const float* wout = args.in[8] + (size_t)l * DM * DM;
            const float* wgate = args.in[15] + (size_t)l * NEXP * DM * DEXP; const float* wup = args.in[16] + (size_t)l * NEXP * DM * DEXP; const float* wdown = args.in[17] + (size_t)l * NEXP * DEXP * DM;
            for (int it = gw; it < CI_TOTAL; it += NGW) {
                int r = it; const float* W; bf16* WT; int ldw, k0, ns, nc = 64, ldt, nd;
                if (r >= CI_TOTAL - CI_ZERO) { r -= CI_TOTAL - CI_ZERO; v4u* zp = (v4u*)((unsigned char*)WIN + (size_t)(11032 + r) * DM); const v4u z4 = {0u, 0u, 0u, 0u};
#pragma unroll
                    for (int q = 0; q < 2; ++q) zp[lane + 64 * q] = z4;
                    continue; }
                if (r < CI_IN) { const int kb = r / 173, nb = r % 173;
                    if (nb < 40) { ns = 64 * nb; nd = ns; } else if (nb < 172) { ns = 2584 + 64 * (nb - 40); nd = 2560 + 64 * (nb - 40); } else { ns = 2560; nd = ZC_GA; nc = 24; }
                    cvt_item64_fp8(w_in, 11032, 64 * kb, ns, nc, (unsigned char*)WIN, DM, nd, FP8_WSCALE, scr, lane); continue; }
                if ((r -= CI_IN) < CI_BRA) { W = wbra; ldw = DM; k0 = 64 * (r / 32); ns = 64 * (r % 32); WT = WBRA; ldt = DM; nd = ns; }
                else if ((r -= CI_BRA) < CI_BRB) { W = wbrb; ldw = DM; k0 = 64 * (r / 32); ns = 64 * (r % 32); WT = WBRA + 1024; ldt = DM; nd = ns; }
                else if ((r -= CI_BRB) < CI_BRC) { W = wbrc; ldw = DM; k0 = 64 * (r / 32); ns = 64 * (r % 32); WT = WBRA + 1536; ldt = DM; nd = ns; }
                else if ((r -= CI_BRC) < CI_OUT) { W = wout; ldw = DM; k0 = 64 * (r / 32); ns = 64 * (r % 32); WT = WOUT; ldt = DM; nd = ns; }
                else if ((r -= CI_OUT) < CI_GU) { const int mat = r >> 7, e = mat >> 1, which = mat & 1, rr = r & 127, f0 = 64 * (rr & 3);
                    cvt_item64_fp8((which ? wup : wgate) + (size_t)e * DM * DEXP, DEXP, 64 * (rr >> 2), f0, 64, (unsigned char*)WGU, DM, e * 512 + (f0 >> 7) * 256 + which * 128 + (f0 & 127), FP8_WSCALE, scr, lane); continue; }
                else if ((r -= CI_GU) < CI_D) { const int e = r >> 7, rr = r & 127; W = wdown + (size_t)e * DEXP * DM; ldw = DM; k0 = 64 * (rr >> 5); ns = 64 * (rr & 31); WT = WD; ldt = DEXP; nd = e * DM + ns; }
                else { r -= CI_D; const int kv = r >> 7, rr = r & 127; W = cmpw + (size_t)kv * 4096 * 128; ldw = 128; k0 = 64 * (rr >> 1); ns = 64 * (rr & 1); WT = WCMP; ldt = 4096; nd = kv * 128 + ns; }
                cvt_item64(W, ldw, k0, ns, nc, WT, ldt, nd, scr, lane);
            }
            if (l == 0) for (int row = gw; row < NT; row += NGW) { const f32x4* xr = (const f32x4*)(x_in + (size_t)row * DM);
#pragma unroll
                for (int j = 0; j < 8; ++j) { const f32x4 v = xr[lane + 64 * j]; ((unsigned*)((unsigned char*)XB + (size_t)row * DM))[lane + 64 * j] = pk4_fp8(v, FP8_XSCALE); } }
        }
        GRID_BAR(); }
#endif
#if PHASES & 2
        for (int rep = 0; rep < 1 + ((DBL >> 1) & 1); ++rep) {
        { PHASE_IDS(); PHASE_PTRS(); pg8::Gemm gm{XB, WIN, NT, ZP, DM / 2, DM / 2, FP8_SCA, FP8_SCB}; pg8::StaticOrder S; S.init(NT, ZP, G, bx);
          pg8::EpiZ E{Z, ZP, ZC_GM / 256};
          pg8::gemm_phase<pg8::EpiZ, pg8::StaticOrder, true, true, true>(lds + RING_OFF, gm, S, E); }
        GRID_BAR(); }
#endif
#if PHASES & 4
        for (int rep = 0; rep < 1 + ((DBL >> 2) & 1); ++rep) {
        { PHASE_IDS(); PHASE_PTRS(); const float* pos = args.in[2] + (size_t)l * 2 * 4096;
          for (int u = bx; u < 256; u += G) cmp_unit(u, Z, WCMP, pos, KCMP, VCMP, ldc, tid, lane, wid);
          for (int u = bx; u < 128; u += G) kmean_unit(u, Z, KMEAN, ldc, tid, lane, wid); }
        GRID_BAR(); }
#endif
#if PHASES & 8
        for (int rep = 0; rep < 1 + ((DBL >> 3) & 1); ++rep) {
        { PHASE_IDS(); PHASE_PTRS(); gu32* qw = ctl + CW_QUEUE + 64 * (2 * l + rep); const float* sink = args.in[4] + l * 8;
          LAS unsigned* uw = (LAS unsigned*)(ldc + att::A_UNI) + 2;
          for (;;) {
              if (tid == 0) *uw = __hip_atomic_fetch_add(qw, 1u, RLX_AGENT);
              __syncthreads();
              const unsigned qi = *uw;
              __syncthreads();
              if (qi >= (unsigned)N_ATT_UNITS) break;
              const int code = g_units.u[qi], kind = code >> 12;
              if (kind == 0) nsa_unit(code, Z, KCMP, VCMP, OA, ldc, tid, wid);
              else if (kind == 1) moba_unit(code, Z, KMEAN, OA, ldc, tid, wid);
              else swa_unit(code, Z, sink, OA, ldc, tid, wid);
          } }
        GRID_BAR(); }
#endif
#if PHASES & 16
        for (int rep = 0; rep < 1 + ((DBL >> 4) & 1); ++rep) {
        { PHASE_IDS(); PHASE_PTRS(); pg8::StaticOrder S; S.init(NT, DM, G, bx);
          pg8::Gemm gm{OA, WBRA, NT, DM, DM, DM}; pg8::EpiBrM E{MB, Z + ZC_GM, ZP};
          pg8::gemm_phase<pg8::EpiBrM, pg8::StaticOrder, true, true>(lds + RING_OFF, gm, S, E); }
        GRID_BAR(); }
#endif
#if PHASES & 32
        for (int rep = 0; rep < 1 + ((DBL >> 5) & 1); ++rep) {
        { PHASE_IDS(); PHASE_PTRS(); pg8::Gemm gm{MB, WOUT, NT, DM, DM, DM}; pg8::StaticOrder S; S.init(NT, DM, G, bx);
          pg8::EpiRes E{MG, l == 0 ? x_in : (const float*)X1, alpha};
          pg8::gemm_phase<pg8::EpiRes, pg8::StaticOrder, true, true>(lds + RING_OFF, gm, S, E); }
        GRID_BAR(); }
#endif
#if PHASES & 64
        for (int rep = 0; rep < 1 + ((DBL >> 6) & 1); ++rep) {
        { PHASE_IDS(); PHASE_PTRS(); const float* g1 = args.in[9] + l * DM; const float* b1 = args.in[10] + l * DM;
          const float* wgrp = args.in[11] + (size_t)l * DM * 4; const float* bgrp = args.in[12] + l * 4; const float* wrt = args.in[13] + (size_t)l * DM * 32; const float* brt = args.in[14] + l * 32;
          for (int t = bx; t < NT / 32; t += G) ln_router_tile(t, MG, g1, b1, X1, MB, wgrp, bgrp, wrt, brt, hist, tok_e, tok_w, tok_p, ldc, tid, lane, wid); }
        GRID_BAR(); }
#endif
#if PHASES & 128
        for (int rep = 0; rep < 1 + ((DBL >> 7) & 1); ++rep) {
        { PHASE_IDS(); PHASE_PTRS();
          const LAS int* off_l = (const LAS int*)ldc; const LAS int* cnt_l = (const LAS int*)(ldc + 256); const LAS int* pre_l = (const LAS int*)(ldc + 512);
          for (int tile = bx; tile < NT / 32; tile += G) {
              const int total = moe_offsets_hist(hist, tile, ldc, tid);
              if (tile == bx) {
                  for (int r = bx * NTHR + tid; r < total; r += G * NTHR) { int e = 0;
                      for (int kk = 1; kk < 32; ++kk) if (off_l[kk] <= r) e = kk;
                      if (r >= off_l[e] + cnt_l[e]) { rowts[r] = -1; roww[r] = 0.f; }
                      if ((r & 255) == 0) panel_e[r >> 8] = e; }
                  if (bx == 0 && tid < 32) cntg[tid] = cnt_l[tid]; }
              { int rowq[8]; v4u dat[8][2]; const int p0_ = tile * 64 + wid * 8;
#pragma unroll
                for (int q = 0; q < 8; ++q) { const int e = tok_e[p0_ + q]; rowq[q] = off_l[e] + pre_l[e] + tok_p[p0_ + q]; }
#pragma unroll
                for (int q = 0; q < 8; ++q) { const v4u* src = (const v4u*)((const unsigned char*)MB + (size_t)((p0_ + q) >> 1) * DM); dat[q][0] = src[lane]; dat[q][1] = src[lane + 64]; }
#pragma unroll
                for (int q = 0; q < 8; ++q) { v4u* dst = (v4u*)((unsigned char*)XS + (size_t)rowq[q] * DM); dst[lane] = dat[q][0]; dst[lane + 64] = dat[q][1];
                    if (lane == 0) { rowts[rowq[q]] = p0_ + q; roww[rowq[q]] = tok_w[p0_ + q]; } } }
              __syncthreads(); }
          __syncthreads(); }
        GRID_BAR(); }
#endif
#if PHASES & 256
        for (int rep = 0; rep < 1 + ((DBL >> 8) & 1); ++rep) {
        { PHASE_IDS(); PHASE_PTRS();
          const int total = moe_offsets(cntg, ldc, tid);
          __syncthreads();
          pg8::Gemm gm{XS, WGU, ROWCAP, NEXP * 512, DM / 2, DM / 2, FP8_SCA, FP8_SCB}; pg8::MoeOrder<2> S{(total >> 8) * 2, G, bx, panel_e};
          pg8::EpiGU E{HB, roww};
          pg8::gemm_phase<pg8::EpiGU, pg8::MoeOrder<2>, true, true, true>(lds + RING_OFF, gm, S, E); }
        GRID_BAR(); }
#endif
#if PHASES & 512
        for (int rep = 0; rep < 1 + ((DBL >> 9) & 1); ++rep) {
        { PHASE_IDS(); PHASE_PTRS();
          const int total = moe_offsets(cntg, ldc, tid);
          __syncthreads();
          pg8::Gemm gm{HB, WD, ROWCAP, NEXP * DM, DEXP, DEXP}; pg8::MoeOrder<8> S{(total >> 8) * 8, G, bx, panel_e};
          pg8::EpiDown E{XS, (unsigned)((WS_Y - WS_XS) / 2), rowts};
          pg8::gemm_phase<pg8::EpiDown, pg8::MoeOrder<8>, true, true>(lds + RING_OFF, gm, S, E); }
        GRID_BAR(); }
#endif
#if PHASES & 1024
        for (int rep = 0; rep < 1 + (((DBL >> 10) & 1) && l == DEPTH - 1 ? 1 : 0); ++rep) {
        { PHASE_IDS(); PHASE_PTRS(); const float* g2 = args.in[18] + l * DM; const float* b2 = args.in[19] + l * DM; const bool last = (l == DEPTH - 1); float* xo = last ? args.out : X1;
          for (int row = gw; row < NT; row += NGW) { f32x4 v[8];
#pragma unroll
              for (int j = 0; j < 8; ++j) { const f32x4 a = ((const f32x4*)(X1 + (size_t)row * DM))[lane + 64 * j];
                  const v2u y0 = ((const v2u*)(YB + (size_t)row * DM))[lane + 64 * j], y1 = ((const v2u*)(YB + ((size_t)NT + row) * DM))[lane + 64 * j];
                  v[j][0] = a[0] * alpha + (bflo(y0.x) + bflo(y1.x)); v[j][1] = a[1] * alpha + (bfhi(y0.x) + bfhi(y1.x));
                  v[j][2] = a[2] * alpha + (bflo(y0.y) + bflo(y1.y)); v[j][3] = a[3] * alpha + (bfhi(y0.y) + bfhi(y1.y)); }
              ln_row(v, g2, b2, lane);
#pragma unroll
              for (int j = 0; j < 8; ++j) { ((f32x4*)(xo + (size_t)row * DM))[lane + 64 * j] = v[j];
                  if (!last) ((unsigned*)((unsigned char*)XB + (size_t)row * DM))[lane + 64 * j] = pk4_fp8(v[j], FP8_XSCALE); } } }
        if (l + 1 < DEPTH) GRID_BAR(); }
#endif
    }
}

extern "C" void kernel_launch(void* const* d_in, const int* in_sizes, int n_in, void* d_out, int out_size, void* d_ws, size_t ws_size, hipStream_t stream) {
    static int grid = 0;
    if (grid == 0) {
        if (n_in != 20 || in_sizes[0] != NT * DM || out_size != NT * DM || ws_size < WS_END) { fprintf(stderr, "kernel_launch: unexpected shapes (n_in %d, in0 %d, out %d, ws %zu < %zu?)\n", n_in, n_in > 0 ? in_sizes[0] : -1, out_size, ws_size, (size_t)WS_END); grid = -1; return; }
        int dev = 0, cus = 0, per_cu = 0;
        if (hipGetDevice(&dev) != hipSuccess || hipDeviceGetAttribute(&cus, hipDeviceAttributeMultiprocessorCount, dev) != hipSuccess) { grid = -1; return; }
        if (hipFuncSetAttribute((const void*)fwd_kernel, hipFuncAttributeMaxDynamicSharedMemorySize, LDS_BYTES) != hipSuccess) { fprintf(stderr, "kernel_launch: hipFuncSetAttribute failed\n"); grid = -1; return; }
        if (hipOccupancyMaxActiveBlocksPerMultiprocessor(&per_cu, (const void*)fwd_kernel, NTHR, LDS_BYTES) != hipSuccess || per_cu < 1) fprintf(stderr, "kernel_launch: occupancy query reports %d\n", per_cu);
        (void)hipGetLastError();
        grid = cus;
    }
    if (grid < 0) return;
    if (hipMemsetAsync((char*)d_ws + WS_CTL, 0, CTL_ZERO_BYTES, stream) != hipSuccess) return;
    Args a{};
    for (int i = 0; i < 20; ++i) a.in[i] = (const float*)d_in[i];
    a.out = (float*)d_out; a.ws = (unsigned char*)d_ws;
    hipLaunchKernelGGL(fwd_kernel, dim3(grid), dim3(NTHR), LDS_BYTES, stream, a);
    const hipError_t le = hipPeekAtLastError();
    if (le != hipSuccess) fprintf(stderr, "kernel_launch: launch failed: %s\n", hipGetErrorName(le));
}
```

```cpp
#include <hip/hip_runtime.h>
#include <cstdio>
#include <cstdint>
#define FMASK 0
#define UMASK 0
#ifndef EMASK
#define EMASK 0
#endif
namespace pg8 {
#define PG8_LAS __attribute__((address_space(3)))
typedef unsigned short bf16_t;
typedef short bf16x8 __attribute__((ext_vector_type(8)));
typedef float f32x4 __attribute__((ext_vector_type(4)));
typedef unsigned u32x4 __attribute__((ext_vector_type(4)));
constexpr int BM = 256, BK = 64, HALF = 128, HTB = HALF * BK * 2  , STAGE_BYTES = 8 * HTB, NXCD = 8, WGM = 8;

__host__ __device__ __forceinline__ int lds_byte(int r, int c) { const int st = (r >> 4) * 2 + (c >> 5), rr = r & 15, cc = c & 31, ob = rr * 64 + cc * 2; return st * 1024 + (ob ^ (((ob >> 9) & 1) << 5)); }
__host__ __device__ __forceinline__ void stage_rc(int b, int& R, int& C) { const int st = b / 1024, sb = b % 1024, swz = sb ^ (((sb >> 9) & 1) << 5); R = (st >> 1) * 16 + swz / 64; C = (st & 1) * 32 + (swz % 64) / 2; }
__host__ __device__ __forceinline__ int perm32(int rho) { const int n = rho >> 4, i = rho & 15; return 8 * (i >> 2) + 4 * n + (i & 3); }

struct Unit { int pm, pn; };
struct Gemm { const bf16_t* A; const bf16_t* Bt; int M, N, K, lda; int sca = 0x7f7f7f7f, scb = 0x7f7f7f7f; int wid = 0; int tp = 0; };
typedef int i32x8 __attribute__((ext_vector_type(8)));

struct StaticOrder {
    int nM, nN, nwg, G, c;
    __host__ __device__ void init(int M, int N, int G_, int c_) { nM = M / BM; nN = N / BM; nwg = nM * nN; G = G_; c = c_; }
    __host__ __device__ bool next(int i, Unit& u) const {
        const long L = (long)i * G + c; if (L >= nwg) return false;
        int wgid = (int)L; { const int q = nwg / NXCD, r = nwg % NXCD, xcd = wgid % NXCD, off = wgid / NXCD; wgid = (xcd < r ? xcd * (q + 1) : r * (q + 1) + (xcd - r) * q) + off; }
        const int nig = WGM * nN, gid = wgid / nig, fm = gid * WGM, gsz = (nM - fm) < WGM ? (nM - fm) : WGM;
        u.pm = fm + ((wgid % nig) % gsz); u.pn = (wgid % nig) / gsz; return true;
    }
    __device__ __forceinline__ void a_ready(const Unit&) const {}
    __device__ __forceinline__ void done(const Unit&) const {}
};
__device__ __forceinline__ unsigned cvt_pk_bf16(float lo, float hi) { unsigned r; asm volatile("v_cvt_pk_bf16_f32 %0, %1, %2" : "=v"(r) : "v"(lo), "v"(hi)); return r; }
__device__ __forceinline__ float bf_lo(unsigned w) { return __uint_as_float(w << 16); }
__device__ __forceinline__ float bf_hi(unsigned w) { return __uint_as_float(w & 0xffff0000u); }
__device__ __forceinline__ float sigmoidf_(float x) { return __builtin_amdgcn_rcpf(1.0f + __builtin_amdgcn_exp2f(-1.4426950408889634f * x)); }
typedef unsigned u32x2 __attribute__((ext_vector_type(2)));
__device__ __forceinline__ unsigned cvt_pk4_fp8(f32x4 v, float s) { int w = 0; w = __builtin_amdgcn_cvt_pk_fp8_f32(v[0] * s, v[1] * s, w, false); w = __builtin_amdgcn_cvt_pk_fp8_f32(v[2] * s, v[3] * s, w, true); return (unsigned)w; }

struct EpiZ {
    static constexpr bool PERM = false, AFTER_DRAIN = false, HOOK = false; static constexpr int HK0 = -1, HK1 = -1;
    bf16_t* O; int ldc; int sig_from;
    __device__ __forceinline__ void operator()(const f32x4 (&acc)[2][2][4][2], const Unit& u, int wr, int wc, int, int) const {
        int t_; asm volatile("v_mbcnt_lo_u32_b32 %0, -1, 0\n\tv_mbcnt_hi_u32_b32 %0, -1, %0" : "=v"(t_)); const int fr = t_ & 15, fq = (t_ >> 4) & 3;
        const int row0 = u.pm * BM + wr * 64 + fr, col0 = u.pn * BM + wc * 32 + 4 * fq; const bool sg = u.pn >= sig_from;
        unsigned eo = (unsigned)row0 * (unsigned)ldc + (unsigned)col0;
#pragma unroll
        for (int ai = 0; ai < 2; ++ai)
#pragma unroll
            for (int m = 0; m < 4; ++m) { asm volatile("" : "+v"(eo)); bf16_t* rowp = O + eo; eo += (unsigned)((m == 3 ? HALF - 48 : 16) * ldc);
#pragma unroll
                for (int bj = 0; bj < 2; ++bj)
#pragma unroll
                    for (int n = 0; n < 2; ++n) { f32x4 v = acc[ai][bj][m][n];
                        if (sg) {
#pragma unroll
                            for (int j = 0; j < 4; ++j) v[j] = sigmoidf_(v[j]); }
                        u32x2 w; w.x = cvt_pk_bf16(v[0], v[1]); w.y = cvt_pk_bf16(v[2], v[3]);
                        *(u32x2*)(rowp + bj * HALF + n * 16) = w; }
                asm volatile("" ::: "memory"); }
    }
};
template <int H0, int H1> struct EpiBrM {
    static constexpr bool PERM = false, AFTER_DRAIN = false, HOOK = true; static constexpr int HK0 = H0, HK1 = H1;
    bf16_t* MB; const bf16_t* Zg; int ldz;
    __device__ __forceinline__ void mid(f32x4 (&acc)[2][2][4][2], const Unit& u, int wr, int wc, int, int, int kt) const {
        int t_; asm volatile("v_mbcnt_lo_u32_b32 %0, -1, 0\n\tv_mbcnt_hi_u32_b32 %0, -1, %0" : "=v"(t_)); const int fr = t_ & 15, fq = (t_ >> 4) & 3;
        const int row0 = u.pm * BM + wr * 64 + fr, col0 = u.pn * BM + wc * 32 + 4 * fq; const bf16_t* zs = Zg + (kt == HK0 ? 0 : 2048);
        unsigned eo = (unsigned)row0 * (unsigned)ldz + (unsigned)col0;
#pragma unroll
        for (int ai = 0; ai < 2; ++ai) { asm volatile("" : "+v"(eo)); u32x2 ga[4][2][2];
#pragma unroll
            for (int m = 0; m < 4; ++m) { const bf16_t* zr = zs + eo + (unsigned)(m * 16 * ldz);
#pragma unroll
                for (int bj = 0; bj < 2; ++bj)
#pragma unroll
                    for (int n = 0; n < 2; ++n) ga[m][bj][n] = *(const u32x2*)(zr + bj * HALF + n * 16); }
#pragma unroll
            for (int m = 0; m < 4; ++m)
#pragma unroll
                for (int bj = 0; bj < 2; ++bj)
#pragma unroll
                    for (int n = 0; n < 2; ++n) { const u32x2 a = ga[m][bj][n]; f32x4 v = acc[ai][bj][m][n];
                        v[0] *= bf_lo(a.x); v[1] *= bf_hi(a.x); v[2] *= bf_lo(a.y); v[3] *= bf_hi(a.y);
                        acc[ai][bj][m][n] = v; }
            eo += (unsigned)(HALF * ldz); asm volatile("" ::: "memory"); }
    }
    __device__ __forceinline__ void operator()(const f32x4 (&acc)[2][2][4][2], const Unit& u, int wr, int wc, int, int) const {
        int t_; asm volatile("v_mbcnt_lo_u32_b32 %0, -1, 0\n\tv_mbcnt_hi_u32_b32 %0, -1, %0" : "=v"(t_)); const int fr = t_ & 15, fq = (t_ >> 4) & 3;
        const int row0 = u.pm * BM + wr * 64 + fr, col0 = u.pn * BM + wc * 32 + 4 * fq;
        unsigned eo = (unsigned)row0 * (unsigned)ldz + (unsigned)col0, mo = (unsigned)row0 * 2048u + (unsigned)col0;
#pragma unroll
        for (int ai = 0; ai < 2; ++ai) { asm volatile("" : "+v"(eo), "+v"(mo)); u32x2 gw[4][2][2];
#pragma unroll
            for (int m = 0; m < 4; ++m)
#pragma unroll
                for (int bj = 0; bj < 2; ++bj)
#pragma unroll
                    for (int n = 0; n < 2; ++n) gw[m][bj][n] = *(const u32x2*)(Zg + eo + (unsigned)(m * 16 * ldz) + 4096 + bj * HALF + n * 16);
#pragma unroll
            for (int m = 0; m < 4; ++m)
#pragma unroll
                for (int bj = 0; bj < 2; ++bj)
#pragma unroll
                    for (int n = 0; n < 2; ++n) { const u32x2 g_ = gw[m][bj][n]; f32x4 v = acc[ai][bj][m][n];
                        v[0] *= bf_lo(g_.x); v[1] *= bf_hi(g_.x); v[2] *= bf_lo(g_.y); v[3] *= bf_hi(g_.y);
                        *(unsigned*)((unsigned char*)MB + mo + (unsigned)(m * 16 * 2048) + bj * HALF + n * 16) = cvt_pk4_fp8(v, 64.f); }
            eo += (unsigned)(HALF * ldz); mo += (unsigned)(HALF * 2048); asm volatile("" ::: "memory"); }
    }
};
struct EpiRes {
    static constexpr bool PERM = false, AFTER_DRAIN = false, HOOK = false; static constexpr int HK0 = -1, HK1 = -1;
    float* R; const float* xres; float alpha;
    __device__ __forceinline__ void operator()(const f32x4 (&acc)[2][2][4][2], const Unit& u, int wr, int wc, int, int) const {
        int t_; asm volatile("v_mbcnt_lo_u32_b32 %0, -1, 0\n\tv_mbcnt_hi_u32_b32 %0, -1, %0" : "=v"(t_)); const int fr = t_ & 15, fq = (t_ >> 4) & 3;
        const int row0 = u.pm * BM + wr * 64 + fr, col0 = u.pn * BM + wc * 32 + 4 * fq;
        unsigned eo = (unsigned)row0 * 2048u + (unsigned)col0;
        f32x4 xr[2][2][2][2]; unsigned bo[2];
#define EPIRES_LOAD(BUF) do { bo[BUF] = eo * 4u; asm volatile("" : "+v"(bo[BUF])); \
        _Pragma("unroll") for (int m2 = 0; m2 < 2; ++m2) _Pragma("unroll") for (int bj = 0; bj < 2; ++bj) _Pragma("unroll") for (int n = 0; n < 2; ++n) \
            xr[BUF][m2][bj][n] = *(const f32x4*)((const char*)xres + bo[BUF] + (unsigned)((m2 * 16 * 2048 + bj * HALF + n * 16) * 4)); } while (0)
        EPIRES_LOAD(0); eo += (unsigned)(32 * 2048);
#pragma unroll
        for (int b = 0; b < 4; ++b) { const int ai = b >> 1, mh = b & 1;
            if (b < 3) { if ((b & 1) == 0) EPIRES_LOAD(1); else EPIRES_LOAD(0); eo += (unsigned)((((b + 1) & 1) == 1 ? HALF - 32 : 32) * 2048); }
            __builtin_amdgcn_sched_barrier(0);
#pragma unroll
            for (int m2 = 0; m2 < 2; ++m2)
#pragma unroll
                for (int bj = 0; bj < 2; ++bj)
#pragma unroll
                    for (int n = 0; n < 2; ++n) { const f32x4 rv = xr[b & 1][m2][bj][n] * alpha + acc[ai][bj][2 * mh + m2][n]; u32x2 w; w.x = cvt_pk_bf16(rv[0], rv[1]); w.y = cvt_pk_bf16(rv[2], rv[3]);
                        *(u32x2*)((char*)R + (bo[b & 1] >> 1) + (unsigned)((m2 * 16 * 2048 + bj * HALF + n * 16) * 2)) = w; }
            __builtin_amdgcn_sched_barrier(0); }
#undef EPIRES_LOAD
    }
};
struct EpiGU {
    static constexpr bool PERM = false, AFTER_DRAIN = false, HOOK = false; static constexpr int HK0 = -1, HK1 = -1;
    bf16_t* H; const float* roww;
    __device__ __forceinline__ void operator()(const f32x4 (&acc)[2][2][4][2], const Unit& u, int wr, int wc, int, int) const {
        int t_; asm volatile("v_mbcnt_lo_u32_b32 %0, -1, 0\n\tv_mbcnt_hi_u32_b32 %0, -1, %0" : "=v"(t_)); const int fr = t_ & 15, fq = (t_ >> 4) & 3;
        const int row0 = u.pm * BM + wr * 64 + fr, col0 = (u.pn & 1) * HALF + wc * 32 + 4 * fq;
        float wrow[2][4];
#pragma unroll
        for (int ai = 0; ai < 2; ++ai)
#pragma unroll
            for (int m = 0; m < 4; ++m) { unsigned wo = (unsigned)(row0 + ai * HALF + m * 16) * 4u; asm volatile("" : "+v"(wo)); wrow[ai][m] = *(const float*)((const char*)roww + wo); }
#pragma unroll
        for (int ai = 0; ai < 2; ++ai)
#pragma unroll
            for (int m = 0; m < 4; ++m) { const int row = row0 + ai * HALF + m * 16; const float w = wrow[ai][m];
                unsigned long long ho = (unsigned long long)((unsigned)row * 256u + (unsigned)col0) * 2ull; asm volatile("" : "+v"(ho));
#pragma unroll
                for (int n = 0; n < 2; ++n) { const f32x4 gt = acc[ai][0][m][n], up = acc[ai][1][m][n]; f32x4 h;
#pragma unroll
                    for (int j = 0; j < 4; ++j) h[j] = gt[j] * sigmoidf_(gt[j]) * up[j] * w;
                    u32x2 o; o.x = cvt_pk_bf16(h[0], h[1]); o.y = cvt_pk_bf16(h[2], h[3]);
                    *(u32x2*)((char*)H + ho + n * 32) = o; }
                asm volatile("" ::: "memory"); }
    }
};
struct EpiDown {
    static constexpr bool PERM = true, AFTER_DRAIN = false, HOOK = false; static constexpr int HK0 = -1, HK1 = -1;
    bf16_t* dump; unsigned yoff; const int* rowts;
    __device__ __forceinline__ void operator()(const f32x4 (&acc)[2][2][4][2], const Unit& u, int wr, int wc, int, int) const {
        int t_; asm volatile("v_mbcnt_lo_u32_b32 %0, -1, 0\n\tv_mbcnt_hi_u32_b32 %0, -1, %0" : "=v"(t_)); const int fr = t_ & 15, fq = (t_ >> 4) & 3;
        const int row0 = u.pm * BM + wr * 64 + fr, col0 = (u.pn & 7) * BM + wc * 32 + 8 * fq;
        int tsr[2][4];
#pragma unroll
        for (int ai = 0; ai < 2; ++ai)
#pragma unroll
            for (int m = 0; m < 4; ++m) tsr[ai][m] = rowts[row0 + ai * HALF + m * 16];
#pragma unroll
        for (int ai = 0; ai < 2; ++ai)
#pragma unroll
            for (int m = 0; m < 4; ++m) { const int row = row0 + ai * HALF + m * 16; const int ts = tsr[ai][m];
                const unsigned eo = (ts >= 0 ? yoff + (unsigned)((ts & 1) * 8192 + (ts >> 1)) * 2048u : (unsigned)row * 2048u) + (unsigned)col0;
                bf16_t* rowp = dump + eo;
                if (ts >= 0) {
#pragma unroll
                for (int bj = 0; bj < 2; ++bj) { const f32x4 v0 = acc[ai][bj][m][0], v1 = acc[ai][bj][m][1];
                    u32x4 w; w.x = cvt_pk_bf16(v0[0], v0[1]); w.y = cvt_pk_bf16(v0[2], v0[3]); w.z = cvt_pk_bf16(v1[0], v1[1]); w.w = cvt_pk_bf16(v1[2], v1[3]);
                    *(u32x4*)(rowp + bj * HALF) = w; } }
                asm volatile("" ::: "memory"); }
    }
};
struct RoundsOrder { StaticOrder base; int r_lo, r_hi;
    __device__ __forceinline__ bool next(int i, Unit& u) const { return i + r_lo < r_hi && base.next(i + r_lo, u); }
    __device__ __forceinline__ void a_ready(const Unit&) const {}
    __device__ __forceinline__ void done(const Unit&) const {} };
template <int NPER> struct MoeOrder {
    int total, G, c; const int* panel_e;
    __device__ __forceinline__ bool next(int i, Unit& u) const { const int L = i * G + c; if (L >= total) return false; const int pm = L / NPER; u.pm = pm; u.pn = panel_e[pm] * NPER + (L % NPER); return true; }
    __device__ __forceinline__ void a_ready(const Unit&) const {}
    __device__ __forceinline__ void done(const Unit&) const {}
};

__device__ __forceinline__ f32x4 zero4() { float z = 0.f; asm volatile("" : "+v"(z)); return (f32x4){z, z, z, z}; }
template <bool F8> struct Frags { bf16x8 At[4][2], B0[2][2], B1[2][2]; };
template <> struct Frags<true> { i32x8 At8[4], B08[2], B18[2]; };
template <class Epi, class Sched, bool ALIGN_EPI = false, bool SP2 = false, bool FP8 = false>
__device__ __forceinline__ void gemm_phase(PG8_LAS unsigned char* lds, const Gemm g, const Sched& S, const Epi& E) {
    int lane_; asm volatile("v_mbcnt_lo_u32_b32 %0, -1, 0\n\tv_mbcnt_hi_u32_b32 %0, -1, %0" : "=v"(lane_));
    const int wid = g.wid, tid = wid * 64 + lane_, lane = lane_, wr = wid >> 2, wc = wid & 3, fr = lane & 15, fq = lane >> 4;
    const int K = g.K, nt = K / BK, LDA = g.lda;
    unsigned voffA[2], voffB[2];
#pragma unroll
    for (int i = 0; i < 2; ++i) { int R, C; stage_rc(tid * 16 + i * 8192, R, C); const int Rb = Epi::PERM ? ((R & ~31) + perm32(R & 31)) : R;
        voffA[i] = (unsigned)(R * LDA + C) * 2u; voffB[i] = (unsigned)(Rb * K + C) * 2u; }
    const size_t kstep = (size_t)(BK * 2);
    const size_t hstep = (size_t)HALF * K * 2, hstepA = (size_t)HALF * LDA * 2;
    const size_t tstep = 2 * hstep, tstepA = 2 * hstepA;
    int scab = (g.scb & 0xff) | ((g.sca & 0xff) << 8); asm volatile("" : "+v"(scab));
    const unsigned ldsbase = (unsigned)__builtin_amdgcn_readfirstlane((int)(unsigned)(uintptr_t)lds + wid * 1024);
    const unsigned ldsw = (unsigned)wid * 1024u;
    const int aoff = lds_byte(wr * 64 + fr, fq * 8), boff = lds_byte(wc * 32 + fr, fq * 8);
#define PG8_CAT(x0, x1) __builtin_bit_cast(i32x8, __builtin_shufflevector(x0, x1, 0, 1, 2, 3, 4, 5, 6, 7, 8, 9, 10, 11, 12, 13, 14, 15))
#define PG8_SA(b, h) (((b) * 2 + (h)) * HTB)
#define PG8_SB(b, h) ((4 + (b) * 2 + (h)) * HTB)
#define PG8_STAGE(bufoff, gbase, voff) do { if constexpr (FP8) { _Pragma("unroll") for (int _i = 0; _i < 2; ++_i) { unsigned keep_; \
            asm volatile("s_mov_b32 %0, m0\n\ts_mov_b32 m0, %3\n\ts_nop 0\n\tglobal_load_lds_dwordx4 %1, %2\n\ts_mov_b32 m0, %0" : "=&s"(keep_) : "v"((voff)[_i]), "s"((const char*)(gbase)), "s"(ldsbase + (unsigned)((bufoff) + _i * 8192)) : "memory"); } } \
        else { _Pragma("unroll") for (int _i = 0; _i < 2; ++_i) \
        __builtin_amdgcn_global_load_lds((const unsigned*)((const char*)(gbase) + (voff)[_i]), (PG8_LAS unsigned*)(lds + (bufoff) + ldsw + _i * 8192), 16, 0, 0); } } while (0)
#define PG8_LDA(dst, b, h) do { if constexpr (FP8) { _Pragma("unroll") for (int m = 0; m < 4; ++m) fg.dst##8[m] = PG8_CAT(*(const PG8_LAS bf16x8*)(lds + PG8_SA(b, h) + aoff + m * 2048), *(const PG8_LAS bf16x8*)(lds + PG8_SA(b, h) + aoff + m * 2048 + 1024)); } \
        else { _Pragma("unroll") for (int m = 0; m < 4; ++m) _Pragma("unroll") for (int k = 0; k < 2; ++k) fg.dst[m][k] = *(const PG8_LAS bf16x8*)(lds + PG8_SA(b, h) + aoff + m * 2048 + k * 1024); } } while (0)
#define PG8_LDB(dst, b, h) do { if constexpr (FP8) { _Pragma("unroll") for (int n = 0; n < 2; ++n) fg.dst##8[n] = PG8_CAT(*(const PG8_LAS bf16x8*)(lds + PG8_SB(b, h) + boff + n * 2048), *(const PG8_LAS bf16x8*)(lds + PG8_SB(b, h) + boff + n * 2048 + 1024)); } \
        else { _Pragma("unroll") for (int n = 0; n < 2; ++n) _Pragma("unroll") for (int k = 0; k < 2; ++k) fg.dst[n][k] = *(const PG8_LAS bf16x8*)(lds + PG8_SB(b, h) + boff + n * 2048 + k * 1024); } } while (0)
#define PG8_MMA(ai, bj, At, Bt) do { __builtin_amdgcn_s_setprio(1); \
        if constexpr (FP8) { _Pragma("unroll") for (int m = 0; m < 4; ++m) _Pragma("unroll") for (int n = 0; n < 2; ++n) \
            acc[ai][bj][m][n] = __builtin_amdgcn_mfma_scale_f32_16x16x128_f8f6f4(fg.Bt##8[n], fg.At##8[m], acc[ai][bj][m][n], 0, 0, 0, scab, 1, scab); }        \
        else { _Pragma("unroll") for (int m = 0; m < 4; ++m) _Pragma("unroll") for (int n = 0; n < 2; ++n) _Pragma("unroll") for (int k = 0; k < 2; ++k) \
            acc[ai][bj][m][n] = __builtin_amdgcn_mfma_f32_16x16x32_bf16(fg.Bt[n][k], fg.At[m][k], acc[ai][bj][m][n], 0, 0, 0); } \
        __builtin_amdgcn_s_setprio(0); } while (0)
#define PG8_WAIT_V(n) asm volatile("s_waitcnt vmcnt(" #n ")" ::: "memory")
#define PG8_WAIT_L(n) asm volatile("s_waitcnt lgkmcnt(" #n ")" ::: "memory")
#define PG8_BAR __builtin_amdgcn_s_barrier()
#define PG8_SCHED __builtin_amdgcn_sched_barrier(0)
    Unit cur, nxt; int ui = 0;
    if (!S.next(0, cur)) return;
    f32x4 acc[2][2][4][2];
#pragma unroll
    for (int a = 0; a < 2; ++a)
#pragma unroll
        for (int b = 0; b < 2; ++b)
#pragma unroll
            for (int m = 0; m < 4; ++m)
#pragma unroll
                for (int n = 0; n < 2; ++n) acc[a][b][m][n] = zero4();
    Frags<FP8> fg;
    const char* cA = (const char*)g.A + (size_t)cur.pm * tstepA; const char* cB = (const char*)g.Bt + (size_t)cur.pn * tstep;
    S.a_ready(cur);
    if constexpr (SP2) {
        PG8_STAGE(PG8_SB(0, 0), cB, voffB); PG8_STAGE(PG8_SB(0, 1), cB + hstep, voffB); PG8_STAGE(PG8_SA(0, 0), cA, voffA); PG8_STAGE(PG8_SA(0, 1), cA + hstepA, voffA);
        if (wr == 1) PG8_BAR;
        PG8_WAIT_V(2); PG8_BAR;
        PG8_STAGE(PG8_SB(1, 0), cB + kstep, voffB); PG8_STAGE(PG8_SA(1, 0), cA + kstep, voffA); PG8_STAGE(PG8_SB(1, 1), cB + hstep + kstep, voffB);
        PG8_WAIT_V(6); PG8_BAR;
    } else {
        PG8_STAGE(PG8_SB(0, 0), cB, voffB); PG8_STAGE(PG8_SA(0, 0), cA, voffA); PG8_STAGE(PG8_SB(0, 1), cB + hstep, voffB); PG8_STAGE(PG8_SA(0, 1), cA + hstepA, voffA);
        if (wr == 1) PG8_BAR;
        PG8_WAIT_V(4); PG8_BAR;
        PG8_STAGE(PG8_SB(1, 0), cB + kstep, voffB); PG8_STAGE(PG8_SA(1, 0), cA + kstep, voffA); PG8_STAGE(PG8_SB(1, 1), cB + hstep + kstep, voffB);
        PG8_WAIT_V(6); PG8_BAR;
    }
    for (;;) {
        const bool has_next = S.next(ui + 1, nxt);
        const char* nA = has_next ? (const char*)g.A + (size_t)nxt.pm * tstepA : cA; const char* nB = has_next ? (const char*)g.Bt + (size_t)nxt.pn * tstep : cB;
#pragma nounroll
        for (int t = 0; t < nt; t += 2) {
            const bool last = (t == nt - 2);
            const char* a1 = cA + (size_t)(t + 1) * kstep;
            const char* a2 = last ? nA : cA + (size_t)(t + 2) * kstep; const char* b2 = last ? nB : cB + (size_t)(t + 2) * kstep;
            const char* a3 = a2 + kstep; const char* b3 = b2 + kstep;
            if (last && has_next) S.a_ready(nxt);
            if constexpr (SP2) {
            PG8_LDB(B0, 0, 0); PG8_LDB(B1, 0, 1); PG8_SCHED; PG8_LDA(At, 0, 0); PG8_STAGE(PG8_SA(1, 1), a1 + hstepA, voffA);
            PG8_WAIT_V(8); PG8_WAIT_L(0); PG8_BAR; PG8_MMA(0, 0, At, B0); PG8_MMA(0, 1, At, B1); PG8_BAR; PG8_SCHED;
            PG8_LDA(At, 0, 1); PG8_STAGE(PG8_SB(0, 0), b2, voffB); PG8_STAGE(PG8_SB(0, 1), b2 + hstep, voffB); PG8_STAGE(PG8_SA(0, 0), a2, voffA);
            PG8_WAIT_V(8); PG8_WAIT_L(0); PG8_BAR; PG8_MMA(1, 0, At, B0); PG8_MMA(1, 1, At, B1); PG8_BAR; PG8_SCHED;
            PG8_LDB(B0, 1, 0); PG8_LDB(B1, 1, 1); PG8_SCHED; PG8_LDA(At, 1, 0); PG8_STAGE(PG8_SA(0, 1), a2 + hstepA, voffA);
            PG8_WAIT_V(8); PG8_WAIT_L(0); PG8_BAR; PG8_MMA(0, 0, At, B0); PG8_MMA(0, 1, At, B1); PG8_BAR; PG8_SCHED;
            PG8_LDA(At, 1, 1); PG8_STAGE(PG8_SB(1, 0), b3, voffB); PG8_STAGE(PG8_SB(1, 1), b3 + hstep, voffB); PG8_STAGE(PG8_SA(1, 0), a3, voffA);
            PG8_WAIT_V(8); PG8_WAIT_L(0); PG8_BAR; PG8_MMA(1, 0, At, B0); PG8_MMA(1, 1, At, B1); PG8_BAR; PG8_SCHED;
            if constexpr (Epi::HOOK) { if (t + 2 == Epi::HK0 || t + 2 == Epi::HK1) E.mid(acc, cur, wr, wc, fr, fq, t + 2); }
            } else {
            PG8_LDB(B0, 0, 0); PG8_SCHED; PG8_LDA(At, 0, 0); PG8_STAGE(PG8_SA(1, 1), a1 + hstepA, voffA);
            PG8_WAIT_L(8); PG8_BAR; PG8_WAIT_L(0); PG8_MMA(0, 0, At, B0); PG8_BAR; PG8_SCHED;
            PG8_LDB(B1, 0, 1); PG8_STAGE(PG8_SB(0, 0), b2, voffB);
            PG8_BAR; PG8_WAIT_L(0); PG8_MMA(0, 1, At, B1); PG8_BAR;
            PG8_LDA(At, 0, 1); PG8_STAGE(PG8_SA(0, 0), a2, voffA);
            PG8_BAR; PG8_WAIT_L(0); PG8_MMA(1, 0, At, B0); PG8_BAR; PG8_SCHED;
            PG8_STAGE(PG8_SB(0, 1), b2 + hstep, voffB);
            PG8_WAIT_V(6); PG8_BAR; PG8_MMA(1, 1, At, B1); PG8_BAR;
            PG8_LDB(B0, 1, 0); PG8_SCHED; PG8_LDA(At, 1, 0); PG8_STAGE(PG8_SA(0, 1), a2 + hstepA, voffA);
            PG8_WAIT_L(8); PG8_BAR; PG8_WAIT_L(0); PG8_MMA(0, 0, At, B0); PG8_BAR; PG8_SCHED;
            PG8_LDB(B1, 1, 1); PG8_STAGE(PG8_SB(1, 0), b3, voffB);
            PG8_BAR; PG8_WAIT_L(0); PG8_MMA(0, 1, At, B1); PG8_BAR;
            PG8_LDA(At, 1, 1); PG8_STAGE(PG8_SA(1, 0), a3, voffA);
            PG8_BAR; PG8_WAIT_L(0); PG8_MMA(1, 0, At, B0); PG8_BAR; PG8_SCHED;
            PG8_STAGE(PG8_SB(1, 1), b3 + hstep, voffB);
            PG8_WAIT_V(6); PG8_BAR; PG8_MMA(1, 1, At, B1); PG8_BAR;
            }
        }
        if constexpr (ALIGN_EPI) { if (wr == 0) PG8_BAR; }
#if EMASK
        unsigned long long te_ = __builtin_amdgcn_s_memrealtime();
#endif
        if constexpr (!Epi::AFTER_DRAIN) { E(acc, cur, wr, wc, fr, fq); S.done(cur); }
#if EMASK
        if (g.tp && wid == 0 && lane == 0) { asm volatile("s_waitcnt vmcnt(0)" ::: "memory"); *(PG8_LAS unsigned long long*)(lds + 131072 + 320 + 64) += __builtin_amdgcn_s_memrealtime() - te_; }
#endif
        if (!has_next) break;
#pragma unroll
        for (int a = 0; a < 2; ++a)
#pragma unroll
            for (int b = 0; b < 2; ++b)
#pragma unroll
                for (int m = 0; m < 4; ++m)
#pragma unroll
                    for (int n = 0; n < 2; ++n) acc[a][b][m][n] = zero4();
        cur = nxt; cA = nA; cB = nB; ++ui;
        if constexpr (ALIGN_EPI) { if (wr == 1) PG8_BAR; }
    }
    PG8_WAIT_V(0);
    if constexpr (!ALIGN_EPI) { if (wr == 0) PG8_BAR; }
    PG8_BAR;
    if constexpr (Epi::AFTER_DRAIN) { E.fused(acc, cur, wr, wc, fr, fq, lds, wid, lane); S.done(cur); }
#undef PG8_SA
#undef PG8_SB
#undef PG8_STAGE
#undef PG8_LDA
#undef PG8_LDB
#undef PG8_MMA
#undef PG8_CAT
#undef PG8_WAIT_V
#undef PG8_WAIT_L
#undef PG8_BAR
#undef PG8_SCHED
}
}

constexpr int NWAVES = 8, NTHR = 512;
constexpr int DM = 2048, NB = 4, SEQ = 2048, NT = NB * SEQ, DEPTH = 2;
constexpr int ZP = 11264;
constexpr int ZC_QA = 0, ZC_KVA = 1024, ZC_QB = 2560, ZC_KB = 3072, ZC_VB = 3200, ZC_QC = 3328, ZC_KC = 3840, ZC_VC = 4352, ZC_GM = 4864, ZC_GA = 11008;
constexpr int OC_A = 0, OC_B = 1024, OC_C = 1536;
constexpr int NEXP = 32, DEXP = 256, ROWCAP = 24576;
constexpr float LN_EPS = 1e-5f, LOG2E = 1.4426950408889634f;
constexpr size_t MiB = 1u << 20;
constexpr size_t WS_CTL = 0, CTL_ZERO_BYTES = 1 * MiB;
constexpr size_t WS_WIN = 2 * MiB, WS_WBRA = 46 * MiB, WS_WBRB = 50 * MiB, WS_WBRC = 52 * MiB, WS_WOUT = 54 * MiB, WS_WGU = 62 * MiB, WS_WD = 126 * MiB, WS_WCMP = 158 * MiB;
constexpr size_t WS_XB = 160 * MiB, WS_Z = 192 * MiB, WS_OA = 370 * MiB, WS_MG = 402 * MiB, WS_MB = 466 * MiB, WS_X1 = 498 * MiB, WS_H = 562 * MiB, WS_SMALL = 574 * MiB, WS_END = 578 * MiB;
constexpr size_t WS_WIN1 = WS_WIN + 22 * MiB, WS_WCMP1 = 576 * MiB;
constexpr size_t WS_OA8 = WS_XB + 16 * MiB;
constexpr size_t WS_XS = WS_Z, WS_Y = WS_Z + 96 * MiB;
constexpr size_t SM_KCMP = 0, SM_VCMP = 256 * 1024, SM_KMEAN = 512 * 1024, SM_TOKE = 640 * 1024, SM_TOKW = 704 * 1024, SM_TOKP = 768 * 1024, SM_ROWTS = 832 * 1024, SM_ROWW = 960 * 1024, SM_PANE = 1088 * 1024, SM_HIST = 1152 * 1024, SM_CNTG = 1200 * 1024;
constexpr int CW_TMO = 0, CW_BAR = 4096, CW_QUEUE = 8192, CW_ECNT = 9216, CW_NPAN = 16384;
constexpr int RING_OFF = 0, RING_BYTES = 131072, LDSCTL_OFF = RING_BYTES, MISC_OFF = LDSCTL_OFF + 320, LDS_BYTES = 147456;

#define GAS __attribute__((address_space(1)))
#define LAS __attribute__((address_space(3)))
typedef unsigned short bf16;
typedef unsigned v4u __attribute__((ext_vector_type(4)));
typedef unsigned v2u __attribute__((ext_vector_type(2)));
typedef float f32x4 __attribute__((ext_vector_type(4)));
typedef float f32x16 __attribute__((ext_vector_type(16)));
typedef short bf16x8 __attribute__((ext_vector_type(8)));
typedef short s16x4 __attribute__((ext_vector_type(4)));
typedef GAS unsigned gu32;
#define RLX_AGENT __ATOMIC_RELAXED, __HIP_MEMORY_SCOPE_AGENT
#define LDS_WAIT() asm volatile("s_waitcnt lgkmcnt(0)" ::: "memory")
#define VM_WAIT() asm volatile("s_waitcnt vmcnt(0)" ::: "memory")
__device__ __forceinline__ int lane_id() { int l; asm volatile("v_mbcnt_lo_u32_b32 %0, -1, 0\n\tv_mbcnt_hi_u32_b32 %0, -1, %0" : "=v"(l)); return l; }
__device__ __forceinline__ unsigned f2bf(float f) { unsigned u = __builtin_bit_cast(unsigned, f); return (u + 0x7fffu + ((u >> 16) & 1u)) >> 16; }
__device__ __forceinline__ unsigned pk2(float lo, float hi) { return f2bf(lo) | (f2bf(hi) << 16); }
__device__ __forceinline__ float bflo(unsigned w) { return __uint_as_float(w << 16); }
__device__ __forceinline__ float bfhi(unsigned w) { return __uint_as_float(w & 0xffff0000u); }
__device__ __forceinline__ float bf2f(bf16 b) { return __uint_as_float(((unsigned)b) << 16); }
__device__ __forceinline__ float shfl_xor_f(float v, int o, int lane) { return __int_as_float(__builtin_amdgcn_ds_bpermute((lane ^ o) << 2, __float_as_int(v))); }
__device__ __forceinline__ unsigned shfl_xor_u(unsigned v, int o, int lane) { return (unsigned)__builtin_amdgcn_ds_bpermute((lane ^ o) << 2, (int)v); }
__device__ __forceinline__ float wave_sum(float v, int lane) {
#pragma unroll
    for (int o = 1; o < 64; o <<= 1) v += shfl_xor_f(v, o, lane);
    return v;
}

#define XB_TMO      128
#define XB_XCNT(j)  (256  + 64 * (j))
#define XB_XSUB(j)  (1280 + 64 * (j))
#define XB_XGEN(j)  (2304 + 64 * (j))
#define XB_TOP      3328
#define XB_TOPGEN   3392
#define XCD_BAR_WORDS 3456
#define XB_SPIN_CAP (1u << 18)

__device__ __forceinline__ unsigned xb_ld(unsigned* p)              { return __hip_atomic_load(p, __ATOMIC_RELAXED, __HIP_MEMORY_SCOPE_AGENT); }
__device__ __forceinline__ unsigned xb_add(unsigned* p, unsigned v) { return __hip_atomic_fetch_add(p, v, __ATOMIC_RELAXED, __HIP_MEMORY_SCOPE_AGENT); }
__device__ __forceinline__ unsigned xb_xcc_id() { return (unsigned)__builtin_amdgcn_s_getreg((3 << 11) | 20) & 0xFu; }
#define XB_SPIN(cond, bar) do { unsigned _sp = 0; while (cond) { __builtin_amdgcn_s_sleep(1); \
    if ((++_sp & 255u) == 0u) { if (xb_ld(&(bar)[XB_TMO])) break; if (_sp > XB_SPIN_CAP) { atomicAdd(&(bar)[XB_TMO], 1u); break; } } } } while (0)

struct XcdBarrier {
    unsigned* bar; unsigned x;
    volatile LAS unsigned* st;
};

__device__ __forceinline__ XcdBarrier xcd_barrier_post(unsigned* bar, volatile LAS unsigned* st) {
    XcdBarrier b; b.bar = bar; b.x = xb_xcc_id(); b.st = st;
    if (threadIdx.x == 0) (void)xb_add(&bar[XB_XCNT(b.x)], 1u);
    return b;
}
__device__ __forceinline__ void xcd_barrier_complete(unsigned* bar, unsigned x, unsigned& nloc, unsigned& nx) {
    const unsigned G = gridDim.x * gridDim.y * gridDim.z;
    unsigned sum, cnt, mine, sp = 0u;
    for (;;) {
        sum = 0u; cnt = 0u; mine = 0u;
#pragma unroll
        for (unsigned j = 0; j < 16; ++j) { const unsigned c = xb_ld(&bar[XB_XCNT(j)]); sum += c; cnt += (c > 0u) ? 1u : 0u; mine = (j == x) ? c : mine; }
        if (sum == G) break;
        __builtin_amdgcn_s_sleep(1);
        if ((++sp & 255u) == 0u) { if (xb_ld(&bar[XB_TMO])) break; if (sp > XB_SPIN_CAP) { atomicAdd(&bar[XB_TMO], 1u); break; } }
    }
    nloc = mine > 0u ? mine : 1u; nx = cnt > 0u ? cnt : 1u;
}

struct NoWork { __device__ __forceinline__ void operator()() const {} };
template <bool FIRST, class W> __device__ __forceinline__ void xcd_barrier_t(const XcdBarrier& b, bool t0, bool worker, const W& work) {
    asm volatile("s_waitcnt vmcnt(0)" ::: "memory");
    __syncthreads();
    if (t0) {
        unsigned* bar = b.bar; unsigned bx_ = b.x; asm volatile("" : "+s"(bx_));
        __builtin_amdgcn_s_waitcnt(0);
        unsigned nloc = b.st[0], nx = b.st[1];
        if constexpr (FIRST) { if (nloc == 0u) { xcd_barrier_complete(bar, bx_, nloc, nx); b.st[0] = nloc; b.st[1] = nx; } }
        const unsigned old = xb_add(&bar[XB_XSUB(bx_)], 1u);
        const unsigned gen = old / nloc;
        if (old + 1u == (gen + 1u) * nloc) {
            __builtin_amdgcn_fence(__ATOMIC_RELEASE, "agent");
            asm volatile("s_waitcnt vmcnt(0)" ::: "memory");
            const unsigned og = xb_add(&bar[XB_TOP], 1u);
            const unsigned tg = og / nx;
            if (og + 1u == (tg + 1u) * nx) xb_add(&bar[XB_TOPGEN], 1u);
            else XB_SPIN(xb_ld(&bar[XB_TOPGEN]) == tg, bar);
            __builtin_amdgcn_fence(__ATOMIC_ACQUIRE, "agent");
            xb_add(&bar[XB_XGEN(bx_)], 1u);
            asm volatile("s_waitcnt vmcnt(0)" ::: "memory");
        } else {
            XB_SPIN(xb_ld(&bar[XB_XGEN(bx_)]) == gen, bar);
            __builtin_amdgcn_fence(__ATOMIC_ACQUIRE, "agent");
            asm volatile("s_waitcnt vmcnt(0)" ::: "memory");
        }
    } else if (worker) work();
    __syncthreads();
}
__device__ __forceinline__ void xcd_barrier(const XcdBarrier& b, bool t0) { xcd_barrier_t<false, NoWork>(b, t0, false, NoWork{}); }


namespace att {
__device__ __forceinline__ int crow(int r, int hi) { return (r & 3) + 8 * (r >> 2) + 4 * hi; }
__device__ __forceinline__ f32x16 zero16() { float z = 0.f; asm volatile("" : "+v"(z)); f32x16 r;
#pragma unroll
    for (int i = 0; i < 16; ++i) r[i] = z;
    return r; }
__device__ __forceinline__ unsigned cvtpk(float lo, float hi) { unsigned r; asm volatile("v_cvt_pk_bf16_f32 %0, %1, %2" : "=v"(r) : "v"(lo), "v"(hi)); return r; }
template <int HD> __device__ __forceinline__ int kswz(int row, int colB) { return row * (HD * 2) + (colB ^ ((row & 7) << 4)); }
template <int HD> __device__ __forceinline__ int v_st(int k, int c) { const int kk = (k & ~0xC) | ((k & 4) << 1) | ((k & 8) >> 1); return ((kk >> 3) * (HD / 32) + (c >> 5)) * 512 + ((kk & 7) * 32 + (c & 31)) * 2; }
__device__ __forceinline__ int v_rd_base(int lane) { return ((lane & 3) << 3) | (((lane >> 2) & 3) << 6) | (((lane >> 4) & 1) << 5) | (((lane >> 5) & 1) << 8); }
template <int HD> constexpr int v_rd_off(int d0, int ks, int half) { return d0 * 512 + (2 * ks + half) * (HD / 32) * 512; }
template <int OFF> __device__ __forceinline__ s16x4 tr_read(int vb) { s16x4 r; asm volatile("ds_read_b64_tr_b16 %0, %1 offset:%2" : "=&v"(r) : "v"(vb), "i"(OFF) : "memory"); return r; }

template <int HD> __device__ __forceinline__ void qkt(f32x16& p0, f32x16& p1, const LAS char* Ks, const bf16x8 (&qr)[HD / 16], int r32, int hi) {
    p0 = zero16(); p1 = zero16();
#pragma unroll
    for (int d0 = 0; d0 < HD / 16; ++d0) { const int cb = (d0 * 16 + hi * 8) * 2;
        const bf16x8 b0 = *(const LAS bf16x8*)(Ks + kswz<HD>(r32, cb));
        const bf16x8 b1 = *(const LAS bf16x8*)(Ks + kswz<HD>(32 + r32, cb));
        p0 = __builtin_amdgcn_mfma_f32_32x32x16_bf16(b0, qr[d0], p0, 0, 0, 0);
        p1 = __builtin_amdgcn_mfma_f32_32x32x16_bf16(b1, qr[d0], p1, 0, 0, 0); }
}
template <int HD> __device__ __forceinline__ void qkt_bias(f32x16& p0, f32x16& p1, const LAS char* Ks, const bf16x8 (&qr)[HD / 16], int r32, int hi, float ba, float bb) {
#pragma unroll
    for (int r = 0; r < 16; ++r) { const float kr = (float)((r & 3) + 8 * (r >> 2)); p0[r] = fmaf(ba, kr, bb); p1[r] = fmaf(ba, kr + 32.f, bb); }
#pragma unroll
    for (int d0 = 0; d0 < HD / 16; ++d0) { const int cb = (d0 * 16 + hi * 8) * 2;
        const bf16x8 b0 = *(const LAS bf16x8*)(Ks + kswz<HD>(r32, cb));
        const bf16x8 b1 = *(const LAS bf16x8*)(Ks + kswz<HD>(32 + r32, cb));
        p0 = __builtin_amdgcn_mfma_f32_32x32x16_bf16(b0, qr[d0], p0, 0, 0, 0);
        p1 = __builtin_amdgcn_mfma_f32_32x32x16_bf16(b1, qr[d0], p1, 0, 0, 0); }
}
#define ATT_PK(L, H) (bf16x8){L[0], L[1], L[2], L[3], H[0], H[1], H[2], H[3]}
template <int HD, int DA, int KA> __device__ __forceinline__ void pv_quad(f32x16& oa, f32x16& ob, int vb, bf16x8 pk0, bf16x8 pk1) {
    const s16x4 al0 = tr_read<v_rd_off<HD>(DA, KA, 0)>(vb), ah0 = tr_read<v_rd_off<HD>(DA, KA, 1)>(vb), bl0 = tr_read<v_rd_off<HD>(DA + 1, KA, 0)>(vb), bh0 = tr_read<v_rd_off<HD>(DA + 1, KA, 1)>(vb);
    const s16x4 al1 = tr_read<v_rd_off<HD>(DA, KA + 1, 0)>(vb), ah1 = tr_read<v_rd_off<HD>(DA, KA + 1, 1)>(vb), bl1 = tr_read<v_rd_off<HD>(DA + 1, KA + 1, 0)>(vb), bh1 = tr_read<v_rd_off<HD>(DA + 1, KA + 1, 1)>(vb);
    asm volatile("s_waitcnt lgkmcnt(0)" ::: "memory"); __builtin_amdgcn_sched_barrier(0);
    oa = __builtin_amdgcn_mfma_f32_32x32x16_bf16(pk0, ATT_PK(al0, ah0), oa, 0, 0, 0);
    ob = __builtin_amdgcn_mfma_f32_32x32x16_bf16(pk0, ATT_PK(bl0, bh0), ob, 0, 0, 0);
    oa = __builtin_amdgcn_mfma_f32_32x32x16_bf16(pk1, ATT_PK(al1, ah1), oa, 0, 0, 0);
    ob = __builtin_amdgcn_mfma_f32_32x32x16_bf16(pk1, ATT_PK(bl1, bh1), ob, 0, 0, 0);
}
template <int HD> __device__ __forceinline__ void pv_all(f32x16 (&o)[HD / 32], int vb, bf16x8 pa0, bf16x8 pa1, bf16x8 pa2, bf16x8 pa3) {
    pv_quad<HD, 0, 0>(o[0], o[1], vb, pa0, pa1); pv_quad<HD, 0, 2>(o[0], o[1], vb, pa2, pa3);
    if constexpr (HD == 128) { pv_quad<HD, 2, 0>(o[2], o[3], vb, pa0, pa1); pv_quad<HD, 2, 2>(o[2], o[3], vb, pa2, pa3); }
}
#define ATT_PK4(P, BASE, OUT) do { const unsigned a0_ = cvtpk(P[BASE + 0], P[BASE + 1]), a1_ = cvtpk(P[BASE + 2], P[BASE + 3]);   \
    const unsigned b0_ = cvtpk(P[BASE + 4], P[BASE + 5]), b1_ = cvtpk(P[BASE + 6], P[BASE + 7]);                              \
    auto r0_ = __builtin_amdgcn_permlane32_swap(a0_, b0_, false, false); auto r1_ = __builtin_amdgcn_permlane32_swap(a1_, b1_, false, false); \
    v4u w_ = {r0_[0], r1_[0], r0_[1], r1_[1]}; OUT = __builtin_bit_cast(bf16x8, w_); } while (0)
__device__ __forceinline__ float xmax32(float v) { auto rr = __builtin_amdgcn_permlane32_swap(__float_as_uint(v), __float_as_uint(v), false, false); return fmaxf(__uint_as_float(rr[0]), __uint_as_float(rr[1])); }
__device__ __forceinline__ float xsum32(float v) { auto rr = __builtin_amdgcn_permlane32_swap(__float_as_uint(v), __float_as_uint(v), false, false); return __uint_as_float(rr[0]) + __uint_as_float(rr[1]); }

struct MaskGen {
    float C, ba, bb, dq, W; int edge;
    __device__ __forceinline__ void edges(f32x16& p0, f32x16& p1) const {
        if (edge == 0) return;
        if (edge == 1) {
#pragma unroll
            for (int r = 0; r < 16; ++r) { const float kr = (float)((r & 3) + 8 * (r >> 2)); p0[r] = dq >= kr ? p0[r] : -INFINITY; p1[r] = dq >= kr + 32.f ? p1[r] : -INFINITY; }
        } else if (edge == 2) {
#pragma unroll
            for (int r = 0; r < 16; ++r) { const float kr = (float)((r & 3) + 8 * (r >> 2)); p0[r] = dq < W + kr ? p0[r] : -INFINITY; p1[r] = dq < W + kr + 32.f ? p1[r] : -INFINITY; }
        } else {
#pragma unroll
            for (int r = 0; r < 16; ++r) { const float kr = (float)((r & 3) + 8 * (r >> 2));
                p0[r] = (dq >= kr && dq < W + kr) ? p0[r] : -INFINITY; p1[r] = (dq >= kr + 32.f && dq < W + kr + 32.f) ? p1[r] : -INFINITY; }
        }
    }
};
__device__ __forceinline__ MaskGen make_mask(float C, float rC, float slC, float dq, float W, bool ok, int edge) { return MaskGen{C, slC * rC, ok ? -slC * dq * rC : -INFINITY, dq, W, edge}; }
template <int HD> __device__ __forceinline__ void softmax_pv(f32x16& p0, f32x16& p1, f32x16 (&o)[HD / 32], float& m_reg, float& l_reg, int vb, LAS float* al_l, int r32, int hi, float C) {
    float pmax = fmaxf(p0[0], p1[0]);
#pragma unroll
    for (int r = 1; r < 16; ++r) pmax = fmaxf(fmaxf(pmax, p0[r]), p1[r]);
    pmax = xmax32(pmax) * C;
    float mn = m_reg, alpha = 1.f;
    if (!__all(pmax - m_reg <= 8.0f)) { mn = fmaxf(m_reg, pmax); alpha = __builtin_amdgcn_exp2f(m_reg - mn); m_reg = mn; }
    float ps4[4] = {0.f, 0.f, 0.f, 0.f}; const float nm = -mn;
#pragma unroll
    for (int r = 0; r < 16; ++r) { p0[r] = __builtin_amdgcn_exp2f(fmaf(p0[r], C, nm)); p1[r] = __builtin_amdgcn_exp2f(fmaf(p1[r], C, nm)); ps4[r & 3] += p0[r] + p1[r]; }
    float ps = (ps4[0] + ps4[1]) + (ps4[2] + ps4[3]);
    ps = xsum32(ps); l_reg = l_reg * alpha + ps;
    bf16x8 pa0, pa1, pa2, pa3; ATT_PK4(p0, 0, pa0); ATT_PK4(p0, 8, pa1); ATT_PK4(p1, 0, pa2); ATT_PK4(p1, 8, pa3);
    if (__any(alpha < 1.f)) { if (hi == 0) al_l[r32] = alpha; LDS_WAIT();
#pragma unroll
        for (int r = 0; r < 16; ++r) { const float a = al_l[crow(r, hi)];
#pragma unroll
            for (int d = 0; d < HD / 32; ++d) o[d][r] *= a; }
        LDS_WAIT(); }
    pv_all<HD>(o, vb, pa0, pa1, pa2, pa3);
}
template <int HD> struct Stg { v4u k0, k1, v0, v1; };
template <int HD> __device__ __forceinline__ void sload(Stg<HD>& s, const bf16* Kp, const bf16* Vp, size_t pitch, int tid) {
    if constexpr (HD == 128) { const int sr = tid >> 4, sc = (tid & 15) * 8;
        s.k0 = *(const v4u*)(Kp + (size_t)sr * pitch + sc); s.k1 = *(const v4u*)(Kp + (size_t)(32 + sr) * pitch + sc);
        s.v0 = *(const v4u*)(Vp + (size_t)sr * pitch + sc); s.v1 = *(const v4u*)(Vp + (size_t)(32 + sr) * pitch + sc); }
    else { const int sr = tid >> 3, sc = (tid & 7) * 8; s.k0 = *(const v4u*)(Kp + (size_t)sr * pitch + sc); s.v0 = *(const v4u*)(Vp + (size_t)sr * pitch + sc); }
}
template <int HD> __device__ __forceinline__ void swrite(const Stg<HD>& s, LAS char* Kt, LAS char* Vt, int tid) {
    if constexpr (HD == 128) { const int sr = tid >> 4, sc = (tid & 15) * 8;
        *(LAS v4u*)(Kt + kswz<HD>(sr, sc * 2)) = s.k0; *(LAS v4u*)(Kt + kswz<HD>(32 + sr, sc * 2)) = s.k1;
        *(LAS v4u*)(Vt + v_st<HD>(sr, sc)) = s.v0; *(LAS v4u*)(Vt + v_st<HD>(32 + sr, sc)) = s.v1; }
    else { const int sr = tid >> 3, sc = (tid & 7) * 8; *(LAS v4u*)(Kt + kswz<HD>(sr, sc * 2)) = s.k0; *(LAS v4u*)(Vt + v_st<HD>(sr, sc)) = s.v0; }
}
constexpr int A_K0 = 0, A_K1 = 16384, A_V0 = 32768, A_V1 = 49152, A_WS = 65536, A_SEL = 67584, A_UNI = 68608, A_IMP = 68864, A_KM = 77312, A_END = 81408, A_IMPH = 81920;

template <int HD, class TF, class SK, class FIN>
__device__ __forceinline__ void run_tiles(unsigned mask0, unsigned mask1, const bf16* Kb0, const bf16* Vb0, const bf16* Kb1, const bf16* Vb1, size_t pitch, LAS char* lds, int tid, int lane,
                                          const bf16x8 (&qr)[HD / 16], f32x16 (&o)[HD / 32], float& m_reg, float& l_reg, LAS float* al_l, const TF& tf, const SK& sk, const FIN& fin) {
    const int r32 = lane & 31, hi = lane >> 5;
    const int vb0 = (int)(uintptr_t)(lds + A_V0) + v_rd_base(lane);
    int ph = 0; unsigned m = mask0; if (m == 0u) { ph = 1; m = mask1; }
    if (m == 0u) return;
    int j = __builtin_ctz(m); m &= m - 1u;
    Stg<HD> st;
    sload<HD>(st, (ph ? Kb1 : Kb0) + (size_t)j * 64 * pitch, (ph ? Vb1 : Vb0) + (size_t)j * 64 * pitch, pitch, tid);
    swrite<HD>(st, lds + A_K0, lds + A_V0, tid);
    __syncthreads();
    int buf = 0;
    for (;;) {
        int phn = ph; unsigned mn = m; if (mn == 0u && ph == 0) { phn = 1; mn = mask1; }
        const int jn = mn ? __builtin_ctz(mn) : -1; mn &= mn - 1u;
        if (jn >= 0) sload<HD>(st, (phn ? Kb1 : Kb0) + (size_t)jn * 64 * pitch, (phn ? Vb1 : Vb0) + (size_t)jn * 64 * pitch, pitch, tid);
        if (!sk(ph, j)) { f32x16 p0, p1; const MaskGen mg = tf(ph, j);
            qkt_bias<HD>(p0, p1, lds + (buf ? A_K1 : A_K0), qr, r32, hi, mg.ba, mg.bb); mg.edges(p0, p1);
            softmax_pv<HD>(p0, p1, o, m_reg, l_reg, vb0 + buf * 16384, al_l, r32, hi, mg.C); }
        if (jn < 0 || phn != ph) fin(ph);
        if (jn >= 0) swrite<HD>(st, lds + (buf ? A_K0 : A_K1), lds + (buf ? A_V0 : A_V1), tid);
        __syncthreads();
        if (jn < 0) break;
        ph = phn; m = mn; j = jn; buf ^= 1;
    }
}
}

constexpr int N_ATT_UNITS = 256 + 128 + 256, CVT_PER_UNIT = 16, N_CVT_UNITS = 14336 / CVT_PER_UNIT, N_RAT_UNITS = 256, N_Q_UNITS = N_ATT_UNITS + N_CVT_UNITS + N_RAT_UNITS;
struct UnitTab { unsigned short u[N_Q_UNITS]; };
constexpr UnitTab make_units() {
    unsigned short a[N_ATT_UNITS] = {}; int n = 0;
    for (int cost = 64; cost >= 0; --cost) {
        for (int c = 0; c < 32; ++c) if (c + 12 == cost) for (int bg = 0; bg < 8; ++bg) a[n++] = (unsigned short)((bg << 5) | c);
        for (int kb = 0; kb < 8; ++kb) if (4 * kb + 3 == cost) for (int bh = 0; bh < 16; ++bh) a[n++] = (unsigned short)((1 << 12) | (bh << 3) | kb);
        if (cost == 2) for (int c = 0; c < 32; ++c) for (int bg = 0; bg < 8; ++bg) a[n++] = (unsigned short)((2 << 12) | (bg << 5) | c);
    }
    UnitTab t{}; int ia = 0, ic = 0; constexpr int SPAN = N_Q_UNITS - 160, NS = N_CVT_UNITS + N_RAT_UNITS;
    for (int q = 0; q < N_Q_UNITS; ++q) {
        const bool sm = q < SPAN && ((q + 1) * NS) / SPAN > (q * NS) / SPAN;
        if (sm && ic < NS) {
            const int nr = (ic * N_RAT_UNITS) / NS, nr1 = ((ic + 1) * N_RAT_UNITS) / NS;
            t.u[q] = (unsigned short)(nr1 > nr ? ((5 << 12) | nr) : ((3 << 12) | (ic - nr)));
            ++ic; }
        else t.u[q] = a[ia++];
    }
    return t;
}
__constant__ UnitTab g_units = make_units();

__device__ __forceinline__ unsigned char f2fp8(float v) { return (unsigned char)(__builtin_amdgcn_cvt_pk_fp8_f32(v * 64.f, v * 64.f, 0, false) & 0xff); }
#define ATT_STORE_O(ND, OVAL) do { unsigned off_ = (unsigned)((4 * hi) * DM + r32); _Pragma("unroll") for (int r_ = 0; r_ < 16; ++r_) { asm volatile("" : "+v"(off_)); \
        unsigned char* op_ = o8base + off_ + (unsigned)(((r_ & 3) + 8 * (r_ >> 2)) * DM); \
        _Pragma("unroll") for (int d_ = 0; d_ < ND; ++d_) op_[32 * d_] = f2fp8(OVAL); asm volatile("" ::: "memory"); } } while (0)
#define ATT_ACC_O(FIRST, LAST) do { unsigned off_ = (unsigned)((4 * hi) * DM + r32) * 2u; \
        _Pragma("unroll") for (int g_ = 0; g_ < 2; ++g_) { asm volatile("" : "+v"(off_)); unsigned short old_[8][4]; \
            if (!(FIRST)) { _Pragma("unroll") for (int q_ = 0; q_ < 8; ++q_) { const int r_ = 8 * g_ + q_; const bf16* op_ = (const bf16*)((const char*)obase + off_ + (unsigned)(((r_ & 3) + 8 * (r_ >> 2)) * DM * 2)); \
                _Pragma("unroll") for (int d_ = 0; d_ < 4; ++d_) old_[q_][d_] = op_[32 * d_]; } } \
            _Pragma("unroll") for (int q_ = 0; q_ < 8; ++q_) { const int r_ = 8 * g_ + q_; const float f_ = fac_l[att::crow(r_, hi)]; bf16* op_ = (bf16*)((char*)obase + off_ + (unsigned)(((r_ & 3) + 8 * (r_ >> 2)) * DM * 2)); \
                _Pragma("unroll") for (int d_ = 0; d_ < 4; ++d_) { float v_ = o[d_][r_] * f_; if (!(FIRST)) v_ += bf2f(old_[q_][d_]); if (LAST) o8base[(off_ >> 1) + (unsigned)(((r_ & 3) + 8 * (r_ >> 2)) * DM) + 32 * d_] = f2fp8(v_); else op_[32 * d_] = (bf16)f2bf(v_); } } \
            asm volatile("" ::: "memory"); } } while (0)

__device__ __forceinline__ void nsa_loop(int code, const bf16* Z, bf16* OA, unsigned char* OA8, LAS char* lds, int tid_in, int wid, unsigned mysel, unsigned uni);
__device__ __forceinline__ void nsa_unit(int code, const bf16* Z, const bf16* KCMP, const bf16* VCMP, bf16* OA, unsigned char* OA8, LAS char* lds, int tid_in, int wid) {
    using namespace att;
    const int lane = lane_id(), tid = wid * 64 + lane; (void)tid_in;
    const int bg = (code >> 5) & 7, c = code & 31, b = bg >> 1, g = bg & 1;
    const int r32 = lane & 31, hi = lane >> 5, hh = wid & 3, tb = wid >> 2, head = g * 4 + hh;
    const int tl = tb * 32 + r32, tpos = c * 64 + tl;
    const size_t trow = (size_t)b * SEQ + tpos;
    const float slC = __builtin_amdgcn_exp2f(-(float)(head + 1)) * LOG2E, C = 0.08838834764831845f * LOG2E, rC = 1.0f / C;
    LAS float* al_l = (LAS float*)(lds + A_WS) + wid * 64; LAS float* fac_l = al_l + 32;
    LAS unsigned* sel_l = (LAS unsigned*)(lds + A_SEL); LAS unsigned* uni_l = (LAS unsigned*)(lds + A_UNI); LAS float* imp_l = (LAS float*)(lds + A_IMP);
    const bf16* qp = Z + trow * ZP + ZC_QA + head * 128 + hi * 8;
    const bf16* gp = Z + trow * ZP + ZC_GA + head * 3;
    const float g0 = bf2f(gp[0]);
    bf16* obase = OA + ((size_t)b * SEQ + c * 64 + tb * 32) * DM + OC_A + head * 128;
    unsigned char* o8base = OA8 + ((size_t)b * SEQ + c * 64 + tb * 32) * DM + OC_A + head * 128; (void)o8base;
    {
        const bf16* kc = KCMP + (size_t)bg * 128 * 128; const bf16* vc = VCMP + (size_t)bg * 128 * 128;
        { Stg<128> s0, s1; sload<128>(s0, kc, vc, 128, tid); sload<128>(s1, kc + 64 * 128, vc + 64 * 128, 128, tid);
          swrite<128>(s0, lds + A_K0, lds + A_V0, tid); swrite<128>(s1, lds + A_K1, lds + A_V1, tid); }
        __syncthreads();
        bf16x8 qc[8];
#pragma unroll
        for (int d0 = 0; d0 < 8; ++d0) qc[d0] = *(const bf16x8*)(qp + d0 * 16);
        const float dq = (float)(tpos - 31 - 64 * hi);
#define NSA_CMP_SCORES(T) do { qkt<128>(a0, a1, lds + ((T) ? A_K1 : A_K0), qc, r32, hi); \
        _Pragma("unroll") for (int r = 0; r < 16; ++r) { const float kr = 16.f * (float)((r & 3) + 8 * (r >> 2)) + 1024.f * (T); const float d0_ = dq - kr, d1_ = dq - kr - 512.f; \
            a0[r] = d0_ >= 0.f ? fmaf(a0[r], C, -slC * d0_) : -INFINITY; a1[r] = d1_ >= 0.f ? fmaf(a1[r], C, -slC * d1_) : -INFINITY; } } while (0)
        f32x16 a0, a1;
        float mx = -INFINITY, ps = 0.f;
        { NSA_CMP_SCORES(0);
#pragma unroll
          for (int r = 0; r < 16; ++r) mx = fmaxf(mx, fmaxf(a0[r], a1[r]));
          float s0 = 0.f; const float m0 = (mx == -INFINITY) ? 0.f : mx;
#pragma unroll
          for (int r = 0; r < 16; ++r) s0 += __builtin_amdgcn_exp2f(a0[r] - m0) + __builtin_amdgcn_exp2f(a1[r] - m0);
          NSA_CMP_SCORES(1);
          float mx1 = mx;
#pragma unroll
          for (int r = 0; r < 16; ++r) mx1 = fmaxf(mx1, fmaxf(a0[r], a1[r]));
          const float m1 = (mx1 == -INFINITY) ? 0.f : mx1;
          float s1 = 0.f;
#pragma unroll
          for (int r = 0; r < 16; ++r) s1 += __builtin_amdgcn_exp2f(a0[r] - m1) + __builtin_amdgcn_exp2f(a1[r] - m1);
          float mh = mx1, sh = s0 * __builtin_amdgcn_exp2f(m0 - m1) + s1;
          const float mo = shfl_xor_f(mh, 32, lane), so = shfl_xor_f(sh, 32, lane);
          const float mf = fmaxf(mh, mo); const float mfz = (mf == -INFINITY) ? 0.f : mf;
          const float mhz = (mh == -INFINITY) ? 0.f : mh, moz = (mo == -INFINITY) ? 0.f : mo;
          ps = sh * __builtin_amdgcn_exp2f(mhz - mfz) + so * __builtin_amdgcn_exp2f(moz - mfz); mx = mfz; }
        const float mm = mx, inv = ps > 0.f ? 1.0f / ps : 0.f;
        LAS float* impr = (LAS float*)(lds + A_IMPH) + (hh * 64 + tl) * 33; float carry_ = 0.f;
#define NSA_IMP(X, GRP) do { _Pragma("unroll") for (int q4 = 0; q4 < 4; ++q4) { const float hb_ = 0.5f * X[4 * q4 + 3] * inv; \
            const float aa_ = (X[4 * q4] + X[4 * q4 + 1] + X[4 * q4 + 2]) * inv + hb_; const float rhb_ = shfl_xor_f(hb_, 32, lane); \
            impr[8 * (GRP) + 2 * q4 + hi] = aa_ + (hi ? rhb_ : carry_); carry_ = rhb_; } } while (0)
        f32x16 o[4];
#pragma unroll
      for (int d = 0; d < 4; ++d) o[d] = att::zero16();
        const int vb0 = (int)(uintptr_t)(lds + A_V0) + v_rd_base(lane);
        { NSA_CMP_SCORES(0);
#pragma unroll
          for (int r = 0; r < 16; ++r) { a0[r] = __builtin_amdgcn_exp2f(a0[r] - mm); a1[r] = __builtin_amdgcn_exp2f(a1[r] - mm); }
          NSA_IMP(a0, 0); NSA_IMP(a1, 1);
          bf16x8 pa0, pa1, pa2, pa3; ATT_PK4(a0, 0, pa0); ATT_PK4(a0, 8, pa1); ATT_PK4(a1, 0, pa2); ATT_PK4(a1, 8, pa3); pv_all<128>(o, vb0, pa0, pa1, pa2, pa3); }
        { NSA_CMP_SCORES(1);
#pragma unroll
          for (int r = 0; r < 16; ++r) { a0[r] = __builtin_amdgcn_exp2f(a0[r] - mm); a1[r] = __builtin_amdgcn_exp2f(a1[r] - mm); }
          NSA_IMP(a0, 2); NSA_IMP(a1, 3);
          bf16x8 pa0, pa1, pa2, pa3; ATT_PK4(a0, 0, pa0); ATT_PK4(a0, 8, pa1); ATT_PK4(a1, 0, pa2); ATT_PK4(a1, 8, pa3); pv_all<128>(o, vb0 + 16384, pa0, pa1, pa2, pa3); }
#undef NSA_IMP
#undef NSA_CMP_SCORES
        if (hi == 0) fac_l[r32] = g0 * inv; LDS_WAIT();
        ATT_ACC_O(true, false);
        LDS_WAIT();
    }
    __syncthreads();
    if (wid == 0) {
        unsigned sel;
        if (c <= 7) sel = (2u << c) - 1u;
        else { sel = 1u | (1u << c) | (1u << (c - 1)); unsigned cand = ((1u << (c - 1)) - 1u) & ~1u;
            const LAS float* ir = (const LAS float*)(lds + A_IMPH) + lane * 33; float iv[30];
#pragma unroll
            for (int j = 1; j <= 29; ++j) iv[j] = (ir[j] + ir[64 * 33 + j]) + (ir[2 * 64 * 33 + j] + ir[3 * 64 * 33 + j]);
#pragma unroll
            for (int k = 0; k < 5; ++k) { int best = -1; float bv = -INFINITY;
#pragma unroll
                for (int j = 1; j <= 29; ++j) { if (((cand >> j) & 1u) && iv[j] > bv) { bv = iv[j]; best = j; } }
                if (best < 0) best = __builtin_ctz(cand);
                sel |= 1u << best; cand &= ~(1u << best); } }
        sel_l[lane] = sel;
        unsigned un = sel;
#pragma unroll
        for (int o_ = 1; o_ < 64; o_ <<= 1) un |= shfl_xor_u(un, o_, lane);
        if (lane == 0) uni_l[0] = un;
    }
    __syncthreads();
    const unsigned mysel = sel_l[tl], uni = uni_l[0];
    asm volatile("" ::: "memory");
    nsa_loop(code, Z, OA, OA8, lds, tid, wid, mysel, uni);
}
__device__ __forceinline__ void nsa_loop(int code, const bf16* Z, bf16* OA, unsigned char* OA8, LAS char* lds, int tid_in, int wid, unsigned mysel, unsigned uni) {
    using namespace att;
    const int lane = lane_id(), tid = wid * 64 + lane; (void)tid_in;
    const int bg = (code >> 5) & 7, c = code & 31, b = bg >> 1, g = bg & 1;
    const int r32 = lane & 31, hi = lane >> 5, hh = wid & 3, tb = wid >> 2, head = g * 4 + hh;
    const int tl = tb * 32 + r32, tpos = c * 64 + tl;
    const size_t trow = (size_t)b * SEQ + tpos;
    const float slC = __builtin_amdgcn_exp2f(-(float)(head + 1)) * LOG2E, C = 0.08838834764831845f * LOG2E, rC = 1.0f / C;
    LAS float* al_l = (LAS float*)(lds + A_WS) + wid * 64; LAS float* fac_l = al_l + 32;
    const bf16* qp = Z + trow * ZP + ZC_QA + head * 128 + hi * 8;
    const bf16* gp = Z + trow * ZP + ZC_GA + head * 3;
    const float g1 = bf2f(gp[1]), g2 = bf2f(gp[2]);
    bf16* obase = OA + ((size_t)b * SEQ + c * 64 + tb * 32) * DM + OC_A + head * 128;
    unsigned char* o8base = OA8 + ((size_t)b * SEQ + c * 64 + tb * 32) * DM + OC_A + head * 128; (void)o8base;
    const bf16* zb = Z + (size_t)b * SEQ * ZP;
    bf16x8 qr[8];
#pragma unroll
    for (int d0 = 0; d0 < 8; ++d0) qr[d0] = *(const bf16x8*)(qp + d0 * 16);
    { f32x16 o[4];
#pragma unroll
      for (int d = 0; d < 4; ++d) o[d] = att::zero16();
      float m_reg = -1e30f, l_reg = 0.f;
      const int jlo = c > 8 ? c - 8 : 0; const unsigned wmask = ((2u << c) - 1u) & ~((1u << jlo) - 1u);
      const int twmin = c * 64 + tb * 32;
      run_tiles<128>(uni, wmask, zb + ZC_KVA + 512 + g * 128, zb + ZC_KVA + 768 + g * 128, zb + ZC_KVA + 1024 + g * 128, zb + ZC_KVA + 1280 + g * 128, (size_t)ZP, lds, tid, lane, qr, o, m_reg, l_reg, al_l,
          [&](int ph, int j) { return make_mask(C, rC, slC, (float)(tpos - 64 * j - 4 * hi), 512.f, ph ? true : (((mysel >> j) & 1u) != 0u), ph ? ((j < c && j >= c - 7) ? 0 : (j == c ? 1 : 2)) : (j < c ? 0 : 1)); },
          [&](int ph, int j) { return ph ? (twmin - (64 * j + 63) >= 512) : !__any((mysel >> j) & 1u); },
          [&](int ph) { if (hi == 0) fac_l[r32] = (ph ? g2 : g1) / l_reg; LDS_WAIT();
              ATT_ACC_O(false, ph != 0);
              LDS_WAIT();
#pragma unroll
      for (int d = 0; d < 4; ++d) o[d] = att::zero16();
              m_reg = -1e30f; l_reg = 0.f; }); }
}

__device__ __forceinline__ void moba_unit(int code, const bf16* Z, const float* KMEAN, bf16* OA, unsigned char* OA8, LAS char* lds, int tid_in, int wid) {
    using namespace att;
    const int lane = lane_id(), tid = wid * 64 + lane; (void)tid_in;
    const int bh = (code >> 3) & 15, kb = code & 7, b = bh >> 2, h = bh & 3;
    const int r32 = lane & 31, hi = lane >> 5, tl = wid * 32 + r32, tpos = kb * 256 + tl;
    const float slC = __builtin_amdgcn_exp2f(-2.0f * (float)(h + 1)) * LOG2E, C = 0.08838834764831845f * LOG2E, rC = 1.0f / C;
    LAS float* al_l = (LAS float*)(lds + A_WS) + wid * 64; LAS float* fac_l = al_l + 32;
    LAS unsigned* sel_l = (LAS unsigned*)(lds + A_SEL); LAS unsigned* uni_l = (LAS unsigned*)(lds + A_UNI); LAS float* km_l = (LAS float*)(lds + A_KM);
    const bf16* zb = Z + (size_t)b * SEQ * ZP;
    v4u qv[8];
    { const bf16* qp = zb + (size_t)tpos * ZP + ZC_QC + h * 128 + hi * 64;
#pragma unroll
        for (int d4 = 0; d4 < 8; ++d4) qv[d4] = *(const v4u*)(qp + d4 * 8); }
    for (int i = tid; i < 1024; i += NTHR) km_l[i] = KMEAN[(size_t)bh * 1024 + i];
    if (tid == 0) uni_l[0] = 0u;
    __syncthreads();
    unsigned mysel;
    { unsigned sel;
        if (kb <= 3) sel = (1u << kb) - 1u;
        else { float sc[7];
#pragma unroll
            for (int n = 0; n < 7; ++n) sc[n] = 0.f;
#pragma unroll
            for (int d4 = 0; d4 < 8; ++d4) { const v4u q = qv[d4];
                const float qf[8] = {bflo(q.x), bfhi(q.x), bflo(q.y), bfhi(q.y), bflo(q.z), bfhi(q.z), bflo(q.w), bfhi(q.w)};
#pragma unroll
                for (int n = 0; n < 7; ++n) { const LAS float* kp = km_l + n * 128 + hi * 64 + d4 * 8;
#pragma unroll
                    for (int i = 0; i < 8; ++i) sc[n] = fmaf(qf[i], kp[i], sc[n]); }
                asm volatile("" ::: "memory"); }
#pragma unroll
            for (int n = 0; n < 7; ++n) sc[n] += shfl_xor_f(sc[n], 32, lane);
            sel = 0u;
#pragma unroll
            for (int k = 0; k < 3; ++k) { int best = -1; float bv = -INFINITY;
#pragma unroll
                for (int n = 0; n < 7; ++n) if (n < kb && !((sel >> n) & 1u) && sc[n] > bv) { bv = sc[n]; best = n; }
                if (best < 0) best = __builtin_ctz(~sel);
                sel |= 1u << best; } }
        mysel = sel; unsigned un = sel;
#pragma unroll
        for (int o_ = 1; o_ < 64; o_ <<= 1) un |= shfl_xor_u(un, o_, lane);
        if (lane == 0) (void)__hip_atomic_fetch_or(uni_l, un, __ATOMIC_RELAXED, __HIP_MEMORY_SCOPE_WORKGROUP);
    }
    bf16x8 qr[8];
    { const bf16* qp = zb + (size_t)tpos * ZP + ZC_QC + h * 128 + hi * 8;
#pragma unroll
      for (int d0 = 0; d0 < 8; ++d0) qr[d0] = *(const bf16x8*)(qp + d0 * 16); }
    __syncthreads();
    const unsigned uni = uni_l[0];
    unsigned tmask = 0xFu << (4 * kb);
    for (int n = 0; n < kb; ++n) if ((uni >> n) & 1u) tmask |= 0xFu << (4 * n);
    f32x16 o[4];
#pragma unroll
      for (int d = 0; d < 4; ++d) o[d] = att::zero16();
    float m_reg = -1e30f, l_reg = 0.f;
    const int twmax = kb * 256 + wid * 32 + 31;
    run_tiles<128>(tmask, 0u, zb + ZC_KC + h * 128, zb + ZC_VC + h * 128, zb, zb, (size_t)ZP, lds, tid, lane, qr, o, m_reg, l_reg, al_l,
        [&](int, int j) { const int blk = j >> 2; return make_mask(C, rC, slC, (float)(tpos - 64 * j - 4 * hi), 1e9f, blk == kb ? true : (((mysel >> blk) & 1u) != 0u), blk != kb ? 0 : 1); },
        [&](int, int j) { const int blk = j >> 2; return blk == kb ? (64 * j > twmax) : !__any((mysel >> blk) & 1u); },
        [&](int) {});
    if (hi == 0) fac_l[r32] = 1.0f / l_reg; LDS_WAIT();
    float fr_[16];
#pragma unroll
    for (int r = 0; r < 16; ++r) fr_[r] = fac_l[crow(r, hi)];
    LDS_WAIT();
    unsigned char* o8base = OA8 + ((size_t)b * SEQ + kb * 256 + wid * 32) * DM + OC_C + h * 128; (void)OA;
    ATT_STORE_O(4, o[d_][r_] * fr_[r_]);
}

__device__ __forceinline__ void swa_unit(int code, const bf16* Z, const float* sink, bf16* OA, unsigned char* OA8, LAS char* lds, int tid_in, int wid) {
    using namespace att;
    const int lane = lane_id(), tid = wid * 64 + lane; (void)tid_in;
    const int bg = (code >> 5) & 7, c = code & 31, b = bg >> 1, g = bg & 1;
    const int r32 = lane & 31, hi = lane >> 5, hh = wid & 3, tb = wid >> 2, head = g * 4 + hh;
    const int tl = tb * 32 + r32, tpos = c * 64 + tl;
    const float slC = __builtin_amdgcn_exp2f(-(float)(head + 1)) * LOG2E, C = 0.125f * LOG2E, rC = 1.0f / C;
    LAS float* al_l = (LAS float*)(lds + A_WS) + wid * 64; LAS float* fac_l = al_l + 32;
    const bf16* zb = Z + (size_t)b * SEQ * ZP;
    bf16x8 qr[4];
    { const bf16* qp = zb + (size_t)tpos * ZP + ZC_QB + head * 64 + hi * 8;
#pragma unroll
      for (int d0 = 0; d0 < 4; ++d0) qr[d0] = *(const bf16x8*)(qp + d0 * 16); }
    f32x16 o[2];
#pragma unroll
      for (int d = 0; d < 2; ++d) o[d] = att::zero16();
    float m_reg = -1e30f, l_reg = 0.f;
    const int jlo = c > 2 ? c - 2 : 0; const unsigned tmask = ((2u << c) - 1u) & ~((1u << jlo) - 1u);
    const int twmin = c * 64 + tb * 32;
    run_tiles<64>(tmask, 0u, zb + ZC_KB + g * 64, zb + ZC_VB + g * 64, zb, zb, (size_t)ZP, lds, tid, lane, qr, o, m_reg, l_reg, al_l,
        [&](int, int j) { return make_mask(C, rC, slC, (float)(tpos - 64 * j - 4 * hi), 128.f, true, j == c - 1 ? 0 : (j == c ? 1 : 2)); },
        [&](int, int j) { return twmin - (64 * j + 63) >= 128; },
        [&](int) {});
    l_reg += __builtin_amdgcn_exp2f(sink[head] * LOG2E - m_reg);
    if (hi == 0) fac_l[r32] = 1.0f / l_reg; LDS_WAIT();
    float fr_[16];
#pragma unroll
    for (int r = 0; r < 16; ++r) fr_[r] = fac_l[crow(r, hi)];
    LDS_WAIT();
    unsigned char* o8base = OA8 + ((size_t)b * SEQ + c * 64 + tb * 32) * DM + OC_B + head * 64; (void)OA;
    ATT_STORE_O(2, o[d_][r_] * fr_[r_]);
}

__device__ __forceinline__ void ratio_unit(int u, bf16* Z, int wid) {
    const int lane = lane_id();
#pragma unroll 1
    for (int i = 0; i < 2; ++i) { bf16* zr = Z + (size_t)(u * 32 + wid * 4 + 2 * i) * ZP + ZC_GM + 8 * lane;
        v4u a[2][4], b[2][4], c[2][4];
#pragma unroll
        for (int rr = 0; rr < 2; ++rr)
#pragma unroll
            for (int q = 0; q < 4; ++q) { const bf16* zq = zr + (size_t)rr * ZP + 512 * q; a[rr][q] = *(const v4u*)zq; b[rr][q] = *(const v4u*)(zq + 2048); c[rr][q] = *(const v4u*)(zq + 4096); }
        __builtin_amdgcn_sched_barrier(0);
#pragma unroll
        for (int rr = 0; rr < 2; ++rr)
#pragma unroll
        for (int q = 0; q < 4; ++q) { v4u r0, r1;
#pragma unroll
            for (int k = 0; k < 4; ++k) { const float i1l = __builtin_amdgcn_rcpf(fmaxf(bflo(b[rr][q][k]), 1e-30f)), i1h = __builtin_amdgcn_rcpf(fmaxf(bfhi(b[rr][q][k]), 1e-30f));
                const float i2l = __builtin_amdgcn_rcpf(fmaxf(bflo(c[rr][q][k]), 1e-30f)), i2h = __builtin_amdgcn_rcpf(fmaxf(bfhi(c[rr][q][k]), 1e-30f));
                r0[k] = pk2(bflo(a[rr][q][k]) * i1l, bfhi(a[rr][q][k]) * i1h); r1[k] = pk2(bflo(b[rr][q][k]) * i2l, bfhi(b[rr][q][k]) * i2h); }
            bf16* zq = zr + (size_t)rr * ZP + 512 * q; *(v4u*)zq = r0; *(v4u*)(zq + 2048) = r1; } }
}


__device__ __forceinline__ void cmp_unit(int u, const bf16* Z, const bf16* WCMP, const float* pos, bf16* KCMP, bf16* VCMP, LAS char* lds, int tid, int lane, int wid) {
    const int bg = u >> 5, kv = (u >> 4) & 1, nt = (u >> 2) & 3, et = u & 3, b = bg >> 1, g = bg & 1, r32 = lane & 31, hi = lane >> 5;
    const int n = nt * 32 + r32, nc = n < 126 ? n : 126;
    const bf16* arow = Z + ((size_t)b * SEQ + 16 * nc) * ZP + ZC_KVA + kv * 256 + g * 128 + hi * 8;
    const bf16* brow = WCMP + ((size_t)kv * 128 + et * 32 + r32) * 4096 + hi * 8;
    const float* prow = pos + kv * 4096 + hi * 8;
    f32x16 acc = att::zero16();
#pragma unroll 1
    for (int ll = 0; ll < 4; ++ll) { const int l = 4 * wid + ll;
        v4u a[8]; f32x4 p0[8], p1[8]; bf16x8 bfg[8];
#pragma unroll
        for (int ds = 0; ds < 8; ++ds) { const int d = ds * 16;
            a[ds] = *(const v4u*)(arow + (size_t)l * ZP + d); p0[ds] = *(const f32x4*)(prow + l * 128 + d); p1[ds] = *(const f32x4*)(prow + l * 128 + d + 4);
            bfg[ds] = *(const bf16x8*)(brow + l * 128 + d); }
        __builtin_amdgcn_sched_barrier(0);
#pragma unroll
        for (int ds = 0; ds < 8; ++ds) { const v4u aa = a[ds];
            v4u af; af.x = pk2(bflo(aa.x) + p0[ds][0], bfhi(aa.x) + p0[ds][1]); af.y = pk2(bflo(aa.y) + p0[ds][2], bfhi(aa.y) + p0[ds][3]); af.z = pk2(bflo(aa.z) + p1[ds][0], bfhi(aa.z) + p1[ds][1]); af.w = pk2(bflo(aa.w) + p1[ds][2], bfhi(aa.w) + p1[ds][3]);
            acc = __builtin_amdgcn_mfma_f32_32x32x16_bf16(__builtin_bit_cast(bf16x8, af), bfg[ds], acc, 0, 0, 0); }
        __builtin_amdgcn_sched_barrier(0); }
    LAS float* part = (LAS float*)lds;
#pragma unroll
    for (int r = 0; r < 16; ++r) part[(wid * 32 + att::crow(r, hi)) * 33 + r32] = acc[r];
    __syncthreads();
#pragma unroll
    for (int k2 = 0; k2 < 2; ++k2) { const int idx = tid + NTHR * k2, row = idx >> 5, col = idx & 31; float s = 0.f;
#pragma unroll
        for (int w = 0; w < 8; ++w) s += part[(w * 32 + row) * 33 + col];
        const int no = nt * 32 + row; if (no == 127) s = 0.f;
        (kv ? VCMP : KCMP)[((size_t)bg * 128 + no) * 128 + et * 32 + col] = (bf16)f2bf(s); }
    __syncthreads();
}
__device__ __forceinline__ void kmean_unit(int u, const bf16* Z, float* KMEAN, LAS char* lds, int tid, int lane, int wid) {
    const int bh = u >> 3, blk = u & 7, b = bh >> 2, h = bh & 3;
    const bf16* kp = Z + ((size_t)b * SEQ + blk * 256 + wid * 32) * ZP + ZC_KC + h * 128 + 2 * lane;
    float s0 = 0.f, s1 = 0.f; unsigned kw[32];
#pragma unroll
    for (int i = 0; i < 32; ++i) kw[i] = *(const unsigned*)(kp + (size_t)i * ZP);
    __builtin_amdgcn_sched_barrier(0);
#pragma unroll
    for (int i = 0; i < 32; ++i) { s0 += bflo(kw[i]); s1 += bfhi(kw[i]); }
    LAS float* part = (LAS float*)lds;
    part[wid * 128 + 2 * lane] = s0; part[wid * 128 + 2 * lane + 1] = s1;
    __syncthreads();
    if (tid < 128) { float s = 0.f;
#pragma unroll
        for (int w = 0; w < 8; ++w) s += part[w * 128 + tid];
        KMEAN[((size_t)bh * 8 + blk) * 128 + tid] = s * (1.0f / 256.0f); }
    __syncthreads();
}

struct CvtItem { const float* W; unsigned char* WT; int ldw, k0, ns, nc, ldt, nd, f8; };
__device__ __forceinline__ void cvt_load(const CvtItem& P, f32x4 (&v)[4][4], int lane) {
    const int nq = lane & 15, kq = lane >> 4; const bool act = 4 * nq < P.nc;
    const float* wp = P.W + (size_t)(P.k0 + 4 * kq) * P.ldw + P.ns + 4 * nq;
#pragma unroll
    for (int i = 0; i < 4; ++i)
#pragma unroll
        for (int rr = 0; rr < 4; ++rr) v[i][rr] = act ? __builtin_nontemporal_load((const f32x4*)(wp + (size_t)(16 * i + rr) * P.ldw)) : pg8::zero4();
}
__device__ __forceinline__ void cvt_finish(const CvtItem& P, const f32x4 (&v)[4][4], float scale, LAS unsigned* scr, int lane) {
    const int nq = lane & 15, kq = lane >> 4;
    if (P.f8) {
#pragma unroll
        for (int i = 0; i < 4; ++i)
#pragma unroll
            for (int j = 0; j < 4; ++j) { int w = 0; w = __builtin_amdgcn_cvt_pk_fp8_f32(v[i][0][j] * scale, v[i][1][j] * scale, w, false); w = __builtin_amdgcn_cvt_pk_fp8_f32(v[i][2][j] * scale, v[i][3][j] * scale, w, true);
                scr[(4 * nq + j) * 17 + kq + 4 * i] = (unsigned)w; }
        LDS_WAIT(); asm volatile("" ::: "memory");
        const int c = lane & 3;
#pragma unroll
        for (int i = 0; i < 4; ++i) { const int n = (lane >> 2) + 16 * i; const LAS unsigned* s = scr + n * 17 + 4 * c;
            v4u o; o.x = s[0]; o.y = s[1]; o.z = s[2]; o.w = s[3];
            if (n < P.nc) __builtin_nontemporal_store(o, (v4u*)(P.WT + (size_t)(P.nd + n) * P.ldt + P.k0 + 16 * c)); }
    } else {
#pragma unroll
        for (int i = 0; i < 4; ++i)
#pragma unroll
            for (int h = 0; h < 2; ++h)
#pragma unroll
                for (int j = 0; j < 4; ++j) scr[(4 * nq + j) * 33 + 2 * kq + 8 * i + h] = pk2(v[i][2 * h][j], v[i][2 * h + 1][j]);
        LDS_WAIT(); asm volatile("" ::: "memory");
        const int c = lane & 7;
#pragma unroll
        for (int i = 0; i < 8; ++i) { const int n = (lane >> 3) + 8 * i; const LAS unsigned* s = scr + n * 33 + 4 * c;
            v4u o; o.x = s[0]; o.y = s[1]; o.z = s[2]; o.w = s[3];
            if (n < P.nc) __builtin_nontemporal_store(o, (v4u*)(P.WT + ((size_t)(P.nd + n) * P.ldt + P.k0 + 8 * c) * 2)); }
    }
    LDS_WAIT(); asm volatile("" ::: "memory");
}
__device__ __forceinline__ unsigned pk4_fp8(f32x4 v, float scale) { int w = 0; w = __builtin_amdgcn_cvt_pk_fp8_f32(v[0] * scale, v[1] * scale, w, false); w = __builtin_amdgcn_cvt_pk_fp8_f32(v[2] * scale, v[3] * scale, w, true); return (unsigned)w; }
constexpr float FP8_XSCALE = 16.f, FP8_WSCALE = 64.f;
constexpr int FP8_SCA = 0x7b7b7b7b, FP8_SCB = 0x79797979;
constexpr int CI_IN = 173 * 32, CI_BRA = 512, CI_BRB = 256, CI_BRC = 256, CI_OUT = 1024, CI_GU = 8192, CI_D = 4096, CI_CMP = 256, CI_ZERO = 232;
constexpr int CI_TOTAL = CI_IN + CI_BRA + CI_BRB + CI_BRC + CI_OUT + CI_GU + CI_D + CI_CMP;

__device__ __forceinline__ void ln_row(f32x4 (&v)[8], const float* g, const float* bta, int lane) {
    f32x4 gg[8], bb[8];
#pragma unroll
    for (int j = 0; j < 8; ++j) { gg[j] = ((const f32x4*)g)[lane + 64 * j]; bb[j] = ((const f32x4*)bta)[lane + 64 * j]; }
    __builtin_amdgcn_sched_barrier(0);
    float s = 0.f;
#pragma unroll
    for (int j = 0; j < 8; ++j) s += (v[j][0] + v[j][1]) + (v[j][2] + v[j][3]);
    const float mean = wave_sum(s, lane) * (1.0f / DM); float s2 = 0.f;
#pragma unroll
    for (int j = 0; j < 8; ++j) { v[j] = v[j] - mean; s2 += (v[j][0] * v[j][0] + v[j][1] * v[j][1]) + (v[j][2] * v[j][2] + v[j][3] * v[j][3]); }
    const float rstd = 1.0f / sqrtf(wave_sum(s2, lane) * (1.0f / DM) + LN_EPS);
#pragma unroll
    for (int j = 0; j < 8; ++j) v[j] = v[j] * rstd * gg[j] + bb[j];
}

__device__ __forceinline__ void ln_router_tile(int tile, const float* R, const float* g, const float* bta, float* X1, bf16* XB, const float* wgrp, const float* bgrp, const float* wrt, const float* brt,
                                               int* hist, int* tok_e, float* tok_w, int* tok_p, LAS char* lds, int, int lane_, int wid) {
    { int l2 = lane_; asm volatile("" : "+v"(l2)); lane_ = l2; } const int lane = lane_, tid = wid * 64 + lane;
    LAS float* glog = (LAS float*)lds;
    LAS float* part = (LAS float*)(lds + 1024);
    LAS float* cb = (LAS float*)(lds + 1024);
    LAS float* elog = (LAS float*)(lds + 1024 + 37888);
    const int row0 = tile * 32;
    LAS f32x4* lg = (LAS f32x4*)(lds + 81920);
    LAS f32x4* lb = lg + 512;
    LAS f32x4* lw = lb + 512;
    unsigned lo16 = (unsigned)lane * 16u; asm volatile("" : "+v"(lo16)); const unsigned lo4 = lo16 >> 2;
    v2u vw[4][8]; const size_t rbase = (size_t)row0 + wid * 4;
#pragma unroll
    for (int i = 0; i < 4; ++i)
#pragma unroll
        for (int j = 0; j < 8; ++j) vw[i][j] = *(const v2u*)((((const char*)R + (rbase + i) * (DM * 2)) + 512 * j) + (size_t)(lo16 >> 1));
    { const f32x4 a = ((const f32x4*)g)[tid], b4 = ((const f32x4*)bta)[tid]; f32x4 w4[4];
#pragma unroll
      for (int q = 0; q < 4; ++q) w4[q] = ((const f32x4*)wgrp)[tid + 512 * q];
      lg[tid] = a; lb[tid] = b4;
#pragma unroll
      for (int q = 0; q < 4; ++q) { const int kk = tid + 512 * q; lw[(kk & 3) * 512 + (kk >> 2)] = w4[q]; } }
    __builtin_amdgcn_sched_barrier(0);
    __syncthreads();
    f32x4 v[4][8];
#pragma unroll
    for (int i = 0; i < 4; ++i)
#pragma unroll
        for (int j = 0; j < 8; ++j) v[i][j] = (f32x4){bflo(vw[i][j].x), bfhi(vw[i][j].x), bflo(vw[i][j].y), bfhi(vw[i][j].y)};
    f32x16 acc = att::zero16(); f32x4 gpo;
    const int ri = lane & 31, kk = lane >> 5;
    GAS const char* wbj = (GAS const char*)(wrt + (size_t)(32 * wid) * 32); asm volatile("" : "+s"(wbj));        const unsigned wo = ((unsigned)kk * 512u + (unsigned)ri) * 4u;
    const unsigned cwo = (unsigned)(wid * 4) * 1040u + lo16, cro = (unsigned)ri * 1040u + (unsigned)(32 * wid + 16 * kk) * 4u;
    float bq[2][16];
#pragma unroll
    for (int t = 0; t < 16; ++t) bq[0][t] = *(GAS const float*)((wbj + t * 128) + (size_t)wo);
    wbj += 256 * 128; asm volatile("" : "+s"(wbj));
    { float mean[4], rstd[4];
#pragma unroll
        for (int i = 0; i < 4; ++i) { float s = 0.f;
#pragma unroll
            for (int j = 0; j < 8; ++j) s += (v[i][j][0] + v[i][j][1]) + (v[i][j][2] + v[i][j][3]);
            mean[i] = s; }
#pragma unroll
        for (int o_ = 1; o_ < 64; o_ <<= 1) {
#pragma unroll
            for (int i = 0; i < 4; ++i) mean[i] += shfl_xor_f(mean[i], o_, lane); }
#pragma unroll
        for (int i = 0; i < 4; ++i) { mean[i] *= (1.0f / DM); float s2 = 0.f;
#pragma unroll
            for (int j = 0; j < 8; ++j) { v[i][j] = v[i][j] - mean[i]; s2 += (v[i][j][0] * v[i][j][0] + v[i][j][1] * v[i][j][1]) + (v[i][j][2] * v[i][j][2] + v[i][j][3] * v[i][j][3]); }
            rstd[i] = s2; }
#pragma unroll
        for (int o_ = 1; o_ < 64; o_ <<= 1) {
#pragma unroll
            for (int i = 0; i < 4; ++i) rstd[i] += shfl_xor_f(rstd[i], o_, lane); }
#pragma unroll
        for (int i = 0; i < 4; ++i) rstd[i] = 1.0f / sqrtf(rstd[i] * (1.0f / DM) + LN_EPS);
        f32x4 gp = {0.f, 0.f, 0.f, 0.f};
#pragma unroll
        for (int j = 0; j < 8; ++j) { const f32x4 gg = lg[lane + 64 * j], bb = lb[lane + 64 * j];
            if (j < 7) {
#pragma unroll
                for (int t = 0; t < 16; ++t) bq[(j + 1) & 1][t] = *(GAS const float*)((wbj + t * 128) + (size_t)wo);
                wbj += 256 * 128; asm volatile("" : "+s"(wbj)); }
#pragma unroll
            for (int i = 0; i < 4; ++i) { const f32x4 y = v[i][j] * rstd[i] * gg + bb;
                { v2u w; w.x = pg8::cvt_pk_bf16(y[0], y[1]); w.y = pg8::cvt_pk_bf16(y[2], y[3]); *(v2u*)((((char*)X1 + (rbase + i) * (DM * 2)) + 512 * j) + (size_t)(lo16 >> 1)) = w; }
                *(unsigned*)((((char*)XB + (rbase + i) * DM) + 256 * j) + (size_t)lo4) = pk4_fp8(y, FP8_XSCALE);
                *(LAS f32x4*)((LAS char*)cb + (j & 1) * 33280 + i * 1040 + cwo) = y; }
            LDS_WAIT(); __builtin_amdgcn_s_barrier(); asm volatile("" ::: "memory");
            f32x4 af[4];
#pragma unroll
            for (int u = 0; u < 4; ++u) af[u] = *(const LAS f32x4*)((const LAS char*)cb + (j & 1) * 33280 + u * 16 + cro);
#pragma unroll
            for (int u = 0; u < 4; ++u)
#pragma unroll
                for (int s = 0; s < 4; ++s) acc = __builtin_amdgcn_mfma_f32_32x32x2f32(af[u][s], bq[j & 1][4 * u + s], acc, 0, 0, 0);
#pragma unroll
            for (int u = 0; u < 4; ++u)
#pragma unroll
                for (int s = 0; s < 4; ++s) { const f32x4 wg4 = lw[s * 512 + 64 * j + 8 * wid + 4 * kk + u]; gp = gp + wg4 * af[u][s]; }
            asm volatile("" ::: "memory"); }
#pragma unroll
        for (int cc = 0; cc < 4; ++cc) gp[cc] += shfl_xor_f(gp[cc], 32, lane);
        gpo = gp;
    }
    LDS_WAIT(); __builtin_amdgcn_s_barrier(); asm volatile("" ::: "memory");
    {
#pragma unroll
      for (int r = 0; r < 16; ++r) part[(wid * 32 + att::crow(r, kk)) * 37 + ri] = acc[r];
      if (kk == 0) {
#pragma unroll
          for (int cc = 0; cc < 4; ++cc) part[(wid * 32 + ri) * 37 + 32 + cc] = gpo[cc]; } }
    __syncthreads();
#pragma unroll
    for (int k2 = 0; k2 < 2; ++k2) { const int idx = tid + NTHR * k2, row = idx >> 5, col = idx & 31; float s = brt[col];
#pragma unroll
        for (int w = 0; w < 8; ++w) s += part[(w * 32 + row) * 37 + col];
        elog[row * 33 + col] = s; }
    if (tid < 128) { const int row = tid >> 2, cc = tid & 3; float s = bgrp[cc];
#pragma unroll
        for (int w = 0; w < 8; ++w) s += part[(w * 32 + row) * 37 + 32 + cc];
        glog[tid] = s; }
    __syncthreads();
    if (tid < 32) { const int token = row0 + tid;
        int gi = 0; float gm = glog[tid * 4];
#pragma unroll
        for (int cc = 1; cc < 4; ++cc) { const float t = glog[tid * 4 + cc]; if (t > gm) { gm = t; gi = cc; } }
        float den = 0.f;
#pragma unroll
        for (int cc = 0; cc < 4; ++cc) den += __expf(glog[tid * 4 + cc] - gm);
        const float gw = 1.0f / den;
        int i0 = 0; float t0 = elog[tid * 33 + gi * 8];
#pragma unroll
        for (int k = 1; k < 8; ++k) { const float t = elog[tid * 33 + gi * 8 + k]; if (t > t0) { t0 = t; i0 = k; } }
        int i1 = -1; float t1 = -INFINITY;
#pragma unroll
        for (int k = 0; k < 8; ++k) { const float t = elog[tid * 33 + gi * 8 + k]; if (k != i0 && t > t1) { t1 = t; i1 = k; } }
        const float ex = __expf(t1 - t0), w0 = gw / (1.0f + ex), w1 = gw * ex / (1.0f + ex);
        const int e0 = gi * 8 + i0, e1 = gi * 8 + i1;
        LAS int* e_l = (LAS int*)(lds + 1024);
        e_l[2 * tid] = e0; e_l[2 * tid + 1] = e1; LDS_WAIT();
        int r0 = 0, r1 = 0, hc = 0;
        for (int q = 0; q < 64; ++q) { const int eq = e_l[q]; if (q < 2 * tid) { r0 += (eq == e0); r1 += (eq == e1); } hc += (eq == tid); }
        hist[tile * 32 + tid] = hc;
        tok_e[token * 2] = e0; tok_e[token * 2 + 1] = e1; tok_w[token * 2] = w0; tok_w[token * 2 + 1] = w1; tok_p[token * 2] = r0; tok_p[token * 2 + 1] = r1; }
    __syncthreads();
}
__device__ __forceinline__ int moe_offsets(const int* cntg, LAS char* lds, int tid) {
    LAS int* off_l = (LAS int*)lds; LAS int* cnt_l = (LAS int*)(lds + 256);
    if (tid < 32) cnt_l[tid] = cntg[tid];
    __syncthreads();
    if (tid == 0) { int o = 0; for (int e = 0; e < 32; ++e) { off_l[e] = o; o += (cnt_l[e] + 255) & ~255; } off_l[32] = o; }
    __syncthreads();
    return off_l[32];
}
__device__ __forceinline__ int moe_offsets_hist(const int* hist, int tile, LAS char* lds, int tid) {
    LAS int* off_l = (LAS int*)lds; LAS int* cnt_l = (LAS int*)(lds + 256); LAS int* pre_l = (LAS int*)(lds + 512); LAS int* pa = (LAS int*)(lds + 1024); LAS int* pb = (LAS int*)(lds + 1024 + 2048);
    const int e = tid & 31, part = tid >> 5; int sa = 0, sb = 0; int hq[16];
#pragma unroll
    for (int q = 0; q < 16; ++q) hq[q] = hist[(part * 16 + q) * 32 + e];
    __builtin_amdgcn_sched_barrier(0);
#pragma unroll
    for (int q = 0; q < 16; ++q) { const int t = part * 16 + q; sa += hq[q]; sb += (t < tile) ? hq[q] : 0; }
    pa[part * 32 + e] = sa; pb[part * 32 + e] = sb;
    __syncthreads();
    if (tid < 32) { int c = 0, p = 0;
#pragma unroll
        for (int q = 0; q < 16; ++q) { c += pa[q * 32 + tid]; p += pb[q * 32 + tid]; }
        cnt_l[tid] = c; pre_l[tid] = p; }
    __syncthreads();
    if (tid == 0) { int o = 0; for (int k = 0; k < 32; ++k) { off_l[k] = o; o += (cnt_l[k] + 255) & ~255; } off_l[32] = o; }
    __syncthreads();
    return off_l[32];
}

struct NextLayerCvt {
    const float* w_in; const float* cmpw; unsigned char* ws; LAS char* lds; int j; int wid;
    __device__ __forceinline__ void operator()() const {
        if (j >= CI_IN + CI_CMP) return;
        CvtItem P; P.nc = 64;
        if (j < CI_IN) { const int kb = j / 173, nb = j % 173; P.W = w_in; P.ldw = 11032; P.k0 = 64 * kb; P.WT = ws + WS_WIN1; P.ldt = DM; P.f8 = 1;
            if (nb < 40) { P.ns = 64 * nb; P.nd = P.ns; } else if (nb < 172) { P.ns = 2584 + 64 * (nb - 40); P.nd = 2560 + 64 * (nb - 40); } else { P.ns = 2560; P.nd = ZC_GA; P.nc = 24; } }
        else { const int r = j - CI_IN, kv = r >> 7, rr = r & 127; P.W = cmpw + (size_t)kv * 4096 * 128; P.ldw = 128; P.k0 = 64 * (rr >> 1); P.ns = 64 * (rr & 1); P.WT = ws + WS_WCMP1; P.ldt = 4096; P.nd = kv * 128 + P.ns; P.f8 = 0; }
        f32x4 cur[4][4]; const int ln = lane_id(); cvt_load(P, cur, ln);
        cvt_finish(P, cur, FP8_WSCALE, (LAS unsigned*)(lds + RING_OFF + wid * 16384), ln);
    }
};

#ifndef DBL
#define DBL 0
#endif
#ifndef TMASK
#define TMASK 0
#endif
#ifndef EMASK
#define EMASK 0
#endif
#ifndef WMASK
#define WMASK 0
#endif
#ifndef PHASES
#define PHASES 0x7FF
#endif
struct Args { const float* in[20]; float* out; unsigned char* ws; };
__global__ void __launch_bounds__(NTHR, 2) fwd_kernel(Args args) {
    extern __shared__ __attribute__((aligned(16))) unsigned char lds_raw[];
    LAS unsigned char* const lds = (LAS unsigned char*)lds_raw;
    LAS char* const ldc = (LAS char*)lds_raw;
    volatile LAS unsigned* MISC = (volatile LAS unsigned*)(lds + MISC_OFF);
    const int G = gridDim.x, bx = blockIdx.x, vcu = (G % 8 == 0) ? (bx % 8) * (G / 8) + bx / 8 : bx, NGW = G * NWAVES;
    const int wid = __builtin_amdgcn_readfirstlane((int)threadIdx.x >> 6);
#define PHASE_IDS() int gw_ = vcu * NWAVES + wid; asm volatile("" : "+s"(gw_)); const int lane = lane_id(), tid = wid * 64 + lane, gw = gw_; (void)gw; (void)lane
    gu32* ctl0 = (gu32*)(args.ws + WS_CTL);
    for (int u = wid * 64 + lane_id(); u < (LDS_BYTES - LDSCTL_OFF) / 4; u += NTHR) ((LAS unsigned*)(lds + LDSCTL_OFF))[u] = 0u;
    __syncthreads();
    XcdBarrier bar = xcd_barrier_post((unsigned*)(ctl0 + CW_BAR), MISC + 8);
#define GRID_BAR() xcd_barrier(bar, wid == 0 && lane_id() == 0)
    xcd_barrier_t<true, NoWork>(bar, wid == 0 && lane_id() == 0, false, NoWork{});
#define GRID_BAR_W(s) do { if (l + 1 < DEPTH && early1) { const NextLayerCvt wk_{args.in[1] + (size_t)(l + 1) * DM * 11032, args.in[3] + (size_t)(l + 1) * 2 * 4096 * 128, args.ws, ldc, (s) * 7 * G + 7 * bx + wid - 1, wid}; \
        xcd_barrier_t<false, NextLayerCvt>(bar, wid == 0 && lane_id() == 0, wid != 0, wk_); } else GRID_BAR(); } while (0)
#define PHASE_PTRS() GAS unsigned char* wsg_ = (GAS unsigned char*)args.ws; asm volatile("" : "+s"(wsg_)); unsigned char* ws = (unsigned char*)wsg_; gu32* ctl = (gu32*)(ws + WS_CTL); (void)ctl; const float* x_in = args.in[0]; (void)x_in; \
    bf16* WIN = (bf16*)(ws + (l ? WS_WIN1 : WS_WIN)); bf16* WBRA = (bf16*)(ws + WS_WBRA); bf16* WBRB = (bf16*)(ws + WS_WBRB); bf16* WBRC = (bf16*)(ws + WS_WBRC); bf16* WOUT = (bf16*)(ws + WS_WOUT); \
    bf16* WGU = (bf16*)(ws + WS_WGU); bf16* WD = (bf16*)(ws + WS_WD); bf16* WCMP = (bf16*)(ws + (l ? WS_WCMP1 : WS_WCMP)); \
    bf16* XB = (bf16*)(ws + WS_XB); bf16* Z = (bf16*)(ws + WS_Z); bf16* OA = (bf16*)(ws + WS_OA); float* MG = (float*)(ws + WS_MG); bf16* MB = (bf16*)(ws + WS_MB); \
    float* X1 = (float*)(ws + WS_X1); bf16* HB = (bf16*)(ws + WS_H); bf16* XS = (bf16*)(ws + WS_XS); bf16* YB = (bf16*)(ws + WS_Y); \
    unsigned char* sm = ws + WS_SMALL; \
    bf16* KCMP = (bf16*)(sm + SM_KCMP); bf16* VCMP = (bf16*)(sm + SM_VCMP); float* KMEAN = (float*)(sm + SM_KMEAN); \
    int* tok_e = (int*)(sm + SM_TOKE); float* tok_w = (float*)(sm + SM_TOKW); int* tok_p = (int*)(sm + SM_TOKP); int* rowts = (int*)(sm + SM_ROWTS); float* roww = (float*)(sm + SM_ROWW); int* panel_e = (int*)(sm + SM_PANE); int* hist = (int*)(sm + SM_HIST); int* cntg = (int*)(sm + SM_CNTG); (void)hist; (void)cntg; \
    (void)WIN; (void)WBRA; (void)WBRB; (void)WBRC; (void)WOUT; (void)WGU; (void)WD; (void)WCMP; (void)XB; (void)Z; (void)OA; (void)MG; (void)MB; (void)X1; (void)HB; (void)XS; (void)YB; \
    (void)KCMP; (void)VCMP; (void)KMEAN; (void)tok_e; (void)tok_w; (void)tok_p; (void)rowts; (void)roww; (void)panel_e
    const float alpha = 1.4142135623730951f;
    const bool early1 = 4 * 7 * G >= CI_IN + CI_CMP;
    unsigned long long tacc = 0;

#define CVT_DECODE(IT, P) do { int r = (IT); (P).nc = 64; (P).f8 = 0; \
                if (r < CI_IN) { const int kb = r / 173, nb = r % 173; (P).W = w_in; (P).ldw = 11032; (P).k0 = 64 * kb; (P).WT = (unsigned char*)WIN; (P).ldt = DM; (P).f8 = 1; \
                    if (nb < 40) { (P).ns = 64 * nb; (P).nd = (P).ns; } else if (nb < 172) { (P).ns = 2584 + 64 * (nb - 40); (P).nd = 2560 + 64 * (nb - 40); } else { (P).ns = 2560; (P).nd = ZC_GA; (P).nc = 24; } } \
                else if ((r -= CI_IN) < CI_BRA) { (P).W = wbra; (P).ldw = DM; (P).k0 = 64 * (r / 32); (P).ns = 64 * (r % 32); (P).WT = (unsigned char*)WBRA; (P).ldt = DM; (P).nd = (P).ns; (P).f8 = 1; } \
                else if ((r -= CI_BRA) < CI_BRB) { (P).W = wbrb; (P).ldw = DM; (P).k0 = 64 * (r / 32); (P).ns = 64 * (r % 32); (P).WT = (unsigned char*)WBRA + 1024; (P).ldt = DM; (P).nd = (P).ns; (P).f8 = 1; } \
                else if ((r -= CI_BRB) < CI_BRC) { (P).W = wbrc; (P).ldw = DM; (P).k0 = 64 * (r / 32); (P).ns = 64 * (r % 32); (P).WT = (unsigned char*)WBRA + 1536; (P).ldt = DM; (P).nd = (P).ns; (P).f8 = 1; } \
                else if ((r -= CI_BRC) < CI_OUT) { (P).W = wout; (P).ldw = DM; (P).k0 = 64 * (r / 32); (P).ns = 64 * (r % 32); (P).WT = (unsigned char*)WOUT; (P).ldt = DM; (P).nd = (P).ns; (P).f8 = 1; } \
                else if ((r -= CI_OUT) < CI_GU) { const int mat = r >> 7, e = mat >> 1, which = mat & 1, rr = r & 127, f0 = 64 * (rr & 3); \
                    (P).W = (which ? wup : wgate) + (size_t)e * DM * DEXP; (P).ldw = DEXP; (P).k0 = 64 * (rr >> 2); (P).ns = f0; (P).WT = (unsigned char*)WGU; (P).ldt = DM; (P).nd = e * 512 + (f0 >> 7) * 256 + which * 128 + (f0 & 127); (P).f8 = 1; } \
                else if ((r -= CI_GU) < CI_D) { const int e = r >> 7, rr = r & 127; (P).W = wdown + (size_t)e * DEXP * DM; (P).ldw = DM; (P).k0 = 64 * (rr >> 5); (P).ns = 64 * (rr & 31); (P).WT = (unsigned char*)WD; (P).ldt = DEXP; (P).nd = e * DM + (P).ns; } \
                else { r -= CI_D; const int kv = r >> 7, rr = r & 127; (P).W = cmpw + (size_t)kv * 4096 * 128; (P).ldw = 128; (P).k0 = 64 * (rr >> 1); (P).ns = 64 * (rr & 1); (P).WT = (unsigned char*)WCMP; (P).ldt = 4096; (P).nd = kv * 128 + (P).ns; } } while (0)
#define CVT_PTRS() const float* w_in = args.in[1] + (size_t)l * DM * 11032; const float* cmpw = args.in[3] + (size_t)l * 2 * 4096 * 128; \
            const float* wbra = args.in[5] + (size_t)l * 1024 * DM; const float* wbrb = args.in[6] + (size_t)l * 512 * DM; const float* wbrc = args.in[7] + (size_t)l * 512 * DM; \
            const float* wout = args.in[8] + (size_t)l * DM * DM; \
            const float* wgate = args.in[15] + (size_t)l * NEXP * DM * DEXP; const float* wup = args.in[16] + (size_t)l * NEXP * DM * DEXP; const float* wdown = args.in[17] + (size_t)l * NEXP * DEXP * DM
    for (int l = 0; l < DEPTH; ++l) {
#if PHASES & 1
        if (l == 0 || !early1) for (int rep = 0; rep < 1 + ((DBL >> 0) & 1); ++rep) {
        unsigned long long tph_ = 0; if ((TMASK >> 0) & 1) tph_ = __builtin_amdgcn_s_memrealtime();
        { PHASE_IDS(); PHASE_PTRS();
            LAS unsigned* scr = (LAS unsigned*)(lds + RING_OFF + wid * 16384);
            CVT_PTRS();
#define P0_IT(j) ((j) < CI_IN ? (j) : (j) - CI_IN + (CI_TOTAL - CI_CMP))
            { CvtItem P, Pn; f32x4 cur[4][4], nxt[4][4]; int it = gw;
              CVT_DECODE(P0_IT(it), P); cvt_load(P, cur, lane);
              do { const int itn = it + NGW; const int itl = itn < CI_IN + CI_CMP ? itn : it;
                  CVT_DECODE(P0_IT(itl), Pn); cvt_load(Pn, nxt, lane);
                  cvt_finish(P, cur, FP8_WSCALE, scr, lane);
                  P = Pn;
#pragma unroll
                  for (int i = 0; i < 4; ++i)
#pragma unroll
                      for (int rr = 0; rr < 4; ++rr) cur[i][rr] = nxt[i][rr];
                  it = itn; } while (it < CI_IN + CI_CMP); }
#undef P0_IT
            for (int r = gw; r < 2 * CI_ZERO; r += NGW) { v4u* zp = (v4u*)(ws + (r >= CI_ZERO ? WS_WIN1 : WS_WIN) + (size_t)(11032 + (r >= CI_ZERO ? r - CI_ZERO : r)) * DM); const v4u z4 = __builtin_bit_cast(v4u, pg8::zero4());
#pragma unroll
                for (int q = 0; q < 2; ++q) zp[lane + 64 * q] = z4; }
            if (l == 0) for (int row = gw; row < NT; row += NGW) { const f32x4* xr = (const f32x4*)(x_in + (size_t)row * DM); f32x4 xv[8];
#pragma unroll
                for (int j = 0; j < 8; ++j) xv[j] = xr[lane + 64 * j];
                __builtin_amdgcn_sched_barrier(0);
#pragma unroll
                for (int j = 0; j < 8; ++j) ((unsigned*)((unsigned char*)XB + (size_t)row * DM))[lane + 64 * j] = pk4_fp8(xv[j], FP8_XSCALE); }
        }
        { unsigned long long tw_ = 0; if ((WMASK >> 0) & 1) tw_ = __builtin_amdgcn_s_memrealtime(); GRID_BAR(); if ((WMASK >> 0) & 1) tacc += __builtin_amdgcn_s_memrealtime() - tw_; } if ((TMASK >> 0) & 1) tacc += __builtin_amdgcn_s_memrealtime() - tph_; }
#endif
#if PHASES & 2
        for (int rep = 0; rep < 1 + ((DBL >> 1) & 1); ++rep) {
        unsigned long long tph_ = 0; if ((TMASK >> 1) & 1) tph_ = __builtin_amdgcn_s_memrealtime();
        { const bool split = (G == 256);
#pragma unroll 1
          for (int part = 0; part < 2; ++part) { PHASE_IDS(); PHASE_PTRS(); const float* pos = args.in[2] + (size_t)l * 2 * 4096;
              if (!(part == 1 && split && bx >= 128)) {
                  pg8::Gemm gm{XB, WIN, NT, ZP, DM / 2, DM / 2, FP8_SCA, FP8_SCB, wid, (EMASK >> 1) & 1}; pg8::RoundsOrder S; S.base.init(NT, ZP, G, bx); S.r_lo = part == 0 ? 0 : 5; S.r_hi = (part == 0 && split) ? 5 : (1 << 20);
                  pg8::EpiZ E{Z, ZP, ZC_GM / 256};
                  pg8::gemm_phase<pg8::EpiZ, pg8::RoundsOrder, true, true, true>(lds + RING_OFF, gm, S, E); }
              if (part == 1) {
                  gu32* pq = ctl + CW_QUEUE + 64 * (8 + l); LAS unsigned* uw = (LAS unsigned*)(ldc + att::A_UNI) + 2;
                  __syncthreads();
                  for (;;) {
                      if (wid == 0 && lane_id() == 0) *uw = __hip_atomic_fetch_add(pq, 1u, RLX_AGENT);
                      __syncthreads();
                      const unsigned qi = *uw;
                      __syncthreads();
                      if (qi >= 384u) break;
                      if (qi < 256u) cmp_unit((int)qi, Z, WCMP, pos, KCMP, VCMP, ldc, tid, lane, wid);
                      else kmean_unit((int)qi - 256, Z, KMEAN, ldc, tid, lane, wid); } }
              GRID_BAR(); } }
        if ((TMASK >> 1) & 1) tacc += __builtin_amdgcn_s_memrealtime() - tph_; }
#endif
#if PHASES & 8
        for (int rep = 0; rep < 1 + ((DBL >> 3) & 1); ++rep) {
        unsigned long long tph_ = 0; if ((TMASK >> 3) & 1) tph_ = __builtin_amdgcn_s_memrealtime();
        { PHASE_IDS(); PHASE_PTRS(); gu32* qw = ctl + CW_QUEUE + 64 * (2 * l + rep); const float* sink = args.in[4] + l * 8; CVT_PTRS();
          LAS unsigned* uw = (LAS unsigned*)(ldc + att::A_UNI) + 2;
          for (;;) {
              if (wid == 0 && lane_id() == 0) *uw = __hip_atomic_fetch_add(qw, 1u, RLX_AGENT);
              __syncthreads();
              const unsigned qi = *uw;
              __syncthreads();
              if (qi >= (unsigned)N_Q_UNITS) break;
              const int code = g_units.u[qi], kind = code >> 12;
              if (kind == 5) { ratio_unit(code & 0xfff, Z, wid); continue; }
              if (kind == 3) {
                  LAS unsigned* scr = (LAS unsigned*)(lds + RING_OFF + wid * 16384); const int ln = lane_id();
                  CvtItem P, Pn; f32x4 cur[4][4], nxt[4][4]; const int it0 = CI_IN + (code & 0xfff) * CVT_PER_UNIT + wid * (CVT_PER_UNIT / 8);
                  CVT_DECODE(it0, P); cvt_load(P, cur, ln);
#pragma unroll 1
                  for (int q = 0; q < CVT_PER_UNIT / 8; ++q) { const int itl = it0 + (q < CVT_PER_UNIT / 8 - 1 ? q + 1 : q);
                      CVT_DECODE(itl, Pn); cvt_load(Pn, nxt, ln);
                      cvt_finish(P, cur, FP8_WSCALE, scr, ln);
                      P = Pn;
#pragma unroll
                      for (int i = 0; i < 4; ++i)
#pragma unroll
                          for (int rr = 0; rr < 4; ++rr) cur[i][rr] = nxt[i][rr]; }
                  __syncthreads();
                  continue; }
              if (kind == 0) nsa_unit(code, Z, KCMP, VCMP, OA, ws + WS_OA8, ldc, 0, wid);
              else if (kind == 1) moba_unit(code, Z, KMEAN, OA, ws + WS_OA8, ldc, 0, wid);
              else swa_unit(code, Z, sink, OA, ws + WS_OA8, ldc, 0, wid);
          } }
        { unsigned long long tw_ = 0; if ((WMASK >> 3) & 1) tw_ = __builtin_amdgcn_s_memrealtime(); GRID_BAR_W(0); if ((WMASK >> 3) & 1) tacc += __builtin_amdgcn_s_memrealtime() - tw_; } if ((TMASK >> 3) & 1) tacc += __builtin_amdgcn_s_memrealtime() - tph_; }
#endif
#if PHASES & 16
        for (int rep = 0; rep < 1 + ((DBL >> 4) & 1); ++rep) {
        unsigned long long tph_ = 0; if ((TMASK >> 4) & 1) tph_ = __builtin_amdgcn_s_memrealtime();
        { PHASE_IDS(); PHASE_PTRS(); pg8::StaticOrder S; S.init(NT, DM, G, bx);
          pg8::Gemm gm{(const bf16*)(ws + WS_OA8), WBRA, NT, DM, DM / 2, DM / 2, 0x79797979, 0x79797979, wid, (EMASK >> 4) & 1}; pg8::EpiBrM<8, 12> E{MB, Z + ZC_GM, ZP};
          pg8::gemm_phase<pg8::EpiBrM<8, 12>, pg8::StaticOrder, true, true, true>(lds + RING_OFF, gm, S, E); }
        { unsigned long long tw_ = 0; if ((WMASK >> 4) & 1) tw_ = __builtin_amdgcn_s_memrealtime(); GRID_BAR_W(1); if ((WMASK >> 4) & 1) tacc += __builtin_amdgcn_s_memrealtime() - tw_; } if ((TMASK >> 4) & 1) tacc += __builtin_amdgcn_s_memrealtime() - tph_; }
#endif
#if PHASES & 32
        for (int rep = 0; rep < 1 + ((DBL >> 5) & 1); ++rep) {
        unsigned long long tph_ = 0; if ((TMASK >> 5) & 1) tph_ = __builtin_amdgcn_s_memrealtime();
        { PHASE_IDS(); PHASE_PTRS(); pg8::Gemm gm{MB, WOUT, NT, DM, DM / 2, DM / 2, 0x79797979, 0x79797979, wid, (EMASK >> 5) & 1}; pg8::StaticOrder S; S.init(NT, DM, G, bx);
          pg8::EpiRes E{MG, l == 0 ? x_in : (const float*)X1, alpha};
          pg8::gemm_phase<pg8::EpiRes, pg8::StaticOrder, true, true, true>(lds + RING_OFF, gm, S, E); }
        { unsigned long long tw_ = 0; if ((WMASK >> 5) & 1) tw_ = __builtin_amdgcn_s_memrealtime(); GRID_BAR_W(2); if ((WMASK >> 5) & 1) tacc += __builtin_amdgcn_s_memrealtime() - tw_; } if ((TMASK >> 5) & 1) tacc += __builtin_amdgcn_s_memrealtime() - tph_; }
#endif
#if PHASES & 64
        for (int rep = 0; rep < 1 + ((DBL >> 6) & 1); ++rep) {
        unsigned long long tph_ = 0; if ((TMASK >> 6) & 1) tph_ = __builtin_amdgcn_s_memrealtime();
        { PHASE_IDS(); PHASE_PTRS(); const float* g1 = args.in[9] + l * DM; const float* b1 = args.in[10] + l * DM;
          const float* wgrp = args.in[11] + (size_t)l * DM * 4; const float* bgrp = args.in[12] + l * 4; const float* wrt = args.in[13] + (size_t)l * DM * 32; const float* brt = args.in[14] + l * 32;
          for (int t = bx; t < NT / 32; t += G) ln_router_tile(t, MG, g1, b1, (float*)((char*)MG + 32 * MiB), MB, wgrp, bgrp, wrt, brt, hist, tok_e, tok_w, tok_p, ldc, tid, lane, wid); }
        { unsigned long long tw_ = 0; if ((WMASK >> 6) & 1) tw_ = __builtin_amdgcn_s_memrealtime(); GRID_BAR_W(3); if ((WMASK >> 6) & 1) tacc += __builtin_amdgcn_s_memrealtime() - tw_; } if ((TMASK >> 6) & 1) tacc += __builtin_amdgcn_s_memrealtime() - tph_; }
#endif
#if PHASES & 128
        for (int rep = 0; rep < 1 + ((DBL >> 7) & 1); ++rep) {
        unsigned long long tph_ = 0; if ((TMASK >> 7) & 1) tph_ = __builtin_amdgcn_s_memrealtime();
        { PHASE_IDS(); PHASE_PTRS();
          const LAS int* off_l = (const LAS int*)ldc; const LAS int* cnt_l = (const LAS int*)(ldc + 256); const LAS int* pre_l = (const LAS int*)(ldc + 512);
          for (int tile = bx; tile < NT / 32; tile += G) {
              const int total = moe_offsets_hist(hist, tile, ldc, tid);
              if (tile == bx) {
                  for (int r = bx * NTHR + tid; r < total; r += G * NTHR) { int e = 0;
                      for (int kk = 1; kk < 32; ++kk) if (off_l[kk] <= r) e = kk;
                      if (r >= off_l[e] + cnt_l[e]) { rowts[r] = -1; roww[r] = 0.f; }
                      if ((r & 255) == 0) panel_e[r >> 8] = e; }
                  if (bx == 0 && tid < 32) cntg[tid] = cnt_l[tid]; }
              { int rowq[8], te[8], tp[8]; float tw[8]; v4u dat[8][2]; const int p0_ = tile * 64 + wid * 8;
#pragma unroll
                for (int q = 0; q < 8; ++q) { te[q] = tok_e[p0_ + q]; tp[q] = tok_p[p0_ + q]; tw[q] = tok_w[p0_ + q]; }
#pragma unroll
                for (int q = 0; q < 8; ++q) { const v4u* src = (const v4u*)((const unsigned char*)MB + (size_t)((p0_ + q) >> 1) * DM); dat[q][0] = src[lane]; dat[q][1] = src[lane + 64]; }
                __builtin_amdgcn_sched_barrier(0);
#pragma unroll
                for (int q = 0; q < 8; ++q) rowq[q] = off_l[te[q]] + pre_l[te[q]] + tp[q];
#pragma unroll
                for (int q = 0; q < 8; ++q) { v4u* dst = (v4u*)((unsigned char*)XS + (size_t)rowq[q] * DM); dst[lane] = dat[q][0]; dst[lane + 64] = dat[q][1];
                    if (lane == 0) { rowts[rowq[q]] = p0_ + q; roww[rowq[q]] = tw[q]; } } }
              __syncthreads(); }
          __syncthreads(); }
        { unsigned long long tw_ = 0; if ((WMASK >> 7) & 1) tw_ = __builtin_amdgcn_s_memrealtime(); GRID_BAR(); if ((WMASK >> 7) & 1) tacc += __builtin_amdgcn_s_memrealtime() - tw_; } if ((TMASK >> 7) & 1) tacc += __builtin_amdgcn_s_memrealtime() - tph_; }
#endif
#if PHASES & 256
        for (int rep = 0; rep < 1 + ((DBL >> 8) & 1); ++rep) {
        unsigned long long tph_ = 0; if ((TMASK >> 8) & 1) tph_ = __builtin_amdgcn_s_memrealtime();
        { PHASE_IDS(); PHASE_PTRS();
          const int total = moe_offsets(cntg, ldc, tid);
          __syncthreads();
          pg8::Gemm gm{XS, WGU, ROWCAP, NEXP * 512, DM / 2, DM / 2, FP8_SCA, FP8_SCB, wid, (EMASK >> 8) & 1}; pg8::MoeOrder<2> S{(total >> 8) * 2, G, bx, panel_e};
          pg8::EpiGU E{HB, roww};
          pg8::gemm_phase<pg8::EpiGU, pg8::MoeOrder<2>, true, true, true>(lds + RING_OFF, gm, S, E); }
        { unsigned long long tw_ = 0; if ((WMASK >> 8) & 1) tw_ = __builtin_amdgcn_s_memrealtime(); GRID_BAR(); if ((WMASK >> 8) & 1) tacc += __builtin_amdgcn_s_memrealtime() - tw_; } if ((TMASK >> 8) & 1) tacc += __builtin_amdgcn_s_memrealtime() - tph_; }
#endif
#if PHASES & 512
        for (int rep = 0; rep < 1 + ((DBL >> 9) & 1); ++rep) {
        unsigned long long tph_ = 0; if ((TMASK >> 9) & 1) tph_ = __builtin_amdgcn_s_memrealtime();
        { PHASE_IDS(); PHASE_PTRS();
          const int total = moe_offsets(cntg, ldc, tid);
          __syncthreads();
          pg8::Gemm gm{HB, WD, ROWCAP, NEXP * DM, DEXP, DEXP, 0x7f7f7f7f, 0x7f7f7f7f, wid, (EMASK >> 9) & 1}; pg8::MoeOrder<8> S{(total >> 8) * 8, G, bx, panel_e};
          pg8::EpiDown E{XS, (unsigned)((WS_Y - WS_XS) / 2), rowts};
          pg8::gemm_phase<pg8::EpiDown, pg8::MoeOrder<8>, true, true>(lds + RING_OFF, gm, S, E); }
        { unsigned long long tw_ = 0; if ((WMASK >> 9) & 1) tw_ = __builtin_amdgcn_s_memrealtime(); GRID_BAR(); if ((WMASK >> 9) & 1) tacc += __builtin_amdgcn_s_memrealtime() - tw_; } if ((TMASK >> 9) & 1) tacc += __builtin_amdgcn_s_memrealtime() - tph_; }
#endif
#if PHASES & 1024
        for (int rep = 0; rep < 1 + (((DBL >> 10) & 1) && l == DEPTH - 1 ? 1 : 0); ++rep) {
        unsigned long long tph_ = 0; if ((TMASK >> 10) & 1) tph_ = __builtin_amdgcn_s_memrealtime();
        { PHASE_IDS(); PHASE_PTRS(); const float* g2 = args.in[18] + l * DM; const float* b2 = args.in[19] + l * DM; const bool last = (l == DEPTH - 1); float* xo = last ? args.out : X1;
          for (int row = gw; row < NT; row += NGW) { f32x4 v[8]; v2u aw[8], y0[8], y1[8];
#pragma unroll
              for (int j = 0; j < 8; ++j) { aw[j] = ((const v2u*)((const char*)MG + 32 * MiB + (size_t)row * (DM * 2)))[lane + 64 * j];
                  y0[j] = ((const v2u*)(YB + (size_t)row * DM))[lane + 64 * j]; y1[j] = ((const v2u*)(YB + ((size_t)NT + row) * DM))[lane + 64 * j]; }
              __builtin_amdgcn_sched_barrier(0);
#pragma unroll
              for (int j = 0; j < 8; ++j) { const f32x4 a = {bflo(aw[j].x), bfhi(aw[j].x), bflo(aw[j].y), bfhi(aw[j].y)};
                  v[j][0] = a[0] * alpha + (bflo(y0[j].x) + bflo(y1[j].x)); v[j][1] = a[1] * alpha + (bfhi(y0[j].x) + bfhi(y1[j].x));
                  v[j][2] = a[2] * alpha + (bflo(y0[j].y) + bflo(y1[j].y)); v[j][3] = a[3] * alpha + (bfhi(y0[j].y) + bfhi(y1[j].y)); }
              ln_row(v, g2, b2, lane);
#pragma unroll
              for (int j = 0; j < 8; ++j) { ((f32x4*)(xo + (size_t)row * DM))[lane + 64 * j] = v[j];
                  if (!last) ((unsigned*)((unsigned char*)XB + (size_t)row * DM))[lane + 64 * j] = pk4_fp8(v[j], FP8_XSCALE); } } }
        if (l + 1 < DEPTH) GRID_BAR(); if ((TMASK >> 10) & 1) tacc += __builtin_amdgcn_s_memrealtime() - tph_; }
#endif
    }
    if ((EMASK != 0 || FMASK != 0) && blockIdx.x == 0 && wid == 0 && lane_id() == 0) tacc += *(LAS unsigned long long*)(lds + MISC_OFF + 64);
    if ((TMASK != 0 || EMASK != 0 || WMASK != 0 || FMASK != 0) && blockIdx.x == 0 && wid == 0 && lane_id() == 0) { const unsigned long long t0_ = __builtin_amdgcn_s_memrealtime(); while (__builtin_amdgcn_s_memrealtime() - t0_ < 4ull * tacc) __builtin_amdgcn_s_sleep(8); }
}

extern "C" void kernel_launch(void* const* d_in, const int* in_sizes, int n_in, void* d_out, int out_size, void* d_ws, size_t ws_size, hipStream_t stream) {
    static int grid = 0;
    if (grid == 0) {
        if (n_in != 20 || in_sizes[0] != NT * DM || out_size != NT * DM || ws_size < WS_END) { fprintf(stderr, "kernel_launch: unexpected shapes (n_in %d, in0 %d, out %d, ws %zu < %zu?)\n", n_in, n_in > 0 ? in_sizes[0] : -1, out_size, ws_size, (size_t)WS_END); grid = -1; return; }
        int dev = 0, cus = 0, per_cu = 0;
        if (hipGetDevice(&dev) != hipSuccess || hipDeviceGetAttribute(&cus, hipDeviceAttributeMultiprocessorCount, dev) != hipSuccess) { grid = -1; return; }
        if (hipFuncSetAttribute((const void*)fwd_kernel, hipFuncAttributeMaxDynamicSharedMemorySize, LDS_BYTES) != hipSuccess) { fprintf(stderr, "kernel_launch: hipFuncSetAttribute failed\n"); grid = -1; return; }
        if (hipOccupancyMaxActiveBlocksPerMultiprocessor(&per_cu, (const void*)fwd_kernel, NTHR, LDS_BYTES) != hipSuccess || per_cu < 1) fprintf(stderr, "kernel_launch: occupancy query reports %d\n", per_cu);
        (void)hipGetLastError();
        grid = cus;
    }
    if (grid < 0) return;
    if (hipMemsetAsync((char*)d_ws + WS_CTL, 0, CTL_ZERO_BYTES, stream) != hipSuccess) return;
    Args a{};
    for (int i = 0; i < 20; ++i) a.in[i] = (const float*)d_in[i];
    a.out = (float*)d_out; a.ws = (unsigned char*)d_ws;
    hipLaunchKernelGGL(fwd_kernel, dim3(grid), dim3(NTHR), LDS_BYTES, stream, a);
    const hipError_t le = hipPeekAtLastError();
    if (le != hipSuccess) fprintf(stderr, "kernel_launch: launch failed: %s\n", hipGetErrorName(le));
}
```

```cpp
#include <hip/hip_runtime.h>
#include <cstdio>
#include <cstdint>
#define FMASK 0
#define UMASK 0
#ifndef EMASK
#define EMASK 0
#endif
namespace pg8 {
#define PG8_LAS __attribute__((address_space(3)))
typedef unsigned short bf16_t;
typedef short bf16x8 __attribute__((ext_vector_type(8)));
typedef float f32x4 __attribute__((ext_vector_type(4)));
typedef unsigned u32x4 __attribute__((ext_vector_type(4)));
constexpr int BM = 256, BK = 64, HALF = 128, HTB = HALF * BK * 2  , STAGE_BYTES = 8 * HTB, NXCD = 8, WGM = 8;

__host__ __device__ __forceinline__ int lds_byte(int r, int c) { const int st = (r >> 4) * 2 + (c >> 5), rr = r & 15, cc = c & 31, ob = rr * 64 + cc * 2; return st * 1024 + (ob ^ (((ob >> 9) & 1) << 5)); }
__host__ __device__ __forceinline__ void stage_rc(int b, int& R, int& C) { const int st = b / 1024, sb = b % 1024, swz = sb ^ (((sb >> 9) & 1) << 5); R = (st >> 1) * 16 + swz / 64; C = (st & 1) * 32 + (swz % 64) / 2; }
__host__ __device__ __forceinline__ int perm32(int rho) { const int n = rho >> 4, i = rho & 15; return 8 * (i >> 2) + 4 * n + (i & 3); }

struct Unit { int pm, pn; };
struct Gemm { const bf16_t* A; const bf16_t* Bt; int M, N, K, lda; int sca = 0x7f7f7f7f, scb = 0x7f7f7f7f; int wid = 0; int tp = 0; };
typedef int i32x8 __attribute__((ext_vector_type(8)));

struct StaticOrder {
    int nM, nN, nwg, G, c;
    __host__ __device__ void init(int M, int N, int G_, int c_) { nM = M / BM; nN = N / BM; nwg = nM * nN; G = G_; c = c_; }
    __host__ __device__ bool next(int i, Unit& u) const {
        const long L = (long)i * G + c; if (L >= nwg) return false;
        int wgid = (int)L; { const int q = nwg / NXCD, r = nwg % NXCD, xcd = wgid % NXCD, off = wgid / NXCD; wgid = (xcd < r ? xcd * (q + 1) : r * (q + 1) + (xcd - r) * q) + off; }
        const int nig = WGM * nN, gid = wgid / nig, fm = gid * WGM, gsz = (nM - fm) < WGM ? (nM - fm) : WGM;
        u.pm = fm + ((wgid % nig) % gsz); u.pn = (wgid % nig) / gsz; return true;
    }
    __device__ __forceinline__ void a_ready(const Unit&) const {}
    __device__ __forceinline__ void done(const Unit&) const {}
};
__device__ __forceinline__ unsigned cvt_pk_bf16(float lo, float hi) { unsigned r; asm volatile("v_cvt_pk_bf16_f32 %0, %1, %2" : "=v"(r) : "v"(lo), "v"(hi)); return r; }
__device__ __forceinline__ float bf_lo(unsigned w) { return __uint_as_float(w << 16); }
__device__ __forceinline__ float bf_hi(unsigned w) { return __uint_as_float(w & 0xffff0000u); }
__device__ __forceinline__ float sigmoidf_(float x) { return __builtin_amdgcn_rcpf(1.0f + __builtin_amdgcn_exp2f(-1.4426950408889634f * x)); }
typedef unsigned u32x2 __attribute__((ext_vector_type(2)));
__device__ __forceinline__ unsigned cvt_pk4_fp8(f32x4 v, float s) { int w = 0; w = __builtin_amdgcn_cvt_pk_fp8_f32(v[0] * s, v[1] * s, w, false); w = __builtin_amdgcn_cvt_pk_fp8_f32(v[2] * s, v[3] * s, w, true); return (unsigned)w; }

struct EpiZ {
    static constexpr bool PERM = false, AFTER_DRAIN = false, HOOK = false; static constexpr int HK0 = -1, HK1 = -1;
    bf16_t* O; int ldc; int sig_from;
    __device__ __forceinline__ void operator()(const f32x4 (&acc)[2][2][4][2], const Unit& u, int wr, int wc, int, int) const {
        int t_; asm volatile("v_mbcnt_lo_u32_b32 %0, -1, 0\n\tv_mbcnt_hi_u32_b32 %0, -1, %0" : "=v"(t_)); const int fr = t_ & 15, fq = (t_ >> 4) & 3;
        const int row0 = u.pm * BM + wr * 64 + fr, col0 = u.pn * BM + wc * 32 + 8 * (fq >> 1) + 16 * (fq & 1); const bool sg = u.pn >= sig_from;
        unsigned eo = (unsigned)row0 * (unsigned)ldc + (unsigned)col0;
#pragma unroll
        for (int ai = 0; ai < 2; ++ai)
#pragma unroll
            for (int m = 0; m < 4; ++m) { asm volatile("" : "+v"(eo)); bf16_t* rowp = O + eo; eo += (unsigned)((m == 3 ? HALF - 48 : 16) * ldc);
#pragma unroll
                for (int bj = 0; bj < 2; ++bj) { u32x2 w[2];
#pragma unroll
                    for (int n = 0; n < 2; ++n) { f32x4 v = acc[ai][bj][m][n];
                        if (sg) {
#pragma unroll
                            for (int j = 0; j < 4; ++j) v[j] = sigmoidf_(v[j]); }
                        w[n].x = cvt_pk_bf16(v[0], v[1]); w[n].y = cvt_pk_bf16(v[2], v[3]); }
                    const auto rx = __builtin_amdgcn_permlane16_swap(w[0].x, w[1].x, false, false), ry = __builtin_amdgcn_permlane16_swap(w[0].y, w[1].y, false, false);
                    u32x4 o; o.x = rx[0]; o.y = ry[0]; o.z = rx[1]; o.w = ry[1];
                    *(u32x4*)(rowp + bj * HALF) = o; }
                asm volatile("" ::: "memory"); }
    }
};
template <int H0, int H1> struct EpiBrM {
    static constexpr bool PERM = false, AFTER_DRAIN = false, HOOK = true; static constexpr int HK0 = H0, HK1 = H1;
    bf16_t* MB; const bf16_t* Zg; int ldz;
    __device__ __forceinline__ void mid(f32x4 (&acc)[2][2][4][2], const Unit& u, int wr, int wc, int, int, int kt) const {
        int t_; asm volatile("v_mbcnt_lo_u32_b32 %0, -1, 0\n\tv_mbcnt_hi_u32_b32 %0, -1, %0" : "=v"(t_)); const int fr = t_ & 15, fq = (t_ >> 4) & 3;
        const int row0 = u.pm * BM + wr * 64 + fr, col0 = u.pn * BM + wc * 32 + 8 * (fq >> 1) + 16 * (fq & 1); const bf16_t* zs = Zg + (kt == HK0 ? 0 : 2048);
        unsigned eo = (unsigned)row0 * (unsigned)ldz + (unsigned)col0; asm volatile("" : "+v"(eo));
        u32x4 ga[4][2];
#define BRM_LD(G) do { const bf16_t* zr_ = zs + eo + (unsigned)((((G) >> 2) * HALF + ((G) & 3) * 16) * ldz); ga[(G) & 3][0] = *(const u32x4*)zr_; ga[(G) & 3][1] = *(const u32x4*)(zr_ + HALF); } while (0)
        BRM_LD(0); BRM_LD(1); BRM_LD(2); BRM_LD(3);
#pragma unroll
        for (int g = 0; g < 8; ++g) { const int ai = g >> 2, m = g & 3; u32x4 cur[2]; cur[0] = ga[g & 3][0]; cur[1] = ga[g & 3][1];
            asm volatile("" : "+v"(cur[0]), "+v"(cur[1]));
            if (g + 4 < 8) { if (g == 0) BRM_LD(4); else if (g == 1) BRM_LD(5); else if (g == 2) BRM_LD(6); else BRM_LD(7); }
#pragma unroll
            for (int bj = 0; bj < 2; ++bj) { const u32x4 o = cur[bj];
                const auto rx = __builtin_amdgcn_permlane16_swap(o.x, o.z, false, false), ry = __builtin_amdgcn_permlane16_swap(o.y, o.w, false, false);
#pragma unroll
                for (int n = 0; n < 2; ++n) { const unsigned ax = rx[n], ay = ry[n]; f32x4 v = acc[ai][bj][m][n];
                    v[0] *= bf_lo(ax); v[1] *= bf_hi(ax); v[2] *= bf_lo(ay); v[3] *= bf_hi(ay);
                    acc[ai][bj][m][n] = v; } } }
#undef BRM_LD
    }
    __device__ __forceinline__ void operator()(const f32x4 (&acc)[2][2][4][2], const Unit& u, int wr, int wc, int, int) const {
        int t_; asm volatile("v_mbcnt_lo_u32_b32 %0, -1, 0\n\tv_mbcnt_hi_u32_b32 %0, -1, %0" : "=v"(t_)); const int fr = t_ & 15, fq = (t_ >> 4) & 3;
        const int row0 = u.pm * BM + wr * 64 + fr, col0 = u.pn * BM + wc * 32 + 8 * (fq >> 1) + 16 * (fq & 1);
        unsigned eo = (unsigned)row0 * (unsigned)ldz + (unsigned)col0, mo = (unsigned)row0 * 2048u + (unsigned)col0; asm volatile("" : "+v"(eo), "+v"(mo));
        u32x4 gw[4][2];
#define BRM_LD(G) do { const bf16_t* zr_ = Zg + eo + (unsigned)((((G) >> 2) * HALF + ((G) & 3) * 16) * ldz) + 4096; gw[(G) & 3][0] = *(const u32x4*)zr_; gw[(G) & 3][1] = *(const u32x4*)(zr_ + HALF); } while (0)
        BRM_LD(0); BRM_LD(1); BRM_LD(2); BRM_LD(3);
#pragma unroll
        for (int g = 0; g < 8; ++g) { const int ai = g >> 2, m = g & 3; u32x4 cur[2]; cur[0] = gw[g & 3][0]; cur[1] = gw[g & 3][1];
            asm volatile("" : "+v"(cur[0]), "+v"(cur[1]));
            if (g + 4 < 8) { if (g == 0) BRM_LD(4); else if (g == 1) BRM_LD(5); else if (g == 2) BRM_LD(6); else BRM_LD(7); }
#pragma unroll
            for (int bj = 0; bj < 2; ++bj) { const u32x4 o = cur[bj];
                const auto rx = __builtin_amdgcn_permlane16_swap(o.x, o.z, false, false), ry = __builtin_amdgcn_permlane16_swap(o.y, o.w, false, false);
                unsigned f8[2];
#pragma unroll
                for (int n = 0; n < 2; ++n) { const unsigned gx = rx[n], gy = ry[n]; f32x4 v = acc[ai][bj][m][n];
                    v[0] *= bf_lo(gx); v[1] *= bf_hi(gx); v[2] *= bf_lo(gy); v[3] *= bf_hi(gy);
                    f8[n] = cvt_pk4_fp8(v, 64.f); }
                const auto rs = __builtin_amdgcn_permlane16_swap(f8[0], f8[1], false, false);
                u32x2 ow; ow.x = rs[0]; ow.y = rs[1];
                *(u32x2*)((unsigned char*)MB + mo + (unsigned)((ai * HALF + m * 16) * 2048) + bj * HALF) = ow; } }
#undef BRM_LD
    }
};
struct EpiRes {
    static constexpr bool PERM = false, AFTER_DRAIN = false, HOOK = false; static constexpr int HK0 = -1, HK1 = -1;
    float* R; const float* xres; float alpha; int xbf;
    __device__ __forceinline__ void operator()(const f32x4 (&acc)[2][2][4][2], const Unit& u, int wr, int wc, int, int) const {
        int t_; asm volatile("v_mbcnt_lo_u32_b32 %0, -1, 0\n\tv_mbcnt_hi_u32_b32 %0, -1, %0" : "=v"(t_)); const int fr = t_ & 15, fq = (t_ >> 4) & 3;
        const int row0 = u.pm * BM + wr * 64 + fr, col0 = u.pn * BM + wc * 32 + 4 * fq;
        const unsigned wsh = (unsigned)((8 * (fq >> 1) + 16 * (fq & 1) - 4 * fq) * 2);
        unsigned eo = (unsigned)row0 * 2048u + (unsigned)col0;
#pragma unroll
        for (int ai = 0; ai < 2; ++ai)
#pragma unroll
            for (int mh = 0; mh < 2; ++mh) { unsigned bo = eo * 4u; asm volatile("" : "+v"(bo)); f32x4 xr[2][2][2];
                if (xbf) {
                    u32x4 xb[2][2];
#pragma unroll
                    for (int m2 = 0; m2 < 2; ++m2)
#pragma unroll
                        for (int bj = 0; bj < 2; ++bj) xb[m2][bj] = *(const u32x4*)((const char*)xres + (bo >> 1) + wsh + (unsigned)((m2 * 16 * 2048 + bj * HALF) * 2));
#pragma unroll
                    for (int m2 = 0; m2 < 2; ++m2)
#pragma unroll
                        for (int bj = 0; bj < 2; ++bj) { const auto qx = __builtin_amdgcn_permlane16_swap(xb[m2][bj].x, xb[m2][bj].z, false, false), qy = __builtin_amdgcn_permlane16_swap(xb[m2][bj].y, xb[m2][bj].w, false, false);
#pragma unroll
                            for (int n = 0; n < 2; ++n) xr[m2][bj][n] = (f32x4){bf_lo(qx[n]), bf_hi(qx[n]), bf_lo(qy[n]), bf_hi(qy[n])}; }
                } else {
#pragma unroll
                for (int m2 = 0; m2 < 2; ++m2)
#pragma unroll
                    for (int bj = 0; bj < 2; ++bj)
#pragma unroll
                        for (int n = 0; n < 2; ++n) xr[m2][bj][n] = *(const f32x4*)((const char*)xres + bo + (unsigned)((m2 * 16 * 2048 + bj * HALF + n * 16) * 4));
                }
#pragma unroll
                for (int m2 = 0; m2 < 2; ++m2)
#pragma unroll
                    for (int bj = 0; bj < 2; ++bj) { u32x2 w[2];
#pragma unroll
                        for (int n = 0; n < 2; ++n) { const f32x4 rv = xr[m2][bj][n] * alpha + acc[ai][bj][2 * mh + m2][n]; w[n].x = cvt_pk_bf16(rv[0], rv[1]); w[n].y = cvt_pk_bf16(rv[2], rv[3]); }
                        const auto rx = __builtin_amdgcn_permlane16_swap(w[0].x, w[1].x, false, false), ry = __builtin_amdgcn_permlane16_swap(w[0].y, w[1].y, false, false);
                        u32x4 o; o.x = rx[0]; o.y = ry[0]; o.z = rx[1]; o.w = ry[1];
                        *(u32x4*)((char*)R + (bo >> 1) + wsh + (unsigned)((m2 * 16 * 2048 + bj * HALF) * 2)) = o; }
                eo += (unsigned)((mh == 1 ? HALF - 32 : 32) * 2048); asm volatile("" ::: "memory"); }
    }
};
struct EpiGU {
    static constexpr bool PERM = false, AFTER_DRAIN = false, HOOK = false; static constexpr int HK0 = -1, HK1 = -1;
    bf16_t* H; const float* roww;
    __device__ __forceinline__ void operator()(const f32x4 (&acc)[2][2][4][2], const Unit& u, int wr, int wc, int, int) const {
        int t_; asm volatile("v_mbcnt_lo_u32_b32 %0, -1, 0\n\tv_mbcnt_hi_u32_b32 %0, -1, %0" : "=v"(t_)); const int fr = t_ & 15, fq = (t_ >> 4) & 3;
        const int row0 = u.pm * BM + wr * 64 + fr, col0 = (u.pn & 1) * HALF + wc * 32 + 8 * (fq >> 1) + 16 * (fq & 1);
        float wrow[2][4];
#pragma unroll
        for (int ai = 0; ai < 2; ++ai)
#pragma unroll
            for (int m = 0; m < 4; ++m) { unsigned wo = (unsigned)(row0 + ai * HALF + m * 16) * 4u; asm volatile("" : "+v"(wo)); wrow[ai][m] = *(const float*)((const char*)roww + wo); }
#pragma unroll
        for (int ai = 0; ai < 2; ++ai)
#pragma unroll
            for (int m = 0; m < 4; ++m) { const int row = row0 + ai * HALF + m * 16; const float w = wrow[ai][m];
                unsigned long long ho = (unsigned long long)((unsigned)row * 256u + (unsigned)col0) * 2ull; asm volatile("" : "+v"(ho));
                u32x2 hw[2];
#pragma unroll
                for (int n = 0; n < 2; ++n) { const f32x4 gt = acc[ai][0][m][n], up = acc[ai][1][m][n]; f32x4 h;
#pragma unroll
                    for (int j = 0; j < 4; ++j) h[j] = gt[j] * sigmoidf_(gt[j]) * up[j] * w;
                    hw[n].x = cvt_pk_bf16(h[0], h[1]); hw[n].y = cvt_pk_bf16(h[2], h[3]); }
                { const auto rx = __builtin_amdgcn_permlane16_swap(hw[0].x, hw[1].x, false, false), ry = __builtin_amdgcn_permlane16_swap(hw[0].y, hw[1].y, false, false);
                  u32x4 o; o.x = rx[0]; o.y = ry[0]; o.z = rx[1]; o.w = ry[1];
                  *(u32x4*)((char*)H + ho) = o; }
                asm volatile("" ::: "memory"); }
    }
};
struct EpiDown {
    static constexpr bool PERM = true, AFTER_DRAIN = false, HOOK = false; static constexpr int HK0 = -1, HK1 = -1;
    bf16_t* dump; unsigned yoff; const int* rowts;
    __device__ __forceinline__ void operator()(const f32x4 (&acc)[2][2][4][2], const Unit& u, int wr, int wc, int, int) const {
        int t_; asm volatile("v_mbcnt_lo_u32_b32 %0, -1, 0\n\tv_mbcnt_hi_u32_b32 %0, -1, %0" : "=v"(t_)); const int fr = t_ & 15, fq = (t_ >> 4) & 3;
        const int row0 = u.pm * BM + wr * 64 + fr, col0 = (u.pn & 7) * BM + wc * 32 + 8 * fq;
        int tsr[2][4];
#pragma unroll
        for (int ai = 0; ai < 2; ++ai)
#pragma unroll
            for (int m = 0; m < 4; ++m) tsr[ai][m] = rowts[row0 + ai * HALF + m * 16];
#pragma unroll
        for (int ai = 0; ai < 2; ++ai)
#pragma unroll
            for (int m = 0; m < 4; ++m) { const int row = row0 + ai * HALF + m * 16; const int ts = tsr[ai][m];
                const unsigned eo = (ts >= 0 ? yoff + (unsigned)((ts & 1) * 8192 + (ts >> 1)) * 2048u : (unsigned)row * 2048u) + (unsigned)col0;
                bf16_t* rowp = dump + eo;
                if (ts >= 0) {
#pragma unroll
                for (int bj = 0; bj < 2; ++bj) { const f32x4 v0 = acc[ai][bj][m][0], v1 = acc[ai][bj][m][1];
                    u32x4 w; w.x = cvt_pk_bf16(v0[0], v0[1]); w.y = cvt_pk_bf16(v0[2], v0[3]); w.z = cvt_pk_bf16(v1[0], v1[1]); w.w = cvt_pk_bf16(v1[2], v1[3]);
                    *(u32x4*)(rowp + bj * HALF) = w; } }
                asm volatile("" ::: "memory"); }
    }
};
struct RoundsOrder { StaticOrder base; int r_lo, r_hi;
    __device__ __forceinline__ bool next(int i, Unit& u) const { return i + r_lo < r_hi && base.next(i + r_lo, u); }
    __device__ __forceinline__ void a_ready(const Unit&) const {}
    __device__ __forceinline__ void done(const Unit&) const {} };
template <int NPER> struct MoeOrder {
    int total, G, c; const int* panel_e;
    __device__ __forceinline__ bool next(int i, Unit& u) const { int L = i * G + c; if (L >= total) return false;
        { const int q = total / NXCD, r = total % NXCD, xcd = L % NXCD, off = L / NXCD; L = (xcd < r ? xcd * (q + 1) : r * (q + 1) + (xcd - r) * q) + off; }
        const int pm = L / NPER; u.pm = pm; u.pn = panel_e[pm] * NPER + (L % NPER); return true; }
    __device__ __forceinline__ void a_ready(const Unit&) const {}
    __device__ __forceinline__ void done(const Unit&) const {}
};

__device__ __forceinline__ f32x4 zero4() { float z = 0.f; asm volatile("" : "+v"(z)); return (f32x4){z, z, z, z}; }
template <bool F8> struct Frags { bf16x8 At[4][2], B0[2][2], B1[2][2]; };
template <> struct Frags<true> { i32x8 At8[4], B08[2], B18[2]; };
template <class Epi, class Sched, bool ALIGN_EPI = false, bool SP2 = false, bool FP8 = false>
__device__ __forceinline__ void gemm_phase(PG8_LAS unsigned char* lds, const Gemm g, const Sched& S, const Epi& E) {
    int lane_; asm volatile("v_mbcnt_lo_u32_b32 %0, -1, 0\n\tv_mbcnt_hi_u32_b32 %0, -1, %0" : "=v"(lane_));
    const int wid = g.wid, tid = wid * 64 + lane_, lane = lane_, wr = wid >> 2, wc = wid & 3, fr = lane & 15, fq = lane >> 4;
    const int K = g.K, nt = K / BK, LDA = g.lda;
    unsigned voffA[2], voffB[2];
#pragma unroll
    for (int i = 0; i < 2; ++i) { int R, C; stage_rc(tid * 16 + i * 8192, R, C); const int Rb = Epi::PERM ? ((R & ~31) + perm32(R & 31)) : R;
        voffA[i] = (unsigned)(R * LDA + C) * 2u; voffB[i] = (unsigned)(Rb * K + C) * 2u; }
    const size_t kstep = (size_t)(BK * 2);
    const size_t hstep = (size_t)HALF * K * 2, hstepA = (size_t)HALF * LDA * 2;
    const size_t tstep = 2 * hstep, tstepA = 2 * hstepA;
    int scab = (g.scb & 0xff) | ((g.sca & 0xff) << 8); asm volatile("" : "+v"(scab));
    const unsigned ldsbase = (unsigned)__builtin_amdgcn_readfirstlane((int)(unsigned)(uintptr_t)lds + wid * 1024);
    const unsigned ldsw = (unsigned)wid * 1024u;
    const int aoff = lds_byte(wr * 64 + fr, fq * 8), boff = lds_byte(wc * 32 + fr, fq * 8);
#define PG8_CAT(x0, x1) __builtin_bit_cast(i32x8, __builtin_shufflevector(x0, x1, 0, 1, 2, 3, 4, 5, 6, 7, 8, 9, 10, 11, 12, 13, 14, 15))
#define PG8_SA(b, h) (((b) * 2 + (h)) * HTB)
#define PG8_SB(b, h) ((4 + (b) * 2 + (h)) * HTB)
#define PG8_STAGE(bufoff, gbase, voff) do { if constexpr (FP8) { _Pragma("unroll") for (int _i = 0; _i < 2; ++_i) { unsigned keep_; \
            asm volatile("s_mov_b32 %0, m0\n\ts_mov_b32 m0, %3\n\ts_nop 0\n\tglobal_load_lds_dwordx4 %1, %2\n\ts_mov_b32 m0, %0" : "=&s"(keep_) : "v"((voff)[_i]), "s"((const char*)(gbase)), "s"(ldsbase + (unsigned)((bufoff) + _i * 8192)) : "memory"); } } \
        else { _Pragma("unroll") for (int _i = 0; _i < 2; ++_i) \
        __builtin_amdgcn_global_load_lds((const unsigned*)((const char*)(gbase) + (voff)[_i]), (PG8_LAS unsigned*)(lds + (bufoff) + ldsw + _i * 8192), 16, 0, 0); } } while (0)
#define PG8_LDA(dst, b, h) do { if constexpr (FP8) { _Pragma("unroll") for (int m = 0; m < 4; ++m) fg.dst##8[m] = PG8_CAT(*(const PG8_LAS bf16x8*)(lds + PG8_SA(b, h) + aoff + m * 2048), *(const PG8_LAS bf16x8*)(lds + PG8_SA(b, h) + aoff + m * 2048 + 1024)); } \
        else { _Pragma("unroll") for (int m = 0; m < 4; ++m) _Pragma("unroll") for (int k = 0; k < 2; ++k) fg.dst[m][k] = *(const PG8_LAS bf16x8*)(lds + PG8_SA(b, h) + aoff + m * 2048 + k * 1024); } } while (0)
#define PG8_LDB(dst, b, h) do { if constexpr (FP8) { _Pragma("unroll") for (int n = 0; n < 2; ++n) fg.dst##8[n] = PG8_CAT(*(const PG8_LAS bf16x8*)(lds + PG8_SB(b, h) + boff + n * 2048), *(const PG8_LAS bf16x8*)(lds + PG8_SB(b, h) + boff + n * 2048 + 1024)); } \
        else { _Pragma("unroll") for (int n = 0; n < 2; ++n) _Pragma("unroll") for (int k = 0; k < 2; ++k) fg.dst[n][k] = *(const PG8_LAS bf16x8*)(lds + PG8_SB(b, h) + boff + n * 2048 + k * 1024); } } while (0)
#define PG8_MMA(ai, bj, At, Bt) do { __builtin_amdgcn_s_setprio(1); \
        if constexpr (FP8) { _Pragma("unroll") for (int m = 0; m < 4; ++m) _Pragma("unroll") for (int n = 0; n < 2; ++n) \
            acc[ai][bj][m][n] = __builtin_amdgcn_mfma_scale_f32_16x16x128_f8f6f4(fg.Bt##8[n], fg.At##8[m], acc[ai][bj][m][n], 0, 0, 0, scab, 1, scab); }        \
        else { _Pragma("unroll") for (int m = 0; m < 4; ++m) _Pragma("unroll") for (int n = 0; n < 2; ++n) _Pragma("unroll") for (int k = 0; k < 2; ++k) \
            acc[ai][bj][m][n] = __builtin_amdgcn_mfma_f32_16x16x32_bf16(fg.Bt[n][k], fg.At[m][k], acc[ai][bj][m][n], 0, 0, 0); } \
        __builtin_amdgcn_s_setprio(0); } while (0)
#define PG8_WAIT_V(n) asm volatile("s_waitcnt vmcnt(" #n ")" ::: "memory")
#define PG8_WAIT_L(n) asm volatile("s_waitcnt lgkmcnt(" #n ")" ::: "memory")
#define PG8_BAR __builtin_amdgcn_s_barrier()
#define PG8_SCHED __builtin_amdgcn_sched_barrier(0)
    Unit cur, nxt; int ui = 0;
    if (!S.next(0, cur)) return;
    f32x4 acc[2][2][4][2];
#pragma unroll
    for (int a = 0; a < 2; ++a)
#pragma unroll
        for (int b = 0; b < 2; ++b)
#pragma unroll
            for (int m = 0; m < 4; ++m)
#pragma unroll
                for (int n = 0; n < 2; ++n) acc[a][b][m][n] = zero4();
    Frags<FP8> fg;
    const char* cA = (const char*)g.A + (size_t)cur.pm * tstepA; const char* cB = (const char*)g.Bt + (size_t)cur.pn * tstep;
    S.a_ready(cur);
    if constexpr (SP2) {
        PG8_STAGE(PG8_SB(0, 0), cB, voffB); PG8_STAGE(PG8_SB(0, 1), cB + hstep, voffB); PG8_STAGE(PG8_SA(0, 0), cA, voffA); PG8_STAGE(PG8_SA(0, 1), cA + hstepA, voffA);
        if (wr == 1) PG8_BAR;
        PG8_WAIT_V(2); PG8_BAR;
        PG8_STAGE(PG8_SB(1, 0), cB + kstep, voffB); PG8_STAGE(PG8_SA(1, 0), cA + kstep, voffA); PG8_STAGE(PG8_SB(1, 1), cB + hstep + kstep, voffB);
        PG8_WAIT_V(6); PG8_BAR;
    } else {
        PG8_STAGE(PG8_SB(0, 0), cB, voffB); PG8_STAGE(PG8_SA(0, 0), cA, voffA); PG8_STAGE(PG8_SB(0, 1), cB + hstep, voffB); PG8_STAGE(PG8_SA(0, 1), cA + hstepA, voffA);
        if (wr == 1) PG8_BAR;
        PG8_WAIT_V(4); PG8_BAR;
        PG8_STAGE(PG8_SB(1, 0), cB + kstep, voffB); PG8_STAGE(PG8_SA(1, 0), cA + kstep, voffA); PG8_STAGE(PG8_SB(1, 1), cB + hstep + kstep, voffB);
        PG8_WAIT_V(6); PG8_BAR;
    }
    for (;;) {
        const bool has_next = S.next(ui + 1, nxt);
        const char* nA = has_next ? (const char*)g.A + (size_t)nxt.pm * tstepA : cA; const char* nB = has_next ? (const char*)g.Bt + (size_t)nxt.pn * tstep : cB;
#pragma nounroll
        for (int t = 0; t < nt; t += 2) {
            const bool last = (t == nt - 2);
            const char* a1 = cA + (size_t)(t + 1) * kstep;
            const char* a2 = last ? nA : cA + (size_t)(t + 2) * kstep; const char* b2 = last ? nB : cB + (size_t)(t + 2) * kstep;
            const char* a3 = a2 + kstep; const char* b3 = b2 + kstep;
            if (last && has_next) S.a_ready(nxt);
            if constexpr (SP2) {
            PG8_LDB(B0, 0, 0); PG8_LDB(B1, 0, 1); PG8_SCHED; PG8_LDA(At, 0, 0); PG8_STAGE(PG8_SA(1, 1), a1 + hstepA, voffA);
            PG8_WAIT_V(8); PG8_WAIT_L(0); PG8_BAR; PG8_MMA(0, 0, At, B0); PG8_MMA(0, 1, At, B1); PG8_BAR; PG8_SCHED;
            PG8_LDA(At, 0, 1); PG8_STAGE(PG8_SB(0, 0), b2, voffB); PG8_STAGE(PG8_SB(0, 1), b2 + hstep, voffB); PG8_STAGE(PG8_SA(0, 0), a2, voffA);
            PG8_WAIT_V(8); PG8_WAIT_L(0); PG8_BAR; PG8_MMA(1, 0, At, B0); PG8_MMA(1, 1, At, B1); PG8_BAR; PG8_SCHED;
            PG8_LDB(B0, 1, 0); PG8_LDB(B1, 1, 1); PG8_SCHED; PG8_LDA(At, 1, 0); PG8_STAGE(PG8_SA(0, 1), a2 + hstepA, voffA);
            PG8_WAIT_V(8); PG8_WAIT_L(0); PG8_BAR; PG8_MMA(0, 0, At, B0); PG8_MMA(0, 1, At, B1); PG8_BAR; PG8_SCHED;
            PG8_LDA(At, 1, 1); PG8_STAGE(PG8_SB(1, 0), b3, voffB); PG8_STAGE(PG8_SB(1, 1), b3 + hstep, voffB); PG8_STAGE(PG8_SA(1, 0), a3, voffA);
            PG8_WAIT_V(8); PG8_WAIT_L(0); PG8_BAR; PG8_MMA(1, 0, At, B0); PG8_MMA(1, 1, At, B1); PG8_BAR; PG8_SCHED;
            if constexpr (Epi::HOOK) { if (t + 2 == Epi::HK0 || t + 2 == Epi::HK1) E.mid(acc, cur, wr, wc, fr, fq, t + 2); }
            } else {
            PG8_LDB(B0, 0, 0); PG8_SCHED; PG8_LDA(At, 0, 0); PG8_STAGE(PG8_SA(1, 1), a1 + hstepA, voffA);
            PG8_WAIT_L(8); PG8_BAR; PG8_WAIT_L(0); PG8_MMA(0, 0, At, B0); PG8_BAR; PG8_SCHED;
            PG8_LDB(B1, 0, 1); PG8_STAGE(PG8_SB(0, 0), b2, voffB);
            PG8_BAR; PG8_WAIT_L(0); PG8_MMA(0, 1, At, B1); PG8_BAR;
            PG8_LDA(At, 0, 1); PG8_STAGE(PG8_SA(0, 0), a2, voffA);
            PG8_BAR; PG8_WAIT_L(0); PG8_MMA(1, 0, At, B0); PG8_BAR; PG8_SCHED;
            PG8_STAGE(PG8_SB(0, 1), b2 + hstep, voffB);
            PG8_WAIT_V(6); PG8_BAR; PG8_MMA(1, 1, At, B1); PG8_BAR;
            PG8_LDB(B0, 1, 0); PG8_SCHED; PG8_LDA(At, 1, 0); PG8_STAGE(PG8_SA(0, 1), a2 + hstepA, voffA);
            PG8_WAIT_L(8); PG8_BAR; PG8_WAIT_L(0); PG8_MMA(0, 0, At, B0); PG8_BAR; PG8_SCHED;
            PG8_LDB(B1, 1, 1); PG8_STAGE(PG8_SB(1, 0), b3, voffB);
            PG8_BAR; PG8_WAIT_L(0); PG8_MMA(0, 1, At, B1); PG8_BAR;
            PG8_LDA(At, 1, 1); PG8_STAGE(PG8_SA(1, 0), a3, voffA);
            PG8_BAR; PG8_WAIT_L(0); PG8_MMA(1, 0, At, B0); PG8_BAR; PG8_SCHED;
            PG8_STAGE(PG8_SB(1, 1), b3 + hstep, voffB);
            PG8_WAIT_V(6); PG8_BAR; PG8_MMA(1, 1, At, B1); PG8_BAR;
            }
        }
        if constexpr (ALIGN_EPI) { if (wr == 0) PG8_BAR; }
#if EMASK
        unsigned long long te_ = __builtin_amdgcn_s_memrealtime();
#endif
        if constexpr (!Epi::AFTER_DRAIN) { E(acc, cur, wr, wc, fr, fq); S.done(cur); }
#if EMASK
        if (g.tp && wid == 0 && lane == 0) { asm volatile("s_waitcnt vmcnt(0)" ::: "memory"); *(PG8_LAS unsigned long long*)(lds + 131072 + 320 + 64) += __builtin_amdgcn_s_memrealtime() - te_; }
#endif
        if (!has_next) break;
#pragma unroll
        for (int a = 0; a < 2; ++a)
#pragma unroll
            for (int b = 0; b < 2; ++b)
#pragma unroll
                for (int m = 0; m < 4; ++m)
#pragma unroll
                    for (int n = 0; n < 2; ++n) acc[a][b][m][n] = zero4();
        cur = nxt; cA = nA; cB = nB; ++ui;
        if constexpr (ALIGN_EPI) { if (wr == 1) PG8_BAR; }
    }
    PG8_WAIT_V(0);
    if constexpr (!ALIGN_EPI) { if (wr == 0) PG8_BAR; }
    PG8_BAR;
    if constexpr (Epi::AFTER_DRAIN) { E.fused(acc, cur, wr, wc, fr, fq, lds, wid, lane); S.done(cur); }
#undef PG8_SA
#undef PG8_SB
#undef PG8_STAGE
#undef PG8_LDA
#undef PG8_LDB
#undef PG8_MMA
#undef PG8_CAT
#undef PG8_WAIT_V
#undef PG8_WAIT_L
#undef PG8_BAR
#undef PG8_SCHED
}
}

constexpr int NWAVES = 8, NTHR = 512;
constexpr int DM = 2048, NB = 4, SEQ = 2048, NT = NB * SEQ, DEPTH = 2;
constexpr int ZP = 11264;
constexpr int ZC_QA = 0, ZC_KVA = 1024, ZC_QB = 2560, ZC_KB = 3072, ZC_VB = 3200, ZC_QC = 3328, ZC_KC = 3840, ZC_VC = 4352, ZC_GM = 4864, ZC_GA = 11008;
constexpr int OC_A = 0, OC_B = 1024, OC_C = 1536;
constexpr int NEXP = 32, DEXP = 256, ROWCAP = 24576;
constexpr float LN_EPS = 1e-5f, LOG2E = 1.4426950408889634f;
constexpr size_t MiB = 1u << 20;
constexpr size_t WS_CTL = 0, CTL_ZERO_BYTES = 1 * MiB;
constexpr size_t WS_WIN = 2 * MiB, WS_WBRA = 46 * MiB, WS_WBRB = 50 * MiB, WS_WBRC = 52 * MiB, WS_WOUT = 54 * MiB, WS_WGU = 62 * MiB, WS_WD = 126 * MiB, WS_WCMP = 158 * MiB;
constexpr size_t WS_XB = 160 * MiB, WS_Z = 192 * MiB, WS_OA = 370 * MiB, WS_MG = 402 * MiB, WS_MB = 466 * MiB, WS_X1 = 498 * MiB, WS_H = 562 * MiB, WS_SMALL = 574 * MiB, WS_END = 578 * MiB;
constexpr size_t WS_WIN1 = WS_WIN + 22 * MiB, WS_WCMP1 = 576 * MiB;
constexpr size_t WS_OA8 = WS_XB + 16 * MiB;
constexpr size_t WS_XS = WS_Z, WS_Y = WS_Z + 96 * MiB;
constexpr size_t SM_KCMP = 0, SM_VCMP = 256 * 1024, SM_KMEAN = 512 * 1024, SM_TOKE = 640 * 1024, SM_TOKW = 704 * 1024, SM_TOKP = 768 * 1024, SM_ROWTS = 832 * 1024, SM_ROWW = 960 * 1024, SM_PANE = 1088 * 1024, SM_HIST = 1152 * 1024, SM_CNTG = 1200 * 1024;
constexpr int CW_TMO = 0, CW_BAR = 4096, CW_QUEUE = 8192, CW_ECNT = 9216, CW_NPAN = 16384;
constexpr int RING_OFF = 0, RING_BYTES = 131072, LDSCTL_OFF = RING_BYTES, MISC_OFF = LDSCTL_OFF + 320, LDS_BYTES = 147456;

#define GAS __attribute__((address_space(1)))
#define LAS __attribute__((address_space(3)))
typedef unsigned short bf16;
typedef unsigned v4u __attribute__((ext_vector_type(4)));
typedef unsigned v2u __attribute__((ext_vector_type(2)));
typedef float f32x4 __attribute__((ext_vector_type(4)));
typedef float f32x16 __attribute__((ext_vector_type(16)));
typedef short bf16x8 __attribute__((ext_vector_type(8)));
typedef short s16x4 __attribute__((ext_vector_type(4)));
typedef GAS unsigned gu32;
#define RLX_AGENT __ATOMIC_RELAXED, __HIP_MEMORY_SCOPE_AGENT
#define LDS_WAIT() asm volatile("s_waitcnt lgkmcnt(0)" ::: "memory")
#define VM_WAIT() asm volatile("s_waitcnt vmcnt(0)" ::: "memory")
__device__ __forceinline__ int lane_id() { int l; asm volatile("v_mbcnt_lo_u32_b32 %0, -1, 0\n\tv_mbcnt_hi_u32_b32 %0, -1, %0" : "=v"(l)); return l; }
__device__ __forceinline__ unsigned f2bf(float f) { unsigned u = __builtin_bit_cast(unsigned, f); return (u + 0x7fffu + ((u >> 16) & 1u)) >> 16; }
__device__ __forceinline__ unsigned pk2(float lo, float hi) { return f2bf(lo) | (f2bf(hi) << 16); }
__device__ __forceinline__ float bflo(unsigned w) { return __uint_as_float(w << 16); }
__device__ __forceinline__ float bfhi(unsigned w) { return __uint_as_float(w & 0xffff0000u); }
__device__ __forceinline__ float bf2f(bf16 b) { return __uint_as_float(((unsigned)b) << 16); }
__device__ __forceinline__ float shfl_xor_f(float v, int o, int lane) { return __int_as_float(__builtin_amdgcn_ds_bpermute((lane ^ o) << 2, __float_as_int(v))); }
__device__ __forceinline__ unsigned shfl_xor_u(unsigned v, int o, int lane) { return (unsigned)__builtin_amdgcn_ds_bpermute((lane ^ o) << 2, (int)v); }
__device__ __forceinline__ float wave_sum(float v, int lane) {
#pragma unroll
    for (int o = 1; o < 64; o <<= 1) v += shfl_xor_f(v, o, lane);
    return v;
}

#define XB_TMO      128
#define XB_XCNT(j)  (256  + 64 * (j))
#define XB_XSUB(j)  (1280 + 64 * (j))
#define XB_XGEN(j)  (2304 + 64 * (j))
#define XB_TOP      3328
#define XB_TOPGEN   3392
#define XCD_BAR_WORDS 3456
#define XB_SPIN_CAP (1u << 18)

__device__ __forceinline__ unsigned xb_ld(unsigned* p)              { return __hip_atomic_load(p, __ATOMIC_RELAXED, __HIP_MEMORY_SCOPE_AGENT); }
__device__ __forceinline__ unsigned xb_add(unsigned* p, unsigned v) { return __hip_atomic_fetch_add(p, v, __ATOMIC_RELAXED, __HIP_MEMORY_SCOPE_AGENT); }
__device__ __forceinline__ unsigned xb_xcc_id() { return (unsigned)__builtin_amdgcn_s_getreg((3 << 11) | 20) & 0xFu; }
#define XB_SPIN(cond, bar) do { unsigned _sp = 0; while (cond) { __builtin_amdgcn_s_sleep(1); \
    if ((++_sp & 255u) == 0u) { if (xb_ld(&(bar)[XB_TMO])) break; if (_sp > XB_SPIN_CAP) { atomicAdd(&(bar)[XB_TMO], 1u); break; } } } } while (0)

struct XcdBarrier {
    unsigned* bar; unsigned x;
    volatile LAS unsigned* st;
};

__device__ __forceinline__ XcdBarrier xcd_barrier_post(unsigned* bar, volatile LAS unsigned* st) {
    XcdBarrier b; b.bar = bar; b.x = xb_xcc_id(); b.st = st;
    if (threadIdx.x == 0) (void)xb_add(&bar[XB_XCNT(b.x)], 1u);
    return b;
}
__device__ __forceinline__ void xcd_barrier_complete(unsigned* bar, unsigned x, unsigned& nloc, unsigned& nx) {
    const unsigned G = gridDim.x * gridDim.y * gridDim.z;
    unsigned sum, cnt, mine, sp = 0u;
    for (;;) {
        sum = 0u; cnt = 0u; mine = 0u;
#pragma unroll
        for (unsigned j = 0; j < 16; ++j) { const unsigned c = xb_ld(&bar[XB_XCNT(j)]); sum += c; cnt += (c > 0u) ? 1u : 0u; mine = (j == x) ? c : mine; }
        if (sum == G) break;
        __builtin_amdgcn_s_sleep(1);
        if ((++sp & 255u) == 0u) { if (xb_ld(&bar[XB_TMO])) break; if (sp > XB_SPIN_CAP) { atomicAdd(&bar[XB_TMO], 1u); break; } }
    }
    nloc = mine > 0u ? mine : 1u; nx = cnt > 0u ? cnt : 1u;
}

struct NoWork { __device__ __forceinline__ void operator()() const {} };
template <bool FIRST, class W> __device__ __forceinline__ void xcd_barrier_t(const XcdBarrier& b, bool t0, bool worker, const W& work) {
    asm volatile("s_waitcnt vmcnt(0)" ::: "memory");
    __syncthreads();
    if (t0) {
        unsigned* bar = b.bar; unsigned bx_ = b.x; asm volatile("" : "+s"(bx_));
        __builtin_amdgcn_s_waitcnt(0);
        unsigned nloc = b.st[0], nx = b.st[1];
        if constexpr (FIRST) { if (nloc == 0u) { xcd_barrier_complete(bar, bx_, nloc, nx); b.st[0] = nloc; b.st[1] = nx; } }
        const unsigned old = xb_add(&bar[XB_XSUB(bx_)], 1u);
        const unsigned gen = old / nloc;
        if (old + 1u == (gen + 1u) * nloc) {
            __builtin_amdgcn_fence(__ATOMIC_RELEASE, "agent");
            asm volatile("s_waitcnt vmcnt(0)" ::: "memory");
            const unsigned og = xb_add(&bar[XB_TOP], 1u);
            const unsigned tg = og / nx;
            if (og + 1u == (tg + 1u) * nx) xb_add(&bar[XB_TOPGEN], 1u);
            else XB_SPIN(xb_ld(&bar[XB_TOPGEN]) == tg, bar);
            __builtin_amdgcn_fence(__ATOMIC_ACQUIRE, "agent");
            xb_add(&bar[XB_XGEN(bx_)], 1u);
            asm volatile("s_waitcnt vmcnt(0)" ::: "memory");
        } else {
            XB_SPIN(xb_ld(&bar[XB_XGEN(bx_)]) == gen, bar);
            __builtin_amdgcn_fence(__ATOMIC_ACQUIRE, "agent");
            asm volatile("s_waitcnt vmcnt(0)" ::: "memory");
        }
    } else if (worker) work();
    __syncthreads();
}
__device__ __forceinline__ void xcd_barrier(const XcdBarrier& b, bool t0) { xcd_barrier_t<false, NoWork>(b, t0, false, NoWork{}); }


namespace att {
__device__ __forceinline__ int crow(int r, int hi) { return (r & 3) + 8 * (r >> 2) + 4 * hi; }
__device__ __forceinline__ f32x16 zero16() { float z = 0.f; asm volatile("" : "+v"(z)); f32x16 r;
#pragma unroll
    for (int i = 0; i < 16; ++i) r[i] = z;
    return r; }
__device__ __forceinline__ unsigned cvtpk(float lo, float hi) { unsigned r; asm volatile("v_cvt_pk_bf16_f32 %0, %1, %2" : "=v"(r) : "v"(lo), "v"(hi)); return r; }
template <int HD> __device__ __forceinline__ int kswz(int row, int colB) { return row * (HD * 2) + (colB ^ ((row & 7) << 4)); }
template <int HD> __device__ __forceinline__ int v_st(int k, int c) { const int kk = (k & ~0xC) | ((k & 4) << 1) | ((k & 8) >> 1); return ((kk >> 3) * (HD / 32) + (c >> 5)) * 512 + ((kk & 7) * 32 + (c & 31)) * 2; }
__device__ __forceinline__ int v_rd_base(int lane) { return ((lane & 3) << 3) | (((lane >> 2) & 3) << 6) | (((lane >> 4) & 1) << 5) | (((lane >> 5) & 1) << 8); }
template <int HD> constexpr int v_rd_off(int d0, int ks, int half) { return d0 * 512 + (2 * ks + half) * (HD / 32) * 512; }
template <int OFF> __device__ __forceinline__ s16x4 tr_read(int vb) { s16x4 r; asm volatile("ds_read_b64_tr_b16 %0, %1 offset:%2" : "=&v"(r) : "v"(vb), "i"(OFF) : "memory"); return r; }

template <int HD> __device__ __forceinline__ void qkt(f32x16& p0, f32x16& p1, const LAS char* Ks, const bf16x8 (&qr)[HD / 16], int r32, int hi) {
    p0 = zero16(); p1 = zero16();
#pragma unroll
    for (int d0 = 0; d0 < HD / 16; ++d0) { const int cb = (d0 * 16 + hi * 8) * 2;
        const bf16x8 b0 = *(const LAS bf16x8*)(Ks + kswz<HD>(r32, cb));
        const bf16x8 b1 = *(const LAS bf16x8*)(Ks + kswz<HD>(32 + r32, cb));
        p0 = __builtin_amdgcn_mfma_f32_32x32x16_bf16(b0, qr[d0], p0, 0, 0, 0);
        p1 = __builtin_amdgcn_mfma_f32_32x32x16_bf16(b1, qr[d0], p1, 0, 0, 0); }
}
template <int HD> __device__ __forceinline__ void qkt_bias(f32x16& p0, f32x16& p1, const LAS char* Ks, const bf16x8 (&qr)[HD / 16], int r32, int hi, float ba, float bb) {
#pragma unroll
    for (int r = 0; r < 16; ++r) { const float kr = (float)((r & 3) + 8 * (r >> 2)); p0[r] = fmaf(ba, kr, bb); p1[r] = fmaf(ba, kr + 32.f, bb); }
#pragma unroll
    for (int d0 = 0; d0 < HD / 16; ++d0) { const int cb = (d0 * 16 + hi * 8) * 2;
        const bf16x8 b0 = *(const LAS bf16x8*)(Ks + kswz<HD>(r32, cb));
        const bf16x8 b1 = *(const LAS bf16x8*)(Ks + kswz<HD>(32 + r32, cb));
        p0 = __builtin_amdgcn_mfma_f32_32x32x16_bf16(b0, qr[d0], p0, 0, 0, 0);
        p1 = __builtin_amdgcn_mfma_f32_32x32x16_bf16(b1, qr[d0], p1, 0, 0, 0); }
}
#define ATT_PK(L, H) (bf16x8){L[0], L[1], L[2], L[3], H[0], H[1], H[2], H[3]}
template <int HD, int DA, int KA> __device__ __forceinline__ void pv_quad(f32x16& oa, f32x16& ob, int vb, bf16x8 pk0, bf16x8 pk1) {
    const s16x4 al0 = tr_read<v_rd_off<HD>(DA, KA, 0)>(vb), ah0 = tr_read<v_rd_off<HD>(DA, KA, 1)>(vb), bl0 = tr_read<v_rd_off<HD>(DA + 1, KA, 0)>(vb), bh0 = tr_read<v_rd_off<HD>(DA + 1, KA, 1)>(vb);
    const s16x4 al1 = tr_read<v_rd_off<HD>(DA, KA + 1, 0)>(vb), ah1 = tr_read<v_rd_off<HD>(DA, KA + 1, 1)>(vb), bl1 = tr_read<v_rd_off<HD>(DA + 1, KA + 1, 0)>(vb), bh1 = tr_read<v_rd_off<HD>(DA + 1, KA + 1, 1)>(vb);
    asm volatile("s_waitcnt lgkmcnt(0)" ::: "memory"); __builtin_amdgcn_sched_barrier(0);
    oa = __builtin_amdgcn_mfma_f32_32x32x16_bf16(pk0, ATT_PK(al0, ah0), oa, 0, 0, 0);
    ob = __builtin_amdgcn_mfma_f32_32x32x16_bf16(pk0, ATT_PK(bl0, bh0), ob, 0, 0, 0);
    oa = __builtin_amdgcn_mfma_f32_32x32x16_bf16(pk1, ATT_PK(al1, ah1), oa, 0, 0, 0);
    ob = __builtin_amdgcn_mfma_f32_32x32x16_bf16(pk1, ATT_PK(bl1, bh1), ob, 0, 0, 0);
}
template <int HD> __device__ __forceinline__ void pv_all(f32x16 (&o)[HD / 32], int vb, bf16x8 pa0, bf16x8 pa1, bf16x8 pa2, bf16x8 pa3) {
    pv_quad<HD, 0, 0>(o[0], o[1], vb, pa0, pa1); pv_quad<HD, 0, 2>(o[0], o[1], vb, pa2, pa3);
    if constexpr (HD == 128) { pv_quad<HD, 2, 0>(o[2], o[3], vb, pa0, pa1); pv_quad<HD, 2, 2>(o[2], o[3], vb, pa2, pa3); }
}
#define ATT_PK4(P, BASE, OUT) do { const unsigned a0_ = cvtpk(P[BASE + 0], P[BASE + 1]), a1_ = cvtpk(P[BASE + 2], P[BASE + 3]);   \
    const unsigned b0_ = cvtpk(P[BASE + 4], P[BASE + 5]), b1_ = cvtpk(P[BASE + 6], P[BASE + 7]);                              \
    auto r0_ = __builtin_amdgcn_permlane32_swap(a0_, b0_, false, false); auto r1_ = __builtin_amdgcn_permlane32_swap(a1_, b1_, false, false); \
    v4u w_ = {r0_[0], r1_[0], r0_[1], r1_[1]}; OUT = __builtin_bit_cast(bf16x8, w_); } while (0)
__device__ __forceinline__ float xmax32(float v) { auto rr = __builtin_amdgcn_permlane32_swap(__float_as_uint(v), __float_as_uint(v), false, false); return fmaxf(__uint_as_float(rr[0]), __uint_as_float(rr[1])); }
__device__ __forceinline__ float xsum32(float v) { auto rr = __builtin_amdgcn_permlane32_swap(__float_as_uint(v), __float_as_uint(v), false, false); return __uint_as_float(rr[0]) + __uint_as_float(rr[1]); }

struct MaskGen {
    float C, ba, bb, dq, W; int edge;
    __device__ __forceinline__ void edges(f32x16& p0, f32x16& p1) const {
        if (edge == 0) return;
        if (edge == 1) {
#pragma unroll
            for (int r = 0; r < 16; ++r) { const float kr = (float)((r & 3) + 8 * (r >> 2)); p0[r] = dq >= kr ? p0[r] : -INFINITY; p1[r] = dq >= kr + 32.f ? p1[r] : -INFINITY; }
        } else if (edge == 2) {
#pragma unroll
            for (int r = 0; r < 16; ++r) { const float kr = (float)((r & 3) + 8 * (r >> 2)); p0[r] = dq < W + kr ? p0[r] : -INFINITY; p1[r] = dq < W + kr + 32.f ? p1[r] : -INFINITY; }
        } else {
#pragma unroll
            for (int r = 0; r < 16; ++r) { const float kr = (float)((r & 3) + 8 * (r >> 2));
                p0[r] = (dq >= kr && dq < W + kr) ? p0[r] : -INFINITY; p1[r] = (dq >= kr + 32.f && dq < W + kr + 32.f) ? p1[r] : -INFINITY; }
        }
    }
};
__device__ __forceinline__ MaskGen make_mask(float C, float rC, float slC, float dq, float W, bool ok, int edge) { return MaskGen{C, slC * rC, ok ? -slC * dq * rC : -INFINITY, dq, W, edge}; }
template <int HD> __device__ __forceinline__ void softmax_pv(f32x16& p0, f32x16& p1, f32x16 (&o)[HD / 32], float& m_reg, float& l_reg, int vb, LAS float* al_l, int r32, int hi, float C) {
    float pmax = fmaxf(p0[0], p1[0]);
#pragma unroll
    for (int r = 1; r < 16; ++r) pmax = fmaxf(fmaxf(pmax, p0[r]), p1[r]);
    pmax = xmax32(pmax) * C;
    float mn = m_reg, alpha = 1.f;
    if (!__all(pmax - m_reg <= 8.0f)) { mn = fmaxf(m_reg, pmax); alpha = __builtin_amdgcn_exp2f(m_reg - mn); m_reg = mn; }
    float ps4[4] = {0.f, 0.f, 0.f, 0.f}; const float nm = -mn;
#pragma unroll
    for (int r = 0; r < 16; ++r) { p0[r] = __builtin_amdgcn_exp2f(fmaf(p0[r], C, nm)); p1[r] = __builtin_amdgcn_exp2f(fmaf(p1[r], C, nm)); ps4[r & 3] += p0[r] + p1[r]; }
    float ps = (ps4[0] + ps4[1]) + (ps4[2] + ps4[3]);
    ps = xsum32(ps); l_reg = l_reg * alpha + ps;
    bf16x8 pa0, pa1, pa2, pa3; ATT_PK4(p0, 0, pa0); ATT_PK4(p0, 8, pa1); ATT_PK4(p1, 0, pa2); ATT_PK4(p1, 8, pa3);
    if (__any(alpha < 1.f)) { if (hi == 0) al_l[r32] = alpha; LDS_WAIT();
#pragma unroll
        for (int r = 0; r < 16; ++r) { const float a = al_l[crow(r, hi)];
#pragma unroll
            for (int d = 0; d < HD / 32; ++d) o[d][r] *= a; }
        LDS_WAIT(); }
    pv_all<HD>(o, vb, pa0, pa1, pa2, pa3);
}
template <int HD> struct Stg { v4u k0, k1, v0, v1; };
template <int HD> __device__ __forceinline__ void sload(Stg<HD>& s, const bf16* Kp, const bf16* Vp, size_t pitch, int tid) {
    if constexpr (HD == 128) { const int sr = tid >> 4, sc = (tid & 15) * 8;
        s.k0 = *(const v4u*)(Kp + (size_t)sr * pitch + sc); s.k1 = *(const v4u*)(Kp + (size_t)(32 + sr) * pitch + sc);
        s.v0 = *(const v4u*)(Vp + (size_t)sr * pitch + sc); s.v1 = *(const v4u*)(Vp + (size_t)(32 + sr) * pitch + sc); }
    else { const int sr = tid >> 3, sc = (tid & 7) * 8; s.k0 = *(const v4u*)(Kp + (size_t)sr * pitch + sc); s.v0 = *(const v4u*)(Vp + (size_t)sr * pitch + sc); }
}
template <int HD> __device__ __forceinline__ void swrite(const Stg<HD>& s, LAS char* Kt, LAS char* Vt, int tid) {
    if constexpr (HD == 128) { const int sr = tid >> 4, sc = (tid & 15) * 8;
        *(LAS v4u*)(Kt + kswz<HD>(sr, sc * 2)) = s.k0; *(LAS v4u*)(Kt + kswz<HD>(32 + sr, sc * 2)) = s.k1;
        *(LAS v4u*)(Vt + v_st<HD>(sr, sc)) = s.v0; *(LAS v4u*)(Vt + v_st<HD>(32 + sr, sc)) = s.v1; }
    else { const int sr = tid >> 3, sc = (tid & 7) * 8; *(LAS v4u*)(Kt + kswz<HD>(sr, sc * 2)) = s.k0; *(LAS v4u*)(Vt + v_st<HD>(sr, sc)) = s.v0; }
}
constexpr int A_K0 = 0, A_K1 = 16384, A_V0 = 32768, A_V1 = 49152, A_WS = 65536, A_SEL = 67584, A_UNI = 68608, A_IMP = 68864, A_KM = 77312, A_END = 81408, A_IMPH = 81920;

template <int HD, class TF, class SK, class FIN>
__device__ __forceinline__ void run_tiles(unsigned mask0, unsigned mask1, const bf16* Kb0, const bf16* Vb0, const bf16* Kb1, const bf16* Vb1, size_t pitch, LAS char* lds, int tid, int lane,
                                          const bf16x8 (&qr)[HD / 16], f32x16 (&o)[HD / 32], float& m_reg, float& l_reg, LAS float* al_l, const TF& tf, const SK& sk, const FIN& fin) {
    const int r32 = lane & 31, hi = lane >> 5;
    const int vb0 = (int)(uintptr_t)(lds + A_V0) + v_rd_base(lane);
    int ph = 0; unsigned m = mask0; if (m == 0u) { ph = 1; m = mask1; }
    if (m == 0u) return;
    int j = __builtin_ctz(m); m &= m - 1u;
    Stg<HD> st;
    sload<HD>(st, (ph ? Kb1 : Kb0) + (size_t)j * 64 * pitch, (ph ? Vb1 : Vb0) + (size_t)j * 64 * pitch, pitch, tid);
    swrite<HD>(st, lds + A_K0, lds + A_V0, tid);
    __syncthreads();
    int buf = 0;
    for (;;) {
        int phn = ph; unsigned mn = m; if (mn == 0u && ph == 0) { phn = 1; mn = mask1; }
        const int jn = mn ? __builtin_ctz(mn) : -1; mn &= mn - 1u;
        if (jn >= 0) sload<HD>(st, (phn ? Kb1 : Kb0) + (size_t)jn * 64 * pitch, (phn ? Vb1 : Vb0) + (size_t)jn * 64 * pitch, pitch, tid);
        if (!sk(ph, j)) { f32x16 p0, p1; const MaskGen mg = tf(ph, j);
            qkt_bias<HD>(p0, p1, lds + (buf ? A_K1 : A_K0), qr, r32, hi, mg.ba, mg.bb); mg.edges(p0, p1);
            softmax_pv<HD>(p0, p1, o, m_reg, l_reg, vb0 + buf * 16384, al_l, r32, hi, mg.C); }
        if (jn < 0 || phn != ph) fin(ph);
        if (jn >= 0) swrite<HD>(st, lds + (buf ? A_K0 : A_K1), lds + (buf ? A_V0 : A_V1), tid);
        __syncthreads();
        if (jn < 0) break;
        ph = phn; m = mn; j = jn; buf ^= 1;
    }
}
}

constexpr int N_SWA_EARLY = 192;
constexpr int N_ATT_UNITS = 256 + 128 + 256, CVT_PER_UNIT = 16, N_CVT_UNITS = 14336 / CVT_PER_UNIT, N_RAT_UNITS = 256, N_Q_UNITS = N_ATT_UNITS + N_CVT_UNITS + N_RAT_UNITS;
struct UnitTab { unsigned short u[N_Q_UNITS]; };
constexpr UnitTab make_units() {
    unsigned short a[N_ATT_UNITS] = {}; int n = 0;
    for (int cost = 64; cost >= 0; --cost) {
        for (int c = 0; c < 32; ++c) if (c + 12 == cost) for (int bg = 0; bg < 8; ++bg) a[n++] = (unsigned short)((bg << 5) | c);
        for (int kb = 0; kb < 8; ++kb) if (4 * kb + 3 == cost) for (int bh = 0; bh < 16; ++bh) a[n++] = (unsigned short)((1 << 12) | (bh << 3) | kb);
        if (cost == 2) for (int c = 0; c < 32; ++c) for (int bg = 0; bg < 8; ++bg) a[n++] = (unsigned short)((2 << 12) | (bg << 5) | c);
    }
    UnitTab t{}; int ia = 0, ic = 0; constexpr int SPAN = N_Q_UNITS - 160, NS = N_CVT_UNITS + N_RAT_UNITS;
    for (int q = 0; q < N_Q_UNITS; ++q) {
        const bool sm = q < SPAN && ((q + 1) * NS) / SPAN > (q * NS) / SPAN;
        if (sm && ic < NS) {
            const int nr = (ic * N_RAT_UNITS) / NS, nr1 = ((ic + 1) * N_RAT_UNITS) / NS;
            t.u[q] = (unsigned short)(nr1 > nr ? ((5 << 12) | nr) : ((3 << 12) | (ic - nr)));
            ++ic; }
        else t.u[q] = a[ia++];
    }
    return t;
}
__constant__ UnitTab g_units = make_units();

__device__ __forceinline__ unsigned char f2fp8(float v) { return (unsigned char)(__builtin_amdgcn_cvt_pk_fp8_f32(v * 64.f, v * 64.f, 0, false) & 0xff); }
#define ATT_STORE_O(ND, OVAL) do { unsigned off_ = (unsigned)((4 * hi) * DM + r32); _Pragma("unroll") for (int r_ = 0; r_ < 16; ++r_) { asm volatile("" : "+v"(off_)); \
        unsigned char* op_ = o8base + off_ + (unsigned)(((r_ & 3) + 8 * (r_ >> 2)) * DM); \
        _Pragma("unroll") for (int d_ = 0; d_ < ND; ++d_) op_[32 * d_] = f2fp8(OVAL); asm volatile("" ::: "memory"); } } while (0)
#define ATT_ACC_O(FIRST, LAST) do { unsigned off_ = (unsigned)((4 * hi) * DM + r32) * 2u; \
        _Pragma("unroll") for (int g_ = 0; g_ < 2; ++g_) { asm volatile("" : "+v"(off_)); unsigned short old_[8][4]; \
            if (!(FIRST)) { _Pragma("unroll") for (int q_ = 0; q_ < 8; ++q_) { const int r_ = 8 * g_ + q_; const bf16* op_ = (const bf16*)((const char*)obase + off_ + (unsigned)(((r_ & 3) + 8 * (r_ >> 2)) * DM * 2)); \
                _Pragma("unroll") for (int d_ = 0; d_ < 4; ++d_) old_[q_][d_] = op_[32 * d_]; } } \
            _Pragma("unroll") for (int q_ = 0; q_ < 8; ++q_) { const int r_ = 8 * g_ + q_; const float f_ = fac_l[att::crow(r_, hi)]; bf16* op_ = (bf16*)((char*)obase + off_ + (unsigned)(((r_ & 3) + 8 * (r_ >> 2)) * DM * 2)); \
                _Pragma("unroll") for (int d_ = 0; d_ < 4; ++d_) { float v_ = o[d_][r_] * f_; if (!(FIRST)) v_ += bf2f(old_[q_][d_]); if (LAST) o8base[(off_ >> 1) + (unsigned)(((r_ & 3) + 8 * (r_ >> 2)) * DM) + 32 * d_] = f2fp8(v_); else op_[32 * d_] = (bf16)f2bf(v_); } } \
            asm volatile("" ::: "memory"); } } while (0)

__device__ __forceinline__ void nsa_loop(int code, const bf16* Z, bf16* OA, unsigned char* OA8, LAS char* lds, int tid_in, int wid, unsigned mysel, unsigned uni);
__device__ __forceinline__ void nsa_unit(int code, const bf16* Z, const bf16* KCMP, const bf16* VCMP, bf16* OA, unsigned char* OA8, LAS char* lds, int tid_in, int wid) {
    using namespace att;
    const int lane = lane_id(), tid = wid * 64 + lane; (void)tid_in;
    const int bg = (code >> 5) & 7, c = code & 31, b = bg >> 1, g = bg & 1;
    const int r32 = lane & 31, hi = lane >> 5, hh = wid & 3, tb = wid >> 2, head = g * 4 + hh;
    const int tl = tb * 32 + r32, tpos = c * 64 + tl;
    const size_t trow = (size_t)b * SEQ + tpos;
    const float slC = __builtin_amdgcn_exp2f(-(float)(head + 1)) * LOG2E, C = 0.08838834764831845f * LOG2E, rC = 1.0f / C;
    LAS float* al_l = (LAS float*)(lds + A_WS) + wid * 64; LAS float* fac_l = al_l + 32;
    LAS unsigned* sel_l = (LAS unsigned*)(lds + A_SEL); LAS unsigned* uni_l = (LAS unsigned*)(lds + A_UNI); LAS float* imp_l = (LAS float*)(lds + A_IMP);
    const bf16* qp = Z + trow * ZP + ZC_QA + head * 128 + hi * 8;
    const bf16* gp = Z + trow * ZP + ZC_GA + head * 3;
    const float g0 = bf2f(gp[0]);
    bf16* obase = OA + ((size_t)b * SEQ + c * 64 + tb * 32) * DM + OC_A + head * 128;
    unsigned char* o8base = OA8 + ((size_t)b * SEQ + c * 64 + tb * 32) * DM + OC_A + head * 128; (void)o8base;
    {
        const bf16* kc = KCMP + (size_t)bg * 128 * 128; const bf16* vc = VCMP + (size_t)bg * 128 * 128;
        { Stg<128> s0, s1; sload<128>(s0, kc, vc, 128, tid); sload<128>(s1, kc + 64 * 128, vc + 64 * 128, 128, tid);
          swrite<128>(s0, lds + A_K0, lds + A_V0, tid); swrite<128>(s1, lds + A_K1, lds + A_V1, tid); }
        __syncthreads();
        bf16x8 qc[8];
#pragma unroll
        for (int d0 = 0; d0 < 8; ++d0) qc[d0] = *(const bf16x8*)(qp + d0 * 16);
        const float dq = (float)(tpos - 31 - 64 * hi);
#define NSA_CMP_SCORES(T) do { qkt<128>(a0, a1, lds + ((T) ? A_K1 : A_K0), qc, r32, hi); \
        _Pragma("unroll") for (int r = 0; r < 16; ++r) { const float kr = 16.f * (float)((r & 3) + 8 * (r >> 2)) + 1024.f * (T); const float d0_ = dq - kr, d1_ = dq - kr - 512.f; \
            a0[r] = d0_ >= 0.f ? fmaf(a0[r], C, -slC * d0_) : -INFINITY; a1[r] = d1_ >= 0.f ? fmaf(a1[r], C, -slC * d1_) : -INFINITY; } } while (0)
        f32x16 a0, a1;
        float mx = -INFINITY, ps = 0.f;
        { NSA_CMP_SCORES(0);
#pragma unroll
          for (int r = 0; r < 16; ++r) mx = fmaxf(mx, fmaxf(a0[r], a1[r]));
          float s0 = 0.f; const float m0 = (mx == -INFINITY) ? 0.f : mx;
#pragma unroll
          for (int r = 0; r < 16; ++r) s0 += __builtin_amdgcn_exp2f(a0[r] - m0) + __builtin_amdgcn_exp2f(a1[r] - m0);
          NSA_CMP_SCORES(1);
          float mx1 = mx;
#pragma unroll
          for (int r = 0; r < 16; ++r) mx1 = fmaxf(mx1, fmaxf(a0[r], a1[r]));
          const float m1 = (mx1 == -INFINITY) ? 0.f : mx1;
          float s1 = 0.f;
#pragma unroll
          for (int r = 0; r < 16; ++r) s1 += __builtin_amdgcn_exp2f(a0[r] - m1) + __builtin_amdgcn_exp2f(a1[r] - m1);
          float mh = mx1, sh = s0 * __builtin_amdgcn_exp2f(m0 - m1) + s1;
          const float mo = shfl_xor_f(mh, 32, lane), so = shfl_xor_f(sh, 32, lane);
          const float mf = fmaxf(mh, mo); const float mfz = (mf == -INFINITY) ? 0.f : mf;
          const float mhz = (mh == -INFINITY) ? 0.f : mh, moz = (mo == -INFINITY) ? 0.f : mo;
          ps = sh * __builtin_amdgcn_exp2f(mhz - mfz) + so * __builtin_amdgcn_exp2f(moz - mfz); mx = mfz; }
        const float mm = mx, inv = ps > 0.f ? 1.0f / ps : 0.f;
        LAS float* impr = (LAS float*)(lds + A_IMPH) + (hh * 64 + tl) * 33; float carry_ = 0.f;
#define NSA_IMP(X, GRP) do { _Pragma("unroll") for (int q4 = 0; q4 < 4; ++q4) { const float hb_ = 0.5f * X[4 * q4 + 3] * inv; \
            const float aa_ = (X[4 * q4] + X[4 * q4 + 1] + X[4 * q4 + 2]) * inv + hb_; const float rhb_ = shfl_xor_f(hb_, 32, lane); \
            impr[8 * (GRP) + 2 * q4 + hi] = aa_ + (hi ? rhb_ : carry_); carry_ = rhb_; } } while (0)
        f32x16 o[4];
#pragma unroll
      for (int d = 0; d < 4; ++d) o[d] = att::zero16();
        const int vb0 = (int)(uintptr_t)(lds + A_V0) + v_rd_base(lane);
        { NSA_CMP_SCORES(0);
#pragma unroll
          for (int r = 0; r < 16; ++r) { a0[r] = __builtin_amdgcn_exp2f(a0[r] - mm); a1[r] = __builtin_amdgcn_exp2f(a1[r] - mm); }
          NSA_IMP(a0, 0); NSA_IMP(a1, 1);
          bf16x8 pa0, pa1, pa2, pa3; ATT_PK4(a0, 0, pa0); ATT_PK4(a0, 8, pa1); ATT_PK4(a1, 0, pa2); ATT_PK4(a1, 8, pa3); pv_all<128>(o, vb0, pa0, pa1, pa2, pa3); }
        { NSA_CMP_SCORES(1);
#pragma unroll
          for (int r = 0; r < 16; ++r) { a0[r] = __builtin_amdgcn_exp2f(a0[r] - mm); a1[r] = __builtin_amdgcn_exp2f(a1[r] - mm); }
          NSA_IMP(a0, 2); NSA_IMP(a1, 3);
          bf16x8 pa0, pa1, pa2, pa3; ATT_PK4(a0, 0, pa0); ATT_PK4(a0, 8, pa1); ATT_PK4(a1, 0, pa2); ATT_PK4(a1, 8, pa3); pv_all<128>(o, vb0 + 16384, pa0, pa1, pa2, pa3); }
#undef NSA_IMP
#undef NSA_CMP_SCORES
        if (hi == 0) fac_l[r32] = g0 * inv; LDS_WAIT();
        ATT_ACC_O(true, false);
        LDS_WAIT();
    }
    __syncthreads();
    if (wid == 0) {
        unsigned sel;
        if (c <= 7) sel = (2u << c) - 1u;
        else { sel = 1u | (1u << c) | (1u << (c - 1)); unsigned cand = ((1u << (c - 1)) - 1u) & ~1u;
            const LAS float* ir = (const LAS float*)(lds + A_IMPH) + lane * 33; float iv[30];
#pragma unroll
            for (int j = 1; j <= 29; ++j) iv[j] = (ir[j] + ir[64 * 33 + j]) + (ir[2 * 64 * 33 + j] + ir[3 * 64 * 33 + j]);
#pragma unroll
            for (int k = 0; k < 5; ++k) { int best = -1; float bv = -INFINITY;
#pragma unroll
                for (int j = 1; j <= 29; ++j) { if (((cand >> j) & 1u) && iv[j] > bv) { bv = iv[j]; best = j; } }
                if (best < 0) best = __builtin_ctz(cand);
                sel |= 1u << best; cand &= ~(1u << best); } }
        sel_l[lane] = sel;
        unsigned un = sel;
#pragma unroll
        for (int o_ = 1; o_ < 64; o_ <<= 1) un |= shfl_xor_u(un, o_, lane);
        if (lane == 0) uni_l[0] = un;
    }
    __syncthreads();
    const unsigned mysel = sel_l[tl], uni = uni_l[0];
    asm volatile("" ::: "memory");
    nsa_loop(code, Z, OA, OA8, lds, tid, wid, mysel, uni);
}
__device__ __forceinline__ void nsa_loop(int code, const bf16* Z, bf16* OA, unsigned char* OA8, LAS char* lds, int tid_in, int wid, unsigned mysel, unsigned uni) {
    using namespace att;
    const int lane = lane_id(), tid = wid * 64 + lane; (void)tid_in;
    const int bg = (code >> 5) & 7, c = code & 31, b = bg >> 1, g = bg & 1;
    const int r32 = lane & 31, hi = lane >> 5, hh = wid & 3, tb = wid >> 2, head = g * 4 + hh;
    const int tl = tb * 32 + r32, tpos = c * 64 + tl;
    const size_t trow = (size_t)b * SEQ + tpos;
    const float slC = __builtin_amdgcn_exp2f(-(float)(head + 1)) * LOG2E, C = 0.08838834764831845f * LOG2E, rC = 1.0f / C;
    LAS float* al_l = (LAS float*)(lds + A_WS) + wid * 64; LAS float* fac_l = al_l + 32;
    const bf16* qp = Z + trow * ZP + ZC_QA + head * 128 + hi * 8;
    const bf16* gp = Z + trow * ZP + ZC_GA + head * 3;
    const float g1 = bf2f(gp[1]), g2 = bf2f(gp[2]);
    bf16* obase = OA + ((size_t)b * SEQ + c * 64 + tb * 32) * DM + OC_A + head * 128;
    unsigned char* o8base = OA8 + ((size_t)b * SEQ + c * 64 + tb * 32) * DM + OC_A + head * 128; (void)o8base;
    const bf16* zb = Z + (size_t)b * SEQ * ZP;
    bf16x8 qr[8];
#pragma unroll
    for (int d0 = 0; d0 < 8; ++d0) qr[d0] = *(const bf16x8*)(qp + d0 * 16);
    { f32x16 o[4];
#pragma unroll
      for (int d = 0; d < 4; ++d) o[d] = att::zero16();
      float m_reg = -1e30f, l_reg = 0.f;
      const int jlo = c > 8 ? c - 8 : 0; const unsigned wmask = ((2u << c) - 1u) & ~((1u << jlo) - 1u);
      const int twmin = c * 64 + tb * 32;
      run_tiles<128>(uni, wmask, zb + ZC_KVA + 512 + g * 128, zb + ZC_KVA + 768 + g * 128, zb + ZC_KVA + 1024 + g * 128, zb + ZC_KVA + 1280 + g * 128, (size_t)ZP, lds, tid, lane, qr, o, m_reg, l_reg, al_l,
          [&](int ph, int j) { return make_mask(C, rC, slC, (float)(tpos - 64 * j - 4 * hi), 512.f, ph ? true : (((mysel >> j) & 1u) != 0u), ph ? ((j < c && j >= c - 7) ? 0 : (j == c ? 1 : 2)) : (j < c ? 0 : 1)); },
          [&](int ph, int j) { return ph ? (twmin - (64 * j + 63) >= 512) : !__any((mysel >> j) & 1u); },
          [&](int ph) { if (hi == 0) fac_l[r32] = (ph ? g2 : g1) / l_reg; LDS_WAIT();
              ATT_ACC_O(false, ph != 0);
              LDS_WAIT();
#pragma unroll
      for (int d = 0; d < 4; ++d) o[d] = att::zero16();
              m_reg = -1e30f; l_reg = 0.f; }); }
}

__device__ __forceinline__ void moba_unit(int code, const bf16* Z, const float* KMEAN, bf16* OA, unsigned char* OA8, LAS char* lds, int tid_in, int wid) {
    using namespace att;
    const int lane = lane_id(), tid = wid * 64 + lane; (void)tid_in;
    const int bh = (code >> 3) & 15, kb = code & 7, b = bh >> 2, h = bh & 3;
    const int r32 = lane & 31, hi = lane >> 5, tl = wid * 32 + r32, tpos = kb * 256 + tl;
    const float slC = __builtin_amdgcn_exp2f(-2.0f * (float)(h + 1)) * LOG2E, C = 0.08838834764831845f * LOG2E, rC = 1.0f / C;
    LAS float* al_l = (LAS float*)(lds + A_WS) + wid * 64; LAS float* fac_l = al_l + 32;
    LAS unsigned* sel_l = (LAS unsigned*)(lds + A_SEL); LAS unsigned* uni_l = (LAS unsigned*)(lds + A_UNI); LAS float* km_l = (LAS float*)(lds + A_KM);
    const bf16* zb = Z + (size_t)b * SEQ * ZP;
    v4u qv[8];
    { const bf16* qp = zb + (size_t)tpos * ZP + ZC_QC + h * 128 + hi * 64;
#pragma unroll
        for (int d4 = 0; d4 < 8; ++d4) qv[d4] = *(const v4u*)(qp + d4 * 8); }
    for (int i = tid; i < 1024; i += NTHR) km_l[i] = KMEAN[(size_t)bh * 1024 + i];
    if (tid == 0) uni_l[0] = 0u;
    __syncthreads();
    unsigned mysel;
    { unsigned sel;
        if (kb <= 3) sel = (1u << kb) - 1u;
        else { float sc[7];
#pragma unroll
            for (int n = 0; n < 7; ++n) sc[n] = 0.f;
#pragma unroll
            for (int d4 = 0; d4 < 8; ++d4) { const v4u q = qv[d4];
                const float qf[8] = {bflo(q.x), bfhi(q.x), bflo(q.y), bfhi(q.y), bflo(q.z), bfhi(q.z), bflo(q.w), bfhi(q.w)};
#pragma unroll
                for (int n = 0; n < 7; ++n) { const LAS float* kp = km_l + n * 128 + hi * 64 + d4 * 8;
#pragma unroll
                    for (int i = 0; i < 8; ++i) sc[n] = fmaf(qf[i], kp[i], sc[n]); }
                asm volatile("" ::: "memory"); }
#pragma unroll
            for (int n = 0; n < 7; ++n) sc[n] += shfl_xor_f(sc[n], 32, lane);
            sel = 0u;
#pragma unroll
            for (int k = 0; k < 3; ++k) { int best = -1; float bv = -INFINITY;
#pragma unroll
                for (int n = 0; n < 7; ++n) if (n < kb && !((sel >> n) & 1u) && sc[n] > bv) { bv = sc[n]; best = n; }
                if (best < 0) best = __builtin_ctz(~sel);
                sel |= 1u << best; } }
        mysel = sel; unsigned un = sel;
#pragma unroll
        for (int o_ = 1; o_ < 64; o_ <<= 1) un |= shfl_xor_u(un, o_, lane);
        if (lane == 0) (void)__hip_atomic_fetch_or(uni_l, un, __ATOMIC_RELAXED, __HIP_MEMORY_SCOPE_WORKGROUP);
    }
    bf16x8 qr[8];
    { const bf16* qp = zb + (size_t)tpos * ZP + ZC_QC + h * 128 + hi * 8;
#pragma unroll
      for (int d0 = 0; d0 < 8; ++d0) qr[d0] = *(const bf16x8*)(qp + d0 * 16); }
    __syncthreads();
    const unsigned uni = uni_l[0];
    unsigned tmask = 0xFu << (4 * kb);
    for (int n = 0; n < kb; ++n) if ((uni >> n) & 1u) tmask |= 0xFu << (4 * n);
    f32x16 o[4];
#pragma unroll
      for (int d = 0; d < 4; ++d) o[d] = att::zero16();
    float m_reg = -1e30f, l_reg = 0.f;
    const int twmax = kb * 256 + wid * 32 + 31;
    run_tiles<128>(tmask, 0u, zb + ZC_KC + h * 128, zb + ZC_VC + h * 128, zb, zb, (size_t)ZP, lds, tid, lane, qr, o, m_reg, l_reg, al_l,
        [&](int, int j) { const int blk = j >> 2; return make_mask(C, rC, slC, (float)(tpos - 64 * j - 4 * hi), 1e9f, blk == kb ? true : (((mysel >> blk) & 1u) != 0u), blk != kb ? 0 : 1); },
        [&](int, int j) { const int blk = j >> 2; return blk == kb ? (64 * j > twmax) : !__any((mysel >> blk) & 1u); },
        [&](int) {});
    if (hi == 0) fac_l[r32] = 1.0f / l_reg; LDS_WAIT();
    float fr_[16];
#pragma unroll
    for (int r = 0; r < 16; ++r) fr_[r] = fac_l[crow(r, hi)];
    LDS_WAIT();
    unsigned char* o8base = OA8 + ((size_t)b * SEQ + kb * 256 + wid * 32) * DM + OC_C + h * 128; (void)OA;
    ATT_STORE_O(4, o[d_][r_] * fr_[r_]);
}

__device__ __forceinline__ void swa_unit(int code, const bf16* Z, const float* sink, bf16* OA, unsigned char* OA8, LAS char* lds, int tid_in, int wid) {
    using namespace att;
    const int lane = lane_id(), tid = wid * 64 + lane; (void)tid_in;
    const int bg = (code >> 5) & 7, c = code & 31, b = bg >> 1, g = bg & 1;
    const int r32 = lane & 31, hi = lane >> 5, hh = wid & 3, tb = wid >> 2, head = g * 4 + hh;
    const int tl = tb * 32 + r32, tpos = c * 64 + tl;
    const float slC = __builtin_amdgcn_exp2f(-(float)(head + 1)) * LOG2E, C = 0.125f * LOG2E, rC = 1.0f / C;
    LAS float* al_l = (LAS float*)(lds + A_WS) + wid * 64; LAS float* fac_l = al_l + 32;
    const bf16* zb = Z + (size_t)b * SEQ * ZP;
    bf16x8 qr[4];
    { const bf16* qp = zb + (size_t)tpos * ZP + ZC_QB + head * 64 + hi * 8;
#pragma unroll
      for (int d0 = 0; d0 < 4; ++d0) qr[d0] = *(const bf16x8*)(qp + d0 * 16); }
    f32x16 o[2];
#pragma unroll
      for (int d = 0; d < 2; ++d) o[d] = att::zero16();
    float m_reg = -1e30f, l_reg = 0.f;
    const int jlo = c > 2 ? c - 2 : 0; const unsigned tmask = ((2u << c) - 1u) & ~((1u << jlo) - 1u);
    const int twmin = c * 64 + tb * 32;
    run_tiles<64>(tmask, 0u, zb + ZC_KB + g * 64, zb + ZC_VB + g * 64, zb, zb, (size_t)ZP, lds, tid, lane, qr, o, m_reg, l_reg, al_l,
        [&](int, int j) { return make_mask(C, rC, slC, (float)(tpos - 64 * j - 4 * hi), 128.f, true, j == c - 1 ? 0 : (j == c ? 1 : 2)); },
        [&](int, int j) { return twmin - (64 * j + 63) >= 128; },
        [&](int) {});
    l_reg += __builtin_amdgcn_exp2f(sink[head] * LOG2E - m_reg);
    if (hi == 0) fac_l[r32] = 1.0f / l_reg; LDS_WAIT();
    float fr_[16];
#pragma unroll
    for (int r = 0; r < 16; ++r) fr_[r] = fac_l[crow(r, hi)];
    LDS_WAIT();
    unsigned char* o8base = OA8 + ((size_t)b * SEQ + c * 64 + tb * 32) * DM + OC_B + head * 64; (void)OA;
    ATT_STORE_O(2, o[d_][r_] * fr_[r_]);
}

__device__ __forceinline__ void ratio_unit(int u, bf16* Z, int wid) {
    const int lane = lane_id();
#pragma unroll 1
    for (int i = 0; i < 2; ++i) { bf16* zr = Z + (size_t)(u * 32 + wid * 4 + 2 * i) * ZP + ZC_GM + 8 * lane;
        v4u a[2][4], b[2][4], c[2][4];
#pragma unroll
        for (int rr = 0; rr < 2; ++rr)
#pragma unroll
            for (int q = 0; q < 4; ++q) { const bf16* zq = zr + (size_t)rr * ZP + 512 * q; a[rr][q] = *(const v4u*)zq; b[rr][q] = *(const v4u*)(zq + 2048); c[rr][q] = *(const v4u*)(zq + 4096); }
        __builtin_amdgcn_sched_barrier(0);
#pragma unroll
        for (int rr = 0; rr < 2; ++rr)
#pragma unroll
        for (int q = 0; q < 4; ++q) { v4u r0, r1;
#pragma unroll
            for (int k = 0; k < 4; ++k) { const float i1l = __builtin_amdgcn_rcpf(fmaxf(bflo(b[rr][q][k]), 1e-30f)), i1h = __builtin_amdgcn_rcpf(fmaxf(bfhi(b[rr][q][k]), 1e-30f));
                const float i2l = __builtin_amdgcn_rcpf(fmaxf(bflo(c[rr][q][k]), 1e-30f)), i2h = __builtin_amdgcn_rcpf(fmaxf(bfhi(c[rr][q][k]), 1e-30f));
                r0[k] = pk2(bflo(a[rr][q][k]) * i1l, bfhi(a[rr][q][k]) * i1h); r1[k] = pk2(bflo(b[rr][q][k]) * i2l, bfhi(b[rr][q][k]) * i2h); }
            bf16* zq = zr + (size_t)rr * ZP + 512 * q; *(v4u*)zq = r0; *(v4u*)(zq + 2048) = r1; } }
}


__device__ __forceinline__ void cmp_unit(int u, const bf16* Z, const bf16* WCMP, const float* pos, bf16* KCMP, bf16* VCMP, LAS char* lds, int tid, int lane, int wid) {
    const int bg = u >> 5, kv = (u >> 4) & 1, nt = (u >> 2) & 3, et = u & 3, b = bg >> 1, g = bg & 1, r32 = lane & 31, hi = lane >> 5;
    const int n = nt * 32 + r32, nc = n < 126 ? n : 126;
    const bf16* arow = Z + ((size_t)b * SEQ + 16 * nc) * ZP + ZC_KVA + kv * 256 + g * 128 + hi * 8;
    const bf16* brow = WCMP + ((size_t)kv * 128 + et * 32 + r32) * 4096 + hi * 8;
    const float* prow = pos + kv * 4096 + hi * 8;
    f32x16 acc = att::zero16();
#pragma unroll 1
    for (int ll = 0; ll < 4; ++ll) { const int l = 4 * wid + ll;
        v4u a[8]; f32x4 p0[8], p1[8]; bf16x8 bfg[8];
#pragma unroll
        for (int ds = 0; ds < 8; ++ds) { const int d = ds * 16;
            a[ds] = *(const v4u*)(arow + (size_t)l * ZP + d); p0[ds] = *(const f32x4*)(prow + l * 128 + d); p1[ds] = *(const f32x4*)(prow + l * 128 + d + 4);
            bfg[ds] = *(const bf16x8*)(brow + l * 128 + d); }
        __builtin_amdgcn_sched_barrier(0);
#pragma unroll
        for (int ds = 0; ds < 8; ++ds) { const v4u aa = a[ds];
            v4u af; af.x = pk2(bflo(aa.x) + p0[ds][0], bfhi(aa.x) + p0[ds][1]); af.y = pk2(bflo(aa.y) + p0[ds][2], bfhi(aa.y) + p0[ds][3]); af.z = pk2(bflo(aa.z) + p1[ds][0], bfhi(aa.z) + p1[ds][1]); af.w = pk2(bflo(aa.w) + p1[ds][2], bfhi(aa.w) + p1[ds][3]);
            acc = __builtin_amdgcn_mfma_f32_32x32x16_bf16(__builtin_bit_cast(bf16x8, af), bfg[ds], acc, 0, 0, 0); }
        __builtin_amdgcn_sched_barrier(0); }
    LAS float* part = (LAS float*)lds;
#pragma unroll
    for (int r = 0; r < 16; ++r) part[(wid * 32 + att::crow(r, hi)) * 33 + r32] = acc[r];
    __syncthreads();
#pragma unroll
    for (int k2 = 0; k2 < 2; ++k2) { const int idx = tid + NTHR * k2, row = idx >> 5, col = idx & 31; float s = 0.f;
#pragma unroll
        for (int w = 0; w < 8; ++w) s += part[(w * 32 + row) * 33 + col];
        const int no = nt * 32 + row; if (no == 127) s = 0.f;
        (kv ? VCMP : KCMP)[((size_t)bg * 128 + no) * 128 + et * 32 + col] = (bf16)f2bf(s); }
    __syncthreads();
}
__device__ __forceinline__ void kmean_unit(int u, const bf16* Z, float* KMEAN, LAS char* lds, int tid, int lane, int wid) {
    const int bh = u >> 3, blk = u & 7, b = bh >> 2, h = bh & 3;
    const bf16* kp = Z + ((size_t)b * SEQ + blk * 256 + wid * 32) * ZP + ZC_KC + h * 128 + 2 * lane;
    float s0 = 0.f, s1 = 0.f; unsigned kw[32];
#pragma unroll
    for (int i = 0; i < 32; ++i) kw[i] = *(const unsigned*)(kp + (size_t)i * ZP);
    __builtin_amdgcn_sched_barrier(0);
#pragma unroll
    for (int i = 0; i < 32; ++i) { s0 += bflo(kw[i]); s1 += bfhi(kw[i]); }
    LAS float* part = (LAS float*)lds;
    part[wid * 128 + 2 * lane] = s0; part[wid * 128 + 2 * lane + 1] = s1;
    __syncthreads();
    if (tid < 128) { float s = 0.f;
#pragma unroll
        for (int w = 0; w < 8; ++w) s += part[w * 128 + tid];
        KMEAN[((size_t)bh * 8 + blk) * 128 + tid] = s * (1.0f / 256.0f); }
    __syncthreads();
}

struct CvtItem { const float* W; unsigned char* WT; int ldw, k0, ns, nc, ldt, nd, f8; };
__device__ __forceinline__ void cvt_load(const CvtItem& P, f32x4 (&v)[4][4], int lane) {
    const int nq = lane & 15, kq = lane >> 4; const bool act = 4 * nq < P.nc;
    const float* wp = P.W + (size_t)(P.k0 + 4 * kq) * P.ldw + P.ns + 4 * nq;
#pragma unroll
    for (int i = 0; i < 4; ++i)
#pragma unroll
        for (int rr = 0; rr < 4; ++rr) v[i][rr] = act ? __builtin_nontemporal_load((const f32x4*)(wp + (size_t)(16 * i + rr) * P.ldw)) : pg8::zero4();
}
__device__ __forceinline__ void cvt_finish(const CvtItem& P, const f32x4 (&v)[4][4], float scale, LAS unsigned* scr, int lane) {
    const int nq = lane & 15, kq = lane >> 4;
    if (P.f8) {
#pragma unroll
        for (int i = 0; i < 4; ++i)
#pragma unroll
            for (int j = 0; j < 4; ++j) { int w = 0; w = __builtin_amdgcn_cvt_pk_fp8_f32(v[i][0][j] * scale, v[i][1][j] * scale, w, false); w = __builtin_amdgcn_cvt_pk_fp8_f32(v[i][2][j] * scale, v[i][3][j] * scale, w, true);
                scr[(4 * nq + j) * 17 + kq + 4 * i] = (unsigned)w; }
        LDS_WAIT(); asm volatile("" ::: "memory");
        const int c = lane & 3;
#pragma unroll
        for (int i = 0; i < 4; ++i) { const int n = (lane >> 2) + 16 * i; const LAS unsigned* s = scr + n * 17 + 4 * c;
            v4u o; o.x = s[0]; o.y = s[1]; o.z = s[2]; o.w = s[3];
            if (n < P.nc) __builtin_nontemporal_store(o, (v4u*)(P.WT + (size_t)(P.nd + n) * P.ldt + P.k0 + 16 * c)); }
    } else {
#pragma unroll
        for (int i = 0; i < 4; ++i)
#pragma unroll
            for (int h = 0; h < 2; ++h)
#pragma unroll
                for (int j = 0; j < 4; ++j) scr[(4 * nq + j) * 33 + 2 * kq + 8 * i + h] = pk2(v[i][2 * h][j], v[i][2 * h + 1][j]);
        LDS_WAIT(); asm volatile("" ::: "memory");
        const int c = lane & 7;
#pragma unroll
        for (int i = 0; i < 8; ++i) { const int n = (lane >> 3) + 8 * i; const LAS unsigned* s = scr + n * 33 + 4 * c;
            v4u o; o.x = s[0]; o.y = s[1]; o.z = s[2]; o.w = s[3];
            if (n < P.nc) __builtin_nontemporal_store(o, (v4u*)(P.WT + ((size_t)(P.nd + n) * P.ldt + P.k0 + 8 * c) * 2)); }
    }
    LDS_WAIT(); asm volatile("" ::: "memory");
}
__device__ __forceinline__ unsigned pk4_fp8(f32x4 v, float scale) { int w = 0; w = __builtin_amdgcn_cvt_pk_fp8_f32(v[0] * scale, v[1] * scale, w, false); w = __builtin_amdgcn_cvt_pk_fp8_f32(v[2] * scale, v[3] * scale, w, true); return (unsigned)w; }
constexpr float FP8_XSCALE = 16.f, FP8_WSCALE = 64.f;
constexpr int FP8_SCA = 0x7b7b7b7b, FP8_SCB = 0x79797979;
constexpr int CI_IN = 173 * 32, CI_BRA = 512, CI_BRB = 256, CI_BRC = 256, CI_OUT = 1024, CI_GU = 8192, CI_D = 4096, CI_CMP = 256, CI_ZERO = 232;
constexpr int CI_TOTAL = CI_IN + CI_BRA + CI_BRB + CI_BRC + CI_OUT + CI_GU + CI_D + CI_CMP;

__device__ __forceinline__ void ln_row(f32x4 (&v)[8], const float* g, const float* bta, int lane) {
    f32x4 gg[8], bb[8];
#pragma unroll
    for (int j = 0; j < 8; ++j) { gg[j] = ((const f32x4*)g)[lane + 64 * j]; bb[j] = ((const f32x4*)bta)[lane + 64 * j]; }
    __builtin_amdgcn_sched_barrier(0);
    float s = 0.f;
#pragma unroll
    for (int j = 0; j < 8; ++j) s += (v[j][0] + v[j][1]) + (v[j][2] + v[j][3]);
    const float mean = wave_sum(s, lane) * (1.0f / DM); float s2 = 0.f;
#pragma unroll
    for (int j = 0; j < 8; ++j) { v[j] = v[j] - mean; s2 += (v[j][0] * v[j][0] + v[j][1] * v[j][1]) + (v[j][2] * v[j][2] + v[j][3] * v[j][3]); }
    const float rstd = 1.0f / sqrtf(wave_sum(s2, lane) * (1.0f / DM) + LN_EPS);
#pragma unroll
    for (int j = 0; j < 8; ++j) v[j] = v[j] * rstd * gg[j] + bb[j];
}

__device__ __forceinline__ void ln_router_tile(int tile, const float* R, const float* g, const float* bta, float* X1, bf16* XB, const float* wgrp, const float* bgrp, const float* wrt, const float* brt,
                                               int* hist, int* tok_e, float* tok_w, int* tok_p, LAS char* lds, int, int lane_, int wid) {
    { int l2 = lane_; asm volatile("" : "+v"(l2)); lane_ = l2; } const int lane = lane_, tid = wid * 64 + lane;
    LAS float* glog = (LAS float*)lds;
    LAS float* part = (LAS float*)(lds + 1024);
    LAS float* cb = (LAS float*)(lds + 1024);
    LAS float* elog = (LAS float*)(lds + 1024 + 37888);
    const int row0 = tile * 32;
    LAS f32x4* lg = (LAS f32x4*)(lds + 81920);
    LAS f32x4* lb = lg + 512;
    LAS f32x4* lw = lb + 512;
    unsigned lo16 = (unsigned)lane * 16u; asm volatile("" : "+v"(lo16)); const unsigned lo4 = lo16 >> 2;
    v2u vw[4][8]; const size_t rbase = (size_t)row0 + wid * 4;
#pragma unroll
    for (int i = 0; i < 4; ++i)
#pragma unroll
        for (int j = 0; j < 8; ++j) vw[i][j] = *(const v2u*)((((const char*)R + (rbase + i) * (DM * 2)) + 512 * j) + (size_t)(lo16 >> 1));
    { const f32x4 a = ((const f32x4*)g)[tid], b4 = ((const f32x4*)bta)[tid]; f32x4 w4[4];
#pragma unroll
      for (int q = 0; q < 4; ++q) w4[q] = ((const f32x4*)wgrp)[tid + 512 * q];
      lg[tid] = a; lb[tid] = b4;
#pragma unroll
      for (int q = 0; q < 4; ++q) { const int kk = tid + 512 * q; lw[(kk & 3) * 512 + (kk >> 2)] = w4[q]; } }
    __builtin_amdgcn_sched_barrier(0);
    __syncthreads();
    f32x4 v[4][8];
#pragma unroll
    for (int i = 0; i < 4; ++i)
#pragma unroll
        for (int j = 0; j < 8; ++j) v[i][j] = (f32x4){bflo(vw[i][j].x), bfhi(vw[i][j].x), bflo(vw[i][j].y), bfhi(vw[i][j].y)};
    f32x16 acc = att::zero16(); f32x4 gpo;
    const int ri = lane & 31, kk = lane >> 5;
    GAS const char* wbj = (GAS const char*)(wrt + (size_t)(32 * wid) * 32); asm volatile("" : "+s"(wbj));
    const unsigned wo = ((unsigned)kk * 256u + (unsigned)ri) * 4u;
    const unsigned cwo = (unsigned)(wid * 4) * 528u + (lo16 >> 1), cro = (unsigned)ri * 528u + (unsigned)(32 * wid + 8 * kk) * 2u;
    float bq[2][16];
#pragma unroll
    for (int t = 0; t < 16; ++t) bq[0][t] = *(GAS const float*)((wbj + ((t >> 3) * 16 + (t & 7)) * 128) + (size_t)wo);
    wbj += 256 * 128; asm volatile("" : "+s"(wbj));
    { float mean[4], rstd[4];
#pragma unroll
        for (int i = 0; i < 4; ++i) { float s = 0.f;
#pragma unroll
            for (int j = 0; j < 8; ++j) s += (v[i][j][0] + v[i][j][1]) + (v[i][j][2] + v[i][j][3]);
            mean[i] = s; }
#pragma unroll
        for (int o_ = 1; o_ < 64; o_ <<= 1) {
#pragma unroll
            for (int i = 0; i < 4; ++i) mean[i] += shfl_xor_f(mean[i], o_, lane); }
#pragma unroll
        for (int i = 0; i < 4; ++i) { mean[i] *= (1.0f / DM); float s2 = 0.f;
#pragma unroll
            for (int j = 0; j < 8; ++j) { v[i][j] = v[i][j] - mean[i]; s2 += (v[i][j][0] * v[i][j][0] + v[i][j][1] * v[i][j][1]) + (v[i][j][2] * v[i][j][2] + v[i][j][3] * v[i][j][3]); }
            rstd[i] = s2; }
#pragma unroll
        for (int o_ = 1; o_ < 64; o_ <<= 1) {
#pragma unroll
            for (int i = 0; i < 4; ++i) rstd[i] += shfl_xor_f(rstd[i], o_, lane); }
#pragma unroll
        for (int i = 0; i < 4; ++i) rstd[i] = 1.0f / sqrtf(rstd[i] * (1.0f / DM) + LN_EPS);
        f32x4 gp = {0.f, 0.f, 0.f, 0.f};
#pragma unroll
        for (int j = 0; j < 8; ++j) { const f32x4 gg = lg[lane + 64 * j], bb = lb[lane + 64 * j];
            if (j < 7) {
#pragma unroll
                for (int t = 0; t < 16; ++t) bq[(j + 1) & 1][t] = *(GAS const float*)((wbj + ((t >> 3) * 16 + (t & 7)) * 128) + (size_t)wo);
                wbj += 256 * 128; asm volatile("" : "+s"(wbj)); }
#pragma unroll
            for (int i = 0; i < 4; ++i) { const f32x4 y = v[i][j] * rstd[i] * gg + bb;
                { v2u w; w.x = pg8::cvt_pk_bf16(y[0], y[1]); w.y = pg8::cvt_pk_bf16(y[2], y[3]); *(v2u*)((((char*)X1 + (rbase + i) * (DM * 2)) + 512 * j) + (size_t)(lo16 >> 1)) = w; }
                *(unsigned*)((((char*)XB + (rbase + i) * DM) + 256 * j) + (size_t)lo4) = pk4_fp8(y, FP8_XSCALE);
                { v2u h; h.x = pg8::cvt_pk_bf16(y[0], y[1]); h.y = pg8::cvt_pk_bf16(y[2], y[3]);
                  v2u lo_; lo_.x = pg8::cvt_pk_bf16(y[0] - bflo(h.x), y[1] - bfhi(h.x)); lo_.y = pg8::cvt_pk_bf16(y[2] - bflo(h.y), y[3] - bfhi(h.y));
                  *(LAS v2u*)((LAS char*)cb + (j & 1) * 33792 + i * 528 + cwo) = h; *(LAS v2u*)((LAS char*)cb + (j & 1) * 33792 + 16896 + i * 528 + cwo) = lo_; } }
            LDS_WAIT(); __builtin_amdgcn_s_barrier(); asm volatile("" ::: "memory");
#pragma unroll
            for (int t = 0; t < 2; ++t) {
                const v4u ah = *(const LAS v4u*)((const LAS char*)cb + (j & 1) * 33792 + t * 32 + cro), al = *(const LAS v4u*)((const LAS char*)cb + (j & 1) * 33792 + 16896 + t * 32 + cro);
                v4u bh, bl;
#pragma unroll
                for (int e2 = 0; e2 < 4; ++e2) { const float b0 = bq[j & 1][8 * t + 2 * e2], b1 = bq[j & 1][8 * t + 2 * e2 + 1]; const unsigned hw = pg8::cvt_pk_bf16(b0, b1);
                    bh[e2] = hw; bl[e2] = pg8::cvt_pk_bf16(b0 - bflo(hw), b1 - bfhi(hw)); }
                acc = __builtin_amdgcn_mfma_f32_32x32x16_bf16(__builtin_bit_cast(bf16x8, ah), __builtin_bit_cast(bf16x8, bh), acc, 0, 0, 0);
                acc = __builtin_amdgcn_mfma_f32_32x32x16_bf16(__builtin_bit_cast(bf16x8, ah), __builtin_bit_cast(bf16x8, bl), acc, 0, 0, 0);
                acc = __builtin_amdgcn_mfma_f32_32x32x16_bf16(__builtin_bit_cast(bf16x8, al), __builtin_bit_cast(bf16x8, bh), acc, 0, 0, 0);
#pragma unroll
                for (int e = 0; e < 8; ++e) { const unsigned hw = ah[e >> 1], lw_ = al[e >> 1]; const float yv = (e & 1) ? (bfhi(hw) + bfhi(lw_)) : (bflo(hw) + bflo(lw_));
                    const f32x4 wg4 = lw[(e & 3) * 512 + 64 * j + 8 * wid + 4 * t + 2 * kk + (e >> 2)]; gp = gp + wg4 * yv; } }
            asm volatile("" ::: "memory"); }
#pragma unroll
        for (int cc = 0; cc < 4; ++cc) gp[cc] += shfl_xor_f(gp[cc], 32, lane);
        gpo = gp;
    }
    LDS_WAIT(); __builtin_amdgcn_s_barrier(); asm volatile("" ::: "memory");
    {
#pragma unroll
      for (int r = 0; r < 16; ++r) part[(wid * 32 + att::crow(r, kk)) * 37 + ri] = acc[r];
      if (kk == 0) {
#pragma unroll
          for (int cc = 0; cc < 4; ++cc) part[(wid * 32 + ri) * 37 + 32 + cc] = gpo[cc]; } }
    __syncthreads();
#pragma unroll
    for (int k2 = 0; k2 < 2; ++k2) { const int idx = tid + NTHR * k2, row = idx >> 5, col = idx & 31; float s = brt[col];
#pragma unroll
        for (int w = 0; w < 8; ++w) s += part[(w * 32 + row) * 37 + col];
        elog[row * 33 + col] = s; }
    if (tid < 128) { const int row = tid >> 2, cc = tid & 3; float s = bgrp[cc];
#pragma unroll
        for (int w = 0; w < 8; ++w) s += part[(w * 32 + row) * 37 + 32 + cc];
        glog[tid] = s; }
    __syncthreads();
    if (wid == 0) { const int tl = lane & 31, token = row0 + tl;
        int gi = 0; float gm = glog[tl * 4];
#pragma unroll
        for (int cc = 1; cc < 4; ++cc) { const float t = glog[tl * 4 + cc]; if (t > gm) { gm = t; gi = cc; } }
        float den = 0.f;
#pragma unroll
        for (int cc = 0; cc < 4; ++cc) den += __expf(glog[tl * 4 + cc] - gm);
        const float gw = 1.0f / den;
        int i0 = 0; float t0 = elog[tl * 33 + gi * 8];
#pragma unroll
        for (int k = 1; k < 8; ++k) { const float t = elog[tl * 33 + gi * 8 + k]; if (t > t0) { t0 = t; i0 = k; } }
        int i1 = -1; float t1 = -INFINITY;
#pragma unroll
        for (int k = 0; k < 8; ++k) { const float t = elog[tl * 33 + gi * 8 + k]; if (k != i0 && t > t1) { t1 = t; i1 = k; } }
        const float ex = __expf(t1 - t0), w0 = gw / (1.0f + ex), w1 = gw * ex / (1.0f + ex);
        const int e0 = gi * 8 + i0, e1 = gi * 8 + i1;
        LAS int* e_l = (LAS int*)(lds + 1024);
        if (lane < 32) { e_l[2 * tl] = e0; e_l[2 * tl + 1] = e1; } LDS_WAIT();
        const int myE = e_l[lane]; int rank = 0, hc = 0;
        const unsigned long long below = (1ull << lane) - 1ull;
#pragma unroll 4
        for (int e = 0; e < 32; ++e) { const unsigned long long mk = __ballot(myE == e); if (myE == e) rank = __popcll(mk & below); if (lane == e) hc = __popcll(mk); }
        tok_p[row0 * 2 + lane] = rank;
        if (lane < 32) { hist[tile * 32 + lane] = hc;
            tok_e[token * 2] = e0; tok_e[token * 2 + 1] = e1; tok_w[token * 2] = w0; tok_w[token * 2 + 1] = w1; } }
    __syncthreads();
}
__device__ __forceinline__ int moe_offsets(const int* cntg, LAS char* lds, int tid) {
    LAS int* off_l = (LAS int*)lds; LAS int* cnt_l = (LAS int*)(lds + 256);
    if (tid < 64) { const int c = cntg[tid & 31]; int x = (c + 255) & ~255; const int pad = x;
#pragma unroll
        for (int d = 1; d < 32; d <<= 1) { const int y = __builtin_amdgcn_ds_bpermute(((tid - d) & 63) << 2, x); if ((tid & 31) >= d) x += y; }
        if (tid < 32) { cnt_l[tid] = c; off_l[tid] = x - pad; if (tid == 31) off_l[32] = x; } }
    __syncthreads();
    return off_l[32];
}
__device__ __forceinline__ int moe_offsets_hist(const int* hist, int tile, LAS char* lds, int tid) {
    LAS int* off_l = (LAS int*)lds; LAS int* cnt_l = (LAS int*)(lds + 256); LAS int* pre_l = (LAS int*)(lds + 512); LAS int* pa = (LAS int*)(lds + 1024); LAS int* pb = (LAS int*)(lds + 1024 + 2048);
    const int e = tid & 31, part = tid >> 5; int sa = 0, sb = 0; int hq[16];
#pragma unroll
    for (int q = 0; q < 16; ++q) hq[q] = hist[(part * 16 + q) * 32 + e];
    __builtin_amdgcn_sched_barrier(0);
#pragma unroll
    for (int q = 0; q < 16; ++q) { const int t = part * 16 + q; sa += hq[q]; sb += (t < tile) ? hq[q] : 0; }
    pa[part * 32 + e] = sa; pb[part * 32 + e] = sb;
    __syncthreads();
    if (tid < 64) { int c = 0, p = 0; const int e32 = tid & 31;
#pragma unroll
        for (int q = 0; q < 16; ++q) { c += pa[q * 32 + e32]; p += pb[q * 32 + e32]; }
        int x = (c + 255) & ~255; const int pad = x;
#pragma unroll
        for (int d = 1; d < 32; d <<= 1) { const int y = __builtin_amdgcn_ds_bpermute(((tid - d) & 63) << 2, x); if (e32 >= d) x += y; }
        if (tid < 32) { cnt_l[tid] = c; pre_l[tid] = p; off_l[tid] = x - pad; if (tid == 31) off_l[32] = x; } }
    __syncthreads();
    return off_l[32];
}

struct NextLayerCvt {
    const float* w_in; const float* cmpw; unsigned char* ws; LAS char* lds; int j; int wid;
    __device__ __forceinline__ void operator()() const {
        if (j >= CI_IN + CI_CMP) return;
        CvtItem P; P.nc = 64;
        if (j < CI_IN) { const int kb = j / 173, nb = j % 173; P.W = w_in; P.ldw = 11032; P.k0 = 64 * kb; P.WT = ws + WS_WIN1; P.ldt = DM; P.f8 = 1;
            if (nb < 40) { P.ns = 64 * nb; P.nd = P.ns; } else if (nb < 172) { P.ns = 2584 + 64 * (nb - 40); P.nd = 2560 + 64 * (nb - 40); } else { P.ns = 2560; P.nd = ZC_GA; P.nc = 24; } }
        else { const int r = j - CI_IN, kv = r >> 7, rr = r & 127; P.W = cmpw + (size_t)kv * 4096 * 128; P.ldw = 128; P.k0 = 64 * (rr >> 1); P.ns = 64 * (rr & 1); P.WT = ws + WS_WCMP1; P.ldt = 4096; P.nd = kv * 128 + P.ns; P.f8 = 0; }
        f32x4 cur[4][4]; const int ln = lane_id(); cvt_load(P, cur, ln);
        cvt_finish(P, cur, FP8_WSCALE, (LAS unsigned*)(lds + RING_OFF + wid * 16384), ln);
    }
};

#ifndef DBL
#define DBL 0
#endif
#ifndef TMASK
#define TMASK 0
#endif
#ifndef EMASK
#define EMASK 0
#endif
#ifndef WMASK
#define WMASK 0
#endif
#ifndef PHASES
#define PHASES 0x7FF
#endif
struct Args { const float* in[20]; float* out; unsigned char* ws; };
__global__ void __launch_bounds__(NTHR, 2) fwd_kernel(Args args) {
    extern __shared__ __attribute__((aligned(16))) unsigned char lds_raw[];
    LAS unsigned char* const lds = (LAS unsigned char*)lds_raw;
    LAS char* const ldc = (LAS char*)lds_raw;
    volatile LAS unsigned* MISC = (volatile LAS unsigned*)(lds + MISC_OFF);
    const int G = gridDim.x, bx = blockIdx.x, vcu = (G % 8 == 0) ? (bx % 8) * (G / 8) + bx / 8 : bx, NGW = G * NWAVES;
    const int wid = __builtin_amdgcn_readfirstlane((int)threadIdx.x >> 6);
#define PHASE_IDS() int gw_ = vcu * NWAVES + wid; asm volatile("" : "+s"(gw_)); const int lane = lane_id(), tid = wid * 64 + lane, gw = gw_; (void)gw; (void)lane
    gu32* ctl0 = (gu32*)(args.ws + WS_CTL);
    for (int u = wid * 64 + lane_id(); u < (LDS_BYTES - LDSCTL_OFF) / 4; u += NTHR) ((LAS unsigned*)(lds + LDSCTL_OFF))[u] = 0u;
    __syncthreads();
    XcdBarrier bar = xcd_barrier_post((unsigned*)(ctl0 + CW_BAR), MISC + 8);
#define GRID_BAR() xcd_barrier(bar, wid == 0 && lane_id() == 0)
#define GRID_BAR_W(s) do { if (l + 1 < DEPTH && early1) { const NextLayerCvt wk_{args.in[1] + (size_t)(l + 1) * DM * 11032, args.in[3] + (size_t)(l + 1) * 2 * 4096 * 128, args.ws, ldc, (s) * 7 * G + 7 * bx + wid - 1, wid}; \
        xcd_barrier_t<false, NextLayerCvt>(bar, wid == 0 && lane_id() == 0, wid != 0, wk_); } else GRID_BAR(); } while (0)
#define PHASE_PTRS() GAS unsigned char* wsg_ = (GAS unsigned char*)args.ws; asm volatile("" : "+s"(wsg_)); unsigned char* ws = (unsigned char*)wsg_; gu32* ctl = (gu32*)(ws + WS_CTL); (void)ctl; const float* x_in = args.in[0]; (void)x_in; \
    bf16* WIN = (bf16*)(ws + (l ? WS_WIN1 : WS_WIN)); bf16* WBRA = (bf16*)(ws + WS_WBRA); bf16* WBRB = (bf16*)(ws + WS_WBRB); bf16* WBRC = (bf16*)(ws + WS_WBRC); bf16* WOUT = (bf16*)(ws + WS_WOUT); \
    bf16* WGU = (bf16*)(ws + WS_WGU); bf16* WD = (bf16*)(ws + WS_WD); bf16* WCMP = (bf16*)(ws + (l ? WS_WCMP1 : WS_WCMP)); \
    bf16* XB = (bf16*)(ws + WS_XB); bf16* Z = (bf16*)(ws + WS_Z); bf16* OA = (bf16*)(ws + WS_OA); float* MG = (float*)(ws + WS_MG); bf16* MB = (bf16*)(ws + WS_MB); \
    float* X1 = (float*)(ws + WS_X1); bf16* HB = (bf16*)(ws + WS_H); bf16* XS = (bf16*)(ws + WS_XS); bf16* YB = (bf16*)(ws + WS_Y); \
    unsigned char* sm = ws + WS_SMALL; \
    bf16* KCMP = (bf16*)(sm + SM_KCMP); bf16* VCMP = (bf16*)(sm + SM_VCMP); float* KMEAN = (float*)(sm + SM_KMEAN); \
    int* tok_e = (int*)(sm + SM_TOKE); float* tok_w = (float*)(sm + SM_TOKW); int* tok_p = (int*)(sm + SM_TOKP); int* rowts = (int*)(sm + SM_ROWTS); float* roww = (float*)(sm + SM_ROWW); int* panel_e = (int*)(sm + SM_PANE); int* hist = (int*)(sm + SM_HIST); int* cntg = (int*)(sm + SM_CNTG); (void)hist; (void)cntg; \
    (void)WIN; (void)WBRA; (void)WBRB; (void)WBRC; (void)WOUT; (void)WGU; (void)WD; (void)WCMP; (void)XB; (void)Z; (void)OA; (void)MG; (void)MB; (void)X1; (void)HB; (void)XS; (void)YB; \
    (void)KCMP; (void)VCMP; (void)KMEAN; (void)tok_e; (void)tok_w; (void)tok_p; (void)rowts; (void)roww; (void)panel_e
    const float alpha = 1.4142135623730951f;
    const bool early1 = 4 * 7 * G >= CI_IN + CI_CMP;
    unsigned long long tacc = 0;

#define CVT_DECODE(IT, P) do { int r = (IT); (P).nc = 64; (P).f8 = 0; \
                if (r < CI_IN) { const int kb = r / 173, nb = r % 173; (P).W = w_in; (P).ldw = 11032; (P).k0 = 64 * kb; (P).WT = (unsigned char*)WIN; (P).ldt = DM; (P).f8 = 1; \
                    if (nb < 40) { (P).ns = 64 * nb; (P).nd = (P).ns; } else if (nb < 172) { (P).ns = 2584 + 64 * (nb - 40); (P).nd = 2560 + 64 * (nb - 40); } else { (P).ns = 2560; (P).nd = ZC_GA; (P).nc = 24; } } \
                else if ((r -= CI_IN) < CI_BRA) { (P).W = wbra; (P).ldw = DM; (P).k0 = 64 * (r / 32); (P).ns = 64 * (r % 32); (P).WT = (unsigned char*)WBRA; (P).ldt = DM; (P).nd = (P).ns; (P).f8 = 1; } \
                else if ((r -= CI_BRA) < CI_BRB) { (P).W = wbrb; (P).ldw = DM; (P).k0 = 64 * (r / 32); (P).ns = 64 * (r % 32); (P).WT = (unsigned char*)WBRA + 1024; (P).ldt = DM; (P).nd = (P).ns; (P).f8 = 1; } \
                else if ((r -= CI_BRB) < CI_BRC) { (P).W = wbrc; (P).ldw = DM; (P).k0 = 64 * (r / 32); (P).ns = 64 * (r % 32); (P).WT = (unsigned char*)WBRA + 1536; (P).ldt = DM; (P).nd = (P).ns; (P).f8 = 1; } \
                else if ((r -= CI_BRC) < CI_OUT) { (P).W = wout; (P).ldw = DM; (P).k0 = 64 * (r / 32); (P).ns = 64 * (r % 32); (P).WT = (unsigned char*)WOUT; (P).ldt = DM; (P).nd = (P).ns; (P).f8 = 1; } \
                else if ((r -= CI_OUT) < CI_GU) { const int mat = r >> 7, e = mat >> 1, which = mat & 1, rr = r & 127, f0 = 64 * (rr & 3); \
                    (P).W = (which ? wup : wgate) + (size_t)e * DM * DEXP; (P).ldw = DEXP; (P).k0 = 64 * (rr >> 2); (P).ns = f0; (P).WT = (unsigned char*)WGU; (P).ldt = DM; (P).nd = e * 512 + (f0 >> 7) * 256 + which * 128 + (f0 & 127); (P).f8 = 1; } \
                else if ((r -= CI_GU) < CI_D) { const int e = r >> 7, rr = r & 127; (P).W = wdown + (size_t)e * DEXP * DM; (P).ldw = DM; (P).k0 = 64 * (rr >> 5); (P).ns = 64 * (rr & 31); (P).WT = (unsigned char*)WD; (P).ldt = DEXP; (P).nd = e * DM + (P).ns; } \
                else { r -= CI_D; const int kv = r >> 7, rr = r & 127; (P).W = cmpw + (size_t)kv * 4096 * 128; (P).ldw = 128; (P).k0 = 64 * (rr >> 1); (P).ns = 64 * (rr & 1); (P).WT = (unsigned char*)WCMP; (P).ldt = 4096; (P).nd = kv * 128 + (P).ns; } } while (0)
#define CVT_PTRS() const float* w_in = args.in[1] + (size_t)l * DM * 11032; const float* cmpw = args.in[3] + (size_t)l * 2 * 4096 * 128; \
            const float* wbra = args.in[5] + (size_t)l * 1024 * DM; const float* wbrb = args.in[6] + (size_t)l * 512 * DM; const float* wbrc = args.in[7] + (size_t)l * 512 * DM; \
            const float* wout = args.in[8] + (size_t)l * DM * DM; \
            const float* wgate = args.in[15] + (size_t)l * NEXP * DM * DEXP; const float* wup = args.in[16] + (size_t)l * NEXP * DM * DEXP; const float* wdown = args.in[17] + (size_t)l * NEXP * DEXP * DM
    for (int l = 0; l < DEPTH; ++l) {
#if PHASES & 1
        if (l == 0 || !early1) for (int rep = 0; rep < 1 + ((DBL >> 0) & 1); ++rep) {
        unsigned long long tph_ = 0; if ((TMASK >> 0) & 1) tph_ = __builtin_amdgcn_s_memrealtime();
        { PHASE_IDS(); PHASE_PTRS();
            LAS unsigned* scr = (LAS unsigned*)(lds + RING_OFF + wid * 16384);
            CVT_PTRS();
#define P0_IT(j) ((j) < CI_IN ? (j) : (j) - CI_IN + (CI_TOTAL - CI_CMP))
            { CvtItem P, Pn; f32x4 cur[4][4], nxt[4][4]; int it = gw;
              CVT_DECODE(P0_IT(it), P); cvt_load(P, cur, lane);
              do { const int itn = it + NGW; const int itl = itn < CI_IN + CI_CMP ? itn : it;
                  CVT_DECODE(P0_IT(itl), Pn); if (itn >= CI_IN + CI_CMP) Pn.nc = 0;
                  cvt_load(Pn, nxt, lane);
                  cvt_finish(P, cur, FP8_WSCALE, scr, lane);
                  P = Pn;
#pragma unroll
                  for (int i = 0; i < 4; ++i)
#pragma unroll
                      for (int rr = 0; rr < 4; ++rr) cur[i][rr] = nxt[i][rr];
                  it = itn; } while (it < CI_IN + CI_CMP); }
#undef P0_IT
            for (int r = gw; r < 2 * CI_ZERO; r += NGW) { v4u* zp = (v4u*)(ws + (r >= CI_ZERO ? WS_WIN1 : WS_WIN) + (size_t)(11032 + (r >= CI_ZERO ? r - CI_ZERO : r)) * DM); const v4u z4 = __builtin_bit_cast(v4u, pg8::zero4());
#pragma unroll
                for (int q = 0; q < 2; ++q) zp[lane + 64 * q] = z4; }
            if (l == 0) { f32x4 xv[8], xn[8];
#pragma unroll
                for (int j = 0; j < 8; ++j) xv[j] = __builtin_nontemporal_load((const f32x4*)(x_in + (size_t)gw * DM) + (lane + 64 * j));
#pragma unroll 1
                for (int row = gw; row < NT; row += NGW) { const int rn = row + NGW < NT ? row + NGW : row;
#pragma unroll
                    for (int j = 0; j < 8; ++j) xn[j] = __builtin_nontemporal_load((const f32x4*)(x_in + (size_t)rn * DM) + (lane + 64 * j));
                    __builtin_amdgcn_sched_barrier(0);
#pragma unroll
                    for (int j = 0; j < 8; ++j) ((unsigned*)((unsigned char*)XB + (size_t)row * DM))[lane + 64 * j] = pk4_fp8(xv[j], FP8_XSCALE);
#pragma unroll
                    for (int j = 0; j < 8; ++j) xv[j] = xn[j]; } }
        }
        { unsigned long long tw_ = 0; if ((WMASK >> 0) & 1) tw_ = __builtin_amdgcn_s_memrealtime(); xcd_barrier_t<true, NoWork>(bar, wid == 0 && lane_id() == 0, false, NoWork{});        if ((WMASK >> 0) & 1) tacc += __builtin_amdgcn_s_memrealtime() - tw_; } if ((TMASK >> 0) & 1) tacc += __builtin_amdgcn_s_memrealtime() - tph_; }
#endif
#if PHASES & 2
        for (int rep = 0; rep < 1 + ((DBL >> 1) & 1); ++rep) {
        unsigned long long tph_ = 0; if ((TMASK >> 1) & 1) tph_ = __builtin_amdgcn_s_memrealtime();
        { const bool split = (G == 256);
#pragma unroll 1
          for (int part = 0; part < 2; ++part) { PHASE_IDS(); PHASE_PTRS(); const float* pos = args.in[2] + (size_t)l * 2 * 4096;
              if (!(part == 1 && split && bx >= 128)) {
                  pg8::Gemm gm{XB, WIN, NT, ZP, DM / 2, DM / 2, FP8_SCA, FP8_SCB, wid, (EMASK >> 1) & 1}; pg8::RoundsOrder S; S.base.init(NT, ZP, G, bx); S.r_lo = part == 0 ? 0 : 5; S.r_hi = (part == 0 && split) ? 5 : (1 << 20);
                  pg8::EpiZ E{Z, ZP, ZC_GM / 256};
                  pg8::gemm_phase<pg8::EpiZ, pg8::RoundsOrder, true, true, true>(lds + RING_OFF, gm, S, E); }
              if (part == 1) {
                  gu32* pq = ctl + CW_QUEUE + 64 * (8 + l); LAS unsigned* uw = (LAS unsigned*)(ldc + att::A_UNI) + 2;
                  __syncthreads();
                  for (;;) {
                      if (wid == 0 && lane_id() == 0) *uw = __hip_atomic_fetch_add(pq, 1u, RLX_AGENT);
                      __syncthreads();
                      const unsigned qi = *uw;
                      __syncthreads();
                      if (qi >= 384u + (unsigned)N_SWA_EARLY) break;
                      if (qi < 256u) cmp_unit((int)qi, Z, WCMP, pos, KCMP, VCMP, ldc, tid, lane, wid);
                      else if (qi < 384u) kmean_unit((int)qi - 256, Z, KMEAN, ldc, tid, lane, wid);
                      else { const int s_ = (int)qi - 384;
                          swa_unit((2 << 12) | ((s_ & 7) << 5) | (s_ >> 3), Z, args.in[4] + l * 8, OA, ws + WS_OA8, ldc, 0, wid); } } }
              GRID_BAR(); } }
        if ((TMASK >> 1) & 1) tacc += __builtin_amdgcn_s_memrealtime() - tph_; }
#endif
#if PHASES & 8
        for (int rep = 0; rep < 1 + ((DBL >> 3) & 1); ++rep) {
        unsigned long long tph_ = 0; if ((TMASK >> 3) & 1) tph_ = __builtin_amdgcn_s_memrealtime();
        { PHASE_IDS(); PHASE_PTRS(); gu32* qw = ctl + CW_QUEUE + 64 * (2 * l + rep); const float* sink = args.in[4] + l * 8; CVT_PTRS();
          LAS unsigned* uw = (LAS unsigned*)(ldc + att::A_UNI) + 2;
          for (;;) {
              if (wid == 0 && lane_id() == 0) *uw = __hip_atomic_fetch_add(qw, 1u, RLX_AGENT);
              __syncthreads();
              const unsigned qi = *uw;
              __syncthreads();
              if (qi >= (unsigned)N_Q_UNITS) break;
              const int code = g_units.u[qi], kind = code >> 12;
              if (kind == 5) { ratio_unit(code & 0xfff, Z, wid); continue; }
              if (kind == 2 && (code & 31) < N_SWA_EARLY / 8) continue;
              if (kind == 3) {
                  LAS unsigned* scr = (LAS unsigned*)(lds + RING_OFF + wid * 16384); const int ln = lane_id();
                  CvtItem P, Pn; f32x4 cur[4][4], nxt[4][4]; const int it0 = CI_IN + (code & 0xfff) * CVT_PER_UNIT + wid * (CVT_PER_UNIT / 8);
                  CVT_DECODE(it0, P); cvt_load(P, cur, ln);
#pragma unroll 1
                  for (int q = 0; q < CVT_PER_UNIT / 8; ++q) { const int itl = it0 + (q < CVT_PER_UNIT / 8 - 1 ? q + 1 : q);
                      CVT_DECODE(itl, Pn); if (q == CVT_PER_UNIT / 8 - 1) Pn.nc = 0;
                      cvt_load(Pn, nxt, ln);
                      cvt_finish(P, cur, FP8_WSCALE, scr, ln);
                      P = Pn;
#pragma unroll
                      for (int i = 0; i < 4; ++i)
#pragma unroll
                          for (int rr = 0; rr < 4; ++rr) cur[i][rr] = nxt[i][rr]; }
                  __syncthreads();
                  continue; }
              if (kind == 0) nsa_unit(code, Z, KCMP, VCMP, OA, ws + WS_OA8, ldc, 0, wid);
              else if (kind == 1) moba_unit(code, Z, KMEAN, OA, ws + WS_OA8, ldc, 0, wid);
              else swa_unit(code, Z, sink, OA, ws + WS_OA8, ldc, 0, wid);
          } }
        { unsigned long long tw_ = 0; if ((WMASK >> 3) & 1) tw_ = __builtin_amdgcn_s_memrealtime(); GRID_BAR_W(0); if ((WMASK >> 3) & 1) tacc += __builtin_amdgcn_s_memrealtime() - tw_; } if ((TMASK >> 3) & 1) tacc += __builtin_amdgcn_s_memrealtime() - tph_; }
#endif
#if PHASES & 16
        for (int rep = 0; rep < 1 + ((DBL >> 4) & 1); ++rep) {
        unsigned long long tph_ = 0; if ((TMASK >> 4) & 1) tph_ = __builtin_amdgcn_s_memrealtime();
        { PHASE_IDS(); PHASE_PTRS(); pg8::StaticOrder S; S.init(NT, DM, G, bx);
          pg8::Gemm gm{(const bf16*)(ws + WS_OA8), WBRA, NT, DM, DM / 2, DM / 2, 0x79797979, 0x79797979, wid, (EMASK >> 4) & 1}; pg8::EpiBrM<8, 12> E{MB, Z + ZC_GM, ZP};
          pg8::gemm_phase<pg8::EpiBrM<8, 12>, pg8::StaticOrder, true, true, true>(lds + RING_OFF, gm, S, E); }
        { unsigned long long tw_ = 0; if ((WMASK >> 4) & 1) tw_ = __builtin_amdgcn_s_memrealtime(); GRID_BAR_W(1); if ((WMASK >> 4) & 1) tacc += __builtin_amdgcn_s_memrealtime() - tw_; } if ((TMASK >> 4) & 1) tacc += __builtin_amdgcn_s_memrealtime() - tph_; }
#endif
#if PHASES & 32
        for (int rep = 0; rep < 1 + ((DBL >> 5) & 1); ++rep) {
        unsigned long long tph_ = 0; if ((TMASK >> 5) & 1) tph_ = __builtin_amdgcn_s_memrealtime();
        { PHASE_IDS(); PHASE_PTRS(); pg8::Gemm gm{MB, WOUT, NT, DM, DM / 2, DM / 2, 0x79797979, 0x79797979, wid, (EMASK >> 5) & 1}; pg8::StaticOrder S; S.init(NT, DM, G, bx);
          pg8::EpiRes E{MG, l == 0 ? x_in : (const float*)X1, alpha, l != 0};
          pg8::gemm_phase<pg8::EpiRes, pg8::StaticOrder, true, true, true>(lds + RING_OFF, gm, S, E); }
        { unsigned long long tw_ = 0; if ((WMASK >> 5) & 1) tw_ = __builtin_amdgcn_s_memrealtime(); GRID_BAR_W(2); if ((WMASK >> 5) & 1) tacc += __builtin_amdgcn_s_memrealtime() - tw_; } if ((TMASK >> 5) & 1) tacc += __builtin_amdgcn_s_memrealtime() - tph_; }
#endif
#if PHASES & 64
        for (int rep = 0; rep < 1 + ((DBL >> 6) & 1); ++rep) {
        unsigned long long tph_ = 0; if ((TMASK >> 6) & 1) tph_ = __builtin_amdgcn_s_memrealtime();
        { PHASE_IDS(); PHASE_PTRS(); const float* g1 = args.in[9] + l * DM; const float* b1 = args.in[10] + l * DM;
          const float* wgrp = args.in[11] + (size_t)l * DM * 4; const float* bgrp = args.in[12] + l * 4; const float* wrt = args.in[13] + (size_t)l * DM * 32; const float* brt = args.in[14] + l * 32;
          for (int t = bx; t < NT / 32; t += G) ln_router_tile(t, MG, g1, b1, (float*)((char*)MG + 32 * MiB), MB, wgrp, bgrp, wrt, brt, hist, tok_e, tok_w, tok_p, ldc, tid, lane, wid); }
        { unsigned long long tw_ = 0; if ((WMASK >> 6) & 1) tw_ = __builtin_amdgcn_s_memrealtime(); GRID_BAR_W(3); if ((WMASK >> 6) & 1) tacc += __builtin_amdgcn_s_memrealtime() - tw_; } if ((TMASK >> 6) & 1) tacc += __builtin_amdgcn_s_memrealtime() - tph_; }
#endif
#if PHASES & 128
        for (int rep = 0; rep < 1 + ((DBL >> 7) & 1); ++rep) {
        unsigned long long tph_ = 0; if ((TMASK >> 7) & 1) tph_ = __builtin_amdgcn_s_memrealtime();
        { PHASE_IDS(); PHASE_PTRS();
          const LAS int* off_l = (const LAS int*)ldc; const LAS int* cnt_l = (const LAS int*)(ldc + 256); const LAS int* pre_l = (const LAS int*)(ldc + 512);
          for (int tile = bx; tile < NT / 32; tile += G) {
              const int total = moe_offsets_hist(hist, tile, ldc, tid);
              if (tile == bx) {
                  for (int r = bx * NTHR + tid; r < total; r += G * NTHR) { int e = 0;
#pragma unroll
                      for (int st_ = 16; st_ > 0; st_ >>= 1) if (off_l[e + st_] <= r) e += st_;
                      if (r >= off_l[e] + cnt_l[e]) { rowts[r] = -1; roww[r] = 0.f; }
                      if ((r & 255) == 0) panel_e[r >> 8] = e; }
                  if (bx == 0 && tid < 32) cntg[tid] = cnt_l[tid]; }
              { int rowq[8], te[8], tp[8]; float tw[8]; v4u dat[8][2]; const int p0_ = tile * 64 + wid * 8;
#pragma unroll
                for (int q = 0; q < 8; ++q) { te[q] = tok_e[p0_ + q]; tp[q] = tok_p[p0_ + q]; tw[q] = tok_w[p0_ + q]; }
#pragma unroll
                for (int q = 0; q < 8; ++q) { const v4u* src = (const v4u*)((const unsigned char*)MB + (size_t)((p0_ + q) >> 1) * DM); dat[q][0] = src[lane]; dat[q][1] = src[lane + 64]; }
                __builtin_amdgcn_sched_barrier(0);
#pragma unroll
                for (int q = 0; q < 8; ++q) rowq[q] = off_l[te[q]] + pre_l[te[q]] + tp[q];
#pragma unroll
                for (int q = 0; q < 8; ++q) { v4u* dst = (v4u*)((unsigned char*)XS + (size_t)rowq[q] * DM); dst[lane] = dat[q][0]; dst[lane + 64] = dat[q][1];
                    if (lane == 0) { rowts[rowq[q]] = p0_ + q; roww[rowq[q]] = tw[q]; } } }
              __syncthreads(); }
          __syncthreads(); }
        { unsigned long long tw_ = 0; if ((WMASK >> 7) & 1) tw_ = __builtin_amdgcn_s_memrealtime(); GRID_BAR(); if ((WMASK >> 7) & 1) tacc += __builtin_amdgcn_s_memrealtime() - tw_; } if ((TMASK >> 7) & 1) tacc += __builtin_amdgcn_s_memrealtime() - tph_; }
#endif
#if PHASES & 256
        for (int rep = 0; rep < 1 + ((DBL >> 8) & 1); ++rep) {
        unsigned long long tph_ = 0; if ((TMASK >> 8) & 1) tph_ = __builtin_amdgcn_s_memrealtime();
        { PHASE_IDS(); PHASE_PTRS();
          const int total = moe_offsets(cntg, ldc, tid);
          __syncthreads();
          pg8::Gemm gm{XS, WGU, ROWCAP, NEXP * 512, DM / 2, DM / 2, FP8_SCA, FP8_SCB, wid, (EMASK >> 8) & 1}; pg8::MoeOrder<2> S{(total >> 8) * 2, G, bx, panel_e};
          pg8::EpiGU E{HB, roww};
          pg8::gemm_phase<pg8::EpiGU, pg8::MoeOrder<2>, true, true, true>(lds + RING_OFF, gm, S, E); }
        { unsigned long long tw_ = 0; if ((WMASK >> 8) & 1) tw_ = __builtin_amdgcn_s_memrealtime(); GRID_BAR(); if ((WMASK >> 8) & 1) tacc += __builtin_amdgcn_s_memrealtime() - tw_; } if ((TMASK >> 8) & 1) tacc += __builtin_amdgcn_s_memrealtime() - tph_; }
#endif
#if PHASES & 512
        for (int rep = 0; rep < 1 + ((DBL >> 9) & 1); ++rep) {
        unsigned long long tph_ = 0; if ((TMASK >> 9) & 1) tph_ = __builtin_amdgcn_s_memrealtime();
        { PHASE_IDS(); PHASE_PTRS();
          const int total = moe_offsets(cntg, ldc, tid);
          __syncthreads();
          pg8::Gemm gm{HB, WD, ROWCAP, NEXP * DM, DEXP, DEXP, 0x7f7f7f7f, 0x7f7f7f7f, wid, (EMASK >> 9) & 1}; pg8::MoeOrder<8> S{(total >> 8) * 8, G, bx, panel_e};
          pg8::EpiDown E{XS, (unsigned)((WS_Y - WS_XS) / 2), rowts};
          pg8::gemm_phase<pg8::EpiDown, pg8::MoeOrder<8>, true, true>(lds + RING_OFF, gm, S, E); }
        { unsigned long long tw_ = 0; if ((WMASK >> 9) & 1) tw_ = __builtin_amdgcn_s_memrealtime(); GRID_BAR(); if ((WMASK >> 9) & 1) tacc += __builtin_amdgcn_s_memrealtime() - tw_; } if ((TMASK >> 9) & 1) tacc += __builtin_amdgcn_s_memrealtime() - tph_; }
#endif
#if PHASES & 1024
        for (int rep = 0; rep < 1 + (((DBL >> 10) & 1) && l == DEPTH - 1 ? 1 : 0); ++rep) {
        unsigned long long tph_ = 0; if ((TMASK >> 10) & 1) tph_ = __builtin_amdgcn_s_memrealtime();
        { PHASE_IDS(); PHASE_PTRS(); const float* g2 = args.in[18] + l * DM; const float* b2 = args.in[19] + l * DM; const bool last = (l == DEPTH - 1); float* xo = last ? args.out : X1;
          for (int row = gw; row < NT; row += NGW) { f32x4 v[8]; v2u aw[8], y0[8], y1[8];
#pragma unroll
              for (int j = 0; j < 8; ++j) { aw[j] = ((const v2u*)((const char*)MG + 32 * MiB + (size_t)row * (DM * 2)))[lane + 64 * j];
                  y0[j] = ((const v2u*)(YB + (size_t)row * DM))[lane + 64 * j]; y1[j] = ((const v2u*)(YB + ((size_t)NT + row) * DM))[lane + 64 * j]; }
              __builtin_amdgcn_sched_barrier(0);
#pragma unroll
              for (int j = 0; j < 8; ++j) { const f32x4 a = {bflo(aw[j].x), bfhi(aw[j].x), bflo(aw[j].y), bfhi(aw[j].y)};
                  v[j][0] = a[0] * alpha + (bflo(y0[j].x) + bflo(y1[j].x)); v[j][1] = a[1] * alpha + (bfhi(y0[j].x) + bfhi(y1[j].x));
                  v[j][2] = a[2] * alpha + (bflo(y0[j].y) + bflo(y1[j].y)); v[j][3] = a[3] * alpha + (bfhi(y0[j].y) + bfhi(y1[j].y)); }
              ln_row(v, g2, b2, lane);
#pragma unroll
              for (int j = 0; j < 8; ++j) { if (last) ((f32x4*)(xo + (size_t)row * DM))[lane + 64 * j] = v[j];
                  else { v2u w; w.x = pg8::cvt_pk_bf16(v[j][0], v[j][1]); w.y = pg8::cvt_pk_bf16(v[j][2], v[j][3]); ((v2u*)((char*)xo + (size_t)row * (DM * 2)))[lane + 64 * j] = w;
                      ((unsigned*)((unsigned char*)XB + (size_t)row * DM))[lane + 64 * j] = pk4_fp8(v[j], FP8_XSCALE); } } } }
        if (l + 1 < DEPTH) GRID_BAR(); if ((TMASK >> 10) & 1) tacc += __builtin_amdgcn_s_memrealtime() - tph_; }
#endif
    }
    if ((EMASK != 0 || FMASK != 0) && blockIdx.x == 0 && wid == 0 && lane_id() == 0) tacc += *(LAS unsigned long long*)(lds + MISC_OFF + 64);
    if ((TMASK != 0 || EMASK != 0 || WMASK != 0 || FMASK != 0) && blockIdx.x == 0 && wid == 0 && lane_id() == 0) { const unsigned long long t0_ = __builtin_amdgcn_s_memrealtime(); while (__builtin_amdgcn_s_memrealtime() - t0_ < 4ull * tacc) __builtin_amdgcn_s_sleep(8); }
}

extern "C" void kernel_launch(void* const* d_in, const int* in_sizes, int n_in, void* d_out, int out_size, void* d_ws, size_t ws_size, hipStream_t stream) {
    static int grid = 0;
    if (grid == 0) {
        if (n_in != 20 || in_sizes[0] != NT * DM || out_size != NT * DM || ws_size < WS_END) { fprintf(stderr, "kernel_launch: unexpected shapes (n_in %d, in0 %d, out %d, ws %zu < %zu?)\n", n_in, n_in > 0 ? in_sizes[0] : -1, out_size, ws_size, (size_t)WS_END); grid = -1; return; }
        int dev = 0, cus = 0, per_cu = 0;
        if (hipGetDevice(&dev) != hipSuccess || hipDeviceGetAttribute(&cus, hipDeviceAttributeMultiprocessorCount, dev) != hipSuccess) { grid = -1; return; }
        if (hipFuncSetAttribute((const void*)fwd_kernel, hipFuncAttributeMaxDynamicSharedMemorySize, LDS_BYTES) != hipSuccess) { fprintf(stderr, "kernel_launch: hipFuncSetAttribute failed\n"); grid = -1; return; }
        if (hipOccupancyMaxActiveBlocksPerMultiprocessor(&per_cu, (const void*)fwd_kernel, NTHR, LDS_BYTES) != hipSuccess || per_cu < 1) fprintf(stderr, "kernel_launch: occupancy query reports %d\n", per_cu);
        (void)hipGetLastError();
        grid = cus;
    }
    if (grid < 0) return;
    if (hipMemsetAsync((char*)d_ws + WS_CTL, 0, CTL_ZERO_BYTES, stream) != hipSuccess) return;
    Args a{};
    for (int i = 0; i < 20; ++i) a.in[i] = (const float*)d_in[i];
    a.out = (float*)d_out; a.ws = (unsigned char*)d_ws;
    hipLaunchKernelGGL(fwd_kernel, dim3(grid), dim3(NTHR), LDS_BYTES, stream, a);
    const hipError_t le = hipPeekAtLastError();
    if (le != hipSuccess) fprintf(stderr, "kernel_launch: launch failed: %s\n", hipGetErrorName(le));
}
```
